# Optimizing an MI355X kernel written in HIP

```python
import math
import jax, jax.numpy as jnp
from jax import lax
import numpy as np

D_MODEL = 1024
BATCH = 2
SEQ = 16384
DEPTH = 2

N_EVEN = (DEPTH + 1) // 2
N_ODD = DEPTH // 2

ATTN_HEADS = 16
HEAD_DIM = 64
ATTN_DIM = ATTN_HEADS * HEAD_DIM
DILATED_PATTERNS = ((128, 1), (512, 4), (2048, 16))
ROPE_THETA = 500000.0
ROPE_DIM = HEAD_DIM // 4

SSD_HEADS = 16
SSD_HEAD_DIM = 64
SSD_DIM = SSD_HEADS * SSD_HEAD_DIM
SSD_GROUPS = 2
SSD_STATE = 128
SSD_CONV = 5
SSD_CHUNK = 128
SSD_XBC = SSD_DIM + 2 * SSD_GROUPS * SSD_STATE

MIX_DIM_EVEN = ATTN_DIM + SSD_DIM
EVEN_SPLIT = (ATTN_DIM, ATTN_DIM, ATTN_DIM, SSD_DIM, SSD_XBC, SSD_HEADS, SSD_HEADS)
IN_DIM_EVEN = sum(EVEN_SPLIT)

CONV_DIM = D_MODEL
SHORT_CONV = 3

N_EXPERTS = 16
CAPACITY_FACTOR = 2
D_FF_EXPERT = 2 * D_MODEL

NORM_EPS = 1e-6

kernel_name = "hybrid_dilated_attn_ssd_shortconv_ecmoe"


def rms_norm(x, g):
    xf = x.astype(jnp.float32)
    y = xf * lax.rsqrt(jnp.mean(xf * xf, axis=-1, keepdims=True) + NORM_EPS)
    return (y * g.astype(jnp.float32)).astype(x.dtype)


def partial_rope(t, positions):
    half = ROPE_DIM // 2
    inv_freq = ROPE_THETA ** (-jnp.arange(half, dtype=jnp.float32) * 2.0 / ROPE_DIM)
    ang = positions[:, None] * inv_freq[None, :]
    cos = jnp.cos(ang)[:, None, :]
    sin = jnp.sin(ang)[:, None, :]
    tf = t.astype(jnp.float32)
    x1, x2, rest = tf[..., :half], tf[..., half:ROPE_DIM], tf[..., ROPE_DIM:]
    return jnp.concatenate([x1 * cos - x2 * sin, x2 * cos + x1 * sin, rest], axis=-1).astype(t.dtype)


def window_branch(q, k, v, dilation, half):
    b, s, h, e = q.shape
    n = s // dilation
    nb = -(-n // half)
    n_pad = nb * half

    def to_blocks(t):
        t = t.reshape(b, n, dilation, h, e).transpose(0, 2, 3, 1, 4)
        t = jnp.pad(t, ((0, 0), (0, 0), (0, 0), (0, n_pad - n), (0, 0)))
        return t.reshape(b, dilation, h, nb, half, e)

    def neighbours(t):
        tp = jnp.pad(t, ((0, 0), (0, 0), (0, 0), (1, 1), (0, 0), (0, 0)))
        return jnp.concatenate([tp[:, :, :, :-2], tp[:, :, :, 1:-1], tp[:, :, :, 2:]], axis=4)

    qb = to_blocks(q)
    kc = neighbours(to_blocks(k))
    vc = neighbours(to_blocks(v))
    blk = jnp.arange(nb)[:, None] * half
    qpos = blk + jnp.arange(half)[None, :]
    kpos = blk + jnp.arange(-half, 2 * half)[None, :]
    mask = ((jnp.abs(qpos[:, :, None] - kpos[:, None, :]) <= half)
            & (kpos >= 0)[:, None, :] & (kpos < n)[:, None, :])
    scores = jnp.einsum("bdhnqe,bdhnke->bdhnqk", qb, kc).astype(jnp.float32) * (e ** -0.5)
    scores = jnp.where(mask, scores, -jnp.inf)
    m = jnp.max(scores, axis=-1, keepdims=True)
    p = jnp.exp(scores - m)
    l = jnp.sum(p, axis=-1, keepdims=True)
    o = jnp.einsum("bdhnqk,bdhnke->bdhnqe", p, vc.astype(jnp.float32)) / l
    lse = m + jnp.log(l)

    def back(t):
        t = t.reshape(b, dilation, h, n_pad, -1)[:, :, :, :n]
        return t.transpose(0, 3, 1, 2, 4).reshape(b, s, h, -1)

    return back(o), back(lse)[..., 0]


def dilated_attention(q, k, v):
    outs, lses = zip(*[window_branch(q, k, v, d, w // (2 * d)) for (w, d) in DILATED_PATTERNS])
    wts = jax.nn.softmax(jnp.stack(lses, axis=0), axis=0)
    return jnp.sum(jnp.stack(outs, axis=0) * wts[..., None], axis=0)


def dwconv_centred(x, w):
    ksz = w.shape[0]
    pad = ksz // 2
    s = x.shape[1]
    xp = jnp.pad(x, ((0, 0), (pad, pad), (0, 0)))
    y = xp[:, 0:s] * w[0]
    for j in range(1, ksz):
        y = y + xp[:, j:j + s] * w[j]
    return y


def segsum(a):
    cs = jnp.cumsum(a, axis=-1)
    t = a.shape[-1]
    diff = cs[..., :, None] - cs[..., None, :]
    return jnp.where(jnp.tril(jnp.ones((t, t), dtype=bool)), diff, -jnp.inf)


def ssd_scan(x, dt, a_neg, bm, cm):
    b, l, h, p = x.shape
    g, n = bm.shape[2], bm.shape[3]
    r = h // g
    c = l // SSD_CHUNK
    xdt = (x * dt[..., None]).reshape(b, c, SSD_CHUNK, g, r, p)
    a = (dt * a_neg).reshape(b, c, SSD_CHUNK, g, r).transpose(0, 3, 4, 1, 2)
    bm = bm.reshape(b, c, SSD_CHUNK, g, n)
    cm = cm.reshape(b, c, SSD_CHUNK, g, n)
    a_cs = jnp.cumsum(a, axis=-1)
    decay_in = jnp.exp(segsum(a))
    y_diag = jnp.einsum("bclgn,bcsgn,bgrcls,bcsgrp->bclgrp", cm, bm, decay_in, xdt)
    decay_to_end = jnp.exp(a_cs[..., -1:] - a_cs)
    chunk_states = jnp.einsum("bclgn,bgrcl,bclgrp->bcgrpn", bm, decay_to_end, xdt)
    chunk_decay = jnp.exp(a_cs[..., -1])

    def step(state, inp):
        st, dec = inp
        return state * dec[..., None, None] + st, state

    _, prev = lax.scan(step, jnp.zeros((b, g, r, p, n), x.dtype),
                       (chunk_states.transpose(1, 0, 2, 3, 4, 5), chunk_decay.transpose(3, 0, 1, 2)))
    prev = prev.transpose(1, 0, 2, 3, 4, 5)
    y_off = jnp.einsum("bclgn,bcgrpn,bgrcl->bclgrp", cm, prev, jnp.exp(a_cs))
    return (y_diag + y_off).reshape(b, l, h, p)


def bidirectional_ssd(xs, bm, cm, dt_f, dt_b, a_log_f, a_log_b, dt_bias_f, dt_bias_b, d_skip):
    f32 = jnp.float32
    step_f = jax.nn.softplus(dt_f + dt_bias_f.astype(f32))
    step_b = jax.nn.softplus(dt_b + dt_bias_b.astype(f32))
    y_f = ssd_scan(xs, step_f, -jnp.exp(a_log_f.astype(f32)), bm, cm)
    flip = lambda t: jnp.flip(t, axis=1)
    y_b = flip(ssd_scan(flip(xs), flip(step_b), -jnp.exp(a_log_b.astype(f32)), flip(bm), flip(cm)))
    return y_f + y_b + xs * d_skip.astype(f32)[:, None]


def even_mixer(h, w_in, q_norm, k_norm, conv_w, conv_b, a_log_f, a_log_b,
               dt_bias_f, dt_bias_b, d_skip, out_norm, w_out, positions):
    b, s, _ = h.shape
    f32 = jnp.float32
    idx = np.cumsum(EVEN_SPLIT)[:-1].tolist()
    q, k, v, z, xbc, dt_f, dt_b = jnp.split(h @ w_in, idx, axis=-1)
    heads = lambda t: t.reshape(b, s, ATTN_HEADS, HEAD_DIM)
    q = partial_rope(rms_norm(heads(q), q_norm), positions)
    k = partial_rope(rms_norm(heads(k), k_norm), positions)
    attn = dilated_attention(q, k, heads(v)).reshape(b, s, ATTN_DIM).astype(h.dtype)
    xbc = jax.nn.silu(dwconv_centred(xbc, conv_w) + conv_b)
    xs, bm, cm = jnp.split(xbc, [SSD_DIM, SSD_DIM + SSD_GROUPS * SSD_STATE], axis=-1)
    y = bidirectional_ssd(
        xs.astype(f32).reshape(b, s, SSD_HEADS, SSD_HEAD_DIM),
        bm.astype(f32).reshape(b, s, SSD_GROUPS, SSD_STATE),
        cm.astype(f32).reshape(b, s, SSD_GROUPS, SSD_STATE),
        dt_f.astype(f32), dt_b.astype(f32), a_log_f, a_log_b, dt_bias_f, dt_bias_b, d_skip)
    y = rms_norm(y.reshape(b, s, SSD_DIM) * jax.nn.silu(z.astype(f32)), out_norm).astype(h.dtype)
    return jnp.concatenate([attn, y], axis=-1) @ w_out


def odd_mixer(h, w_in, conv_w, w_out):
    gate_b, gate_c, u = jnp.split(h @ w_in, 3, axis=-1)
    return (gate_b * dwconv_centred(gate_c * u, conv_w)) @ w_out


def expert_choice_moe(h, router_w, w_gate, w_up, w_down):
    b, s, _ = h.shape
    cap = CAPACITY_FACTOR * s // N_EXPERTS
    affinity = jax.nn.softmax((h @ router_w).astype(jnp.float32), axis=-1)
    gate, idx = lax.top_k(jnp.swapaxes(affinity, 1, 2), cap)
    bidx = jnp.arange(b)[:, None, None]
    xe = h[bidx, idx]
    hid = jax.nn.silu(jnp.einsum("becd,edf->becf", xe, w_gate)) * jnp.einsum("becd,edf->becf", xe, w_up)
    ye = jnp.einsum("becf,efd->becd", hid, w_down) * gate[..., None].astype(h.dtype)
    return jnp.zeros_like(h).at[bidx, idx].add(ye)


def setup_inputs(seed: int = 0) -> dict:
    key = jax.random.key(seed)
    ks = jax.random.split(key, 24)
    f32 = jnp.float32
    nrm = lambda k, shape, fan_in: jax.random.normal(k, shape, f32) * (fan_in ** -0.5)
    gain = lambda k, shape: 1.0 + 0.05 * jax.random.normal(k, shape, f32)

    def dt_bias(k, shape):
        dt = jnp.exp(jax.random.uniform(k, shape, f32, minval=math.log(1e-3), maxval=math.log(1e-1)))
        return dt + jnp.log(-jnp.expm1(-dt))

    return {
        "x": jax.random.normal(ks[0], (BATCH, SEQ, D_MODEL), f32),
        "attn_norm": gain(ks[1], (N_EVEN, D_MODEL)),
        "w_in_even": nrm(ks[2], (N_EVEN, D_MODEL, IN_DIM_EVEN), D_MODEL),
        "q_norm": gain(ks[3], (N_EVEN, HEAD_DIM)),
        "k_norm": gain(ks[4], (N_EVEN, HEAD_DIM)),
        "ssd_conv_w": nrm(ks[5], (N_EVEN, SSD_CONV, SSD_XBC), SSD_CONV),
        "ssd_conv_b": 0.02 * jax.random.normal(ks[6], (N_EVEN, SSD_XBC), f32),
        "ssd_a_log_fwd": jnp.log(jax.random.uniform(ks[7], (N_EVEN, SSD_HEADS), f32, minval=1.0, maxval=16.0)),
        "ssd_a_log_bwd": jnp.log(jax.random.uniform(ks[8], (N_EVEN, SSD_HEADS), f32, minval=1.0, maxval=16.0)),
        "ssd_dt_bias_fwd": dt_bias(ks[9], (N_EVEN, SSD_HEADS)),
        "ssd_dt_bias_bwd": dt_bias(ks[10], (N_EVEN, SSD_HEADS)),
        "ssd_d": gain(ks[11], (N_EVEN, SSD_HEADS)),
        "ssd_out_norm": gain(ks[12], (N_EVEN, SSD_DIM)),
        "w_out_even": nrm(ks[13], (N_EVEN, MIX_DIM_EVEN, D_MODEL), MIX_DIM_EVEN),
        "conv_norm": gain(ks[14], (N_ODD, D_MODEL)),
        "conv_w_in": nrm(ks[15], (N_ODD, D_MODEL, 3 * CONV_DIM), D_MODEL),
        "conv_w": nrm(ks[16], (N_ODD, SHORT_CONV, CONV_DIM), SHORT_CONV),
        "conv_w_out": nrm(ks[17], (N_ODD, CONV_DIM, D_MODEL), CONV_DIM),
        "ffn_norm": gain(ks[18], (DEPTH, D_MODEL)),
        "router_w": nrm(ks[19], (DEPTH, D_MODEL, N_EXPERTS), D_MODEL),
        "expert_w_gate": nrm(ks[20], (DEPTH, N_EXPERTS, D_MODEL, D_FF_EXPERT), D_MODEL),
        "expert_w_up": nrm(ks[21], (DEPTH, N_EXPERTS, D_MODEL, D_FF_EXPERT), D_MODEL),
        "expert_w_down": nrm(ks[22], (DEPTH, N_EXPERTS, D_FF_EXPERT, D_MODEL), D_FF_EXPERT),
    }


def reference(x, attn_norm, w_in_even, q_norm, k_norm, ssd_conv_w, ssd_conv_b,
              ssd_a_log_fwd, ssd_a_log_bwd, ssd_dt_bias_fwd, ssd_dt_bias_bwd, ssd_d,
              ssd_out_norm, w_out_even, conv_norm, conv_w_in, conv_w, conv_w_out,
              ffn_norm, router_w, expert_w_gate, expert_w_up, expert_w_down):
    positions = jnp.arange(x.shape[1], dtype=jnp.float32)
    for layer in range(DEPTH):
        i = layer // 2
        if layer % 2 == 0:
            x = x + even_mixer(rms_norm(x, attn_norm[i]), w_in_even[i], q_norm[i], k_norm[i],
                               ssd_conv_w[i], ssd_conv_b[i], ssd_a_log_fwd[i], ssd_a_log_bwd[i],
                               ssd_dt_bias_fwd[i], ssd_dt_bias_bwd[i], ssd_d[i], ssd_out_norm[i],
                               w_out_even[i], positions)
        else:
            x = x + odd_mixer(rms_norm(x, conv_norm[i]), conv_w_in[i], conv_w[i], conv_w_out[i])
        x = x + expert_choice_moe(rms_norm(x, ffn_norm[layer]), router_w[layer],
                                  expert_w_gate[layer], expert_w_up[layer], expert_w_down[layer])
    return x
```

```cpp
#ifndef HOST_EMU
#include <hip/hip_runtime.h>
#define HD __host__ __device__ __forceinline__
#define DEV __device__ __forceinline__
#else
#include <cmath>
#include <cstdio>
#include <cstdlib>
#include <cstring>
#include <cstddef>
#define HD inline
#define DEV inline
struct float4 { float x, y, z, w; };
struct uint4 { unsigned x, y, z, w; };
struct uint2 { unsigned x, y; };
static thread_local size_t emu_tid = 0; static size_t emu_nthreads = 1;
#endif

#ifndef BATCH
#define BATCH 2
#endif
#ifndef SEQ
#define SEQ 16384
#endif
#ifndef NAIVE_GEMM
#define NAIVE_GEMM 1
#endif
#ifndef NAIVE_ATTN
#define NAIVE_ATTN 1
#endif
#ifndef NAIVE_SSD
#define NAIVE_SSD 1
#endif
#ifndef NAIVE_TOPK
#define NAIVE_TOPK 1
#endif
#ifndef ONE_LAUNCH
#define ONE_LAUNCH 1
#endif

typedef unsigned short bf16_t;
constexpr int T = BATCH * SEQ;
constexpr int DM = 1024;
constexpr int NIN = 5664, NIN_PAD = 5888;
constexpr int NE = 16;
constexpr int CAP = 2 * SEQ / NE;
constexpr int NSLOT = BATCH * NE * CAP;
constexpr int DFF = 2048;
constexpr int NCHUNK = SEQ / 128;

HD float bf2f(bf16_t v) { union { unsigned u; float f; } x; x.u = ((unsigned)v) << 16; return x.f; }
HD bf16_t f2bf(float f) { union { unsigned u; float f; } x; x.f = f; unsigned u = x.u; u += 0x7fffu + ((u >> 16) & 1u); return (bf16_t)(u >> 16); }
HD unsigned pack2(float lo, float hi) { return (unsigned)f2bf(lo) | ((unsigned)f2bf(hi) << 16); }
HD float silu_f(float v) { return v / (1.0f + expf(-v)); }
HD float softplus_f(float v) { return v > 20.f ? v : log1pf(expf(v)); }

#ifndef HOST_EMU
#define LANES 64
#define GTID ((size_t)blockIdx.x * blockDim.x + threadIdx.x)
#define GSTRIDE ((size_t)gridDim.x * blockDim.x)
#define LANE ((int)(threadIdx.x & 63))
DEV float wave_sum(float v) {
#pragma unroll
    for (int o = 32; o >= 1; o >>= 1) v += __shfl_xor(v, o);
    return v;
}
#else
#define LANES 1
#define GTID (emu_tid)
#define GSTRIDE (emu_nthreads)
#define LANE 0
DEV float wave_sum(float v) { return v; }
#endif
#define GWAVE (GTID / LANES)
#define NWAVES_G (GSTRIDE / LANES)

struct P {
    const float *x, *attn_norm, *w_in, *q_norm, *k_norm, *conv_w, *conv_b, *a_log_f, *a_log_b, *dtb_f, *dtb_b, *ssd_d, *out_norm, *w_out,
        *conv_norm, *cw_in, *cw, *cw_out, *ffn_norm, *router_w, *wg, *wu, *wd;
    float* out;
    bf16_t *WinT, *WoutT, *WciT, *WcoT, *WguT, *WdT, *hn, *qkv, *z, *xbcraw, *xbc, *mix, *yssd, *xe, *hid, *ye, *pbuf, *gb, *abuf;
    float *dtraw, *step, *aff, *gate, *rope, *ytmp, *states;
    int *idx, *slotmap;
    unsigned* bar;
};

constexpr size_t MiB = 1024 * 1024;
constexpr size_t al(size_t v) { return (v + 4095) & ~(size_t)4095; }
constexpr size_t WS_BAR = 0;
constexpr size_t WS_WIN = 65536;
constexpr size_t WS_WOUT = WS_WIN + al((size_t)NIN_PAD * 1024 * 2);
constexpr size_t WS_WCI = WS_WOUT + al((size_t)1024 * 2048 * 2);
constexpr size_t WS_WCO = WS_WCI + al((size_t)3072 * 1024 * 2);
constexpr size_t WS_WGU = WS_WCO + al((size_t)1024 * 1024 * 2);
constexpr size_t WS_WD = WS_WGU + al((size_t)NE * 4096 * 1024 * 2);
constexpr size_t WS_ROPE = WS_WD + al((size_t)NE * 1024 * 2048 * 2);
constexpr size_t WS_AFF = WS_ROPE + al((size_t)SEQ * 16 * 4);
constexpr size_t WS_GATE = WS_AFF + al((size_t)BATCH * NE * SEQ * 4);
constexpr size_t WS_IDX = WS_GATE + al((size_t)NSLOT * 4);
constexpr size_t WS_SMAP = WS_IDX + al((size_t)NSLOT * 4);
constexpr size_t WS_HN = WS_SMAP + al((size_t)BATCH * NE * SEQ * 4);
constexpr size_t WS_E = WS_HN + al((size_t)T * 1024 * 2);
constexpr size_t WS_QKV = WS_E;
constexpr size_t WS_XBCRAW = WS_QKV + al((size_t)T * 3072 * 2);
constexpr size_t WS_Z = WS_XBCRAW + al((size_t)T * 1536 * 2);
constexpr size_t WS_XBC = WS_Z + al((size_t)T * 1024 * 2);
constexpr size_t WS_DTRAW = WS_XBC + al((size_t)T * 1536 * 2);
constexpr size_t WS_STEP = WS_DTRAW + al((size_t)T * 32 * 4);
constexpr size_t WS_MIX = WS_STEP + al((size_t)T * 32 * 4);
constexpr size_t WS_YSSD = WS_MIX + al((size_t)T * 2048 * 2);
constexpr size_t WS_E_END = WS_YSSD + al((size_t)T * 1024 * 2);
constexpr size_t WS_STATES = WS_QKV;
constexpr size_t WS_XE = WS_E;
constexpr size_t WS_HID = WS_XE + al((size_t)NSLOT * 1024 * 2);
constexpr size_t WS_YE = WS_HID + al((size_t)NSLOT * 2048 * 2);
constexpr size_t WS_F_END = WS_YE + al((size_t)NSLOT * 1024 * 2);
constexpr size_t WS_PBUF = WS_E;
constexpr size_t WS_GB = WS_PBUF + al((size_t)T * 1024 * 2);
constexpr size_t WS_ABUF = WS_GB + al((size_t)T * 1024 * 2);
constexpr size_t WS_END = WS_E_END > WS_F_END ? WS_E_END : WS_F_END;
static_assert((size_t)T * 3072 * 2 + (size_t)T * 1536 * 2 >= (size_t)BATCH * 2 * NCHUNK * 16 * 64 * 128 * 4, "states overlay");
static_assert(BATCH != 2 || SEQ != 16384 || WS_END <= 1024 * MiB, "workspace");

struct CmIdent { int nvalid; HD int operator()(int n) const { return n < nvalid ? n : -1; } };
struct CmGateUp { HD int operator()(int n) const { return n; } };
struct CmOddIn { HD int operator()(int n) const {
        if (n >= 2048) return n - 2048; const int pn = n >> 8, j = n & 255; return j < 128 ? 1024 + pn * 128 + j : 2048 + pn * 128 + (j - 128); } };

template <class CM> DEV void convT(const float* src, int ldsrc, int K, bf16_t* dst, int Ndst, CM cm) {
#ifndef HOST_EMU
    const size_t nitems = (size_t)Ndst * (K / 8);
    for (size_t i = GTID; i < nitems; i += GSTRIDE) {
        const int n = (int)(i % Ndst), k8 = (int)(i / Ndst); const int c = cm(n);
        unsigned w[4];
#pragma unroll
        for (int j = 0; j < 4; ++j) { float a = 0.f, b = 0.f; if (c >= 0) { a = src[(size_t)(k8 * 8 + 2 * j) * ldsrc + c]; b = src[(size_t)(k8 * 8 + 2 * j + 1) * ldsrc + c]; } w[j] = pack2(a, b); }
        *(uint4*)(dst + (size_t)n * K + k8 * 8) = uint4{w[0], w[1], w[2], w[3]};
    }
#else
    for (size_t i = GTID; i < (size_t)Ndst * K; i += GSTRIDE) { const int n = (int)(i / K), k = (int)(i % K); const int c = cm(n); dst[i] = c >= 0 ? f2bf(src[(size_t)k * ldsrc + c]) : (bf16_t)0; }
#endif
}
struct CmGU { const float* dummy; HD int operator()(int n) const { return n; } };
template <int WHICH> struct CmHalf { HD int operator()(int n) const { const int j = n & 255; const bool isup = j >= 128; if ((int)isup != WHICH) return -2; return (n >> 8) * 128 + (j & 127); } };
DEV void conv_gateup(const float* sg, const float* su, bf16_t* dst) {
#ifndef HOST_EMU
    const size_t nitems = (size_t)4096 * 128;
    for (size_t i = GTID; i < nitems; i += GSTRIDE) {
        const int n = (int)(i % 4096), k8 = (int)(i / 4096); const int j = n & 255; const float* src = j >= 128 ? su : sg; const int c = (n >> 8) * 128 + (j & 127);
        unsigned w[4];
#pragma unroll
        for (int q = 0; q < 4; ++q) w[q] = pack2(src[(size_t)(k8 * 8 + 2 * q) * 2048 + c], src[(size_t)(k8 * 8 + 2 * q + 1) * 2048 + c]);
        *(uint4*)(dst + (size_t)n * 1024 + k8 * 8) = uint4{w[0], w[1], w[2], w[3]};
    }
#else
    for (size_t i = GTID; i < (size_t)4096 * 1024; i += GSTRIDE) { const int n = (int)(i / 1024), k = (int)(i % 1024); const int j = n & 255; const float* src = j >= 128 ? su : sg; dst[i] = f2bf(src[(size_t)k * 2048 + (n >> 8) * 128 + (j & 127)]); }
#endif
}
DEV void ph_convert_small(const P& p) {
    convT(p.w_in, NIN, 1024, p.WinT, NIN_PAD, CmIdent{NIN});
    convT(p.w_out, 1024, 2048, p.WoutT, 1024, CmIdent{1024});
    convT(p.cw_in, 3072, 1024, p.WciT, 3072, CmOddIn{});
    convT(p.cw_out, 1024, 1024, p.WcoT, 1024, CmIdent{1024});
    for (size_t i = GTID; i < (size_t)SEQ * 8; i += GSTRIDE) {
        const int pos = (int)(i >> 3), j = (int)(i & 7);
        const float inv = powf(500000.0f, -((float)j * 2.0f / 16.0f)); const float ang = (float)pos * inv;
        p.rope[(size_t)pos * 16 + j] = cosf(ang); p.rope[(size_t)pos * 16 + 8 + j] = sinf(ang);
    }
}
DEV void ph_convert_experts(const P& p, int layer) {
    for (int e = 0; e < NE; ++e) {
        const size_t off = ((size_t)layer * NE + e) * 1024 * 2048;
        conv_gateup(p.wg + off, p.wu + off, p.WguT + (size_t)e * 4096 * 1024);
        convT(p.wd + off, 1024, 2048, p.WdT + (size_t)e * 1024 * 2048, 1024, CmIdent{1024});
    }
}

constexpr int NV = 256 / LANES;
DEV void ph_rmsnorm(const float* src, const float* g, bf16_t* dst) {
    for (size_t row = GWAVE; row < (size_t)T; row += NWAVES_G) {
        const float4* s4 = (const float4*)(src + row * 1024); float4 v[NV]; float ss = 0.f;
#pragma unroll
        for (int j = 0; j < NV; ++j) { v[j] = s4[j * LANES + LANE]; ss += v[j].x * v[j].x + v[j].y * v[j].y + v[j].z * v[j].z + v[j].w * v[j].w; }
        ss = wave_sum(ss); const float r = 1.0f / sqrtf(ss * (1.0f / 1024.0f) + 1e-6f);
#pragma unroll
        for (int j = 0; j < NV; ++j) { const int c4 = j * LANES + LANE; const float4 gg = ((const float4*)g)[c4];
            *(uint2*)(dst + row * 1024 + c4 * 4) = uint2{pack2(v[j].x * r * gg.x, v[j].y * r * gg.y), pack2(v[j].z * r * gg.z, v[j].w * r * gg.w)}; }
    }
}
DEV void ph_norm_router(const P& p, int layer) {
    const float* g = p.ffn_norm + (size_t)layer * 1024; const float* rw = p.router_w + (size_t)layer * 1024 * 16;
    for (size_t row = GWAVE; row < (size_t)T; row += NWAVES_G) {
        const float4* s4 = (const float4*)(p.out + row * 1024); float4 v[NV]; float ss = 0.f;
#pragma unroll
        for (int j = 0; j < NV; ++j) { v[j] = s4[j * LANES + LANE]; ss += v[j].x * v[j].x + v[j].y * v[j].y + v[j].z * v[j].z + v[j].w * v[j].w; }
        ss = wave_sum(ss); const float r = 1.0f / sqrtf(ss * (1.0f / 1024.0f) + 1e-6f);
        float lg[16];
#pragma unroll
        for (int e = 0; e < 16; ++e) lg[e] = 0.f;
#pragma unroll
        for (int j = 0; j < NV; ++j) { const int c4 = j * LANES + LANE; const float4 gg = ((const float4*)g)[c4];
            const float h0 = v[j].x * r * gg.x, h1 = v[j].y * r * gg.y, h2 = v[j].z * r * gg.z, h3 = v[j].w * r * gg.w;
            *(uint2*)(p.hn + row * 1024 + c4 * 4) = uint2{pack2(h0, h1), pack2(h2, h3)};
            const float4* w4 = (const float4*)(rw + (size_t)c4 * 4 * 16);
#pragma unroll
            for (int q = 0; q < 4; ++q) { const float4 a = w4[q], b = w4[4 + q], c = w4[8 + q], d = w4[12 + q];
                lg[4 * q + 0] += h0 * a.x + h1 * b.x + h2 * c.x + h3 * d.x; lg[4 * q + 1] += h0 * a.y + h1 * b.y + h2 * c.y + h3 * d.y;
                lg[4 * q + 2] += h0 * a.z + h1 * b.z + h2 * c.z + h3 * d.z; lg[4 * q + 3] += h0 * a.w + h1 * b.w + h2 * c.w + h3 * d.w; } }
        float mx = -1e30f;
#pragma unroll
        for (int e = 0; e < 16; ++e) { lg[e] = wave_sum(lg[e]); mx = fmaxf(mx, lg[e]); }
        float den = 0.f;
#pragma unroll
        for (int e = 0; e < 16; ++e) { lg[e] = expf(lg[e] - mx); den += lg[e]; }
        const float inv = 1.0f / den; const int b = (int)(row / SEQ), s = (int)(row % SEQ);
#pragma unroll
        for (int e = 0; e < 16; ++e) if (LANE == (e & (LANES - 1))) p.aff[((size_t)b * NE + e) * SEQ + s] = lg[e] * inv;
    }
}
DEV void ph_gated_norm(const P& p) {
    for (size_t row = GWAVE; row < (size_t)T; row += NWAVES_G) {
        float4 v[NV]; float ss = 0.f;
#pragma unroll
        for (int j = 0; j < NV; ++j) { const int c4 = j * LANES + LANE; const uint2 y = *(const uint2*)(p.yssd + row * 1024 + c4 * 4), zz = *(const uint2*)(p.z + row * 1024 + c4 * 4);
            v[j].x = bf2f((bf16_t)(y.x & 0xffff)) * silu_f(bf2f((bf16_t)(zz.x & 0xffff))); v[j].y = bf2f((bf16_t)(y.x >> 16)) * silu_f(bf2f((bf16_t)(zz.x >> 16)));
            v[j].z = bf2f((bf16_t)(y.y & 0xffff)) * silu_f(bf2f((bf16_t)(zz.y & 0xffff))); v[j].w = bf2f((bf16_t)(y.y >> 16)) * silu_f(bf2f((bf16_t)(zz.y >> 16)));
            ss += v[j].x * v[j].x + v[j].y * v[j].y + v[j].z * v[j].z + v[j].w * v[j].w; }
        ss = wave_sum(ss); const float r = 1.0f / sqrtf(ss * (1.0f / 1024.0f) + 1e-6f);
#pragma unroll
        for (int j = 0; j < NV; ++j) { const int c4 = j * LANES + LANE; const float4 gg = ((const float4*)p.out_norm)[c4];
            *(uint2*)(p.mix + row * 2048 + 1024 + c4 * 4) = uint2{pack2(v[j].x * r * gg.x, v[j].y * r * gg.y), pack2(v[j].z * r * gg.z, v[j].w * r * gg.w)}; }
    }
}
DEV void ph_combine(const P& p, const float* g) {
    for (size_t row = GWAVE; row < (size_t)T; row += NWAVES_G) {
        const int b = (int)(row / SEQ), s = (int)(row % SEQ);
        float4* o4 = (float4*)(p.out + row * 1024); float4 v[NV];
#pragma unroll
        for (int j = 0; j < NV; ++j) v[j] = o4[j * LANES + LANE];
        for (int e = 0; e < NE; ++e) {
            const int sl = p.slotmap[((size_t)b * NE + e) * SEQ + s];
            if (sl >= 0) { const size_t r = ((size_t)b * NE + e) * CAP + sl; const float gt = p.gate[r];
#pragma unroll
                for (int j = 0; j < NV; ++j) { const int c4 = j * LANES + LANE; const uint2 y = *(const uint2*)(p.ye + r * 1024 + c4 * 4);
                    v[j].x += gt * bf2f((bf16_t)(y.x & 0xffff)); v[j].y += gt * bf2f((bf16_t)(y.x >> 16)); v[j].z += gt * bf2f((bf16_t)(y.y & 0xffff)); v[j].w += gt * bf2f((bf16_t)(y.y >> 16)); } }
        }
        float ss = 0.f;
#pragma unroll
        for (int j = 0; j < NV; ++j) { o4[j * LANES + LANE] = v[j]; ss += v[j].x * v[j].x + v[j].y * v[j].y + v[j].z * v[j].z + v[j].w * v[j].w; }
        if (g) { ss = wave_sum(ss); const float r = 1.0f / sqrtf(ss * (1.0f / 1024.0f) + 1e-6f);
#pragma unroll
            for (int j = 0; j < NV; ++j) { const int c4 = j * LANES + LANE; const float4 gg = ((const float4*)g)[c4];
                *(uint2*)(p.hn + row * 1024 + c4 * 4) = uint2{pack2(v[j].x * r * gg.x, v[j].y * r * gg.y), pack2(v[j].z * r * gg.z, v[j].w * r * gg.w)}; } }
    }
}

DEV void ld8(const bf16_t* p, float (&f)[8]) { const uint4 u = *(const uint4*)p; const unsigned w[4] = {u.x, u.y, u.z, u.w};
#pragma unroll
    for (int j = 0; j < 4; ++j) { f[2 * j] = bf2f((bf16_t)(w[j] & 0xffff)); f[2 * j + 1] = bf2f((bf16_t)(w[j] >> 16)); } }
DEV void st8(bf16_t* p, const float (&f)[8]) { *(uint4*)p = uint4{pack2(f[0], f[1]), pack2(f[2], f[3]), pack2(f[4], f[5]), pack2(f[6], f[7])}; }

DEV void ph_prep(const P& p) {
    for (size_t i = GTID; i < (size_t)T * 32; i += GSTRIDE) {
        const size_t t = i >> 5; const int hh = (int)(i & 31); const int isk = hh >> 4, h = hh & 15; const int pos = (int)(t % SEQ);
        bf16_t* ptr = p.qkv + t * 3072 + isk * 1024 + h * 64; const float* gn = isk ? p.k_norm : p.q_norm;
        float v[64]; float ss = 0.f;
#pragma unroll
        for (int c = 0; c < 8; ++c) { float f[8]; ld8(ptr + c * 8, f);
#pragma unroll
            for (int j = 0; j < 8; ++j) { v[c * 8 + j] = f[j]; ss += f[j] * f[j]; } }
        const float r = 1.0f / sqrtf(ss * (1.0f / 64.0f) + 1e-6f);
#pragma unroll
        for (int c = 0; c < 64; ++c) v[c] = v[c] * r * gn[c];
#pragma unroll
        for (int j = 0; j < 8; ++j) { const float cs = p.rope[(size_t)pos * 16 + j], sn = p.rope[(size_t)pos * 16 + 8 + j]; const float x1 = v[j], x2 = v[8 + j]; v[j] = x1 * cs - x2 * sn; v[8 + j] = x2 * cs + x1 * sn; }
#pragma unroll
        for (int c = 0; c < 8; ++c) { float f[8];
#pragma unroll
            for (int j = 0; j < 8; ++j) f[j] = v[c * 8 + j];
            st8(ptr + c * 8, f); }
    }
    for (size_t i = GTID; i < (size_t)T * 192; i += GSTRIDE) {
        const size_t t = i / 192; const int c8 = (int)(i % 192) * 8; const int pos = (int)(t % SEQ);
        float acc[8];
#pragma unroll
        for (int j = 0; j < 8; ++j) acc[j] = p.conv_b[c8 + j];
#pragma unroll
        for (int k = 0; k < 5; ++k) { const int pp = pos + k - 2; if (pp < 0 || pp >= SEQ) continue; float f[8]; ld8(p.xbcraw + (t + k - 2) * 1536 + c8, f);
#pragma unroll
            for (int j = 0; j < 8; ++j) acc[j] += f[j] * p.conv_w[k * 1536 + c8 + j]; }
#pragma unroll
        for (int j = 0; j < 8; ++j) acc[j] = silu_f(acc[j]);
        st8(p.xbc + t * 1536 + c8, acc);
    }
    for (size_t i = GTID; i < (size_t)T * 32; i += GSTRIDE) { const int j = (int)(i & 31); p.step[i] = softplus_f(p.dtraw[i] + (j < 16 ? p.dtb_f[j] : p.dtb_b[j - 16])); }
}
DEV void ph_gather(const P& p) {
    for (size_t i = GTID; i < (size_t)NSLOT * 128; i += GSTRIDE) { const size_t r = i >> 7; const int j = (int)(i & 127); const int b = (int)(r / ((size_t)NE * CAP));
        *(uint4*)(p.xe + r * 1024 + j * 8) = *(const uint4*)(p.hn + ((size_t)b * SEQ + p.idx[r]) * 1024 + j * 8); }
}
DEV void ph_conv3(const P& p) {
    for (size_t i = GTID; i < (size_t)T * 128; i += GSTRIDE) {
        const size_t t = i >> 7; const int c8 = (int)(i & 127) * 8; const int pos = (int)(t % SEQ);
        float acc[8], f[8];
#pragma unroll
        for (int j = 0; j < 8; ++j) acc[j] = 0.f;
#pragma unroll
        for (int k = 0; k < 3; ++k) { const int pp = pos + k - 1; if (pp < 0 || pp >= SEQ) continue; ld8(p.pbuf + (t + k - 1) * 1024 + c8, f);
#pragma unroll
            for (int j = 0; j < 8; ++j) acc[j] += f[j] * p.cw[k * 1024 + c8 + j]; }
        ld8(p.gb + t * 1024 + c8, f);
#pragma unroll
        for (int j = 0; j < 8; ++j) acc[j] *= f[j];
        st8(p.abuf + t * 1024 + c8, acc);
    }
}

DEV float dot_bf(const bf16_t* a, const bf16_t* b, int K) { float acc = 0.f; for (int k = 0; k < K; k += 8) { float fa[8], fb[8]; ld8(a + k, fa); ld8(b + k, fb);
#pragma unroll
        for (int j = 0; j < 8; ++j) acc += fa[j] * fb[j]; } return acc; }
DEV void nv_g1(const P& p) {
    for (size_t i = GTID; i < (size_t)T * NIN; i += GSTRIDE) { const size_t m = i / NIN; const int n = (int)(i % NIN); const float acc = dot_bf(p.hn + m * 1024, p.WinT + (size_t)n * 1024, 1024);
        if (n < 3072) p.qkv[m * 3072 + n] = f2bf(acc); else if (n < 4096) p.z[m * 1024 + n - 3072] = f2bf(acc); else if (n < 5632) p.xbcraw[m * 1536 + n - 4096] = f2bf(acc); else p.dtraw[m * 32 + n - 5632] = acc; }
}
DEV void nv_g2(const P& p) {
    for (size_t i = GTID; i < (size_t)T * 1024; i += GSTRIDE) { const size_t m = i >> 10; const int n = (int)(i & 1023); p.out[i] = p.x[i] + dot_bf(p.mix + m * 2048, p.WoutT + (size_t)n * 2048, 2048); }
}
DEV void nv_up(const P& p) {
    for (size_t i = GTID; i < (size_t)NSLOT * 2048; i += GSTRIDE) { const size_t r = i >> 11; const int n = (int)(i & 2047); const int e = (int)((r / CAP) % NE);
        const bf16_t* w = p.WguT + (size_t)e * 4096 * 1024 + (size_t)((n >> 7) * 256 + (n & 127)) * 1024;
        const float g = dot_bf(p.xe + r * 1024, w, 1024), u = dot_bf(p.xe + r * 1024, w + (size_t)128 * 1024, 1024); p.hid[i] = f2bf(silu_f(g) * u); }
}
DEV void nv_down(const P& p) {
    for (size_t i = GTID; i < (size_t)NSLOT * 1024; i += GSTRIDE) { const size_t r = i >> 10; const int n = (int)(i & 1023); const int e = (int)((r / CAP) % NE);
        p.ye[i] = f2bf(dot_bf(p.hid + r * 2048, p.WdT + (size_t)e * 1024 * 2048 + (size_t)n * 2048, 2048)); }
}
DEV void nv_g3(const P& p) {
    for (size_t i = GTID; i < (size_t)T * 2048; i += GSTRIDE) { const size_t m = i >> 11; const int n = (int)(i & 2047);
        if (n < 1024) { const bf16_t* w = p.WciT + (size_t)((n >> 7) * 256 + (n & 127)) * 1024; p.pbuf[m * 1024 + n] = f2bf(dot_bf(p.hn + m * 1024, w, 1024) * dot_bf(p.hn + m * 1024, w + (size_t)128 * 1024, 1024)); }
        else p.gb[m * 1024 + n - 1024] = f2bf(dot_bf(p.hn + m * 1024, p.WciT + (size_t)(2048 + n - 1024) * 1024, 1024)); }
}
DEV void nv_g4(const P& p) {
    for (size_t i = GTID; i < (size_t)T * 1024; i += GSTRIDE) { const size_t m = i >> 10; const int n = (int)(i & 1023); p.out[i] += dot_bf(p.abuf + m * 1024, p.WcoT + (size_t)n * 1024, 1024); }
}
DEV void nv_attn(const P& p) {
    for (size_t i = GTID; i < (size_t)T * 16; i += GSTRIDE) {
        const size_t t = i >> 4; const int h = (int)(i & 15); const int pos = (int)(t % SEQ); const size_t t0 = t - pos;
        const bf16_t* qp = p.qkv + t * 3072 + h * 64;
        float o[64]; float m = -1e30f, l = 0.f;
#pragma unroll
        for (int c = 0; c < 64; ++c) o[c] = 0.f;
        for (int pat = 0; pat < 3; ++pat) { const int d = pat == 0 ? 1 : (pat == 1 ? 4 : 16);
            for (int j = -64; j <= 64; ++j) { const int kp = pos + d * j; if (kp < 0 || kp >= SEQ) continue;
                const bf16_t* kr = p.qkv + (t0 + kp) * 3072 + 1024 + h * 64; const bf16_t* vr = kr + 1024;
                const float s = dot_bf(qp, kr, 64) * 0.125f;
                const float mn = fmaxf(m, s), sc = expf(m - mn), pe = expf(s - mn); l = l * sc + pe; m = mn;
#pragma unroll
                for (int c = 0; c < 8; ++c) { float f[8]; ld8(vr + c * 8, f);
#pragma unroll
                    for (int q = 0; q < 8; ++q) o[c * 8 + q] = o[c * 8 + q] * sc + pe * f[q]; } } }
        const float inv = 1.0f / l;
#pragma unroll
        for (int c = 0; c < 8; ++c) { float f[8];
#pragma unroll
            for (int q = 0; q < 8; ++q) f[q] = o[c * 8 + q] * inv;
            st8(p.mix + t * 2048 + h * 64 + c * 8, f); }
    }
}
DEV void nv_ssd(const P& p) {
    const size_t nitem = (size_t)BATCH * 16 * 64;
#ifndef HOST_EMU
    if (LANE != 0) return;
#endif
    for (size_t it = GWAVE; it < nitem; it += NWAVES_G) {
        const int b = (int)(it / 1024), h = (int)((it >> 6) & 15), pc = (int)(it & 63), g = h >> 3;
        const float af = -expf(p.a_log_f[h]), ab = -expf(p.a_log_b[h]), dsk = p.ssd_d[h];
        float st[128];
        for (int dir = 0; dir < 2; ++dir) {
#pragma unroll
            for (int n = 0; n < 128; ++n) st[n] = 0.f;
            for (int tt = 0; tt < SEQ; ++tt) { const int s = dir ? SEQ - 1 - tt : tt; const size_t row = (size_t)b * SEQ + s;
                const float dt = p.step[row * 32 + dir * 16 + h]; const float dec = expf(dt * (dir ? ab : af)); const float xv = bf2f(p.xbc[row * 1536 + h * 64 + pc]); const float xdt = xv * dt;
                const bf16_t* bm = p.xbc + row * 1536 + 1024 + g * 128; const bf16_t* cm = bm + 256; float y = 0.f;
#pragma unroll
                for (int n8 = 0; n8 < 16; ++n8) { float fb[8], fc[8]; ld8(bm + n8 * 8, fb); ld8(cm + n8 * 8, fc);
#pragma unroll
                    for (int j = 0; j < 8; ++j) { st[n8 * 8 + j] = st[n8 * 8 + j] * dec + xdt * fb[j]; y += fc[j] * st[n8 * 8 + j]; } }
                if (dir == 0) p.ytmp[row * 1024 + h * 64 + pc] = y; else p.yssd[row * 1024 + h * 64 + pc] = f2bf(p.ytmp[row * 1024 + h * 64 + pc] + y + xv * dsk); }
        }
    }
}
DEV void nv_topk(const P& p) {
    for (size_t i = GTID; i < (size_t)BATCH * NE * SEQ; i += GSTRIDE) { const size_t be = i / SEQ; const int s = (int)(i % SEQ); const float* a = p.aff + be * SEQ; const float v = a[s]; int rank = 0;
        for (int j = 0; j < SEQ; ++j) { const float w = a[j]; rank += (w > v || (w == v && j < s)) ? 1 : 0; }
        if (rank < CAP) { p.idx[be * CAP + rank] = s; p.gate[be * CAP + rank] = v; p.slotmap[i] = rank; } else p.slotmap[i] = -1; }
}

static void make_params(P& p, void* const* d_in, void* d_out, void* d_ws) {
    const float** ins = (const float**)&p.x;
    for (int i = 0; i < 23; ++i) ins[i] = (const float*)d_in[i];
    p.out = (float*)d_out;
    unsigned char* ws = (unsigned char*)d_ws;
    p.WinT = (bf16_t*)(ws + WS_WIN); p.WoutT = (bf16_t*)(ws + WS_WOUT); p.WciT = (bf16_t*)(ws + WS_WCI); p.WcoT = (bf16_t*)(ws + WS_WCO); p.WguT = (bf16_t*)(ws + WS_WGU); p.WdT = (bf16_t*)(ws + WS_WD);
    p.hn = (bf16_t*)(ws + WS_HN); p.qkv = (bf16_t*)(ws + WS_QKV); p.z = (bf16_t*)(ws + WS_Z); p.xbcraw = (bf16_t*)(ws + WS_XBCRAW); p.xbc = (bf16_t*)(ws + WS_XBC); p.mix = (bf16_t*)(ws + WS_MIX); p.yssd = (bf16_t*)(ws + WS_YSSD);
    p.xe = (bf16_t*)(ws + WS_XE); p.hid = (bf16_t*)(ws + WS_HID); p.ye = (bf16_t*)(ws + WS_YE); p.pbuf = (bf16_t*)(ws + WS_PBUF); p.gb = (bf16_t*)(ws + WS_GB); p.abuf = (bf16_t*)(ws + WS_ABUF);
    p.dtraw = (float*)(ws + WS_DTRAW); p.step = (float*)(ws + WS_STEP); p.aff = (float*)(ws + WS_AFF); p.gate = (float*)(ws + WS_GATE); p.rope = (float*)(ws + WS_ROPE); p.ytmp = (float*)(ws + WS_STATES); p.states = (float*)(ws + WS_STATES);
    p.idx = (int*)(ws + WS_IDX); p.slotmap = (int*)(ws + WS_SMAP); p.bar = (unsigned*)(ws + WS_BAR);
}
#ifndef HOST_EMU
#define XB_TMO      128
#define XB_XCNT(j)  (256  + 64 * (j))
#define XB_XSUB(j)  (1280 + 64 * (j))
#define XB_XGEN(j)  (2304 + 64 * (j))
#define XB_TOP      3328
#define XB_TOPGEN   3392
#define XCD_BAR_WORDS 3456
#define XB_SPIN_CAP (1u << 18)
#define LAS __attribute__((address_space(3)))

__device__ __forceinline__ unsigned xb_ld(unsigned* p)              { return __hip_atomic_load(p, __ATOMIC_RELAXED, __HIP_MEMORY_SCOPE_AGENT); }
__device__ __forceinline__ unsigned xb_add(unsigned* p, unsigned v) { return __hip_atomic_fetch_add(p, v, __ATOMIC_RELAXED, __HIP_MEMORY_SCOPE_AGENT); }
__device__ __forceinline__ unsigned xb_xcc_id() { return (unsigned)__builtin_amdgcn_s_getreg((3 << 11) | 20) & 0xFu; }
#define XB_SPIN(cond, bar) do { unsigned _sp = 0; while (cond) { __builtin_amdgcn_s_sleep(1); \
    if ((++_sp & 255u) == 0u) { if (xb_ld(&(bar)[XB_TMO])) break; if (_sp > XB_SPIN_CAP) { atomicAdd(&(bar)[XB_TMO], 1u); break; } } } } while (0)

struct XcdBarrier {
    unsigned* bar; unsigned x;
    volatile LAS unsigned* st;
};

__device__ __forceinline__ XcdBarrier xcd_barrier_post(unsigned* bar, volatile LAS unsigned* st) {
    XcdBarrier b; b.bar = bar; b.x = xb_xcc_id(); b.st = st;
    if (threadIdx.x == 0) (void)xb_add(&bar[XB_XCNT(b.x)], 1u);
    return b;
}
__device__ __forceinline__ void xcd_barrier_complete(unsigned* bar, unsigned x, unsigned& nloc, unsigned& nx) {
    const unsigned G = gridDim.x * gridDim.y * gridDim.z;
    unsigned sum, cnt, mine, sp = 0u;
    for (;;) {
        sum = 0u; cnt = 0u; mine = 0u;
#pragma unroll
        for (unsigned j = 0; j < 16; ++j) { const unsigned c = xb_ld(&bar[XB_XCNT(j)]); sum += c; cnt += (c > 0u) ? 1u : 0u; mine = (j == x) ? c : mine; }
        if (sum == G) break;
        __builtin_amdgcn_s_sleep(1);
        if ((++sp & 255u) == 0u) { if (xb_ld(&bar[XB_TMO])) break; if (sp > XB_SPIN_CAP) { atomicAdd(&bar[XB_TMO], 1u); break; } }
    }
    nloc = mine > 0u ? mine : 1u; nx = cnt > 0u ? cnt : 1u;
}

__device__ __forceinline__ void xcd_barrier(const XcdBarrier& b) {
    asm volatile("s_waitcnt vmcnt(0)" ::: "memory");
    __syncthreads();
    if (threadIdx.x == 0) {
        unsigned* bar = b.bar;
        __builtin_amdgcn_s_waitcnt(0);
        unsigned nloc = b.st[0], nx = b.st[1];
        if (nloc == 0u) { xcd_barrier_complete(bar, b.x, nloc, nx); b.st[0] = nloc; b.st[1] = nx; }
        const unsigned old = xb_add(&bar[XB_XSUB(b.x)], 1u);
        const unsigned gen = old / nloc;
        if (old + 1u == (gen + 1u) * nloc) {
            __builtin_amdgcn_fence(__ATOMIC_RELEASE, "agent");
            asm volatile("s_waitcnt vmcnt(0)" ::: "memory");
            const unsigned og = xb_add(&bar[XB_TOP], 1u);
            const unsigned tg = og / nx;
            if (og + 1u == (tg + 1u) * nx) xb_add(&bar[XB_TOPGEN], 1u);
            else XB_SPIN(xb_ld(&bar[XB_TOPGEN]) == tg, bar);
            __builtin_amdgcn_fence(__ATOMIC_ACQUIRE, "agent");
            xb_add(&bar[XB_XGEN(b.x)], 1u);
            asm volatile("s_waitcnt vmcnt(0)" ::: "memory");
        } else {
            XB_SPIN(xb_ld(&bar[XB_XGEN(b.x)]) == gen, bar);
            __builtin_amdgcn_fence(__ATOMIC_ACQUIRE, "agent");
            asm volatile("s_waitcnt vmcnt(0)" ::: "memory");
        }
    }
    __syncthreads();
}


enum { PH_CONV = 0, PH_NORM0, PH_G1, PH_PREP, PH_ATTN, PH_SSD, PH_GNORM, PH_G2, PH_CVX0, PH_ROUTE0, PH_TOPK0, PH_GATHER0, PH_UP0, PH_DOWN0, PH_COMB0, PH_G3, PH_CONV3, PH_G4, PH_CVX1, PH_ROUTE1, PH_TOPK1, PH_GATHER1, PH_UP1,
       PH_DOWN1, PH_COMB1, NPH };

constexpr int LDS_BYTES = 147456;
constexpr int LDS_XB = LDS_BYTES - 16;
__global__ void __launch_bounds__(512, 2) fwd(P p, int lo, int hi) {
    extern __shared__ __attribute__((aligned(16))) unsigned char shm[];
    LAS unsigned char* lds = (LAS unsigned char*)shm;
    XcdBarrier bar; bar.bar = p.bar; bar.x = 0; bar.st = (volatile LAS unsigned*)(lds + LDS_XB);
    if (hi - lo > 1) {
        if (threadIdx.x == 0) { ((LAS unsigned*)(lds + LDS_XB))[0] = 0u; ((LAS unsigned*)(lds + LDS_XB))[1] = 0u; }
        __syncthreads();
        bar = xcd_barrier_post(p.bar, (volatile LAS unsigned*)(lds + LDS_XB));
    }
#define PHASE(i, body) if (lo <= (i) && (i) < hi) { body; if ((i) + 1 < hi) xcd_barrier(bar); }
    PHASE(PH_CONV, ph_convert_small(p))
    PHASE(PH_NORM0, ph_rmsnorm(p.x, p.attn_norm, p.hn))
    PHASE(PH_G1, nv_g1(p))
    PHASE(PH_PREP, ph_prep(p))
    PHASE(PH_ATTN, nv_attn(p))
    PHASE(PH_SSD, nv_ssd(p))
    PHASE(PH_GNORM, ph_gated_norm(p))
    PHASE(PH_G2, nv_g2(p))
    PHASE(PH_CVX0, ph_convert_experts(p, 0))
    PHASE(PH_ROUTE0, ph_norm_router(p, 0))
    PHASE(PH_TOPK0, nv_topk(p))
    PHASE(PH_GATHER0, ph_gather(p))
    PHASE(PH_UP0, nv_up(p))
    PHASE(PH_DOWN0, nv_down(p))
    PHASE(PH_COMB0, ph_combine(p, p.conv_norm))
    PHASE(PH_G3, nv_g3(p))
    PHASE(PH_CONV3, ph_conv3(p))
    PHASE(PH_G4, nv_g4(p))
    PHASE(PH_CVX1, ph_convert_experts(p, 1))
    PHASE(PH_ROUTE1, ph_norm_router(p, 1))
    PHASE(PH_TOPK1, nv_topk(p))
    PHASE(PH_GATHER1, ph_gather(p))
    PHASE(PH_UP1, nv_up(p))
    PHASE(PH_DOWN1, nv_down(p))
    PHASE(PH_COMB1, ph_combine(p, nullptr))
}

extern "C" void kernel_launch(void* const* d_in, const int* in_sizes, int n_in, void* d_out, int out_size, void* d_ws, size_t ws_size, hipStream_t stream) {
    (void)in_sizes; (void)n_in; (void)out_size; (void)ws_size;
    P p{};
    make_params(p, d_in, d_out, d_ws);
    static int grid = 0;
    if (grid == 0) {
        int dev = 0, cus = 0;
        if (hipGetDevice(&dev) != hipSuccess || hipDeviceGetAttribute(&cus, hipDeviceAttributeMultiprocessorCount, dev) != hipSuccess) cus = 256;
        (void)hipFuncSetAttribute((const void*)fwd, hipFuncAttributeMaxDynamicSharedMemorySize, LDS_BYTES);
        (void)hipGetLastError();
        grid = cus > 0 ? cus : 256;
    }
#if ONE_LAUNCH
    (void)hipMemsetAsync(p.bar, 0, XCD_BAR_WORDS * sizeof(unsigned), stream);
    hipLaunchKernelGGL(fwd, dim3(grid), dim3(512), LDS_BYTES, stream, p, 0, (int)NPH);
#else
    for (int ph = 0; ph < NPH; ++ph) hipLaunchKernelGGL(fwd, dim3(grid), dim3(512), LDS_BYTES, stream, p, ph, ph + 1);
#endif
}
#endif
```

```cpp
#ifndef HOST_EMU
#include <hip/hip_runtime.h>
#define HD __host__ __device__ __forceinline__
#define DEV __device__ __forceinline__
#else
#include <cmath>
#include <cstdio>
#include <cstdlib>
#include <cstring>
#include <cstddef>
#define HD inline
#define DEV inline
struct float4 { float x, y, z, w; };
struct uint4 { unsigned x, y, z, w; };
struct uint2 { unsigned x, y; };
static thread_local size_t emu_tid = 0; static size_t emu_nthreads = 1;
#endif

#ifndef BATCH
#define BATCH 2
#endif
#ifndef SEQ
#define SEQ 16384
#endif
#ifndef NAIVE_GEMM
#define NAIVE_GEMM 0
#endif
#ifndef NAIVE_ATTN
#define NAIVE_ATTN 0
#endif
#ifndef NAIVE_SSD
#define NAIVE_SSD 0
#endif
#ifndef NAIVE_TOPK
#define NAIVE_TOPK 0
#endif
#ifndef ONE_LAUNCH
#define ONE_LAUNCH 1
#endif

typedef unsigned short bf16_t;
constexpr int T = BATCH * SEQ;
constexpr int DM = 1024;
constexpr int NIN = 5664, NIN_PAD = 5888;
constexpr int NE = 16;
constexpr int CAP = 2 * SEQ / NE;
constexpr int NSLOT = BATCH * NE * CAP;
constexpr int DFF = 2048;
constexpr int NCHUNK = SEQ / 128;

HD float bf2f(bf16_t v) { union { unsigned u; float f; } x; x.u = ((unsigned)v) << 16; return x.f; }
HD bf16_t f2bf(float f) { union { unsigned u; float f; } x; x.f = f; unsigned u = x.u; u += 0x7fffu + ((u >> 16) & 1u); return (bf16_t)(u >> 16); }
HD unsigned pack2(float lo, float hi) { return (unsigned)f2bf(lo) | ((unsigned)f2bf(hi) << 16); }
HD float silu_f(float v) { return v / (1.0f + expf(-v)); }
HD float softplus_f(float v) { return v > 20.f ? v : log1pf(expf(v)); }

#ifndef HOST_EMU
#define LANES 64
#define GTID ((size_t)blockIdx.x * blockDim.x + threadIdx.x)
#define GSTRIDE ((size_t)gridDim.x * blockDim.x)
#define LANE ((int)(threadIdx.x & 63))
DEV float wave_sum(float v) {
#pragma unroll
    for (int o = 32; o >= 1; o >>= 1) v += __shfl_xor(v, o);
    return v;
}
#else
#define LANES 1
#define GTID (emu_tid)
#define GSTRIDE (emu_nthreads)
#define LANE 0
DEV float wave_sum(float v) { return v; }
#endif
#define GWAVE (GTID / LANES)
#define NWAVES_G (GSTRIDE / LANES)

struct P {
    const float *x, *attn_norm, *w_in, *q_norm, *k_norm, *conv_w, *conv_b, *a_log_f, *a_log_b, *dtb_f, *dtb_b, *ssd_d, *out_norm, *w_out,
        *conv_norm, *cw_in, *cw, *cw_out, *ffn_norm, *router_w, *wg, *wu, *wd;
    float* out;
    bf16_t *WinT, *WoutT, *WciT, *WcoT, *WguT, *WdT, *hn, *qkv, *z, *xbcraw, *bc, *xsT, *bmT, *states, *mix, *yssd, *xe, *hid, *ye, *pbuf, *gb, *abuf;
    float *dtraw, *step, *stT, *csT, *wdT, *cdec, *aff, *gate, *rope, *ytmp;
    int *idx, *slotmap;
    unsigned* bar;
};

constexpr size_t MiB = 1024 * 1024;
constexpr size_t al(size_t v) { return (v + 4095) & ~(size_t)4095; }
constexpr size_t WS_BAR = 0;
constexpr size_t WS_WIN = 65536;
constexpr size_t WS_WOUT = WS_WIN + al((size_t)NIN_PAD * 1024 * 2);
constexpr size_t WS_WCI = WS_WOUT + al((size_t)1024 * 2048 * 2);
constexpr size_t WS_WCO = WS_WCI + al((size_t)3072 * 1024 * 2);
constexpr size_t WS_WGU = WS_WCO + al((size_t)1024 * 1024 * 2);
constexpr size_t WS_WD = WS_WGU + al((size_t)NE * 4096 * 1024 * 2);
constexpr size_t WS_ROPE = WS_WD + al((size_t)NE * 1024 * 2048 * 2);
constexpr size_t WS_AFF = WS_ROPE + al((size_t)SEQ * 16 * 4);
constexpr size_t WS_GATE = WS_AFF + al((size_t)BATCH * NE * SEQ * 4);
constexpr size_t WS_IDX = WS_GATE + al((size_t)NSLOT * 4);
constexpr size_t WS_SMAP = WS_IDX + al((size_t)NSLOT * 4);
constexpr size_t WS_HN = WS_SMAP + al((size_t)BATCH * NE * SEQ * 4);
constexpr size_t WS_E = WS_HN + al((size_t)T * 1024 * 2);
constexpr size_t WS_XBCRAW = WS_E;
constexpr size_t WS_QKV = WS_XBCRAW + al((size_t)T * 1536 * 2);
constexpr size_t WS_Z = WS_QKV + al((size_t)T * 3072 * 2);
constexpr size_t WS_BC = WS_Z + al((size_t)T * 1024 * 2);
constexpr size_t WS_XST = WS_BC + al((size_t)T * 512 * 2);
constexpr size_t WS_BMT = WS_XST + al((size_t)T * 1024 * 2);
constexpr size_t WS_DTRAW = WS_BMT + al((size_t)T * 256 * 2);
constexpr size_t WS_STEP = WS_DTRAW + al((size_t)T * 32 * 4);
constexpr size_t WS_STT = WS_STEP + al((size_t)T * 32 * 4);
constexpr size_t WS_CST = WS_STT + al((size_t)T * 32 * 4);
constexpr size_t WS_WDT = WS_CST + al((size_t)T * 32 * 4);
constexpr size_t WS_CDEC = WS_WDT + al((size_t)T * 32 * 4);
constexpr size_t WS_MIX = WS_CDEC + al((size_t)BATCH * 32 * NCHUNK * 4);
constexpr size_t WS_YSSD = WS_MIX + al((size_t)T * 2048 * 2);
constexpr size_t WS_E_END = WS_YSSD + al((size_t)T * 1024 * 2);
constexpr size_t WS_STATES = WS_HN;
constexpr size_t WS_XE = WS_E;
constexpr size_t WS_HID = WS_XE + al((size_t)NSLOT * 1024 * 2);
constexpr size_t WS_YE = WS_HID + al((size_t)NSLOT * 2048 * 2);
constexpr size_t WS_F_END = WS_YE + al((size_t)NSLOT * 1024 * 2);
constexpr size_t WS_PBUF = WS_E;
constexpr size_t WS_GB = WS_PBUF + al((size_t)T * 1024 * 2);
constexpr size_t WS_ABUF = WS_GB + al((size_t)T * 1024 * 2);
constexpr size_t WS_END = WS_E_END > WS_F_END ? WS_E_END : WS_F_END;
static_assert((size_t)T * 1024 * 2 + (size_t)T * 1536 * 2 >= (size_t)T * 1024 * 4, "ytmp overlay");
static_assert((size_t)T * 1024 * 2 + (size_t)T * 1536 * 2 >= (size_t)BATCH * 2 * NCHUNK * 16 * 64 * 128 * 2, "states overlay");
static_assert(BATCH != 2 || SEQ != 16384 || WS_END <= 1024 * MiB, "workspace");

struct CmIdent { int nvalid; HD int operator()(int n) const { return n < nvalid ? n : -1; } };
struct CmGateUp { HD int operator()(int n) const { return n; } };
struct CmOddIn { HD int operator()(int n) const {
        if (n >= 2048) return n - 2048; const int pn = n >> 8, j = n & 255; return j < 128 ? 1024 + pn * 128 + j : 2048 + pn * 128 + (j - 128); } };

template <class CM> DEV void convT(const float* src, int ldsrc, int K, bf16_t* dst, int Ndst, CM cm) {
#ifndef HOST_EMU
    const size_t nitems = (size_t)Ndst * (K / 8);
    for (size_t i = GTID; i < nitems; i += GSTRIDE) {
        const int n = (int)(i % Ndst), k8 = (int)(i / Ndst); const int c = cm(n);
        unsigned w[4];
#pragma unroll
        for (int j = 0; j < 4; ++j) { float a = 0.f, b = 0.f; if (c >= 0) { a = src[(size_t)(k8 * 8 + 2 * j) * ldsrc + c]; b = src[(size_t)(k8 * 8 + 2 * j + 1) * ldsrc + c]; } w[j] = pack2(a, b); }
        *(uint4*)(dst + (size_t)n * K + k8 * 8) = uint4{w[0], w[1], w[2], w[3]};
    }
#else
    for (size_t i = GTID; i < (size_t)Ndst * K; i += GSTRIDE) { const int n = (int)(i / K), k = (int)(i % K); const int c = cm(n); dst[i] = c >= 0 ? f2bf(src[(size_t)k * ldsrc + c]) : (bf16_t)0; }
#endif
}
struct CmGU { const float* dummy; HD int operator()(int n) const { return n; } };
template <int WHICH> struct CmHalf { HD int operator()(int n) const { const int j = n & 255; const bool isup = j >= 128; if ((int)isup != WHICH) return -2; return (n >> 8) * 128 + (j & 127); } };
DEV void conv_gateup(const float* sg, const float* su, bf16_t* dst) {
#ifndef HOST_EMU
    const size_t nitems = (size_t)4096 * 128;
    for (size_t i = GTID; i < nitems; i += GSTRIDE) {
        const int n = (int)(i % 4096), k8 = (int)(i / 4096); const int j = n & 255; const float* src = j >= 128 ? su : sg; const int c = (n >> 8) * 128 + (j & 127);
        unsigned w[4];
#pragma unroll
        for (int q = 0; q < 4; ++q) w[q] = pack2(src[(size_t)(k8 * 8 + 2 * q) * 2048 + c], src[(size_t)(k8 * 8 + 2 * q + 1) * 2048 + c]);
        *(uint4*)(dst + (size_t)n * 1024 + k8 * 8) = uint4{w[0], w[1], w[2], w[3]};
    }
#else
    for (size_t i = GTID; i < (size_t)4096 * 1024; i += GSTRIDE) { const int n = (int)(i / 1024), k = (int)(i % 1024); const int j = n & 255; const float* src = j >= 128 ? su : sg; dst[i] = f2bf(src[(size_t)k * 2048 + (n >> 8) * 128 + (j & 127)]); }
#endif
}
DEV void ph_convert_small(const P& p) {
    convT(p.w_in, NIN, 1024, p.WinT, NIN_PAD, CmIdent{NIN});
    convT(p.w_out, 1024, 2048, p.WoutT, 1024, CmIdent{1024});
    convT(p.cw_in, 3072, 1024, p.WciT, 3072, CmOddIn{});
    convT(p.cw_out, 1024, 1024, p.WcoT, 1024, CmIdent{1024});
    for (size_t i = GTID; i < (size_t)SEQ * 8; i += GSTRIDE) {
        const int pos = (int)(i >> 3), j = (int)(i & 7);
        const float inv = powf(500000.0f, -((float)j * 2.0f / 16.0f)); const float ang = (float)pos * inv;
        p.rope[(size_t)pos * 16 + j] = cosf(ang); p.rope[(size_t)pos * 16 + 8 + j] = sinf(ang);
    }
}
DEV void ph_convert_experts(const P& p, int layer) {
    for (int e = 0; e < NE; ++e) {
        const size_t off = ((size_t)layer * NE + e) * 1024 * 2048;
        conv_gateup(p.wg + off, p.wu + off, p.WguT + (size_t)e * 4096 * 1024);
        convT(p.wd + off, 1024, 2048, p.WdT + (size_t)e * 1024 * 2048, 1024, CmIdent{1024});
    }
}

constexpr int NV = 256 / LANES;
DEV void ph_rmsnorm(const float* src, const float* g, bf16_t* dst) {
    for (size_t row = GWAVE; row < (size_t)T; row += NWAVES_G) {
        const float4* s4 = (const float4*)(src + row * 1024); float4 v[NV]; float ss = 0.f;
#pragma unroll
        for (int j = 0; j < NV; ++j) { v[j] = s4[j * LANES + LANE]; ss += v[j].x * v[j].x + v[j].y * v[j].y + v[j].z * v[j].z + v[j].w * v[j].w; }
        ss = wave_sum(ss); const float r = 1.0f / sqrtf(ss * (1.0f / 1024.0f) + 1e-6f);
#pragma unroll
        for (int j = 0; j < NV; ++j) { const int c4 = j * LANES + LANE; const float4 gg = ((const float4*)g)[c4];
            *(uint2*)(dst + row * 1024 + c4 * 4) = uint2{pack2(v[j].x * r * gg.x, v[j].y * r * gg.y), pack2(v[j].z * r * gg.z, v[j].w * r * gg.w)}; }
    }
}
DEV void ph_norm_router(const P& p, int layer) {
    const float* g = p.ffn_norm + (size_t)layer * 1024; const float* rw = p.router_w + (size_t)layer * 1024 * 16;
    for (size_t row = GWAVE; row < (size_t)T; row += NWAVES_G) {
        const float4* s4 = (const float4*)(p.out + row * 1024); float4 v[NV]; float ss = 0.f;
#pragma unroll
        for (int j = 0; j < NV; ++j) { v[j] = s4[j * LANES + LANE]; ss += v[j].x * v[j].x + v[j].y * v[j].y + v[j].z * v[j].z + v[j].w * v[j].w; }
        ss = wave_sum(ss); const float r = 1.0f / sqrtf(ss * (1.0f / 1024.0f) + 1e-6f);
        float lg[16];
#pragma unroll
        for (int e = 0; e < 16; ++e) lg[e] = 0.f;
#pragma unroll
        for (int j = 0; j < NV; ++j) { const int c4 = j * LANES + LANE; const float4 gg = ((const float4*)g)[c4];
            const float h0 = v[j].x * r * gg.x, h1 = v[j].y * r * gg.y, h2 = v[j].z * r * gg.z, h3 = v[j].w * r * gg.w;
            *(uint2*)(p.hn + row * 1024 + c4 * 4) = uint2{pack2(h0, h1), pack2(h2, h3)};
            const float4* w4 = (const float4*)(rw + (size_t)c4 * 4 * 16);
#pragma unroll
            for (int q = 0; q < 4; ++q) { const float4 a = w4[q], b = w4[4 + q], c = w4[8 + q], d = w4[12 + q];
                lg[4 * q + 0] += h0 * a.x + h1 * b.x + h2 * c.x + h3 * d.x; lg[4 * q + 1] += h0 * a.y + h1 * b.y + h2 * c.y + h3 * d.y;
                lg[4 * q + 2] += h0 * a.z + h1 * b.z + h2 * c.z + h3 * d.z; lg[4 * q + 3] += h0 * a.w + h1 * b.w + h2 * c.w + h3 * d.w; } }
        float mx = -1e30f;
#pragma unroll
        for (int e = 0; e < 16; ++e) { lg[e] = wave_sum(lg[e]); mx = fmaxf(mx, lg[e]); }
        float den = 0.f;
#pragma unroll
        for (int e = 0; e < 16; ++e) { lg[e] = expf(lg[e] - mx); den += lg[e]; }
        const float inv = 1.0f / den; const int b = (int)(row / SEQ), s = (int)(row % SEQ);
#pragma unroll
        for (int e = 0; e < 16; ++e) if (LANE == (e & (LANES - 1))) p.aff[((size_t)b * NE + e) * SEQ + s] = lg[e] * inv;
    }
}
DEV void ph_gated_norm(const P& p) {
    for (size_t row = GWAVE; row < (size_t)T; row += NWAVES_G) {
        float4 v[NV]; float ss = 0.f;
#pragma unroll
        for (int j = 0; j < NV; ++j) { const int c4 = j * LANES + LANE; const uint2 y = *(const uint2*)(p.yssd + row * 1024 + c4 * 4), zz = *(const uint2*)(p.z + row * 1024 + c4 * 4);
            v[j].x = bf2f((bf16_t)(y.x & 0xffff)) * silu_f(bf2f((bf16_t)(zz.x & 0xffff))); v[j].y = bf2f((bf16_t)(y.x >> 16)) * silu_f(bf2f((bf16_t)(zz.x >> 16)));
            v[j].z = bf2f((bf16_t)(y.y & 0xffff)) * silu_f(bf2f((bf16_t)(zz.y & 0xffff))); v[j].w = bf2f((bf16_t)(y.y >> 16)) * silu_f(bf2f((bf16_t)(zz.y >> 16)));
            ss += v[j].x * v[j].x + v[j].y * v[j].y + v[j].z * v[j].z + v[j].w * v[j].w; }
        ss = wave_sum(ss); const float r = 1.0f / sqrtf(ss * (1.0f / 1024.0f) + 1e-6f);
#pragma unroll
        for (int j = 0; j < NV; ++j) { const int c4 = j * LANES + LANE; const float4 gg = ((const float4*)p.out_norm)[c4];
            *(uint2*)(p.mix + row * 2048 + 1024 + c4 * 4) = uint2{pack2(v[j].x * r * gg.x, v[j].y * r * gg.y), pack2(v[j].z * r * gg.z, v[j].w * r * gg.w)}; }
    }
}
DEV void ph_combine(const P& p, const float* g) {
    for (size_t row = GWAVE; row < (size_t)T; row += NWAVES_G) {
        const int b = (int)(row / SEQ), s = (int)(row % SEQ);
        float4* o4 = (float4*)(p.out + row * 1024); float4 v[NV];
#pragma unroll
        for (int j = 0; j < NV; ++j) v[j] = o4[j * LANES + LANE];
        for (int e = 0; e < NE; ++e) {
            const int sl = p.slotmap[((size_t)b * NE + e) * SEQ + s];
            if (sl >= 0) { const size_t r = ((size_t)b * NE + e) * CAP + sl; const float gt = p.gate[r];
#pragma unroll
                for (int j = 0; j < NV; ++j) { const int c4 = j * LANES + LANE; const uint2 y = *(const uint2*)(p.ye + r * 1024 + c4 * 4);
                    v[j].x += gt * bf2f((bf16_t)(y.x & 0xffff)); v[j].y += gt * bf2f((bf16_t)(y.x >> 16)); v[j].z += gt * bf2f((bf16_t)(y.y & 0xffff)); v[j].w += gt * bf2f((bf16_t)(y.y >> 16)); } }
        }
        float ss = 0.f;
#pragma unroll
        for (int j = 0; j < NV; ++j) { o4[j * LANES + LANE] = v[j]; ss += v[j].x * v[j].x + v[j].y * v[j].y + v[j].z * v[j].z + v[j].w * v[j].w; }
        if (g) { ss = wave_sum(ss); const float r = 1.0f / sqrtf(ss * (1.0f / 1024.0f) + 1e-6f);
#pragma unroll
            for (int j = 0; j < NV; ++j) { const int c4 = j * LANES + LANE; const float4 gg = ((const float4*)g)[c4];
                *(uint2*)(p.hn + row * 1024 + c4 * 4) = uint2{pack2(v[j].x * r * gg.x, v[j].y * r * gg.y), pack2(v[j].z * r * gg.z, v[j].w * r * gg.w)}; } }
    }
}

DEV void ld8(const bf16_t* p, float (&f)[8]) { const uint4 u = *(const uint4*)p; const unsigned w[4] = {u.x, u.y, u.z, u.w};
#pragma unroll
    for (int j = 0; j < 4; ++j) { f[2 * j] = bf2f((bf16_t)(w[j] & 0xffff)); f[2 * j + 1] = bf2f((bf16_t)(w[j] >> 16)); } }
DEV void st8(bf16_t* p, const float (&f)[8]) { *(uint4*)p = uint4{pack2(f[0], f[1]), pack2(f[2], f[3]), pack2(f[4], f[5]), pack2(f[6], f[7])}; }

DEV void ph_prep(const P& p) {
    for (size_t i = GTID; i < (size_t)T * 32; i += GSTRIDE) {
        const size_t t = i >> 5; const int hh = (int)(i & 31); const int isk = hh >> 4, h = hh & 15; const int pos = (int)(t % SEQ);
        bf16_t* ptr = p.qkv + t * 3072 + isk * 1024 + h * 64; const float* gn = isk ? p.k_norm : p.q_norm;
        float v[64]; float ss = 0.f;
#pragma unroll
        for (int c = 0; c < 8; ++c) { float f[8]; ld8(ptr + c * 8, f);
#pragma unroll
            for (int j = 0; j < 8; ++j) { v[c * 8 + j] = f[j]; ss += f[j] * f[j]; } }
        const float r = 1.0f / sqrtf(ss * (1.0f / 64.0f) + 1e-6f);
#pragma unroll
        for (int c = 0; c < 64; ++c) v[c] = v[c] * r * gn[c];
#pragma unroll
        for (int j = 0; j < 8; ++j) { const float cs = p.rope[(size_t)pos * 16 + j], sn = p.rope[(size_t)pos * 16 + 8 + j]; const float x1 = v[j], x2 = v[8 + j]; v[j] = x1 * cs - x2 * sn; v[8 + j] = x2 * cs + x1 * sn; }
#pragma unroll
        for (int c = 0; c < 8; ++c) { float f[8];
#pragma unroll
            for (int j = 0; j < 8; ++j) f[j] = v[c * 8 + j];
            st8(ptr + c * 8, f); }
    }
    for (size_t i = GTID; i < (size_t)T * 192; i += GSTRIDE) {
        const size_t t = i % T; const int c8 = (int)(i / T) * 8; const int pos = (int)(t % SEQ); const int b = (int)(t / SEQ);
        float acc[8];
#pragma unroll
        for (int j = 0; j < 8; ++j) acc[j] = p.conv_b[c8 + j];
#pragma unroll
        for (int k = 0; k < 5; ++k) { const int pp = pos + k - 2; if (pp < 0 || pp >= SEQ) continue; float f[8]; ld8(p.xbcraw + (t + k - 2) * 1536 + c8, f);
#pragma unroll
            for (int j = 0; j < 8; ++j) acc[j] += f[j] * p.conv_w[k * 1536 + c8 + j]; }
#pragma unroll
        for (int j = 0; j < 8; ++j) acc[j] = silu_f(acc[j]);
        if (c8 < 1024) {
#pragma unroll
            for (int j = 0; j < 8; ++j) p.xsT[((size_t)b * 1024 + c8 + j) * SEQ + pos] = f2bf(acc[j]);
        } else {
            st8(p.bc + t * 512 + (c8 - 1024), acc);
            if (c8 < 1280) {
#pragma unroll
                for (int j = 0; j < 8; ++j) p.bmT[((size_t)b * 256 + (c8 - 1024) + j) * SEQ + pos] = f2bf(acc[j]); }
        }
    }
    for (size_t i = GTID; i < (size_t)BATCH * NCHUNK * 32; i += GSTRIDE) {
        const int j = (int)(i & 31); const int c = (int)((i >> 5) % NCHUNK), b = (int)((i >> 5) / NCHUNK); const int dir = j >> 4, h = j & 15;
        const float A = -expf(dir ? p.a_log_b[h] : p.a_log_f[h]), bias = dir ? p.dtb_b[h] : p.dtb_f[h];
        const size_t row0 = (size_t)b * SEQ + (size_t)c * 128; float* stT = p.stT + ((size_t)b * 32 + j) * SEQ + c * 128; float* csT = p.csT + ((size_t)b * 32 + j) * SEQ + c * 128; float* wdT = p.wdT + ((size_t)b * 32 + j) * SEQ + c * 128;
        float run = 0.f;
        for (int ll = 0; ll < 128; ++ll) { const int l = dir ? 127 - ll : ll; const float dt = softplus_f(p.dtraw[(row0 + l) * 32 + j] + bias); p.step[(row0 + l) * 32 + j] = dt; stT[l] = dt; run += dt * A; csT[l] = run; }
        for (int l = 0; l < 128; ++l) wdT[l] = stT[l] * expf(run - csT[l]);
        p.cdec[((size_t)b * 32 + j) * NCHUNK + c] = expf(run);
    }
}
DEV void ph_gather(const P& p) {
    for (size_t i = GTID; i < (size_t)NSLOT * 128; i += GSTRIDE) { const size_t r = i >> 7; const int j = (int)(i & 127); const int b = (int)(r / ((size_t)NE * CAP));
        *(uint4*)(p.xe + r * 1024 + j * 8) = *(const uint4*)(p.hn + ((size_t)b * SEQ + p.idx[r]) * 1024 + j * 8); }
}
DEV void ph_conv3(const P& p) {
    for (size_t i = GTID; i < (size_t)T * 128; i += GSTRIDE) {
        const size_t t = i >> 7; const int c8 = (int)(i & 127) * 8; const int pos = (int)(t % SEQ);
        float acc[8], f[8];
#pragma unroll
        for (int j = 0; j < 8; ++j) acc[j] = 0.f;
#pragma unroll
        for (int k = 0; k < 3; ++k) { const int pp = pos + k - 1; if (pp < 0 || pp >= SEQ) continue; ld8(p.pbuf + (t + k - 1) * 1024 + c8, f);
#pragma unroll
            for (int j = 0; j < 8; ++j) acc[j] += f[j] * p.cw[k * 1024 + c8 + j]; }
        ld8(p.gb + t * 1024 + c8, f);
#pragma unroll
        for (int j = 0; j < 8; ++j) acc[j] *= f[j];
        st8(p.abuf + t * 1024 + c8, acc);
    }
}

DEV float dot_bf(const bf16_t* a, const bf16_t* b, int K) { float acc = 0.f; for (int k = 0; k < K; k += 8) { float fa[8], fb[8]; ld8(a + k, fa); ld8(b + k, fb);
#pragma unroll
        for (int j = 0; j < 8; ++j) acc += fa[j] * fb[j]; } return acc; }
DEV void nv_g1(const P& p) {
    for (size_t i = GTID; i < (size_t)T * NIN; i += GSTRIDE) { const size_t m = i / NIN; const int n = (int)(i % NIN); const float acc = dot_bf(p.hn + m * 1024, p.WinT + (size_t)n * 1024, 1024);
        if (n < 3072) p.qkv[m * 3072 + n] = f2bf(acc); else if (n < 4096) p.z[m * 1024 + n - 3072] = f2bf(acc); else if (n < 5632) p.xbcraw[m * 1536 + n - 4096] = f2bf(acc); else p.dtraw[m * 32 + n - 5632] = acc; }
}
DEV void nv_g2(const P& p) {
    for (size_t i = GTID; i < (size_t)T * 1024; i += GSTRIDE) { const size_t m = i >> 10; const int n = (int)(i & 1023); p.out[i] = p.x[i] + dot_bf(p.mix + m * 2048, p.WoutT + (size_t)n * 2048, 2048); }
}
DEV void nv_up(const P& p) {
    for (size_t i = GTID; i < (size_t)NSLOT * 2048; i += GSTRIDE) { const size_t r = i >> 11; const int n = (int)(i & 2047); const int e = (int)((r / CAP) % NE);
        const bf16_t* w = p.WguT + (size_t)e * 4096 * 1024 + (size_t)((n >> 7) * 256 + (n & 127)) * 1024;
        const float g = dot_bf(p.xe + r * 1024, w, 1024), u = dot_bf(p.xe + r * 1024, w + (size_t)128 * 1024, 1024); p.hid[i] = f2bf(silu_f(g) * u); }
}
DEV void nv_down(const P& p) {
    for (size_t i = GTID; i < (size_t)NSLOT * 1024; i += GSTRIDE) { const size_t r = i >> 10; const int n = (int)(i & 1023); const int e = (int)((r / CAP) % NE);
        p.ye[i] = f2bf(dot_bf(p.hid + r * 2048, p.WdT + (size_t)e * 1024 * 2048 + (size_t)n * 2048, 2048)); }
}
DEV void nv_g3(const P& p) {
    for (size_t i = GTID; i < (size_t)T * 2048; i += GSTRIDE) { const size_t m = i >> 11; const int n = (int)(i & 2047);
        if (n < 1024) { const bf16_t* w = p.WciT + (size_t)((n >> 7) * 256 + (n & 127)) * 1024; p.pbuf[m * 1024 + n] = f2bf(dot_bf(p.hn + m * 1024, w, 1024) * dot_bf(p.hn + m * 1024, w + (size_t)128 * 1024, 1024)); }
        else p.gb[m * 1024 + n - 1024] = f2bf(dot_bf(p.hn + m * 1024, p.WciT + (size_t)(2048 + n - 1024) * 1024, 1024)); }
}
DEV void nv_g4(const P& p) {
    for (size_t i = GTID; i < (size_t)T * 1024; i += GSTRIDE) { const size_t m = i >> 10; const int n = (int)(i & 1023); p.out[i] += dot_bf(p.abuf + m * 1024, p.WcoT + (size_t)n * 1024, 1024); }
}
DEV void nv_attn(const P& p) {
    for (size_t i = GTID; i < (size_t)T * 16; i += GSTRIDE) {
        const size_t t = i >> 4; const int h = (int)(i & 15); const int pos = (int)(t % SEQ); const size_t t0 = t - pos;
        const bf16_t* qp = p.qkv + t * 3072 + h * 64;
        float o[64]; float m = -1e30f, l = 0.f;
#pragma unroll
        for (int c = 0; c < 64; ++c) o[c] = 0.f;
        for (int pat = 0; pat < 3; ++pat) { const int d = pat == 0 ? 1 : (pat == 1 ? 4 : 16);
            for (int j = -64; j <= 64; ++j) { const int kp = pos + d * j; if (kp < 0 || kp >= SEQ) continue;
                const bf16_t* kr = p.qkv + (t0 + kp) * 3072 + 1024 + h * 64; const bf16_t* vr = kr + 1024;
                const float s = dot_bf(qp, kr, 64) * 0.125f;
                const float mn = fmaxf(m, s), sc = expf(m - mn), pe = expf(s - mn); l = l * sc + pe; m = mn;
#pragma unroll
                for (int c = 0; c < 8; ++c) { float f[8]; ld8(vr + c * 8, f);
#pragma unroll
                    for (int q = 0; q < 8; ++q) o[c * 8 + q] = o[c * 8 + q] * sc + pe * f[q]; } } }
        const float inv = 1.0f / l;
#pragma unroll
        for (int c = 0; c < 8; ++c) { float f[8];
#pragma unroll
            for (int q = 0; q < 8; ++q) f[q] = o[c * 8 + q] * inv;
            st8(p.mix + t * 2048 + h * 64 + c * 8, f); }
    }
}
DEV void nv_ssd(const P& p) {
    const size_t nitem = (size_t)BATCH * 16 * 64;
#ifndef HOST_EMU
    if (LANE != 0) return;
#endif
    for (size_t it = GWAVE; it < nitem; it += NWAVES_G) {
        const int b = (int)(it / 1024), h = (int)((it >> 6) & 15), pc = (int)(it & 63), g = h >> 3;
        const float af = -expf(p.a_log_f[h]), ab = -expf(p.a_log_b[h]), dsk = p.ssd_d[h];
        float st[128];
        for (int dir = 0; dir < 2; ++dir) {
#pragma unroll
            for (int n = 0; n < 128; ++n) st[n] = 0.f;
            for (int tt = 0; tt < SEQ; ++tt) { const int s = dir ? SEQ - 1 - tt : tt; const size_t row = (size_t)b * SEQ + s;
                const float dt = p.step[row * 32 + dir * 16 + h]; const float dec = expf(dt * (dir ? ab : af)); const float xv = bf2f(p.xsT[((size_t)b * 1024 + h * 64 + pc) * SEQ + s]); const float xdt = xv * dt;
                const bf16_t* bm = p.bc + row * 512 + g * 128; const bf16_t* cm = bm + 256; float y = 0.f;
#pragma unroll
                for (int n8 = 0; n8 < 16; ++n8) { float fb[8], fc[8]; ld8(bm + n8 * 8, fb); ld8(cm + n8 * 8, fc);
#pragma unroll
                    for (int j = 0; j < 8; ++j) { st[n8 * 8 + j] = st[n8 * 8 + j] * dec + xdt * fb[j]; y += fc[j] * st[n8 * 8 + j]; } }
                if (dir == 0) p.ytmp[row * 1024 + h * 64 + pc] = y; else p.yssd[row * 1024 + h * 64 + pc] = f2bf(p.ytmp[row * 1024 + h * 64 + pc] + y + xv * dsk); }
        }
    }
}
DEV void nv_topk(const P& p) {
    for (size_t i = GTID; i < (size_t)BATCH * NE * SEQ; i += GSTRIDE) { const size_t be = i / SEQ; const int s = (int)(i % SEQ); const float* a = p.aff + be * SEQ; const float v = a[s]; int rank = 0;
        for (int j = 0; j < SEQ; ++j) { const float w = a[j]; rank += (w > v || (w == v && j < s)) ? 1 : 0; }
        if (rank < CAP) { p.idx[be * CAP + rank] = s; p.gate[be * CAP + rank] = v; p.slotmap[i] = rank; } else p.slotmap[i] = -1; }
}

static void make_params(P& p, void* const* d_in, void* d_out, void* d_ws) {
    const float** ins = (const float**)&p.x;
    for (int i = 0; i < 23; ++i) ins[i] = (const float*)d_in[i];
    p.out = (float*)d_out;
    unsigned char* ws = (unsigned char*)d_ws;
    p.WinT = (bf16_t*)(ws + WS_WIN); p.WoutT = (bf16_t*)(ws + WS_WOUT); p.WciT = (bf16_t*)(ws + WS_WCI); p.WcoT = (bf16_t*)(ws + WS_WCO); p.WguT = (bf16_t*)(ws + WS_WGU); p.WdT = (bf16_t*)(ws + WS_WD);
    p.hn = (bf16_t*)(ws + WS_HN); p.qkv = (bf16_t*)(ws + WS_QKV); p.z = (bf16_t*)(ws + WS_Z); p.xbcraw = (bf16_t*)(ws + WS_XBCRAW); p.bc = (bf16_t*)(ws + WS_BC); p.xsT = (bf16_t*)(ws + WS_XST); p.bmT = (bf16_t*)(ws + WS_BMT); p.states = (bf16_t*)(ws + WS_STATES); p.mix = (bf16_t*)(ws + WS_MIX); p.yssd = (bf16_t*)(ws + WS_YSSD);
    p.xe = (bf16_t*)(ws + WS_XE); p.hid = (bf16_t*)(ws + WS_HID); p.ye = (bf16_t*)(ws + WS_YE); p.pbuf = (bf16_t*)(ws + WS_PBUF); p.gb = (bf16_t*)(ws + WS_GB); p.abuf = (bf16_t*)(ws + WS_ABUF);
    p.dtraw = (float*)(ws + WS_DTRAW); p.step = (float*)(ws + WS_STEP); p.aff = (float*)(ws + WS_AFF); p.gate = (float*)(ws + WS_GATE); p.rope = (float*)(ws + WS_ROPE); p.ytmp = (float*)(ws + WS_STATES); p.stT = (float*)(ws + WS_STT); p.csT = (float*)(ws + WS_CST); p.wdT = (float*)(ws + WS_WDT); p.cdec = (float*)(ws + WS_CDEC);
    p.idx = (int*)(ws + WS_IDX); p.slotmap = (int*)(ws + WS_SMAP); p.bar = (unsigned*)(ws + WS_BAR);
}
#ifndef HOST_EMU
#define LAS __attribute__((address_space(3)))
typedef short bf16x8 __attribute__((ext_vector_type(8)));
typedef float f32x4 __attribute__((ext_vector_type(4)));
typedef unsigned u32x4 __attribute__((ext_vector_type(4)));
namespace pg8 {
constexpr int BM = 256, BK = 64, HALF = 128, HTB = HALF * BK * 2  , STAGE_BYTES = 8 * HTB, NXCD = 8, WGM = 8;
DEV int lds_byte(int r, int c) { const int st = (r >> 4) * 2 + (c >> 5), rr = r & 15, cc = c & 31, ob = rr * 64 + cc * 2; return st * 1024 + (ob ^ (((ob >> 9) & 1) << 5)); }
DEV void stage_rc(int b, int& R, int& C) { const int st = b / 1024, sb = b % 1024, swz = sb ^ (((sb >> 9) & 1) << 5); R = (st >> 1) * 16 + swz / 64; C = (st & 1) * 32 + (swz % 64) / 2; }
DEV int perm32(int rho) { const int n = rho >> 4, i = rho & 15; return 8 * (i >> 2) + 4 * n + (i & 3); }
struct Unit { int row0, col0, brow0; };
struct StaticOrder {
    int nM, nN, nwg, G, c, brows, tpg;
    DEV void init(int M, int N, int G_, int c_, int brows_, int tpg_) { nM = M / BM; nN = N / BM; nwg = nM * nN; G = G_; c = c_; brows = brows_; tpg = tpg_; }
    DEV bool next(int i, Unit& u) const {
        const long L = (long)i * G + c; if (L >= nwg) return false;
        int wgid = (int)L; { const int q = nwg / NXCD, r = nwg % NXCD, xcd = wgid % NXCD, off = wgid / NXCD; wgid = (xcd < r ? xcd * (q + 1) : r * (q + 1) + (xcd - r) * q) + off; }
        const int nig = WGM * nN, gid = wgid / nig, fm = gid * WGM, gsz = (nM - fm) < WGM ? (nM - fm) : WGM;
        const int pm = fm + ((wgid % nig) % gsz), pn = (wgid % nig) / gsz;
        u.row0 = pm * BM; u.col0 = pn * BM; u.brow0 = pn * BM + (brows ? ((pm / tpg) % NE) * brows : 0); return true;
    }
};
DEV unsigned cvt_pk_bf16(float lo, float hi) { unsigned r; asm volatile("v_cvt_pk_bf16_f32 %0, %1, %2" : "=v"(r) : "v"(lo), "v"(hi)); return r; }
typedef float f32x2_t __attribute__((ext_vector_type(2)));
typedef __bf16 bf16x2_t __attribute__((ext_vector_type(2)));
DEV unsigned cvt_pk_safe(float lo, float hi) { const f32x2_t v = {lo, hi}; return __builtin_bit_cast(unsigned, __builtin_convertvector(v, bf16x2_t)); }

template <class Epi, class Sched>
DEV void gemm_phase(LAS unsigned char* lds, const bf16_t* A, const bf16_t* Bt, const int K, const Sched& S, const Epi& E) {
    const int tid = threadIdx.x, wid = __builtin_amdgcn_readfirstlane(tid >> 6), lane = tid & 63, wr = wid >> 2, wc = wid & 3, fr = lane & 15, fq = lane >> 4;
    const int nt = K / BK;
    unsigned voffA[2], voffB[2];
#pragma unroll
    for (int i = 0; i < 2; ++i) { int R, C; stage_rc(tid * 16 + i * 8192, R, C); const int Rb = Epi::PERM ? ((R & ~31) + perm32(R & 31)) : R;
        voffA[i] = (unsigned)(R * K + C) * 2u; voffB[i] = (unsigned)(Rb * K + C) * 2u; }
    const size_t kstep = (size_t)(BK * 2);
    const size_t hstep = (size_t)HALF * K * 2;
    const size_t rstep = (size_t)K * 2;
    const unsigned ldsw = (unsigned)wid * 1024u;
    const int aoff = lds_byte(wr * 64 + fr, fq * 8), boff = lds_byte(wc * 32 + fr, fq * 8);
#define PG8_SA(b, h) (((b) * 2 + (h)) * HTB)
#define PG8_SB(b, h) ((4 + (b) * 2 + (h)) * HTB)
#define PG8_STAGE(bufoff, gbase, voff) do { _Pragma("unroll") for (int _i = 0; _i < 2; ++_i) \
        __builtin_amdgcn_global_load_lds((const unsigned*)((const char*)(gbase) + (voff)[_i]), (LAS unsigned*)(lds + (bufoff) + ldsw + _i * 8192), 16, 0, 0); } while (0)
#define PG8_LDA(dst, b, h) do { _Pragma("unroll") for (int m = 0; m < 4; ++m) _Pragma("unroll") for (int k = 0; k < 2; ++k) dst[m][k] = *(const LAS bf16x8*)(lds + PG8_SA(b, h) + aoff + m * 2048 + k * 1024); } while (0)
#define PG8_LDB(dst, b, h) do { _Pragma("unroll") for (int n = 0; n < 2; ++n) _Pragma("unroll") for (int k = 0; k < 2; ++k) dst[n][k] = *(const LAS bf16x8*)(lds + PG8_SB(b, h) + boff + n * 2048 + k * 1024); } while (0)
#define PG8_MMA(ai, bj, At, Bt_) do { __builtin_amdgcn_s_setprio(1); _Pragma("unroll") for (int m = 0; m < 4; ++m) _Pragma("unroll") for (int n = 0; n < 2; ++n) _Pragma("unroll") for (int k = 0; k < 2; ++k) \
        acc[ai][bj][m][n] = __builtin_amdgcn_mfma_f32_16x16x32_bf16(Bt_[n][k], At[m][k], acc[ai][bj][m][n], 0, 0, 0); __builtin_amdgcn_s_setprio(0); } while (0)
#define PG8_WAIT_V(n) asm volatile("s_waitcnt vmcnt(" #n ")" ::: "memory")
#define PG8_WAIT_L(n) asm volatile("s_waitcnt lgkmcnt(" #n ")" ::: "memory")
#define PG8_BAR __builtin_amdgcn_s_barrier()
#define PG8_SCHED __builtin_amdgcn_sched_barrier(0)
    Unit cur, nxt; int ui = 0;
    if (!S.next(0, cur)) return;
    f32x4 acc[2][2][4][2];
#pragma unroll
    for (int a = 0; a < 2; ++a)
#pragma unroll
        for (int b = 0; b < 2; ++b)
#pragma unroll
            for (int m = 0; m < 4; ++m)
#pragma unroll
                for (int n = 0; n < 2; ++n) acc[a][b][m][n] = (f32x4){0.f, 0.f, 0.f, 0.f};
    bf16x8 At[4][2], B0[2][2], B1[2][2];
    const char* cA = (const char*)A + (size_t)cur.row0 * rstep; const char* cB = (const char*)Bt + (size_t)cur.brow0 * rstep;
    PG8_STAGE(PG8_SB(0, 0), cB, voffB); PG8_STAGE(PG8_SA(0, 0), cA, voffA); PG8_STAGE(PG8_SB(0, 1), cB + hstep, voffB); PG8_STAGE(PG8_SA(0, 1), cA + hstep, voffA);
    if (wr == 1) PG8_BAR;
    PG8_WAIT_V(4); PG8_BAR;
    PG8_STAGE(PG8_SB(1, 0), cB + kstep, voffB); PG8_STAGE(PG8_SA(1, 0), cA + kstep, voffA); PG8_STAGE(PG8_SB(1, 1), cB + hstep + kstep, voffB);
    PG8_WAIT_V(6); PG8_BAR;
    for (;;) {
        const bool has_next = S.next(ui + 1, nxt);
        const char* nA = has_next ? (const char*)A + (size_t)nxt.row0 * rstep : cA; const char* nB = has_next ? (const char*)Bt + (size_t)nxt.brow0 * rstep : cB;
        for (int t = 0; t < nt; t += 2) {
            const bool last = (t == nt - 2);
            const char* a1 = cA + (size_t)(t + 1) * kstep;
            const char* a2 = last ? nA : cA + (size_t)(t + 2) * kstep; const char* b2 = last ? nB : cB + (size_t)(t + 2) * kstep;
            const char* a3 = a2 + kstep; const char* b3 = b2 + kstep;
            PG8_LDB(B0, 0, 0); PG8_SCHED; PG8_LDA(At, 0, 0); PG8_STAGE(PG8_SA(1, 1), a1 + hstep, voffA);
            PG8_WAIT_L(8); PG8_BAR; PG8_WAIT_L(0); PG8_MMA(0, 0, At, B0); PG8_BAR; PG8_SCHED;
            PG8_LDB(B1, 0, 1); PG8_STAGE(PG8_SB(0, 0), b2, voffB);
            PG8_BAR; PG8_WAIT_L(0); PG8_MMA(0, 1, At, B1); PG8_BAR;
            PG8_LDA(At, 0, 1); PG8_STAGE(PG8_SA(0, 0), a2, voffA);
            PG8_BAR; PG8_WAIT_L(0); PG8_MMA(1, 0, At, B0); PG8_BAR; PG8_SCHED;
            PG8_STAGE(PG8_SB(0, 1), b2 + hstep, voffB);
            PG8_WAIT_V(6); PG8_BAR; PG8_MMA(1, 1, At, B1); PG8_BAR;
            PG8_LDB(B0, 1, 0); PG8_SCHED; PG8_LDA(At, 1, 0); PG8_STAGE(PG8_SA(0, 1), a2 + hstep, voffA);
            PG8_WAIT_L(8); PG8_BAR; PG8_WAIT_L(0); PG8_MMA(0, 0, At, B0); PG8_BAR; PG8_SCHED;
            PG8_LDB(B1, 1, 1); PG8_STAGE(PG8_SB(1, 0), b3, voffB);
            PG8_BAR; PG8_WAIT_L(0); PG8_MMA(0, 1, At, B1); PG8_BAR;
            PG8_LDA(At, 1, 1); PG8_STAGE(PG8_SA(1, 0), a3, voffA);
            PG8_BAR; PG8_WAIT_L(0); PG8_MMA(1, 0, At, B0); PG8_BAR; PG8_SCHED;
            PG8_STAGE(PG8_SB(1, 1), b3 + hstep, voffB);
            PG8_WAIT_V(6); PG8_BAR; PG8_MMA(1, 1, At, B1); PG8_BAR;
        }
        E(acc, cur, wr, wc, fr, fq);
        if (!has_next) break;
#pragma unroll
        for (int a = 0; a < 2; ++a)
#pragma unroll
            for (int b = 0; b < 2; ++b)
#pragma unroll
                for (int m = 0; m < 4; ++m)
#pragma unroll
                    for (int n = 0; n < 2; ++n) acc[a][b][m][n] = (f32x4){0.f, 0.f, 0.f, 0.f};
        cur = nxt; cA = nA; cB = nB; ++ui;
    }
    PG8_WAIT_V(0);
    if (wr == 0) PG8_BAR;
    PG8_BAR;
#undef PG8_SA
#undef PG8_SB
#undef PG8_STAGE
#undef PG8_LDA
#undef PG8_LDB
#undef PG8_MMA
#undef PG8_WAIT_V
#undef PG8_WAIT_L
#undef PG8_BAR
#undef PG8_SCHED
}
typedef const f32x4 (&AccRef)[2][2][4][2];
DEV u32x4 pk8(const f32x4 a, const f32x4 b) { u32x4 w; w.x = cvt_pk_bf16(a[0], a[1]); w.y = cvt_pk_bf16(a[2], a[3]); w.z = cvt_pk_bf16(b[0], b[1]); w.w = cvt_pk_bf16(b[2], b[3]); return w; }
DEV f32x4 silu4(const f32x4 v) { f32x4 r;
#pragma unroll
    for (int i = 0; i < 4; ++i) r[i] = v[i] * __builtin_amdgcn_rcpf(1.0f + __expf(-v[i]));
    return r; }
struct EpiG1 { static constexpr bool PERM = true; bf16_t *qkv, *z, *xbcraw; float* dtraw;
    DEV void operator()(AccRef acc, const Unit& u, int wr, int wc, int fr, int fq) const {
        const int ct = u.col0, rbase = u.row0 + wr * 64 + fr;
        if (ct < 5632) {
            bf16_t* base; int ld, cc;
            if (ct < 3072) { base = qkv; ld = 3072; cc = ct; } else if (ct < 4096) { base = z; ld = 1024; cc = ct - 3072; } else { base = xbcraw; ld = 1536; cc = ct - 4096; }
            const int col = cc + wc * 32 + 8 * fq;
#pragma unroll
            for (int ai = 0; ai < 2; ++ai)
#pragma unroll
                for (int m = 0; m < 4; ++m) { bf16_t* rowp = base + (size_t)(rbase + ai * HALF + m * 16) * ld + col;
#pragma unroll
                    for (int bj = 0; bj < 2; ++bj) *(u32x4*)(rowp + bj * HALF) = pk8(acc[ai][bj][m][0], acc[ai][bj][m][1]); }
        } else if (wc == 0) {
#pragma unroll
            for (int ai = 0; ai < 2; ++ai)
#pragma unroll
                for (int m = 0; m < 4; ++m) { float* rowp = dtraw + (size_t)(rbase + ai * HALF + m * 16) * 32 + 8 * fq; *(f32x4*)rowp = acc[ai][0][m][0]; *(f32x4*)(rowp + 4) = acc[ai][0][m][1]; }
        }
    } };
struct EpiResF32 { static constexpr bool PERM = false; float* out; const float* resid;
    DEV void operator()(AccRef acc, const Unit& u, int wr, int wc, int fr, int fq) const {
        const int rbase = u.row0 + wr * 64 + fr, col = u.col0 + wc * 32 + 4 * fq;
#pragma unroll
        for (int ai = 0; ai < 2; ++ai)
#pragma unroll
            for (int m = 0; m < 4; ++m) { const size_t ro = (size_t)(rbase + ai * HALF + m * 16) * 1024 + col;
#pragma unroll
                for (int bj = 0; bj < 2; ++bj)
#pragma unroll
                    for (int n = 0; n < 2; ++n) *(f32x4*)(out + ro + bj * HALF + n * 16) = *(const f32x4*)(resid + ro + bj * HALF + n * 16) + acc[ai][bj][m][n]; }
    } };
struct EpiSwiglu { static constexpr bool PERM = true; bf16_t* hid;
    DEV void operator()(AccRef acc, const Unit& u, int wr, int wc, int fr, int fq) const {
        const int rbase = u.row0 + wr * 64 + fr, col = (u.col0 >> 1) + wc * 32 + 8 * fq;
#pragma unroll
        for (int ai = 0; ai < 2; ++ai)
#pragma unroll
            for (int m = 0; m < 4; ++m) *(u32x4*)(hid + (size_t)(rbase + ai * HALF + m * 16) * 2048 + col) = pk8(silu4(acc[ai][0][m][0]) * acc[ai][1][m][0], silu4(acc[ai][0][m][1]) * acc[ai][1][m][1]);
    } };
struct EpiBf16Plain { static constexpr bool PERM = true; bf16_t* O; int ld;
    DEV void operator()(AccRef acc, const Unit& u, int wr, int wc, int fr, int fq) const {
        const int rbase = u.row0 + wr * 64 + fr, col = u.col0 + wc * 32 + 8 * fq;
#pragma unroll
        for (int ai = 0; ai < 2; ++ai)
#pragma unroll
            for (int m = 0; m < 4; ++m) { bf16_t* rowp = O + (size_t)(rbase + ai * HALF + m * 16) * ld + col;
#pragma unroll
                for (int bj = 0; bj < 2; ++bj) *(u32x4*)(rowp + bj * HALF) = pk8(acc[ai][bj][m][0], acc[ai][bj][m][1]); }
    } };
struct EpiG3 { static constexpr bool PERM = true; bf16_t *pbuf, *gb;
    DEV void operator()(AccRef acc, const Unit& u, int wr, int wc, int fr, int fq) const {
        const int rbase = u.row0 + wr * 64 + fr;
        if (u.col0 < 2048) { const int col = (u.col0 >> 1) + wc * 32 + 8 * fq;
#pragma unroll
            for (int ai = 0; ai < 2; ++ai)
#pragma unroll
                for (int m = 0; m < 4; ++m) *(u32x4*)(pbuf + (size_t)(rbase + ai * HALF + m * 16) * 1024 + col) = pk8(acc[ai][0][m][0] * acc[ai][1][m][0], acc[ai][0][m][1] * acc[ai][1][m][1]);
        } else { const int col = u.col0 - 2048 + wc * 32 + 8 * fq;
#pragma unroll
            for (int ai = 0; ai < 2; ++ai)
#pragma unroll
                for (int m = 0; m < 4; ++m) { bf16_t* rowp = gb + (size_t)(rbase + ai * HALF + m * 16) * 1024 + col;
#pragma unroll
                    for (int bj = 0; bj < 2; ++bj) *(u32x4*)(rowp + bj * HALF) = pk8(acc[ai][bj][m][0], acc[ai][bj][m][1]); }
        }
    } };
}
DEV void ph_g1(const P& p, LAS unsigned char* lds) { pg8::StaticOrder S; S.init(T, NIN_PAD, (int)gridDim.x, (int)blockIdx.x, 0, 1); pg8::EpiG1 E{p.qkv, p.z, p.xbcraw, p.dtraw}; pg8::gemm_phase(lds, p.hn, p.WinT, 1024, S, E); }
DEV void ph_g2(const P& p, LAS unsigned char* lds) { pg8::StaticOrder S; S.init(T, 1024, (int)gridDim.x, (int)blockIdx.x, 0, 1); pg8::EpiResF32 E{p.out, p.x}; pg8::gemm_phase(lds, p.mix, p.WoutT, 2048, S, E); }
DEV void ph_up(const P& p, LAS unsigned char* lds) { pg8::StaticOrder S; S.init(NSLOT, 4096, (int)gridDim.x, (int)blockIdx.x, 4096, CAP / 256); pg8::EpiSwiglu E{p.hid}; pg8::gemm_phase(lds, p.xe, p.WguT, 1024, S, E); }
DEV void ph_down(const P& p, LAS unsigned char* lds) { pg8::StaticOrder S; S.init(NSLOT, 1024, (int)gridDim.x, (int)blockIdx.x, 1024, CAP / 256); pg8::EpiBf16Plain E{p.ye, 1024}; pg8::gemm_phase(lds, p.hid, p.WdT, 2048, S, E); }
DEV void ph_g3(const P& p, LAS unsigned char* lds) { pg8::StaticOrder S; S.init(T, 3072, (int)gridDim.x, (int)blockIdx.x, 0, 1); pg8::EpiG3 E{p.pbuf, p.gb}; pg8::gemm_phase(lds, p.hn, p.WciT, 1024, S, E); }
DEV void ph_g4(const P& p, LAS unsigned char* lds) { pg8::StaticOrder S; S.init(T, 1024, (int)gridDim.x, (int)blockIdx.x, 0, 1); pg8::EpiResF32 E{p.out, p.out}; pg8::gemm_phase(lds, p.abuf, p.WcoT, 1024, S, E); }

DEV bf16x8 ldg8(const bf16_t* p) { return *(const bf16x8*)p; }
DEV f32x4 mfma16(bf16x8 a, bf16x8 b, f32x4 c) { return __builtin_amdgcn_mfma_f32_16x16x32_bf16(a, b, c, 0, 0, 0); }
DEV bf16x8 pack8(const float (&m)[8]) { u32x4 r; r.x = pg8::cvt_pk_safe(m[0], m[1]); r.y = pg8::cvt_pk_safe(m[2], m[3]); r.z = pg8::cvt_pk_safe(m[4], m[5]); r.w = pg8::cvt_pk_safe(m[6], m[7]); return __builtin_bit_cast(bf16x8, r); }
DEV void unpack8(bf16x8 v, float (&f)[8]) { const u32x4 u = __builtin_bit_cast(u32x4, v);
#pragma unroll
    for (int q = 0; q < 4; ++q) { f[2 * q] = __uint_as_float(u[q] << 16); f[2 * q + 1] = __uint_as_float(u[q] & 0xffff0000u); } }
typedef unsigned u32x2 __attribute__((ext_vector_type(2)));
DEV u32x2 pk4(const f32x4 a) { u32x2 r; r.x = pg8::cvt_pk_safe(a[0], a[1]); r.y = pg8::cvt_pk_safe(a[2], a[3]); return r; }
DEV void ph_ssd_states(const P& p) {
    const int wid = threadIdx.x >> 6, lane = threadIdx.x & 63, fr = lane & 15, fq = lane >> 4;
    for (int it = blockIdx.x * 8 + wid; it < BATCH * NCHUNK * 32; it += gridDim.x * 8) {
        const int dir = it & 1, h = (it >> 1) & 15, c = (it >> 5) % NCHUNK, b = (it >> 5) / NCHUNK, g = h >> 3, j = dir * 16 + h;
        const bf16_t* xT = p.xsT + ((size_t)b * 1024 + h * 64 + fr) * SEQ + c * 128 + 8 * fq;
        const bf16_t* bT = p.bmT + ((size_t)b * 256 + g * 128 + fr) * SEQ + c * 128 + 8 * fq;
        const float* w = p.wdT + ((size_t)b * 32 + j) * SEQ + c * 128 + 8 * fq;
        f32x4 acc[8][4];
#pragma unroll
        for (int nb = 0; nb < 8; ++nb)
#pragma unroll
            for (int pb = 0; pb < 4; ++pb) acc[nb][pb] = (f32x4){0.f, 0.f, 0.f, 0.f};
#pragma unroll 1
        for (int ks = 0; ks < 4; ++ks) {
            const f32x4 w0 = *(const f32x4*)(w + 32 * ks), w1 = *(const f32x4*)(w + 32 * ks + 4);
            bf16x8 xf[4];
#pragma unroll
            for (int pb = 0; pb < 4; ++pb) { float f[8]; unpack8(ldg8(xT + (size_t)pb * 16 * SEQ + 32 * ks), f);
#pragma unroll
                for (int q = 0; q < 4; ++q) { f[q] *= w0[q]; f[4 + q] *= w1[q]; }
                xf[pb] = pack8(f); }
#pragma unroll
            for (int nb = 0; nb < 8; ++nb) { const bf16x8 bfv = ldg8(bT + (size_t)nb * 16 * SEQ + 32 * ks);
#pragma unroll
                for (int pb = 0; pb < 4; ++pb) acc[nb][pb] = mfma16(bfv, xf[pb], acc[nb][pb]); }
        }
        bf16_t* st = p.states + ((((size_t)b * 2 + dir) * NCHUNK + c) * 16 + h) * 8192;
#pragma unroll
        for (int nb = 0; nb < 8; ++nb)
#pragma unroll
            for (int pb = 0; pb < 4; ++pb) *(u32x2*)(st + (16 * pb + fr) * 128 + 16 * nb + 4 * fq) = pk4(acc[nb][pb]);
    }
}
DEV void ph_ssd_scan(const P& p) {
    for (size_t i = GTID; i < (size_t)BATCH * 2 * 16 * 64 * 32; i += GSTRIDE) {
        const int n4 = (int)(i & 31), pp = (int)((i >> 5) & 63), h = (int)((i >> 11) & 15), dir = (int)((i >> 15) & 1), b = (int)(i >> 16);
        bf16_t* base = p.states + (((size_t)b * 2 + dir) * NCHUNK * 16 + h) * 8192 + pp * 128 + n4 * 4;
        const float* dec = p.cdec + ((size_t)b * 32 + dir * 16 + h) * NCHUNK;
        float r0 = 0.f, r1 = 0.f, r2 = 0.f, r3 = 0.f;
#pragma unroll 8
        for (int cc = 0; cc < NCHUNK; ++cc) { const int c = dir ? NCHUNK - 1 - cc : cc; uint2* q = (uint2*)(base + (size_t)c * 16 * 8192); const uint2 v = *q; const float d = dec[c];
            *q = uint2{pg8::cvt_pk_safe(r0, r1), pg8::cvt_pk_safe(r2, r3)};
            r0 = r0 * d + __uint_as_float(v.x << 16); r1 = r1 * d + __uint_as_float(v.x & 0xffff0000u); r2 = r2 * d + __uint_as_float(v.y << 16); r3 = r3 * d + __uint_as_float(v.y & 0xffff0000u); }
    }
}
constexpr int GLD = 136;
DEV void ph_ssd_out(const P& p, LAS unsigned char* lds) {
    const int wid = threadIdx.x >> 6, lane = threadIdx.x & 63, fr = lane & 15, fq = lane >> 4;
    LAS bf16_t* Gl = (LAS bf16_t*)lds;
    LAS float* vec = (LAS float*)(lds + 64 * GLD * 2) + wid * 512;
    for (int u = blockIdx.x; u < BATCH * NCHUNK * 4; u += gridDim.x) {
        const int lh = u & 1, g = (u >> 1) & 1, c = (u >> 2) % NCHUNK, b = (u >> 2) / NCHUNK, h = 8 * g + wid, l0 = 64 * lh; const size_t row0 = (size_t)b * SEQ + (size_t)c * 128;
        const bf16_t* bmrow = p.bc + (row0 + 16 * wid + fr) * 512 + g * 128 + 8 * fq;
        const bf16_t* cmrow = p.bc + (row0 + l0 + fr) * 512 + 256 + g * 128 + 8 * fq;
        f32x4 ag[4];
#pragma unroll
        for (int lb = 0; lb < 4; ++lb) ag[lb] = (f32x4){0.f, 0.f, 0.f, 0.f};
#pragma unroll
        for (int ks = 0; ks < 4; ++ks) { const bf16x8 a = ldg8(bmrow + 32 * ks);
#pragma unroll
            for (int lb = 0; lb < 4; ++lb) ag[lb] = mfma16(a, ldg8(cmrow + (size_t)lb * 16 * 512 + 32 * ks), ag[lb]); }
        __syncthreads();
#pragma unroll
        for (int lb = 0; lb < 4; ++lb) *(LAS u32x2*)(Gl + (16 * lb + fr) * GLD + 16 * wid + 4 * fq) = pk4(ag[lb]);
#pragma unroll
        for (int q = 0; q < 2; ++q) { const int s = lane + 64 * q; const size_t o = ((size_t)b * 32 + h) * SEQ + c * 128 + s;
            vec[s] = p.csT[o]; vec[128 + s] = p.csT[o + (size_t)16 * SEQ]; vec[256 + s] = p.stT[o]; vec[384 + s] = p.stT[o + (size_t)16 * SEQ]; }
        __syncthreads();
        f32x4 acc[4][4];
#pragma unroll
        for (int pb = 0; pb < 4; ++pb)
#pragma unroll
            for (int lb = 0; lb < 4; ++lb) acc[pb][lb] = (f32x4){0.f, 0.f, 0.f, 0.f};
        float csfl[4], cbl[4];
#pragma unroll
        for (int lb = 0; lb < 4; ++lb) { csfl[lb] = vec[l0 + 16 * lb + fr]; cbl[lb] = vec[128 + l0 + 16 * lb + fr]; }
        const bf16_t* xT = p.xsT + ((size_t)b * 1024 + h * 64 + fr) * SEQ + c * 128 + 8 * fq;
        const float Dh = p.ssd_d[h];
#pragma unroll 1
        for (int ks = 0; ks < 4; ++ks) {
            const int s0 = 32 * ks + 8 * fq;
            bf16x8 xf[4];
#pragma unroll
            for (int pb = 0; pb < 4; ++pb) xf[pb] = ldg8(xT + (size_t)pb * 16 * SEQ + 32 * ks);
            float cs_s[8], cb_s[8], df[8], db[8];
#pragma unroll
            for (int j = 0; j < 8; ++j) { cs_s[j] = vec[s0 + j]; cb_s[j] = vec[128 + s0 + j]; df[j] = vec[256 + s0 + j]; db[j] = vec[384 + s0 + j]; }
#pragma unroll
            for (int lb = 0; lb < 4; ++lb) {
                const int l = l0 + 16 * lb + fr;
                float gf[8], m[8]; unpack8(*(const LAS bf16x8*)(Gl + (16 * lb + fr) * GLD + s0), gf);
#pragma unroll
                for (int j = 0; j < 8; ++j) { const int s = s0 + j;
                    const float wf = s <= l ? df[j] * __expf(fminf(csfl[lb] - cs_s[j], 0.f)) : 0.f, wb = s >= l ? db[j] * __expf(fminf(cbl[lb] - cb_s[j], 0.f)) : 0.f;
                    m[j] = gf[j] * (wf + wb) + (s == l ? Dh : 0.f); }
                const bf16x8 mf = pack8(m);
#pragma unroll
                for (int pb = 0; pb < 4; ++pb) acc[pb][lb] = mfma16(xf[pb], mf, acc[pb][lb]);
            }
        }
#pragma unroll
        for (int dir = 0; dir < 2; ++dir) {
            const bf16_t* pv = p.states + ((((size_t)b * 2 + dir) * NCHUNK + c) * 16 + h) * 8192 + fr * 128 + 8 * fq;
            float sc[4];
#pragma unroll
            for (int lb = 0; lb < 4; ++lb) sc[lb] = __expf(dir ? cbl[lb] : csfl[lb]);
#pragma unroll 1
            for (int ks = 0; ks < 4; ++ks) {
                bf16x8 pf[4];
#pragma unroll
                for (int pb = 0; pb < 4; ++pb) pf[pb] = ldg8(pv + pb * 2048 + 32 * ks);
#pragma unroll
                for (int lb = 0; lb < 4; ++lb) { float f[8]; unpack8(ldg8(cmrow + (size_t)lb * 16 * 512 + 32 * ks), f);
#pragma unroll
                    for (int j = 0; j < 8; ++j) f[j] *= sc[lb];
                    const bf16x8 cf = pack8(f);
#pragma unroll
                    for (int pb = 0; pb < 4; ++pb) acc[pb][lb] = mfma16(pf[pb], cf, acc[pb][lb]); }
            }
        }
#pragma unroll
        for (int pb = 0; pb < 4; ++pb)
#pragma unroll
            for (int lb = 0; lb < 4; ++lb) *(u32x2*)(p.yssd + (row0 + l0 + 16 * lb + fr) * 1024 + h * 64 + 16 * pb + 4 * fq) = pk4(acc[pb][lb]);
    }
}

typedef short s16x4 __attribute__((ext_vector_type(4)));
constexpr int VLD = 144;
DEV void ph_attn(const P& p, LAS unsigned char* lds) {
    const int wid = threadIdx.x >> 6, lane = threadIdx.x & 63, fr = lane & 15, fq = lane >> 4;
    LAS unsigned char* vt = lds + wid * (32 * VLD);
    float gq = 0.f, gk = 0.f;
    for (int c = 0; c < 64; ++c) { gq = fmaxf(gq, fabsf(p.q_norm[c])); gk = fmaxf(gk, fabsf(p.k_norm[c])); }
    const float c1 = 0.125f * 1.44269504089f, c2 = 8.0f * gq * gk * 1.44269504089f;
    const int trq = fr >> 2, trp = fr & 3;
    constexpr int NJB = SEQ / 256;
    for (int it = blockIdx.x * 8 + wid; it < BATCH * 16 * NJB * 16; it += gridDim.x * 8) {
        const int r = it & 15, jb = (it >> 4) % NJB, h = ((it >> 4) / NJB) & 15, b = ((it >> 4) / NJB) >> 4;
        const size_t rowb = (size_t)b * SEQ; const int base = r + 256 * jb;
        const bf16_t* qp = p.qkv + (rowb + base + 16 * fr) * 3072 + h * 64 + 8 * fq;
        const bf16x8 qf0 = ldg8(qp), qf1 = ldg8(qp + 32);
        const bf16_t* kbase = p.qkv + rowb * 3072 + 1024 + h * 64 + 8 * fq;
        const bf16_t* vbase = p.qkv + rowb * 3072 + 2048 + h * 64;
        f32x4 o[4];
#pragma unroll
        for (int mb = 0; mb < 4; ++mb) o[mb] = (f32x4){0.f, 0.f, 0.f, 0.f};
        float lsum = 0.f;
#pragma unroll
        for (int pat = 0; pat < 3; ++pat) {
            const int d = pat == 0 ? 1 : (pat == 1 ? 4 : 16), nks = pat == 0 ? 12 : (pat == 1 ? 6 : 5);
            const int kq = fr * (16 / d);
#pragma unroll 1
            for (int kk = 0; kk < nks; ++kk) {
                const int k0 = -64 + 32 * kk;
                bf16x8 vr[4];
#pragma unroll
                for (int c4 = 0; c4 < 4; ++c4) { const int id = lane + 64 * c4, row = id >> 3, ch = id & 7; int pos = base + d * (k0 + row); pos = pos < 0 ? 0 : (pos > SEQ - 1 ? SEQ - 1 : pos);
                    vr[c4] = ldg8(vbase + (size_t)pos * 3072 + 8 * ch); }
                bf16x8 kf[2][2];
#pragma unroll
                for (int x = 0; x < 2; ++x) { int pos = base + d * (k0 + 8 * (fr >> 2) + 4 * x + (fr & 3)); pos = pos < 0 ? 0 : (pos > SEQ - 1 ? SEQ - 1 : pos);
                    kf[x][0] = ldg8(kbase + (size_t)pos * 3072); kf[x][1] = ldg8(kbase + (size_t)pos * 3072 + 32); }
                f32x4 s0 = mfma16(kf[0][0], qf0, (f32x4){0.f, 0.f, 0.f, 0.f}); s0 = mfma16(kf[0][1], qf1, s0);
                f32x4 s1 = mfma16(kf[1][0], qf0, (f32x4){0.f, 0.f, 0.f, 0.f}); s1 = mfma16(kf[1][1], qf1, s1);
                float pv[8];
#pragma unroll
                for (int j = 0; j < 8; ++j) { const int kap = k0 + 8 * fq + j, pos = base + d * kap, dk = kap - kq;
                    const bool valid = dk <= 64 && dk >= -64 && pos >= 0 && pos < SEQ; const float sv = j < 4 ? s0[j & 3] : s1[j & 3];
                    pv[j] = valid ? __builtin_amdgcn_exp2f(sv * c1 - c2) : 0.f; lsum += pv[j]; }
                const bf16x8 pf = pack8(pv);
                asm volatile("" ::: "memory");
#pragma unroll
                for (int c4 = 0; c4 < 4; ++c4) { const int id = lane + 64 * c4, row = id >> 3, ch = id & 7; *(LAS bf16x8*)(vt + row * VLD + ch * 16) = vr[c4]; }
                asm volatile("s_waitcnt lgkmcnt(0)" ::: "memory");
#pragma unroll
                for (int mb = 0; mb < 4; ++mb) {
                    const s16x4 t0 = __builtin_amdgcn_ds_read_tr16_b64_v4i16((LAS s16x4*)(vt + (8 * fq + trq) * VLD + (16 * mb + 4 * trp) * 2));
                    const s16x4 t1 = __builtin_amdgcn_ds_read_tr16_b64_v4i16((LAS s16x4*)(vt + (8 * fq + 4 + trq) * VLD + (16 * mb + 4 * trp) * 2));
                    const bf16x8 vf = __builtin_shufflevector(t0, t1, 0, 1, 2, 3, 4, 5, 6, 7);
                    o[mb] = mfma16(vf, pf, o[mb]);
                }
                asm volatile("" ::: "memory");
            }
        }
        lsum += __shfl_xor(lsum, 16); lsum += __shfl_xor(lsum, 32);
        const float inv = 1.0f / lsum;
#pragma unroll
        for (int mb = 0; mb < 4; ++mb) *(u32x2*)(p.mix + (rowb + base + 16 * fr) * 2048 + h * 64 + 16 * mb + 4 * fq) = pk4(o[mb] * inv);
    }
}

static_assert(SEQ % 512 == 0, "top-k: SEQ / 512 values per thread");
DEV void ph_topk(const P& p, LAS unsigned char* lds) {
    constexpr int NV_T = SEQ / 512;
    LAS unsigned* hist = (LAS unsigned*)lds; LAS unsigned* wtot = hist + 256; LAS unsigned* bcw = hist + 272;
    const int tid = threadIdx.x, lane = tid & 63, wid = tid >> 6;
    for (int be = blockIdx.x; be < BATCH * NE; be += gridDim.x) {
        const float* a = p.aff + (size_t)be * SEQ + (size_t)tid * NV_T;
        unsigned v[NV_T];
#pragma unroll
        for (int q = 0; q < NV_T / 4; ++q) { const uint4 u = *(const uint4*)(a + 4 * q); v[4 * q] = u.x; v[4 * q + 1] = u.y; v[4 * q + 2] = u.z; v[4 * q + 3] = u.w; }
        unsigned prefix = 0u, kk = CAP;
#pragma unroll 1
        for (int pass = 0; pass < 4; ++pass) {
            const int shift = 24 - 8 * pass;
            if (tid < 256) hist[tid] = 0u;
            __syncthreads();
#pragma unroll
            for (int j = 0; j < NV_T; ++j) { const bool m = pass == 0 || (v[j] >> (shift + 8)) == prefix; if (m) atomicAdd((unsigned*)&hist[(v[j] >> shift) & 255u], 1u); }
            __syncthreads();
            if (wid == 0) {
                const unsigned c0 = hist[255 - 4 * lane], c1 = hist[254 - 4 * lane], c2 = hist[253 - 4 * lane], c3 = hist[252 - 4 * lane];
                const unsigned tot = c0 + c1 + c2 + c3; unsigned inc = tot;
#pragma unroll
                for (int o = 1; o < 64; o <<= 1) { const unsigned t = __shfl_up(inc, o); if (lane >= o) inc += t; }
                const unsigned exc = inc - tot;
                if (exc < kk && kk <= inc) { const unsigned r = kk - exc; unsigned bin, before;
                    if (r <= c0) { bin = 255 - 4 * lane; before = exc; } else if (r <= c0 + c1) { bin = 254 - 4 * lane; before = exc + c0; } else if (r <= c0 + c1 + c2) { bin = 253 - 4 * lane; before = exc + c0 + c1; } else { bin = 252 - 4 * lane; before = exc + c0 + c1 + c2; }
                    bcw[0] = bin; bcw[1] = kk - before; }
            }
            __syncthreads();
            prefix = (prefix << 8) | bcw[0]; kk = bcw[1];
        }
        const unsigned Tb = prefix, need = kk, cgt = CAP - need;
        unsigned ngt = 0u, neq = 0u;
#pragma unroll
        for (int j = 0; j < NV_T; ++j) { ngt += v[j] > Tb ? 1u : 0u; neq += v[j] == Tb ? 1u : 0u; }
        const unsigned packed = ngt | (neq << 16); unsigned inc = packed;
#pragma unroll
        for (int o = 1; o < 64; o <<= 1) { const unsigned t = __shfl_up(inc, o); if (lane >= o) inc += t; }
        if (lane == 63) wtot[wid] = inc;
        __syncthreads();
        unsigned wbase = 0u;
        for (int w = 0; w < wid; ++w) wbase += wtot[w];
        const unsigned exc = wbase + inc - packed; unsigned gbase = exc & 0xffffu, ebase = exc >> 16;
        int* smp = p.slotmap + (size_t)be * SEQ + (size_t)tid * NV_T;
#pragma unroll
        for (int q = 0; q < NV_T / 4; ++q) { int sl[4];
#pragma unroll
            for (int i = 0; i < 4; ++i) { const int j = 4 * q + i; int slot = -1;
                if (v[j] > Tb) { slot = (int)gbase; ++gbase; } else if (v[j] == Tb) { if (ebase < need) slot = (int)(cgt + ebase); ++ebase; }
                if (slot >= 0) { p.idx[(size_t)be * CAP + slot] = tid * NV_T + j; p.gate[(size_t)be * CAP + slot] = __uint_as_float(v[j]); }
                sl[i] = slot; }
            *(int4*)(smp + 4 * q) = int4{sl[0], sl[1], sl[2], sl[3]}; }
        __syncthreads();
    }
}

#define XB_TMO      128
#define XB_XCNT(j)  (256  + 64 * (j))
#define XB_XSUB(j)  (1280 + 64 * (j))
#define XB_XGEN(j)  (2304 + 64 * (j))
#define XB_TOP      3328
#define XB_TOPGEN   3392
#define XCD_BAR_WORDS 3456
#define XB_SPIN_CAP (1u << 18)

__device__ __forceinline__ unsigned xb_ld(unsigned* p)              { return __hip_atomic_load(p, __ATOMIC_RELAXED, __HIP_MEMORY_SCOPE_AGENT); }
__device__ __forceinline__ unsigned xb_add(unsigned* p, unsigned v) { return __hip_atomic_fetch_add(p, v, __ATOMIC_RELAXED, __HIP_MEMORY_SCOPE_AGENT); }
__device__ __forceinline__ unsigned xb_xcc_id() { return (unsigned)__builtin_amdgcn_s_getreg((3 << 11) | 20) & 0xFu; }
#define XB_SPIN(cond, bar) do { unsigned _sp = 0; while (cond) { __builtin_amdgcn_s_sleep(1); \
    if ((++_sp & 255u) == 0u) { if (xb_ld(&(bar)[XB_TMO])) break; if (_sp > XB_SPIN_CAP) { atomicAdd(&(bar)[XB_TMO], 1u); break; } } } } while (0)

struct XcdBarrier {
    unsigned* bar; unsigned x;
    volatile LAS unsigned* st;
};

__device__ __forceinline__ XcdBarrier xcd_barrier_post(unsigned* bar, volatile LAS unsigned* st) {
    XcdBarrier b; b.bar = bar; b.x = xb_xcc_id(); b.st = st;
    if (threadIdx.x == 0) (void)xb_add(&bar[XB_XCNT(b.x)], 1u);
    return b;
}
__device__ __forceinline__ void xcd_barrier_complete(unsigned* bar, unsigned x, unsigned& nloc, unsigned& nx) {
    const unsigned G = gridDim.x * gridDim.y * gridDim.z;
    unsigned sum, cnt, mine, sp = 0u;
    for (;;) {
        sum = 0u; cnt = 0u; mine = 0u;
#pragma unroll
        for (unsigned j = 0; j < 16; ++j) { const unsigned c = xb_ld(&bar[XB_XCNT(j)]); sum += c; cnt += (c > 0u) ? 1u : 0u; mine = (j == x) ? c : mine; }
        if (sum == G) break;
        __builtin_amdgcn_s_sleep(1);
        if ((++sp & 255u) == 0u) { if (xb_ld(&bar[XB_TMO])) break; if (sp > XB_SPIN_CAP) { atomicAdd(&bar[XB_TMO], 1u); break; } }
    }
    nloc = mine > 0u ? mine : 1u; nx = cnt > 0u ? cnt : 1u;
}

__device__ __forceinline__ void xcd_barrier(const XcdBarrier& b) {
    asm volatile("s_waitcnt vmcnt(0)" ::: "memory");
    __syncthreads();
    if (threadIdx.x == 0) {
        unsigned* bar = b.bar;
        __builtin_amdgcn_s_waitcnt(0);
        unsigned nloc = b.st[0], nx = b.st[1];
        if (nloc == 0u) { xcd_barrier_complete(bar, b.x, nloc, nx); b.st[0] = nloc; b.st[1] = nx; }
        const unsigned old = xb_add(&bar[XB_XSUB(b.x)], 1u);
        const unsigned gen = old / nloc;
        if (old + 1u == (gen + 1u) * nloc) {
            __builtin_amdgcn_fence(__ATOMIC_RELEASE, "agent");
            asm volatile("s_waitcnt vmcnt(0)" ::: "memory");
            const unsigned og = xb_add(&bar[XB_TOP], 1u);
            const unsigned tg = og / nx;
            if (og + 1u == (tg + 1u) * nx) xb_add(&bar[XB_TOPGEN], 1u);
            else XB_SPIN(xb_ld(&bar[XB_TOPGEN]) == tg, bar);
            __builtin_amdgcn_fence(__ATOMIC_ACQUIRE, "agent");
            xb_add(&bar[XB_XGEN(b.x)], 1u);
            asm volatile("s_waitcnt vmcnt(0)" ::: "memory");
        } else {
            XB_SPIN(xb_ld(&bar[XB_XGEN(b.x)]) == gen, bar);
            __builtin_amdgcn_fence(__ATOMIC_ACQUIRE, "agent");
            asm volatile("s_waitcnt vmcnt(0)" ::: "memory");
        }
    }
    __syncthreads();
}


enum { PH_CONV = 0, PH_NORM0, PH_G1, PH_PREP, PH_ATTN, PH_SSDA, PH_SSDB, PH_SSDC, PH_GNORM, PH_G2, PH_CVX0, PH_ROUTE0, PH_TOPK0, PH_GATHER0, PH_UP0, PH_DOWN0, PH_COMB0, PH_G3, PH_CONV3, PH_G4, PH_CVX1, PH_ROUTE1, PH_TOPK1, PH_GATHER1, PH_UP1,
       PH_DOWN1, PH_COMB1, NPH };

constexpr int LDS_BYTES = 147456;
constexpr int LDS_XB = LDS_BYTES - 16;
__global__ void __launch_bounds__(512, 2) fwd(P p, int lo, int hi) {
    extern __shared__ __attribute__((aligned(16))) unsigned char shm[];
    LAS unsigned char* lds = (LAS unsigned char*)shm;
    XcdBarrier bar; bar.bar = p.bar; bar.x = 0; bar.st = (volatile LAS unsigned*)(lds + LDS_XB);
    if (hi - lo > 1) {
        if (threadIdx.x == 0) { ((LAS unsigned*)(lds + LDS_XB))[0] = 0u; ((LAS unsigned*)(lds + LDS_XB))[1] = 0u; }
        __syncthreads();
        bar = xcd_barrier_post(p.bar, (volatile LAS unsigned*)(lds + LDS_XB));
    }
#if NAIVE_GEMM
#define GEMM_SEL(a, b) a
#else
#define GEMM_SEL(a, b) b
#endif
#if NAIVE_SSD
#define SSD_SEL(a, b) a
#else
#define SSD_SEL(a, b) b
#endif
#if NAIVE_ATTN
#define ATTN_SEL(a, b) a
#else
#define ATTN_SEL(a, b) b
#endif
#if NAIVE_TOPK
#define TOPK_SEL(a, b) a
#else
#define TOPK_SEL(a, b) b
#endif
#define PHASE(i, body) if (lo <= (i) && (i) < hi) { body; if ((i) + 1 < hi) xcd_barrier(bar); }
    PHASE(PH_CONV, ph_convert_small(p))
    PHASE(PH_NORM0, ph_rmsnorm(p.x, p.attn_norm, p.hn))
    PHASE(PH_G1, GEMM_SEL(nv_g1(p), ph_g1(p, lds)))
    PHASE(PH_PREP, ph_prep(p))
    PHASE(PH_ATTN, ATTN_SEL(nv_attn(p), ph_attn(p, lds)))
    PHASE(PH_SSDA, SSD_SEL(nv_ssd(p), ph_ssd_states(p)))
    PHASE(PH_SSDB, SSD_SEL((void)0, ph_ssd_scan(p)))
    PHASE(PH_SSDC, SSD_SEL((void)0, ph_ssd_out(p, lds)))
    PHASE(PH_GNORM, ph_gated_norm(p))
    PHASE(PH_G2, GEMM_SEL(nv_g2(p), ph_g2(p, lds)))
    PHASE(PH_CVX0, ph_convert_experts(p, 0))
    PHASE(PH_ROUTE0, ph_norm_router(p, 0))
    PHASE(PH_TOPK0, TOPK_SEL(nv_topk(p), ph_topk(p, lds)))
    PHASE(PH_GATHER0, ph_gather(p))
    PHASE(PH_UP0, GEMM_SEL(nv_up(p), ph_up(p, lds)))
    PHASE(PH_DOWN0, GEMM_SEL(nv_down(p), ph_down(p, lds)))
    PHASE(PH_COMB0, ph_combine(p, p.conv_norm))
    PHASE(PH_G3, GEMM_SEL(nv_g3(p), ph_g3(p, lds)))
    PHASE(PH_CONV3, ph_conv3(p))
    PHASE(PH_G4, GEMM_SEL(nv_g4(p), ph_g4(p, lds)))
    PHASE(PH_CVX1, ph_convert_experts(p, 1))
    PHASE(PH_ROUTE1, ph_norm_router(p, 1))
    PHASE(PH_TOPK1, TOPK_SEL(nv_topk(p), ph_topk(p, lds)))
    PHASE(PH_GATHER1, ph_gather(p))
    PHASE(PH_UP1, GEMM_SEL(nv_up(p), ph_up(p, lds)))
    PHASE(PH_DOWN1, GEMM_SEL(nv_down(p), ph_down(p, lds)))
    PHASE(PH_COMB1, ph_combine(p, nullptr))
}

extern "C" void kernel_launch(void* const* d_in, const int* in_sizes, int n_in, void* d_out, int out_size, void* d_ws, size_t ws_size, hipStream_t stream) {
    (void)in_sizes; (void)n_in; (void)out_size; (void)ws_size;
    P p{};
    make_params(p, d_in, d_out, d_ws);
    static int grid = 0;
    if (grid == 0) {
        int dev = 0, cus = 0;
        if (hipGetDevice(&dev) != hipSuccess || hipDeviceGetAttribute(&cus, hipDeviceAttributeMultiprocessorCount, dev) != hipSuccess) cus = 256;
        (void)hipFuncSetAttribute((const void*)fwd, hipFuncAttributeMaxDynamicSharedMemorySize, LDS_BYTES);
        (void)hipGetLastError();
        grid = cus > 0 ? cus : 256;
    }
#if ONE_LAUNCH
    (void)hipMemsetAsync(p.bar, 0, XCD_BAR_WORDS * sizeof(unsigned), stream);
    hipLaunchKernelGGL(fwd, dim3(grid), dim3(512), LDS_BYTES, stream, p, 0, (int)NPH);
#else
    for (int ph = 0; ph < NPH; ++ph) hipLaunchKernelGGL(fwd, dim3(grid), dim3(512), LDS_BYTES, stream, p, ph, ph + 1);
#endif
}
#endif
```

```cpp
#ifndef HOST_EMU
#include <hip/hip_runtime.h>
#define HD __host__ __device__ __forceinline__
#define DEV __device__ __forceinline__
#else
#include <cmath>
#include <cstdio>
#include <cstdlib>
#include <cstring>
#include <cstddef>
#define HD inline
#define DEV inline
struct float4 { float x, y, z, w; };
struct uint4 { unsigned x, y, z, w; };
struct uint2 { unsigned x, y; };
static thread_local size_t emu_tid = 0; static size_t emu_nthreads = 1;
#endif

#ifndef BATCH
#define BATCH 2
#endif
#ifndef SEQ
#define SEQ 16384
#endif
#ifndef NAIVE_GEMM
#define NAIVE_GEMM 0
#endif
#ifndef NAIVE_ATTN
#define NAIVE_ATTN 0
#endif
#ifndef NAIVE_SSD
#define NAIVE_SSD 0
#endif
#ifndef NAIVE_TOPK
#define NAIVE_TOPK 0
#endif
#ifndef ONE_LAUNCH
#define ONE_LAUNCH 1
#endif

typedef unsigned short bf16_t;
constexpr int T = BATCH * SEQ;
constexpr int DM = 1024;
constexpr int NIN = 5664, NIN_PAD = 5888;
constexpr int NE = 16;
constexpr int CAP = 2 * SEQ / NE;
constexpr int NSLOT = BATCH * NE * CAP;
constexpr int DFF = 2048;
constexpr int NCHUNK = SEQ / 128;

HD float bf2f(bf16_t v) { union { unsigned u; float f; } x; x.u = ((unsigned)v) << 16; return x.f; }
HD bf16_t f2bf(float f) { union { unsigned u; float f; } x; x.f = f; unsigned u = x.u; u += 0x7fffu + ((u >> 16) & 1u); return (bf16_t)(u >> 16); }
HD unsigned pack2(float lo, float hi) { return (unsigned)f2bf(lo) | ((unsigned)f2bf(hi) << 16); }
HD float silu_f(float v) { return v / (1.0f + expf(-v)); }
HD float softplus_f(float v) { return v > 20.f ? v : log1pf(expf(v)); }

#ifndef HOST_EMU
#define LANES 64
#define GTID ((size_t)blockIdx.x * blockDim.x + threadIdx.x)
#define GSTRIDE ((size_t)gridDim.x * blockDim.x)
#define LANE ((int)(threadIdx.x & 63))
DEV float wave_sum(float v) {
#pragma unroll
    for (int o = 32; o >= 1; o >>= 1) v += __shfl_xor(v, o);
    return v;
}
#else
#define LANES 1
#define GTID (emu_tid)
#define GSTRIDE (emu_nthreads)
#define LANE 0
DEV float wave_sum(float v) { return v; }
#endif
#define GWAVE (GTID / LANES)
#define NWAVES_G (GSTRIDE / LANES)

struct P {
    const float *x, *attn_norm, *w_in, *q_norm, *k_norm, *conv_w, *conv_b, *a_log_f, *a_log_b, *dtb_f, *dtb_b, *ssd_d, *out_norm, *w_out,
        *conv_norm, *cw_in, *cw, *cw_out, *ffn_norm, *router_w, *wg, *wu, *wd;
    float* out;
    bf16_t *WinT, *WoutT, *WciT, *WcoT, *WguT, *WdT, *hn, *qkv, *z, *xbcraw, *bc, *xsT, *bmT, *states, *mix, *yssd, *xe, *hid, *ye, *pbuf, *gb, *abuf;
    float *dtraw, *step, *stT, *csT, *wdT, *cdec, *aff, *gate, *rope, *ytmp;
    int *idx, *slotmap;
    unsigned* bar;
};

constexpr size_t MiB = 1024 * 1024;
constexpr size_t al(size_t v) { return (v + 4095) & ~(size_t)4095; }
constexpr size_t WS_BAR = 0;
constexpr size_t WS_WIN = 65536;
constexpr size_t WS_WOUT = WS_WIN + al((size_t)NIN_PAD * 1024 * 2);
constexpr size_t WS_WCI = WS_WOUT + al((size_t)1024 * 2048 * 2);
constexpr size_t WS_WCO = WS_WCI + al((size_t)3072 * 1024 * 2);
constexpr size_t WS_WGU = WS_WCO + al((size_t)1024 * 1024 * 2);
constexpr size_t WS_WD = WS_WGU + al((size_t)NE * 4096 * 1024 * 2);
constexpr size_t WS_ROPE = WS_WD + al((size_t)NE * 1024 * 2048 * 2);
constexpr size_t WS_AFF = WS_ROPE + al((size_t)SEQ * 16 * 4);
constexpr size_t WS_GATE = WS_AFF + al((size_t)BATCH * NE * SEQ * 4);
constexpr size_t WS_IDX = WS_GATE + al((size_t)NSLOT * 4);
constexpr size_t WS_SMAP = WS_IDX + al((size_t)NSLOT * 4);
constexpr size_t WS_HN = WS_SMAP + al((size_t)BATCH * NE * SEQ * 4);
constexpr size_t WS_E = WS_HN + al((size_t)T * 1024 * 2);
constexpr size_t WS_XBCRAW = WS_E;
constexpr size_t WS_QKV = WS_XBCRAW + al((size_t)T * 1536 * 2);
constexpr size_t WS_Z = WS_QKV + al((size_t)T * 3072 * 2);
constexpr size_t WS_BC = WS_Z + al((size_t)T * 1024 * 2);
constexpr size_t WS_XST = WS_BC + al((size_t)T * 512 * 2);
constexpr size_t WS_BMT = WS_XST + al((size_t)T * 1024 * 2);
constexpr size_t WS_DTRAW = WS_BMT + al((size_t)T * 256 * 2);
constexpr size_t WS_STEP = WS_DTRAW + al((size_t)T * 32 * 4);
constexpr size_t WS_STT = WS_STEP + al((size_t)T * 32 * 4);
constexpr size_t WS_CST = WS_STT + al((size_t)T * 32 * 4);
constexpr size_t WS_WDT = WS_CST + al((size_t)T * 32 * 4);
constexpr size_t WS_CDEC = WS_WDT + al((size_t)T * 32 * 4);
constexpr size_t WS_MIX = WS_CDEC + al((size_t)BATCH * 32 * NCHUNK * 4);
constexpr size_t WS_YSSD = WS_MIX + al((size_t)T * 2048 * 2);
constexpr size_t WS_E_END = WS_YSSD + al((size_t)T * 1024 * 2);
constexpr size_t WS_STATES = WS_HN;
constexpr size_t WS_XE = WS_E;
constexpr size_t WS_HID = WS_XE + al((size_t)NSLOT * 1024 * 2);
constexpr size_t WS_YE = WS_HID + al((size_t)NSLOT * 2048 * 2);
constexpr size_t WS_F_END = WS_YE + al((size_t)NSLOT * 1024 * 2);
constexpr size_t WS_PBUF = WS_E;
constexpr size_t WS_GB = WS_PBUF + al((size_t)T * 1024 * 2);
constexpr size_t WS_ABUF = WS_GB + al((size_t)T * 1024 * 2);
constexpr size_t WS_END = WS_E_END > WS_F_END ? WS_E_END : WS_F_END;
static_assert((size_t)T * 1024 * 2 + (size_t)T * 1536 * 2 >= (size_t)T * 1024 * 4, "ytmp overlay");
static_assert((size_t)T * 1024 * 2 + (size_t)T * 1536 * 2 >= (size_t)BATCH * 2 * NCHUNK * 16 * 64 * 128 * 2, "states overlay");
static_assert(BATCH != 2 || SEQ != 16384 || WS_END <= 1024 * MiB, "workspace");

struct CmIdent { int nvalid; HD int operator()(int n) const { return n < nvalid ? n : -1; } };
struct CmGateUp { HD int operator()(int n) const { return n; } };
struct CmOddIn { HD int operator()(int n) const {
        if (n >= 2048) return n - 2048; const int pn = n >> 8, j = n & 255; return j < 128 ? 1024 + pn * 128 + j : 2048 + pn * 128 + (j - 128); } };

template <class CM> DEV void convT(const float* src, int ldsrc, int K, bf16_t* dst, int Ndst, CM cm) {
#ifndef HOST_EMU
    const size_t nitems = (size_t)Ndst * (K / 32);
    for (size_t i = GTID; i < nitems; i += GSTRIDE) {
        const int n = (int)(i % Ndst), k32 = (int)(i / Ndst); const int c = cm(n);
        float v[32];
#pragma unroll
        for (int j = 0; j < 32; ++j) v[j] = c >= 0 ? src[(size_t)(k32 * 32 + j) * ldsrc + c] : 0.f;
#pragma unroll
        for (int q = 0; q < 4; ++q) *(uint4*)(dst + (size_t)n * K + k32 * 32 + q * 8) = uint4{pack2(v[8 * q], v[8 * q + 1]), pack2(v[8 * q + 2], v[8 * q + 3]), pack2(v[8 * q + 4], v[8 * q + 5]), pack2(v[8 * q + 6], v[8 * q + 7])};
    }
#else
    for (size_t i = GTID; i < (size_t)Ndst * K; i += GSTRIDE) { const int n = (int)(i / K), k = (int)(i % K); const int c = cm(n); dst[i] = c >= 0 ? f2bf(src[(size_t)k * ldsrc + c]) : (bf16_t)0; }
#endif
}
struct CmGU { const float* dummy; HD int operator()(int n) const { return n; } };
template <int WHICH> struct CmHalf { HD int operator()(int n) const { const int j = n & 255; const bool isup = j >= 128; if ((int)isup != WHICH) return -2; return (n >> 8) * 128 + (j & 127); } };
DEV void conv_gateup(const float* sg, const float* su, bf16_t* dst) {
#ifndef HOST_EMU
    const size_t nitems = (size_t)4096 * 32;
    for (size_t i = GTID; i < nitems; i += GSTRIDE) {
        const int n = (int)(i % 4096), k32 = (int)(i / 4096); const int j0 = n & 255; const float* src = (j0 >= 128 ? su : sg) + (n >> 8) * 128 + (j0 & 127);
        float v[32];
#pragma unroll
        for (int j = 0; j < 32; ++j) v[j] = src[(size_t)(k32 * 32 + j) * 2048];
#pragma unroll
        for (int q = 0; q < 4; ++q) *(uint4*)(dst + (size_t)n * 1024 + k32 * 32 + q * 8) = uint4{pack2(v[8 * q], v[8 * q + 1]), pack2(v[8 * q + 2], v[8 * q + 3]), pack2(v[8 * q + 4], v[8 * q + 5]), pack2(v[8 * q + 6], v[8 * q + 7])};
    }
#else
    for (size_t i = GTID; i < (size_t)4096 * 1024; i += GSTRIDE) { const int n = (int)(i / 1024), k = (int)(i % 1024); const int j = n & 255; const float* src = j >= 128 ? su : sg; dst[i] = f2bf(src[(size_t)k * 2048 + (n >> 8) * 128 + (j & 127)]); }
#endif
}
DEV void ph_convert_small(const P& p) {
    convT(p.w_in, NIN, 1024, p.WinT, NIN_PAD, CmIdent{NIN});
    convT(p.w_out, 1024, 2048, p.WoutT, 1024, CmIdent{1024});
    convT(p.cw_in, 3072, 1024, p.WciT, 3072, CmOddIn{});
    convT(p.cw_out, 1024, 1024, p.WcoT, 1024, CmIdent{1024});
    for (size_t i = GTID; i < (size_t)SEQ * 8; i += GSTRIDE) {
        const int pos = (int)(i >> 3), j = (int)(i & 7);
        const float inv = powf(500000.0f, -((float)j * 2.0f / 16.0f)); const float ang = (float)pos * inv;
        p.rope[(size_t)pos * 16 + j] = cosf(ang); p.rope[(size_t)pos * 16 + 8 + j] = sinf(ang);
    }
}
DEV void ph_convert_experts(const P& p, int layer) {
    for (int e = 0; e < NE; ++e) {
        const size_t off = ((size_t)layer * NE + e) * 1024 * 2048;
        conv_gateup(p.wg + off, p.wu + off, p.WguT + (size_t)e * 4096 * 1024);
        convT(p.wd + off, 1024, 2048, p.WdT + (size_t)e * 1024 * 2048, 1024, CmIdent{1024});
    }
}

constexpr int NV = 256 / LANES;
DEV void ph_rmsnorm(const float* src, const float* g, bf16_t* dst) {
    for (size_t row = GWAVE; row < (size_t)T; row += NWAVES_G) {
        const float4* s4 = (const float4*)(src + row * 1024); float4 v[NV]; float ss = 0.f;
#pragma unroll
        for (int j = 0; j < NV; ++j) { v[j] = s4[j * LANES + LANE]; ss += v[j].x * v[j].x + v[j].y * v[j].y + v[j].z * v[j].z + v[j].w * v[j].w; }
        ss = wave_sum(ss); const float r = 1.0f / sqrtf(ss * (1.0f / 1024.0f) + 1e-6f);
#pragma unroll
        for (int j = 0; j < NV; ++j) { const int c4 = j * LANES + LANE; const float4 gg = ((const float4*)g)[c4];
            *(uint2*)(dst + row * 1024 + c4 * 4) = uint2{pack2(v[j].x * r * gg.x, v[j].y * r * gg.y), pack2(v[j].z * r * gg.z, v[j].w * r * gg.w)}; }
    }
}
DEV void ph_norm_router(const P& p, int layer) {
    const float* g = p.ffn_norm + (size_t)layer * 1024; const float* rw = p.router_w + (size_t)layer * 1024 * 16;
    for (size_t row = GWAVE; row < (size_t)T; row += NWAVES_G) {
        const float4* s4 = (const float4*)(p.out + row * 1024); float4 v[NV]; float ss = 0.f;
#pragma unroll
        for (int j = 0; j < NV; ++j) { v[j] = s4[j * LANES + LANE]; ss += v[j].x * v[j].x + v[j].y * v[j].y + v[j].z * v[j].z + v[j].w * v[j].w; }
        ss = wave_sum(ss); const float r = 1.0f / sqrtf(ss * (1.0f / 1024.0f) + 1e-6f);
        float lg[16];
#pragma unroll
        for (int e = 0; e < 16; ++e) lg[e] = 0.f;
#pragma unroll
        for (int j = 0; j < NV; ++j) { const int c4 = j * LANES + LANE; const float4 gg = ((const float4*)g)[c4];
            const float h0 = v[j].x * r * gg.x, h1 = v[j].y * r * gg.y, h2 = v[j].z * r * gg.z, h3 = v[j].w * r * gg.w;
            *(uint2*)(p.hn + row * 1024 + c4 * 4) = uint2{pack2(h0, h1), pack2(h2, h3)};
            const float4* w4 = (const float4*)(rw + (size_t)c4 * 4 * 16);
#pragma unroll
            for (int q = 0; q < 4; ++q) { const float4 a = w4[q], b = w4[4 + q], c = w4[8 + q], d = w4[12 + q];
                lg[4 * q + 0] += h0 * a.x + h1 * b.x + h2 * c.x + h3 * d.x; lg[4 * q + 1] += h0 * a.y + h1 * b.y + h2 * c.y + h3 * d.y;
                lg[4 * q + 2] += h0 * a.z + h1 * b.z + h2 * c.z + h3 * d.z; lg[4 * q + 3] += h0 * a.w + h1 * b.w + h2 * c.w + h3 * d.w; } }
        float mx = -1e30f;
#pragma unroll
        for (int e = 0; e < 16; ++e) { lg[e] = wave_sum(lg[e]); mx = fmaxf(mx, lg[e]); }
        float den = 0.f;
#pragma unroll
        for (int e = 0; e < 16; ++e) { lg[e] = expf(lg[e] - mx); den += lg[e]; }
        const float inv = 1.0f / den; const int b = (int)(row / SEQ), s = (int)(row % SEQ);
#pragma unroll
        for (int e = 0; e < 16; ++e) if (LANE == (e & (LANES - 1))) p.aff[((size_t)b * NE + e) * SEQ + s] = lg[e] * inv;
    }
}
DEV void ph_gated_norm(const P& p) {
    for (size_t row = GWAVE; row < (size_t)T; row += NWAVES_G) {
        float4 v[NV]; float ss = 0.f;
#pragma unroll
        for (int j = 0; j < NV; ++j) { const int c4 = j * LANES + LANE; const uint2 y = *(const uint2*)(p.yssd + row * 1024 + c4 * 4), zz = *(const uint2*)(p.z + row * 1024 + c4 * 4);
            v[j].x = bf2f((bf16_t)(y.x & 0xffff)) * silu_f(bf2f((bf16_t)(zz.x & 0xffff))); v[j].y = bf2f((bf16_t)(y.x >> 16)) * silu_f(bf2f((bf16_t)(zz.x >> 16)));
            v[j].z = bf2f((bf16_t)(y.y & 0xffff)) * silu_f(bf2f((bf16_t)(zz.y & 0xffff))); v[j].w = bf2f((bf16_t)(y.y >> 16)) * silu_f(bf2f((bf16_t)(zz.y >> 16)));
            ss += v[j].x * v[j].x + v[j].y * v[j].y + v[j].z * v[j].z + v[j].w * v[j].w; }
        ss = wave_sum(ss); const float r = 1.0f / sqrtf(ss * (1.0f / 1024.0f) + 1e-6f);
#pragma unroll
        for (int j = 0; j < NV; ++j) { const int c4 = j * LANES + LANE; const float4 gg = ((const float4*)p.out_norm)[c4];
            *(uint2*)(p.mix + row * 2048 + 1024 + c4 * 4) = uint2{pack2(v[j].x * r * gg.x, v[j].y * r * gg.y), pack2(v[j].z * r * gg.z, v[j].w * r * gg.w)}; }
    }
}
DEV void ph_combine(const P& p, const float* g) {
    for (size_t row = GWAVE; row < (size_t)T; row += NWAVES_G) {
        const int b = (int)(row / SEQ), s = (int)(row % SEQ);
        float4* o4 = (float4*)(p.out + row * 1024); float4 v[NV];
#pragma unroll
        for (int j = 0; j < NV; ++j) v[j] = o4[j * LANES + LANE];
        for (int e = 0; e < NE; ++e) {
            const int sl = p.slotmap[((size_t)b * NE + e) * SEQ + s];
            if (sl >= 0) { const size_t r = ((size_t)b * NE + e) * CAP + sl; const float gt = p.gate[r];
#pragma unroll
                for (int j = 0; j < NV; ++j) { const int c4 = j * LANES + LANE; const uint2 y = *(const uint2*)(p.ye + r * 1024 + c4 * 4);
                    v[j].x += gt * bf2f((bf16_t)(y.x & 0xffff)); v[j].y += gt * bf2f((bf16_t)(y.x >> 16)); v[j].z += gt * bf2f((bf16_t)(y.y & 0xffff)); v[j].w += gt * bf2f((bf16_t)(y.y >> 16)); } }
        }
        float ss = 0.f;
#pragma unroll
        for (int j = 0; j < NV; ++j) { o4[j * LANES + LANE] = v[j]; ss += v[j].x * v[j].x + v[j].y * v[j].y + v[j].z * v[j].z + v[j].w * v[j].w; }
        if (g) { ss = wave_sum(ss); const float r = 1.0f / sqrtf(ss * (1.0f / 1024.0f) + 1e-6f);
#pragma unroll
            for (int j = 0; j < NV; ++j) { const int c4 = j * LANES + LANE; const float4 gg = ((const float4*)g)[c4];
                *(uint2*)(p.hn + row * 1024 + c4 * 4) = uint2{pack2(v[j].x * r * gg.x, v[j].y * r * gg.y), pack2(v[j].z * r * gg.z, v[j].w * r * gg.w)}; } }
    }
}

DEV void ld8(const bf16_t* p, float (&f)[8]) { const uint4 u = *(const uint4*)p; const unsigned w[4] = {u.x, u.y, u.z, u.w};
#pragma unroll
    for (int j = 0; j < 4; ++j) { f[2 * j] = bf2f((bf16_t)(w[j] & 0xffff)); f[2 * j + 1] = bf2f((bf16_t)(w[j] >> 16)); } }
DEV void st8(bf16_t* p, const float (&f)[8]) { *(uint4*)p = uint4{pack2(f[0], f[1]), pack2(f[2], f[3]), pack2(f[4], f[5]), pack2(f[6], f[7])}; }

DEV void ph_prep(const P& p, bool doqk = true) {
    for (size_t i = GTID; doqk && i < (size_t)T * 32; i += GSTRIDE) {
        const size_t t = i >> 5; const int hh = (int)(i & 31); const int isk = hh >> 4, h = hh & 15; const int pos = (int)(t % SEQ);
        bf16_t* ptr = p.qkv + t * 3072 + isk * 1024 + h * 64; const float* gn = isk ? p.k_norm : p.q_norm;
        float v[64]; float ss = 0.f;
#pragma unroll
        for (int c = 0; c < 8; ++c) { float f[8]; ld8(ptr + c * 8, f);
#pragma unroll
            for (int j = 0; j < 8; ++j) { v[c * 8 + j] = f[j]; ss += f[j] * f[j]; } }
        const float r = 1.0f / sqrtf(ss * (1.0f / 64.0f) + 1e-6f);
#pragma unroll
        for (int c = 0; c < 64; ++c) v[c] = v[c] * r * gn[c];
#pragma unroll
        for (int j = 0; j < 8; ++j) { const float cs = p.rope[(size_t)pos * 16 + j], sn = p.rope[(size_t)pos * 16 + 8 + j]; const float x1 = v[j], x2 = v[8 + j]; v[j] = x1 * cs - x2 * sn; v[8 + j] = x2 * cs + x1 * sn; }
#pragma unroll
        for (int c = 0; c < 8; ++c) { float f[8];
#pragma unroll
            for (int j = 0; j < 8; ++j) f[j] = v[c * 8 + j];
            st8(ptr + c * 8, f); }
    }
    for (size_t i = GTID; i < (size_t)T * 192; i += GSTRIDE) {
        const size_t t = i % T; const int c8 = (int)(i / T) * 8; const int pos = (int)(t % SEQ); const int b = (int)(t / SEQ);
        float acc[8];
#pragma unroll
        for (int j = 0; j < 8; ++j) acc[j] = p.conv_b[c8 + j];
#pragma unroll
        for (int k = 0; k < 5; ++k) { const int pp = pos + k - 2; if (pp < 0 || pp >= SEQ) continue; float f[8]; ld8(p.xbcraw + (t + k - 2) * 1536 + c8, f);
#pragma unroll
            for (int j = 0; j < 8; ++j) acc[j] += f[j] * p.conv_w[k * 1536 + c8 + j]; }
#pragma unroll
        for (int j = 0; j < 8; ++j) acc[j] = silu_f(acc[j]);
        if (c8 < 1024) {
#pragma unroll
            for (int j = 0; j < 8; ++j) p.xsT[((size_t)b * 1024 + c8 + j) * SEQ + pos] = f2bf(acc[j]);
        } else {
            st8(p.bc + t * 512 + (c8 - 1024), acc);
            if (c8 < 1280) {
#pragma unroll
                for (int j = 0; j < 8; ++j) p.bmT[((size_t)b * 256 + (c8 - 1024) + j) * SEQ + pos] = f2bf(acc[j]); }
        }
    }
    for (size_t i = GTID; i < (size_t)BATCH * NCHUNK * 32; i += GSTRIDE) {
        const int j = (int)(i & 31); const int c = (int)((i >> 5) % NCHUNK), b = (int)((i >> 5) / NCHUNK); const int dir = j >> 4, h = j & 15;
        const float A = -expf(dir ? p.a_log_b[h] : p.a_log_f[h]), bias = dir ? p.dtb_b[h] : p.dtb_f[h];
        const size_t row0 = (size_t)b * SEQ + (size_t)c * 128; float* stT = p.stT + ((size_t)b * 32 + j) * SEQ + c * 128; float* csT = p.csT + ((size_t)b * 32 + j) * SEQ + c * 128; float* wdT = p.wdT + ((size_t)b * 32 + j) * SEQ + c * 128;
        float run = 0.f;
        for (int ll = 0; ll < 128; ++ll) { const int l = dir ? 127 - ll : ll; const float dt = softplus_f(p.dtraw[(row0 + l) * 32 + j] + bias); p.step[(row0 + l) * 32 + j] = dt; stT[l] = dt; run += dt * A; csT[l] = run; }
        for (int l = 0; l < 128; ++l) wdT[l] = stT[l] * expf(run - csT[l]);
        p.cdec[((size_t)b * 32 + j) * NCHUNK + c] = expf(run);
    }
}
DEV void ph_gather(const P& p) {
    for (size_t i = GTID; i < (size_t)NSLOT * 128; i += GSTRIDE) { const size_t r = i >> 7; const int j = (int)(i & 127); const int b = (int)(r / ((size_t)NE * CAP));
        *(uint4*)(p.xe + r * 1024 + j * 8) = *(const uint4*)(p.hn + ((size_t)b * SEQ + p.idx[r]) * 1024 + j * 8); }
}
DEV void ph_conv3(const P& p) {
    for (size_t i = GTID; i < (size_t)T * 128; i += GSTRIDE) {
        const size_t t = i >> 7; const int c8 = (int)(i & 127) * 8; const int pos = (int)(t % SEQ);
        float acc[8], f[8];
#pragma unroll
        for (int j = 0; j < 8; ++j) acc[j] = 0.f;
#pragma unroll
        for (int k = 0; k < 3; ++k) { const int pp = pos + k - 1; if (pp < 0 || pp >= SEQ) continue; ld8(p.pbuf + (t + k - 1) * 1024 + c8, f);
#pragma unroll
            for (int j = 0; j < 8; ++j) acc[j] += f[j] * p.cw[k * 1024 + c8 + j]; }
        ld8(p.gb + t * 1024 + c8, f);
#pragma unroll
        for (int j = 0; j < 8; ++j) acc[j] *= f[j];
        st8(p.abuf + t * 1024 + c8, acc);
    }
}

DEV float dot_bf(const bf16_t* a, const bf16_t* b, int K) { float acc = 0.f; for (int k = 0; k < K; k += 8) { float fa[8], fb[8]; ld8(a + k, fa); ld8(b + k, fb);
#pragma unroll
        for (int j = 0; j < 8; ++j) acc += fa[j] * fb[j]; } return acc; }
DEV void nv_g1(const P& p) {
    for (size_t i = GTID; i < (size_t)T * NIN; i += GSTRIDE) { const size_t m = i / NIN; const int n = (int)(i % NIN); const float acc = dot_bf(p.hn + m * 1024, p.WinT + (size_t)n * 1024, 1024);
        if (n < 3072) p.qkv[m * 3072 + n] = f2bf(acc); else if (n < 4096) p.z[m * 1024 + n - 3072] = f2bf(acc); else if (n < 5632) p.xbcraw[m * 1536 + n - 4096] = f2bf(acc); else p.dtraw[m * 32 + n - 5632] = acc; }
}
DEV void nv_g2(const P& p) {
    for (size_t i = GTID; i < (size_t)T * 1024; i += GSTRIDE) { const size_t m = i >> 10; const int n = (int)(i & 1023); p.out[i] = p.x[i] + dot_bf(p.mix + m * 2048, p.WoutT + (size_t)n * 2048, 2048); }
}
DEV void nv_up(const P& p) {
    for (size_t i = GTID; i < (size_t)NSLOT * 2048; i += GSTRIDE) { const size_t r = i >> 11; const int n = (int)(i & 2047); const int e = (int)((r / CAP) % NE);
        const bf16_t* w = p.WguT + (size_t)e * 4096 * 1024 + (size_t)((n >> 7) * 256 + (n & 127)) * 1024;
        const float g = dot_bf(p.xe + r * 1024, w, 1024), u = dot_bf(p.xe + r * 1024, w + (size_t)128 * 1024, 1024); p.hid[i] = f2bf(silu_f(g) * u); }
}
DEV void nv_down(const P& p) {
    for (size_t i = GTID; i < (size_t)NSLOT * 1024; i += GSTRIDE) { const size_t r = i >> 10; const int n = (int)(i & 1023); const int e = (int)((r / CAP) % NE);
        p.ye[i] = f2bf(dot_bf(p.hid + r * 2048, p.WdT + (size_t)e * 1024 * 2048 + (size_t)n * 2048, 2048)); }
}
DEV void nv_g3(const P& p) {
    for (size_t i = GTID; i < (size_t)T * 2048; i += GSTRIDE) { const size_t m = i >> 11; const int n = (int)(i & 2047);
        if (n < 1024) { const bf16_t* w = p.WciT + (size_t)((n >> 7) * 256 + (n & 127)) * 1024; p.pbuf[m * 1024 + n] = f2bf(dot_bf(p.hn + m * 1024, w, 1024) * dot_bf(p.hn + m * 1024, w + (size_t)128 * 1024, 1024)); }
        else p.gb[m * 1024 + n - 1024] = f2bf(dot_bf(p.hn + m * 1024, p.WciT + (size_t)(2048 + n - 1024) * 1024, 1024)); }
}
DEV void nv_g4(const P& p) {
    for (size_t i = GTID; i < (size_t)T * 1024; i += GSTRIDE) { const size_t m = i >> 10; const int n = (int)(i & 1023); p.out[i] += dot_bf(p.abuf + m * 1024, p.WcoT + (size_t)n * 1024, 1024); }
}
DEV void nv_attn(const P& p) {
    for (size_t i = GTID; i < (size_t)T * 16; i += GSTRIDE) {
        const size_t t = i >> 4; const int h = (int)(i & 15); const int pos = (int)(t % SEQ); const size_t t0 = t - pos;
        const bf16_t* qp = p.qkv + t * 3072 + h * 64;
        float o[64]; float m = -1e30f, l = 0.f;
#pragma unroll
        for (int c = 0; c < 64; ++c) o[c] = 0.f;
        for (int pat = 0; pat < 3; ++pat) { const int d = pat == 0 ? 1 : (pat == 1 ? 4 : 16);
            for (int j = -64; j <= 64; ++j) { const int kp = pos + d * j; if (kp < 0 || kp >= SEQ) continue;
                const bf16_t* kr = p.qkv + (t0 + kp) * 3072 + 1024 + h * 64; const bf16_t* vr = kr + 1024;
                const float s = dot_bf(qp, kr, 64) * 0.125f;
                const float mn = fmaxf(m, s), sc = expf(m - mn), pe = expf(s - mn); l = l * sc + pe; m = mn;
#pragma unroll
                for (int c = 0; c < 8; ++c) { float f[8]; ld8(vr + c * 8, f);
#pragma unroll
                    for (int q = 0; q < 8; ++q) o[c * 8 + q] = o[c * 8 + q] * sc + pe * f[q]; } } }
        const float inv = 1.0f / l;
#pragma unroll
        for (int c = 0; c < 8; ++c) { float f[8];
#pragma unroll
            for (int q = 0; q < 8; ++q) f[q] = o[c * 8 + q] * inv;
            st8(p.mix + t * 2048 + h * 64 + c * 8, f); }
    }
}
DEV void nv_ssd(const P& p) {
    const size_t nitem = (size_t)BATCH * 16 * 64;
#ifndef HOST_EMU
    if (LANE != 0) return;
#endif
    for (size_t it = GWAVE; it < nitem; it += NWAVES_G) {
        const int b = (int)(it / 1024), h = (int)((it >> 6) & 15), pc = (int)(it & 63), g = h >> 3;
        const float af = -expf(p.a_log_f[h]), ab = -expf(p.a_log_b[h]), dsk = p.ssd_d[h];
        float st[128];
        for (int dir = 0; dir < 2; ++dir) {
#pragma unroll
            for (int n = 0; n < 128; ++n) st[n] = 0.f;
            for (int tt = 0; tt < SEQ; ++tt) { const int s = dir ? SEQ - 1 - tt : tt; const size_t row = (size_t)b * SEQ + s;
                const float dt = p.step[row * 32 + dir * 16 + h]; const float dec = expf(dt * (dir ? ab : af)); const float xv = bf2f(p.xsT[((size_t)b * 1024 + h * 64 + pc) * SEQ + s]); const float xdt = xv * dt;
                const bf16_t* bm = p.bc + row * 512 + g * 128; const bf16_t* cm = bm + 256; float y = 0.f;
#pragma unroll
                for (int n8 = 0; n8 < 16; ++n8) { float fb[8], fc[8]; ld8(bm + n8 * 8, fb); ld8(cm + n8 * 8, fc);
#pragma unroll
                    for (int j = 0; j < 8; ++j) { st[n8 * 8 + j] = st[n8 * 8 + j] * dec + xdt * fb[j]; y += fc[j] * st[n8 * 8 + j]; } }
                if (dir == 0) p.ytmp[row * 1024 + h * 64 + pc] = y; else p.yssd[row * 1024 + h * 64 + pc] = f2bf(p.ytmp[row * 1024 + h * 64 + pc] + y + xv * dsk); }
        }
    }
}
DEV void nv_topk(const P& p) {
    for (size_t i = GTID; i < (size_t)BATCH * NE * SEQ; i += GSTRIDE) { const size_t be = i / SEQ; const int s = (int)(i % SEQ); const float* a = p.aff + be * SEQ; const float v = a[s]; int rank = 0;
        for (int j = 0; j < SEQ; ++j) { const float w = a[j]; rank += (w > v || (w == v && j < s)) ? 1 : 0; }
        if (rank < CAP) { p.idx[be * CAP + rank] = s; p.gate[be * CAP + rank] = v; p.slotmap[i] = rank; } else p.slotmap[i] = -1; }
}

static void make_params(P& p, void* const* d_in, void* d_out, void* d_ws) {
    const float** ins = (const float**)&p.x;
    for (int i = 0; i < 23; ++i) ins[i] = (const float*)d_in[i];
    p.out = (float*)d_out;
    unsigned char* ws = (unsigned char*)d_ws;
    p.WinT = (bf16_t*)(ws + WS_WIN); p.WoutT = (bf16_t*)(ws + WS_WOUT); p.WciT = (bf16_t*)(ws + WS_WCI); p.WcoT = (bf16_t*)(ws + WS_WCO); p.WguT = (bf16_t*)(ws + WS_WGU); p.WdT = (bf16_t*)(ws + WS_WD);
    p.hn = (bf16_t*)(ws + WS_HN); p.qkv = (bf16_t*)(ws + WS_QKV); p.z = (bf16_t*)(ws + WS_Z); p.xbcraw = (bf16_t*)(ws + WS_XBCRAW); p.bc = (bf16_t*)(ws + WS_BC); p.xsT = (bf16_t*)(ws + WS_XST); p.bmT = (bf16_t*)(ws + WS_BMT); p.states = (bf16_t*)(ws + WS_STATES); p.mix = (bf16_t*)(ws + WS_MIX); p.yssd = (bf16_t*)(ws + WS_YSSD);
    p.xe = (bf16_t*)(ws + WS_XE); p.hid = (bf16_t*)(ws + WS_HID); p.ye = (bf16_t*)(ws + WS_YE); p.pbuf = (bf16_t*)(ws + WS_PBUF); p.gb = (bf16_t*)(ws + WS_GB); p.abuf = (bf16_t*)(ws + WS_ABUF);
    p.dtraw = (float*)(ws + WS_DTRAW); p.step = (float*)(ws + WS_STEP); p.aff = (float*)(ws + WS_AFF); p.gate = (float*)(ws + WS_GATE); p.rope = (float*)(ws + WS_ROPE); p.ytmp = (float*)(ws + WS_STATES); p.stT = (float*)(ws + WS_STT); p.csT = (float*)(ws + WS_CST); p.wdT = (float*)(ws + WS_WDT); p.cdec = (float*)(ws + WS_CDEC);
    p.idx = (int*)(ws + WS_IDX); p.slotmap = (int*)(ws + WS_SMAP); p.bar = (unsigned*)(ws + WS_BAR);
}
#ifndef HOST_EMU
DEV void ph_norm_router_dev(const P& p, int layer) {
    const float4* g4 = (const float4*)(p.ffn_norm + (size_t)layer * 1024); const float4* rw4 = (const float4*)(p.router_w + (size_t)layer * 1024 * 16);
    const int lane = LANE;
    for (size_t row0 = GWAVE * 4; row0 < (size_t)T; row0 += NWAVES_G * 4) {
        float rinv[4];
        { float ss[4] = {0.f, 0.f, 0.f, 0.f};
#pragma unroll
          for (int j = 0; j < 4; ++j)
#pragma unroll
            for (int r = 0; r < 4; ++r) { const float4 t = ((const float4*)(p.out + (row0 + r) * 1024))[j * 64 + lane]; ss[r] += t.x * t.x + t.y * t.y + t.z * t.z + t.w * t.w; }
#pragma unroll
          for (int r = 0; r < 4; ++r) { const float q = wave_sum(ss[r]); rinv[r] = 1.0f / sqrtf(q * (1.0f / 1024.0f) + 1e-6f); } }
        float lg[4][16];
#pragma unroll
        for (int r = 0; r < 4; ++r)
#pragma unroll
            for (int e = 0; e < 16; ++e) lg[r][e] = 0.f;
#pragma unroll 1
        for (int j = 0; j < 4; ++j) { const int c4 = j * 64 + lane; const float4 gg = g4[c4]; float h[4][4];
#pragma unroll
            for (int r = 0; r < 4; ++r) { const float4 t = ((const float4*)(p.out + (row0 + r) * 1024))[c4];
                h[r][0] = t.x * rinv[r] * gg.x; h[r][1] = t.y * rinv[r] * gg.y; h[r][2] = t.z * rinv[r] * gg.z; h[r][3] = t.w * rinv[r] * gg.w;
                *(uint2*)(p.hn + (row0 + r) * 1024 + c4 * 4) = uint2{pack2(h[r][0], h[r][1]), pack2(h[r][2], h[r][3])}; }
#pragma unroll
            for (int cc = 0; cc < 4; ++cc) {
#pragma unroll
                for (int q = 0; q < 4; ++q) { const float4 w = rw4[(size_t)(c4 * 4 + cc) * 4 + q];
#pragma unroll
                    for (int r = 0; r < 4; ++r) { lg[r][4 * q] += h[r][cc] * w.x; lg[r][4 * q + 1] += h[r][cc] * w.y; lg[r][4 * q + 2] += h[r][cc] * w.z; lg[r][4 * q + 3] += h[r][cc] * w.w; } }
                asm volatile("" ::: "memory"); } }
#pragma unroll
        for (int r = 0; r < 4; ++r) { float mx = -1e30f;
#pragma unroll
            for (int e = 0; e < 16; ++e) { lg[r][e] = wave_sum(lg[r][e]); mx = fmaxf(mx, lg[r][e]); }
            float den = 0.f;
#pragma unroll
            for (int e = 0; e < 16; ++e) { lg[r][e] = expf(lg[r][e] - mx); den += lg[r][e]; }
            const float inv = 1.0f / den; const size_t row = row0 + r; const int b = (int)(row / SEQ), s = (int)(row % SEQ);
#pragma unroll
            for (int e = 0; e < 16; ++e) if (lane == e) p.aff[((size_t)b * NE + e) * SEQ + s] = lg[r][e] * inv; }
    }
}
DEV void ph_gated_norm_dev(const P& p) {
    const int lane = LANE;
    for (size_t row0 = GWAVE * 2; row0 < (size_t)T; row0 += NWAVES_G * 2) {
        uint2 yv[2][4], zv[2][4];
#pragma unroll
        for (int r = 0; r < 2; ++r)
#pragma unroll
            for (int j = 0; j < 4; ++j) { const int c4 = j * 64 + lane; yv[r][j] = *(const uint2*)(p.yssd + (row0 + r) * 1024 + c4 * 4); zv[r][j] = *(const uint2*)(p.z + (row0 + r) * 1024 + c4 * 4); }
#pragma unroll
        for (int r = 0; r < 2; ++r) { float4 v[4]; float ss = 0.f;
#pragma unroll
            for (int j = 0; j < 4; ++j) { const uint2 y = yv[r][j], zz = zv[r][j];
                const float z0 = __uint_as_float(zz.x << 16), z1 = __uint_as_float(zz.x & 0xffff0000u), z2 = __uint_as_float(zz.y << 16), z3 = __uint_as_float(zz.y & 0xffff0000u);
                v[j].x = __uint_as_float(y.x << 16) * z0 * __builtin_amdgcn_rcpf(1.0f + __expf(-z0)); v[j].y = __uint_as_float(y.x & 0xffff0000u) * z1 * __builtin_amdgcn_rcpf(1.0f + __expf(-z1));
                v[j].z = __uint_as_float(y.y << 16) * z2 * __builtin_amdgcn_rcpf(1.0f + __expf(-z2)); v[j].w = __uint_as_float(y.y & 0xffff0000u) * z3 * __builtin_amdgcn_rcpf(1.0f + __expf(-z3));
                ss += v[j].x * v[j].x + v[j].y * v[j].y + v[j].z * v[j].z + v[j].w * v[j].w; }
            ss = wave_sum(ss); const float rr = 1.0f / sqrtf(ss * (1.0f / 1024.0f) + 1e-6f);
#pragma unroll
            for (int j = 0; j < 4; ++j) { const int c4 = j * 64 + lane; const float4 gg = ((const float4*)p.out_norm)[c4];
                *(uint2*)(p.mix + (row0 + r) * 2048 + 1024 + c4 * 4) = uint2{pack2(v[j].x * rr * gg.x, v[j].y * rr * gg.y), pack2(v[j].z * rr * gg.z, v[j].w * rr * gg.w)}; } }
    }
}
DEV void ph_combine_dev(const P& p, const float* g) {
    const int lane = LANE;
    for (size_t row = GWAVE; row < (size_t)T; row += NWAVES_G) {
        const int b = (int)(row / SEQ), s = (int)(row % SEQ);
        int mysl = -1; float mygt = 0.f;
        if (lane < 16) { mysl = p.slotmap[((size_t)b * NE + lane) * SEQ + s]; if (mysl >= 0) mygt = p.gate[((size_t)b * NE + lane) * CAP + mysl]; }
        float4* o4 = (float4*)(p.out + row * 1024); float4 v[4];
#pragma unroll
        for (int j = 0; j < 4; ++j) v[j] = o4[j * 64 + lane];
        unsigned long long mask = __ballot(mysl >= 0);
        while (mask) {
            const int e = __builtin_ctzll(mask); mask &= mask - 1;
            const int sl = __shfl(mysl, e); const float gt = __shfl(mygt, e); const size_t r = ((size_t)b * NE + e) * CAP + sl;
            uint2 y[4];
#pragma unroll
            for (int j = 0; j < 4; ++j) y[j] = *(const uint2*)(p.ye + r * 1024 + (j * 64 + lane) * 4);
#pragma unroll
            for (int j = 0; j < 4; ++j) { v[j].x += gt * __uint_as_float(y[j].x << 16); v[j].y += gt * __uint_as_float(y[j].x & 0xffff0000u); v[j].z += gt * __uint_as_float(y[j].y << 16); v[j].w += gt * __uint_as_float(y[j].y & 0xffff0000u); }
        }
        float ss = 0.f;
#pragma unroll
        for (int j = 0; j < 4; ++j) { o4[j * 64 + lane] = v[j]; ss += v[j].x * v[j].x + v[j].y * v[j].y + v[j].z * v[j].z + v[j].w * v[j].w; }
        if (g) { ss = wave_sum(ss); const float rr = 1.0f / sqrtf(ss * (1.0f / 1024.0f) + 1e-6f);
#pragma unroll
            for (int j = 0; j < 4; ++j) { const int c4 = j * 64 + lane; const float4 gg = ((const float4*)g)[c4];
                *(uint2*)(p.hn + row * 1024 + c4 * 4) = uint2{pack2(v[j].x * rr * gg.x, v[j].y * rr * gg.y), pack2(v[j].z * rr * gg.z, v[j].w * rr * gg.w)}; } }
    }
}

#define LAS __attribute__((address_space(3)))
typedef short bf16x8 __attribute__((ext_vector_type(8)));
typedef float f32x4 __attribute__((ext_vector_type(4)));
typedef unsigned u32x4 __attribute__((ext_vector_type(4)));
namespace pg8 {
constexpr int BM = 256, BK = 64, HALF = 128, HTB = HALF * BK * 2  , STAGE_BYTES = 8 * HTB, NXCD = 8, WGM = 8;
DEV int lds_byte(int r, int c) { const int st = (r >> 4) * 2 + (c >> 5), rr = r & 15, cc = c & 31, ob = rr * 64 + cc * 2; return st * 1024 + (ob ^ (((ob >> 9) & 1) << 5)); }
DEV void stage_rc(int b, int& R, int& C) { const int st = b / 1024, sb = b % 1024, swz = sb ^ (((sb >> 9) & 1) << 5); R = (st >> 1) * 16 + swz / 64; C = (st & 1) * 32 + (swz % 64) / 2; }
DEV int perm32(int rho) { const int n = rho >> 4, i = rho & 15; return 8 * (i >> 2) + 4 * n + (i & 3); }
struct Unit { int row0, col0, brow0; };
struct StaticOrder {
    int nM, nN, nwg, G, c, brows, tpg;
    DEV void init(int M, int N, int G_, int c_, int brows_, int tpg_) { nM = M / BM; nN = N / BM; nwg = nM * nN; G = G_; c = c_; brows = brows_; tpg = tpg_; }
    DEV bool next(int i, Unit& u) const {
        const long L = (long)i * G + c; if (L >= nwg) return false;
        int wgid = (int)L; { const int q = nwg / NXCD, r = nwg % NXCD, xcd = wgid % NXCD, off = wgid / NXCD; wgid = (xcd < r ? xcd * (q + 1) : r * (q + 1) + (xcd - r) * q) + off; }
        const int nig = WGM * nN, gid = wgid / nig, fm = gid * WGM, gsz = (nM - fm) < WGM ? (nM - fm) : WGM;
        const int pm = fm + ((wgid % nig) % gsz), pn = (wgid % nig) / gsz;
        u.row0 = pm * BM; u.col0 = pn * BM; u.brow0 = pn * BM + (brows ? ((pm / tpg) % NE) * brows : 0); return true;
    }
};
DEV unsigned cvt_pk_bf16(float lo, float hi) { unsigned r; asm volatile("v_cvt_pk_bf16_f32 %0, %1, %2" : "=v"(r) : "v"(lo), "v"(hi)); return r; }
typedef float f32x2_t __attribute__((ext_vector_type(2)));
typedef __bf16 bf16x2_t __attribute__((ext_vector_type(2)));
DEV unsigned cvt_pk_safe(float lo, float hi) { const f32x2_t v = {lo, hi}; return __builtin_bit_cast(unsigned, __builtin_convertvector(v, bf16x2_t)); }

template <class Epi, class Sched>
DEV void gemm_phase(LAS unsigned char* lds, const bf16_t* A, const bf16_t* Bt, const int K, const Sched& S, const Epi& E) {
    const int tid = threadIdx.x, wid = __builtin_amdgcn_readfirstlane(tid >> 6), lane = tid & 63, wr = wid >> 2, wc = wid & 3, fr = lane & 15, fq = lane >> 4;
    const int nt = K / BK;
    unsigned voffA[2], voffB[2];
#pragma unroll
    for (int i = 0; i < 2; ++i) { int R, C; stage_rc(tid * 16 + i * 8192, R, C); const int Rb = Epi::PERM ? ((R & ~31) + perm32(R & 31)) : R;
        voffA[i] = (unsigned)(R * K + C) * 2u; voffB[i] = (unsigned)(Rb * K + C) * 2u; }
    const size_t kstep = (size_t)(BK * 2);
    const size_t hstep = (size_t)HALF * K * 2;
    const size_t rstep = (size_t)K * 2;
    const unsigned ldsw = (unsigned)wid * 1024u;
    const int aoff = lds_byte(wr * 64 + fr, fq * 8), boff = lds_byte(wc * 32 + fr, fq * 8);
#define PG8_SA(b, h) (((b) * 2 + (h)) * HTB)
#define PG8_SB(b, h) ((4 + (b) * 2 + (h)) * HTB)
#define PG8_STAGE(bufoff, gbase, voff) do { _Pragma("unroll") for (int _i = 0; _i < 2; ++_i) \
        __builtin_amdgcn_global_load_lds((const unsigned*)((const char*)(gbase) + (voff)[_i]), (LAS unsigned*)(lds + (bufoff) + ldsw + _i * 8192), 16, 0, 0); } while (0)
#define PG8_LDA(dst, b, h) do { _Pragma("unroll") for (int m = 0; m < 4; ++m) _Pragma("unroll") for (int k = 0; k < 2; ++k) dst[m][k] = *(const LAS bf16x8*)(lds + PG8_SA(b, h) + aoff + m * 2048 + k * 1024); } while (0)
#define PG8_LDB(dst, b, h) do { _Pragma("unroll") for (int n = 0; n < 2; ++n) _Pragma("unroll") for (int k = 0; k < 2; ++k) dst[n][k] = *(const LAS bf16x8*)(lds + PG8_SB(b, h) + boff + n * 2048 + k * 1024); } while (0)
#define PG8_MMA(ai, bj, At, Bt_) do { __builtin_amdgcn_s_setprio(1); _Pragma("unroll") for (int m = 0; m < 4; ++m) _Pragma("unroll") for (int n = 0; n < 2; ++n) _Pragma("unroll") for (int k = 0; k < 2; ++k) \
        acc[ai][bj][m][n] = __builtin_amdgcn_mfma_f32_16x16x32_bf16(Bt_[n][k], At[m][k], acc[ai][bj][m][n], 0, 0, 0); __builtin_amdgcn_s_setprio(0); } while (0)
#define PG8_WAIT_V(n) asm volatile("s_waitcnt vmcnt(" #n ")" ::: "memory")
#define PG8_WAIT_L(n) asm volatile("s_waitcnt lgkmcnt(" #n ")" ::: "memory")
#define PG8_BAR __builtin_amdgcn_s_barrier()
#define PG8_SCHED __builtin_amdgcn_sched_barrier(0)
    Unit cur, nxt; int ui = 0;
    if (!S.next(0, cur)) return;
    f32x4 acc[2][2][4][2];
#pragma unroll
    for (int a = 0; a < 2; ++a)
#pragma unroll
        for (int b = 0; b < 2; ++b)
#pragma unroll
            for (int m = 0; m < 4; ++m)
#pragma unroll
                for (int n = 0; n < 2; ++n) acc[a][b][m][n] = (f32x4){0.f, 0.f, 0.f, 0.f};
    bf16x8 At[4][2], B0[2][2], B1[2][2];
    const char* cA = (const char*)A + (size_t)cur.row0 * rstep; const char* cB = (const char*)Bt + (size_t)cur.brow0 * rstep;
    PG8_STAGE(PG8_SB(0, 0), cB, voffB); PG8_STAGE(PG8_SA(0, 0), cA, voffA); PG8_STAGE(PG8_SB(0, 1), cB + hstep, voffB); PG8_STAGE(PG8_SA(0, 1), cA + hstep, voffA);
    if (wr == 1) PG8_BAR;
    PG8_WAIT_V(4); PG8_BAR;
    PG8_STAGE(PG8_SB(1, 0), cB + kstep, voffB); PG8_STAGE(PG8_SA(1, 0), cA + kstep, voffA); PG8_STAGE(PG8_SB(1, 1), cB + hstep + kstep, voffB);
    PG8_WAIT_V(6); PG8_BAR;
    for (;;) {
        const bool has_next = S.next(ui + 1, nxt);
        const char* nA = has_next ? (const char*)A + (size_t)nxt.row0 * rstep : cA; const char* nB = has_next ? (const char*)Bt + (size_t)nxt.brow0 * rstep : cB;
        for (int t = 0; t < nt; t += 2) {
            const bool last = (t == nt - 2);
            const char* a1 = cA + (size_t)(t + 1) * kstep;
            const char* a2 = last ? nA : cA + (size_t)(t + 2) * kstep; const char* b2 = last ? nB : cB + (size_t)(t + 2) * kstep;
            const char* a3 = a2 + kstep; const char* b3 = b2 + kstep;
            PG8_LDB(B0, 0, 0); PG8_SCHED; PG8_LDA(At, 0, 0); PG8_STAGE(PG8_SA(1, 1), a1 + hstep, voffA);
            PG8_WAIT_L(8); PG8_BAR; PG8_WAIT_L(0); PG8_MMA(0, 0, At, B0); PG8_BAR; PG8_SCHED;
            PG8_LDB(B1, 0, 1); PG8_STAGE(PG8_SB(0, 0), b2, voffB);
            PG8_BAR; PG8_WAIT_L(0); PG8_MMA(0, 1, At, B1); PG8_BAR;
            PG8_LDA(At, 0, 1); PG8_STAGE(PG8_SA(0, 0), a2, voffA);
            PG8_BAR; PG8_WAIT_L(0); PG8_MMA(1, 0, At, B0); PG8_BAR; PG8_SCHED;
            PG8_STAGE(PG8_SB(0, 1), b2 + hstep, voffB);
            PG8_WAIT_V(6); PG8_BAR; PG8_MMA(1, 1, At, B1); PG8_BAR;
            PG8_LDB(B0, 1, 0); PG8_SCHED; PG8_LDA(At, 1, 0); PG8_STAGE(PG8_SA(0, 1), a2 + hstep, voffA);
            PG8_WAIT_L(8); PG8_BAR; PG8_WAIT_L(0); PG8_MMA(0, 0, At, B0); PG8_BAR; PG8_SCHED;
            PG8_LDB(B1, 1, 1); PG8_STAGE(PG8_SB(1, 0), b3, voffB);
            PG8_BAR; PG8_WAIT_L(0); PG8_MMA(0, 1, At, B1); PG8_BAR;
            PG8_LDA(At, 1, 1); PG8_STAGE(PG8_SA(1, 0), a3, voffA);
            PG8_BAR; PG8_WAIT_L(0); PG8_MMA(1, 0, At, B0); PG8_BAR; PG8_SCHED;
            PG8_STAGE(PG8_SB(1, 1), b3 + hstep, voffB);
            PG8_WAIT_V(6); PG8_BAR; PG8_MMA(1, 1, At, B1); PG8_BAR;
        }
        E(acc, cur, wr, wc, fr, fq);
        if (!has_next) break;
#pragma unroll
        for (int a = 0; a < 2; ++a)
#pragma unroll
            for (int b = 0; b < 2; ++b)
#pragma unroll
                for (int m = 0; m < 4; ++m)
#pragma unroll
                    for (int n = 0; n < 2; ++n) acc[a][b][m][n] = (f32x4){0.f, 0.f, 0.f, 0.f};
        cur = nxt; cA = nA; cB = nB; ++ui;
    }
    PG8_WAIT_V(0);
    if (wr == 0) PG8_BAR;
    PG8_BAR;
#undef PG8_SA
#undef PG8_SB
#undef PG8_STAGE
#undef PG8_LDA
#undef PG8_LDB
#undef PG8_MMA
#undef PG8_WAIT_V
#undef PG8_WAIT_L
#undef PG8_BAR
#undef PG8_SCHED
}
typedef const f32x4 (&AccRef)[2][2][4][2];
DEV u32x4 pk8(const f32x4 a, const f32x4 b) { u32x4 w; w.x = cvt_pk_bf16(a[0], a[1]); w.y = cvt_pk_bf16(a[2], a[3]); w.z = cvt_pk_bf16(b[0], b[1]); w.w = cvt_pk_bf16(b[2], b[3]); return w; }
DEV f32x4 silu4(const f32x4 v) { f32x4 r;
#pragma unroll
    for (int i = 0; i < 4; ++i) r[i] = v[i] * __builtin_amdgcn_rcpf(1.0f + __expf(-v[i]));
    return r; }
struct EpiG1 { static constexpr bool PERM = true; bf16_t *qkv, *z, *xbcraw; float* dtraw;
    DEV void operator()(AccRef acc, const Unit& u, int wr, int wc, int fr, int fq) const {
        const int ct = u.col0, rbase = u.row0 + wr * 64 + fr;
        if (ct < 5632) {
            bf16_t* base; int ld, cc;
            if (ct < 3072) { base = qkv; ld = 3072; cc = ct; } else if (ct < 4096) { base = z; ld = 1024; cc = ct - 3072; } else { base = xbcraw; ld = 1536; cc = ct - 4096; }
            const int col = cc + wc * 32 + 8 * fq;
#pragma unroll
            for (int ai = 0; ai < 2; ++ai)
#pragma unroll
                for (int m = 0; m < 4; ++m) { bf16_t* rowp = base + (size_t)(rbase + ai * HALF + m * 16) * ld + col;
#pragma unroll
                    for (int bj = 0; bj < 2; ++bj) *(u32x4*)(rowp + bj * HALF) = pk8(acc[ai][bj][m][0], acc[ai][bj][m][1]); }
        } else if (wc == 0) {
#pragma unroll
            for (int ai = 0; ai < 2; ++ai)
#pragma unroll
                for (int m = 0; m < 4; ++m) { float* rowp = dtraw + (size_t)(rbase + ai * HALF + m * 16) * 32 + 8 * fq; *(f32x4*)rowp = acc[ai][0][m][0]; *(f32x4*)(rowp + 4) = acc[ai][0][m][1]; }
        }
    } };
struct EpiResF32 { static constexpr bool PERM = false; float* out; const float* resid;
    DEV void operator()(AccRef acc, const Unit& u, int wr, int wc, int fr, int fq) const {
        const int rbase = u.row0 + wr * 64 + fr, col = u.col0 + wc * 32 + 4 * fq;
#pragma unroll
        for (int ai = 0; ai < 2; ++ai)
#pragma unroll
            for (int m = 0; m < 4; ++m) { const size_t ro = (size_t)(rbase + ai * HALF + m * 16) * 1024 + col;
#pragma unroll
                for (int bj = 0; bj < 2; ++bj)
#pragma unroll
                    for (int n = 0; n < 2; ++n) *(f32x4*)(out + ro + bj * HALF + n * 16) = *(const f32x4*)(resid + ro + bj * HALF + n * 16) + acc[ai][bj][m][n]; }
    } };
struct EpiSwiglu { static constexpr bool PERM = true; bf16_t* hid;
    DEV void operator()(AccRef acc, const Unit& u, int wr, int wc, int fr, int fq) const {
        const int rbase = u.row0 + wr * 64 + fr, col = (u.col0 >> 1) + wc * 32 + 8 * fq;
#pragma unroll
        for (int ai = 0; ai < 2; ++ai)
#pragma unroll
            for (int m = 0; m < 4; ++m) *(u32x4*)(hid + (size_t)(rbase + ai * HALF + m * 16) * 2048 + col) = pk8(silu4(acc[ai][0][m][0]) * acc[ai][1][m][0], silu4(acc[ai][0][m][1]) * acc[ai][1][m][1]);
    } };
struct EpiBf16Plain { static constexpr bool PERM = true; bf16_t* O; int ld;
    DEV void operator()(AccRef acc, const Unit& u, int wr, int wc, int fr, int fq) const {
        const int rbase = u.row0 + wr * 64 + fr, col = u.col0 + wc * 32 + 8 * fq;
#pragma unroll
        for (int ai = 0; ai < 2; ++ai)
#pragma unroll
            for (int m = 0; m < 4; ++m) { bf16_t* rowp = O + (size_t)(rbase + ai * HALF + m * 16) * ld + col;
#pragma unroll
                for (int bj = 0; bj < 2; ++bj) *(u32x4*)(rowp + bj * HALF) = pk8(acc[ai][bj][m][0], acc[ai][bj][m][1]); }
    } };
struct EpiG3 { static constexpr bool PERM = true; bf16_t *pbuf, *gb;
    DEV void operator()(AccRef acc, const Unit& u, int wr, int wc, int fr, int fq) const {
        const int rbase = u.row0 + wr * 64 + fr;
        if (u.col0 < 2048) { const int col = (u.col0 >> 1) + wc * 32 + 8 * fq;
#pragma unroll
            for (int ai = 0; ai < 2; ++ai)
#pragma unroll
                for (int m = 0; m < 4; ++m) *(u32x4*)(pbuf + (size_t)(rbase + ai * HALF + m * 16) * 1024 + col) = pk8(acc[ai][0][m][0] * acc[ai][1][m][0], acc[ai][0][m][1] * acc[ai][1][m][1]);
        } else { const int col = u.col0 - 2048 + wc * 32 + 8 * fq;
#pragma unroll
            for (int ai = 0; ai < 2; ++ai)
#pragma unroll
                for (int m = 0; m < 4; ++m) { bf16_t* rowp = gb + (size_t)(rbase + ai * HALF + m * 16) * 1024 + col;
#pragma unroll
                    for (int bj = 0; bj < 2; ++bj) *(u32x4*)(rowp + bj * HALF) = pk8(acc[ai][bj][m][0], acc[ai][bj][m][1]); }
        }
    } };
}
DEV void ph_g1(const P& p, LAS unsigned char* lds) { pg8::StaticOrder S; S.init(T, NIN_PAD, (int)gridDim.x, (int)blockIdx.x, 0, 1); pg8::EpiG1 E{p.qkv, p.z, p.xbcraw, p.dtraw}; pg8::gemm_phase(lds, p.hn, p.WinT, 1024, S, E); }
DEV void ph_g2(const P& p, LAS unsigned char* lds) { pg8::StaticOrder S; S.init(T, 1024, (int)gridDim.x, (int)blockIdx.x, 0, 1); pg8::EpiResF32 E{p.out, p.x}; pg8::gemm_phase(lds, p.mix, p.WoutT, 2048, S, E); }
DEV void ph_up(const P& p, LAS unsigned char* lds) { pg8::StaticOrder S; S.init(NSLOT, 4096, (int)gridDim.x, (int)blockIdx.x, 4096, CAP / 256); pg8::EpiSwiglu E{p.hid}; pg8::gemm_phase(lds, p.xe, p.WguT, 1024, S, E); }
DEV void ph_down(const P& p, LAS unsigned char* lds) { pg8::StaticOrder S; S.init(NSLOT, 1024, (int)gridDim.x, (int)blockIdx.x, 1024, CAP / 256); pg8::EpiBf16Plain E{p.ye, 1024}; pg8::gemm_phase(lds, p.hid, p.WdT, 2048, S, E); }
DEV void ph_g3(const P& p, LAS unsigned char* lds) { pg8::StaticOrder S; S.init(T, 3072, (int)gridDim.x, (int)blockIdx.x, 0, 1); pg8::EpiG3 E{p.pbuf, p.gb}; pg8::gemm_phase(lds, p.hn, p.WciT, 1024, S, E); }
DEV void ph_g4(const P& p, LAS unsigned char* lds) { pg8::StaticOrder S; S.init(T, 1024, (int)gridDim.x, (int)blockIdx.x, 0, 1); pg8::EpiResF32 E{p.out, p.out}; pg8::gemm_phase(lds, p.abuf, p.WcoT, 1024, S, E); }

DEV bf16x8 ldg8(const bf16_t* p) { return *(const bf16x8*)p; }
DEV f32x4 mfma16(bf16x8 a, bf16x8 b, f32x4 c) { return __builtin_amdgcn_mfma_f32_16x16x32_bf16(a, b, c, 0, 0, 0); }
DEV bf16x8 pack8(const float (&m)[8]) { u32x4 r; r.x = pg8::cvt_pk_safe(m[0], m[1]); r.y = pg8::cvt_pk_safe(m[2], m[3]); r.z = pg8::cvt_pk_safe(m[4], m[5]); r.w = pg8::cvt_pk_safe(m[6], m[7]); return __builtin_bit_cast(bf16x8, r); }
DEV void unpack8(bf16x8 v, float (&f)[8]) { const u32x4 u = __builtin_bit_cast(u32x4, v);
#pragma unroll
    for (int q = 0; q < 4; ++q) { f[2 * q] = __uint_as_float(u[q] << 16); f[2 * q + 1] = __uint_as_float(u[q] & 0xffff0000u); } }
typedef unsigned u32x2 __attribute__((ext_vector_type(2)));
DEV u32x2 pk4(const f32x4 a) { u32x2 r; r.x = pg8::cvt_pk_safe(a[0], a[1]); r.y = pg8::cvt_pk_safe(a[2], a[3]); return r; }
DEV void ph_ssd_states(const P& p) {
    const int wid = threadIdx.x >> 6, lane = threadIdx.x & 63, fr = lane & 15, fq = lane >> 4;
    for (int it = blockIdx.x * 8 + wid; it < BATCH * NCHUNK * 32; it += gridDim.x * 8) {
        const int dir = it & 1, h = (it >> 1) & 15, c = (it >> 5) % NCHUNK, b = (it >> 5) / NCHUNK, g = h >> 3, j = dir * 16 + h;
        const bf16_t* xT = p.xsT + ((size_t)b * 1024 + h * 64 + fr) * SEQ + c * 128 + 8 * fq;
        const bf16_t* bT = p.bmT + ((size_t)b * 256 + g * 128 + fr) * SEQ + c * 128 + 8 * fq;
        const float* w = p.wdT + ((size_t)b * 32 + j) * SEQ + c * 128 + 8 * fq;
        f32x4 acc[8][4];
#pragma unroll
        for (int nb = 0; nb < 8; ++nb)
#pragma unroll
            for (int pb = 0; pb < 4; ++pb) acc[nb][pb] = (f32x4){0.f, 0.f, 0.f, 0.f};
#pragma unroll 1
        for (int ks = 0; ks < 4; ++ks) {
            const f32x4 w0 = *(const f32x4*)(w + 32 * ks), w1 = *(const f32x4*)(w + 32 * ks + 4);
            bf16x8 xf[4];
#pragma unroll
            for (int pb = 0; pb < 4; ++pb) { float f[8]; unpack8(ldg8(xT + (size_t)pb * 16 * SEQ + 32 * ks), f);
#pragma unroll
                for (int q = 0; q < 4; ++q) { f[q] *= w0[q]; f[4 + q] *= w1[q]; }
                xf[pb] = pack8(f); }
#pragma unroll
            for (int nb = 0; nb < 8; ++nb) { const bf16x8 bfv = ldg8(bT + (size_t)nb * 16 * SEQ + 32 * ks);
#pragma unroll
                for (int pb = 0; pb < 4; ++pb) acc[nb][pb] = mfma16(bfv, xf[pb], acc[nb][pb]); }
        }
        bf16_t* st = p.states + ((((size_t)b * 2 + dir) * NCHUNK + c) * 16 + h) * 8192;
#pragma unroll
        for (int nb = 0; nb < 8; ++nb)
#pragma unroll
            for (int pb = 0; pb < 4; ++pb) *(u32x2*)(st + (16 * pb + fr) * 128 + 16 * nb + 4 * fq) = pk4(acc[nb][pb]);
    }
}
DEV void ph_ssd_scan(const P& p) {
    for (size_t i = GTID; i < (size_t)BATCH * 2 * 16 * 64 * 32; i += GSTRIDE) {
        const int n4 = (int)(i & 31), pp = (int)((i >> 5) & 63), h = (int)((i >> 11) & 15), dir = (int)((i >> 15) & 1), b = (int)(i >> 16);
        bf16_t* base = p.states + (((size_t)b * 2 + dir) * NCHUNK * 16 + h) * 8192 + pp * 128 + n4 * 4;
        const float* dec = p.cdec + ((size_t)b * 32 + dir * 16 + h) * NCHUNK;
        float r0 = 0.f, r1 = 0.f, r2 = 0.f, r3 = 0.f;
#pragma unroll 8
        for (int cc = 0; cc < NCHUNK; ++cc) { const int c = dir ? NCHUNK - 1 - cc : cc; uint2* q = (uint2*)(base + (size_t)c * 16 * 8192); const uint2 v = *q; const float d = dec[c];
            *q = uint2{pg8::cvt_pk_safe(r0, r1), pg8::cvt_pk_safe(r2, r3)};
            r0 = r0 * d + __uint_as_float(v.x << 16); r1 = r1 * d + __uint_as_float(v.x & 0xffff0000u); r2 = r2 * d + __uint_as_float(v.y << 16); r3 = r3 * d + __uint_as_float(v.y & 0xffff0000u); }
    }
}
constexpr int GLD = 136;
DEV void ph_ssd_out(const P& p, LAS unsigned char* lds) {
    const int wid = threadIdx.x >> 6, lane = threadIdx.x & 63, fr = lane & 15, fq = lane >> 4;
    LAS bf16_t* Gl = (LAS bf16_t*)lds;
    LAS float* vec = (LAS float*)(lds + 64 * GLD * 2) + wid * 512;
    for (int u = blockIdx.x; u < BATCH * NCHUNK * 4; u += gridDim.x) {
        const int lh = u & 1, g = (u >> 1) & 1, c = (u >> 2) % NCHUNK, b = (u >> 2) / NCHUNK, h = 8 * g + wid, l0 = 64 * lh; const size_t row0 = (size_t)b * SEQ + (size_t)c * 128;
        const bf16_t* bmrow = p.bc + (row0 + 16 * wid + fr) * 512 + g * 128 + 8 * fq;
        const bf16_t* cmrow = p.bc + (row0 + l0 + fr) * 512 + 256 + g * 128 + 8 * fq;
        f32x4 ag[4];
#pragma unroll
        for (int lb = 0; lb < 4; ++lb) ag[lb] = (f32x4){0.f, 0.f, 0.f, 0.f};
#pragma unroll
        for (int ks = 0; ks < 4; ++ks) { const bf16x8 a = ldg8(bmrow + 32 * ks);
#pragma unroll
            for (int lb = 0; lb < 4; ++lb) ag[lb] = mfma16(a, ldg8(cmrow + (size_t)lb * 16 * 512 + 32 * ks), ag[lb]); }
        __syncthreads();
#pragma unroll
        for (int lb = 0; lb < 4; ++lb) *(LAS u32x2*)(Gl + (16 * lb + fr) * GLD + 16 * wid + 4 * fq) = pk4(ag[lb]);
#pragma unroll
        for (int q = 0; q < 2; ++q) { const int s = lane + 64 * q; const size_t o = ((size_t)b * 32 + h) * SEQ + c * 128 + s;
            vec[s] = p.csT[o]; vec[128 + s] = p.csT[o + (size_t)16 * SEQ]; vec[256 + s] = p.stT[o]; vec[384 + s] = p.stT[o + (size_t)16 * SEQ]; }
        __syncthreads();
        f32x4 acc[4][4];
#pragma unroll
        for (int pb = 0; pb < 4; ++pb)
#pragma unroll
            for (int lb = 0; lb < 4; ++lb) acc[pb][lb] = (f32x4){0.f, 0.f, 0.f, 0.f};
        float csfl[4], cbl[4];
#pragma unroll
        for (int lb = 0; lb < 4; ++lb) { csfl[lb] = vec[l0 + 16 * lb + fr]; cbl[lb] = vec[128 + l0 + 16 * lb + fr]; }
        const bf16_t* xT = p.xsT + ((size_t)b * 1024 + h * 64 + fr) * SEQ + c * 128 + 8 * fq;
        const float Dh = p.ssd_d[h];
#pragma unroll 1
        for (int ks = 0; ks < 4; ++ks) {
            const int s0 = 32 * ks + 8 * fq;
            bf16x8 xf[4];
#pragma unroll
            for (int pb = 0; pb < 4; ++pb) xf[pb] = ldg8(xT + (size_t)pb * 16 * SEQ + 32 * ks);
            float cs_s[8], cb_s[8], df[8], db[8];
#pragma unroll
            for (int j = 0; j < 8; ++j) { cs_s[j] = vec[s0 + j]; cb_s[j] = vec[128 + s0 + j]; df[j] = vec[256 + s0 + j]; db[j] = vec[384 + s0 + j]; }
#pragma unroll
            for (int lb = 0; lb < 4; ++lb) {
                const int l = l0 + 16 * lb + fr;
                float gf[8], m[8]; unpack8(*(const LAS bf16x8*)(Gl + (16 * lb + fr) * GLD + s0), gf);
#pragma unroll
                for (int j = 0; j < 8; ++j) { const int s = s0 + j;
                    const float wf = s <= l ? df[j] * __expf(fminf(csfl[lb] - cs_s[j], 0.f)) : 0.f, wb = s >= l ? db[j] * __expf(fminf(cbl[lb] - cb_s[j], 0.f)) : 0.f;
                    m[j] = gf[j] * (wf + wb) + (s == l ? Dh : 0.f); }
                const bf16x8 mf = pack8(m);
#pragma unroll
                for (int pb = 0; pb < 4; ++pb) acc[pb][lb] = mfma16(xf[pb], mf, acc[pb][lb]);
            }
        }
#pragma unroll
        for (int dir = 0; dir < 2; ++dir) {
            const bf16_t* pv = p.states + ((((size_t)b * 2 + dir) * NCHUNK + c) * 16 + h) * 8192 + fr * 128 + 8 * fq;
            float sc[4];
#pragma unroll
            for (int lb = 0; lb < 4; ++lb) sc[lb] = __expf(dir ? cbl[lb] : csfl[lb]);
#pragma unroll 1
            for (int ks = 0; ks < 4; ++ks) {
                bf16x8 pf[4];
#pragma unroll
                for (int pb = 0; pb < 4; ++pb) pf[pb] = ldg8(pv + pb * 2048 + 32 * ks);
#pragma unroll
                for (int lb = 0; lb < 4; ++lb) { float f[8]; unpack8(ldg8(cmrow + (size_t)lb * 16 * 512 + 32 * ks), f);
#pragma unroll
                    for (int j = 0; j < 8; ++j) f[j] *= sc[lb];
                    const bf16x8 cf = pack8(f);
#pragma unroll
                    for (int pb = 0; pb < 4; ++pb) acc[pb][lb] = mfma16(pf[pb], cf, acc[pb][lb]); }
            }
        }
#pragma unroll
        for (int pb = 0; pb < 4; ++pb)
#pragma unroll
            for (int lb = 0; lb < 4; ++lb) *(u32x2*)(p.yssd + (row0 + l0 + 16 * lb + fr) * 1024 + h * 64 + 16 * pb + 4 * fq) = pk4(acc[pb][lb]);
    }
}

DEV void cvx_src(const P& p, int layer, int id, int seg, const float*& src, int& ld, int& k0) {
    const int e = id / 384, r = id % 384; const size_t off = ((size_t)layer * NE + e) * 1024 * 2048;
    if (r < 256) { const int pn = r >> 4, kt = r & 15; src = (seg ? p.wu : p.wg) + off + 128 * pn; ld = 2048; k0 = 64 * kt; }
    else { const int r2 = r - 256, nt = r2 >> 5, kt = r2 & 31; src = p.wd + off + 256 * nt + 128 * seg; ld = 1024; k0 = 64 * kt; }
}
DEV void ph_convert_experts_dev(const P& p, int layer, LAS unsigned char* lds) {
    LAS unsigned* tl = (LAS unsigned*)lds;
    const int tid = threadIdx.x, n4 = tid & 31, seg = (tid >> 5) & 1, kp = tid >> 6;
    const int rrow = tid >> 1, rhalf = tid & 1, rseg = rrow >> 7, rq = (rrow >> 5) & 3, rn4 = rrow & 31;
    constexpr int NTILE = NE * 384;
    float4 cur[8], nxt[8];
#define CVX_LOAD(ID, DST) do { const float* s_; int ld_, k0_; cvx_src(p, layer, (ID), seg, s_, ld_, k0_); \
        _Pragma("unroll") for (int i = 0; i < 4; ++i) { const size_t ro = (size_t)(k0_ + 2 * (kp + 8 * i)) * ld_ + 4 * n4; DST[2 * i] = *(const float4*)(s_ + ro); DST[2 * i + 1] = *(const float4*)(s_ + ro + ld_); } } while (0)
    int id = blockIdx.x;
    if (id < NTILE) CVX_LOAD(id, cur);
    for (; id < NTILE; id += gridDim.x) {
        const int nid = id + gridDim.x;
        if (nid < NTILE) CVX_LOAD(nid, nxt);
        __syncthreads();
#pragma unroll
        for (int i = 0; i < 4; ++i) { const float4 a = cur[2 * i], b = cur[2 * i + 1]; const int kd = kp + 8 * i; const int rb = seg * 128 + n4;
            tl[(rb) * 33 + kd] = pack2(a.x, b.x); tl[(rb + 32) * 33 + kd] = pack2(a.y, b.y); tl[(rb + 64) * 33 + kd] = pack2(a.z, b.z); tl[(rb + 96) * 33 + kd] = pack2(a.w, b.w); }
        __syncthreads();
        { const int e = id / 384, r = id % 384; bf16_t* d; int K, n0, k0;
          if (r < 256) { d = p.WguT + (size_t)e * 4096 * 1024; K = 1024; n0 = 256 * (r >> 4); k0 = 64 * (r & 15); } else { const int r2 = r - 256; d = p.WdT + (size_t)e * 1024 * 2048; K = 2048; n0 = 256 * (r2 >> 5); k0 = 64 * (r2 & 31); }
          unsigned w[16];
#pragma unroll
          for (int i = 0; i < 16; ++i) w[i] = tl[rrow * 33 + 16 * rhalf + i];
          bf16_t* dp = d + (size_t)(n0 + rseg * 128 + 4 * rn4 + rq) * K + k0 + 32 * rhalf;
#pragma unroll
          for (int q = 0; q < 4; ++q) *(uint4*)(dp + 8 * q) = uint4{w[4 * q], w[4 * q + 1], w[4 * q + 2], w[4 * q + 3]}; }
#pragma unroll
        for (int i = 0; i < 8; ++i) cur[i] = nxt[i];
    }
#undef CVX_LOAD
    __syncthreads();
}

constexpr int CTLD = 136;
DEV void ph_prep_dev(const P& p, LAS unsigned char* lds) {
    for (size_t i = GTID; i < (size_t)T * 256; i += GSTRIDE) {
        const int sub = (int)(i & 7); const size_t hrow = i >> 3; const size_t t = hrow >> 5; const int hh = (int)(hrow & 31), isk = hh >> 4, h = hh & 15, pos = (int)(t % SEQ);
        bf16_t* ptr = p.qkv + t * 3072 + isk * 1024 + h * 64 + sub * 8; const float* gn = (isk ? p.k_norm : p.q_norm) + sub * 8;
        float f[8]; ld8(ptr, f); float ss = 0.f;
#pragma unroll
        for (int j = 0; j < 8; ++j) ss += f[j] * f[j];
        ss += __shfl_xor(ss, 1); ss += __shfl_xor(ss, 2); ss += __shfl_xor(ss, 4);
        const float r = 1.0f / sqrtf(ss * (1.0f / 64.0f) + 1e-6f);
        const float4 c0 = *(const float4*)(p.rope + (size_t)pos * 16), c1 = *(const float4*)(p.rope + (size_t)pos * 16 + 4), s0 = *(const float4*)(p.rope + (size_t)pos * 16 + 8), s1 = *(const float4*)(p.rope + (size_t)pos * 16 + 12);
        const float cs[8] = {c0.x, c0.y, c0.z, c0.w, c1.x, c1.y, c1.z, c1.w}, sn[8] = {s0.x, s0.y, s0.z, s0.w, s1.x, s1.y, s1.z, s1.w};
#pragma unroll
        for (int j = 0; j < 8; ++j) { f[j] = f[j] * r * gn[j]; const float other = __shfl_xor(f[j], 1);
            f[j] = sub == 0 ? f[j] * cs[j] - other * sn[j] : (sub == 1 ? f[j] * cs[j] + other * sn[j] : f[j]); }
        st8(ptr, f);
    }
    {
        LAS bf16_t* tl = (LAS bf16_t*)lds;
        const int tid = threadIdx.x, c8 = tid & 7, trw = tid >> 3;
        for (int tile = blockIdx.x; tile < (T / 128) * 24; tile += gridDim.x) {
            const int ct = tile % 24, tt = tile / 24, c0 = ct * 64; const size_t t0 = (size_t)tt * 128; const int b = (int)(t0 / SEQ), pos0 = (int)(t0 % SEQ);
            float wgt[5][8], bias[8];
#pragma unroll
            for (int j = 0; j < 8; ++j) { bias[j] = p.conv_b[c0 + c8 * 8 + j];
#pragma unroll
                for (int k = 0; k < 5; ++k) wgt[k][j] = p.conv_w[k * 1536 + c0 + c8 * 8 + j]; }
            __syncthreads();
#pragma unroll
            for (int half = 0; half < 2; ++half) { const int tloc = trw + 64 * half, pos = pos0 + tloc; const size_t t = t0 + tloc;
                float acc[8];
#pragma unroll
                for (int j = 0; j < 8; ++j) acc[j] = bias[j];
#pragma unroll
                for (int k = 0; k < 5; ++k) { const int pp = pos + k - 2; if (pp < 0 || pp >= SEQ) continue; float f[8]; ld8(p.xbcraw + (t + k - 2) * 1536 + c0 + c8 * 8, f);
#pragma unroll
                    for (int j = 0; j < 8; ++j) acc[j] += f[j] * wgt[k][j]; }
#pragma unroll
                for (int j = 0; j < 8; ++j) acc[j] = acc[j] * __builtin_amdgcn_rcpf(1.0f + __expf(-acc[j]));
                if (c0 >= 1024) st8(p.bc + t * 512 + (c0 - 1024) + c8 * 8, acc);
                if (c0 < 1280) {
#pragma unroll
                    for (int j = 0; j < 8; ++j) tl[(c8 * 8 + j) * CTLD + tloc] = f2bf(acc[j]); }
            }
            __syncthreads();
            if (c0 < 1280) {
                bf16_t* dst = c0 < 1024 ? p.xsT + ((size_t)b * 1024 + c0 + trw) * SEQ + pos0 : p.bmT + ((size_t)b * 256 + (c0 - 1024) + trw) * SEQ + pos0;
#pragma unroll
                for (int half = 0; half < 2; ++half) *(u32x4*)(dst + 64 * half + 8 * c8) = *(const LAS u32x4*)(tl + trw * CTLD + 64 * half + 8 * c8);
            }
        }
    }
    {
        const int lane = LANE;
        for (size_t it = GWAVE; it < (size_t)BATCH * NCHUNK * 32; it += NWAVES_G) {
            const int j = (int)(it & 31), c = (int)((it >> 5) % NCHUNK), b = (int)((it >> 5) / NCHUNK), dir = j >> 4, h = j & 15;
            const float A = -expf(dir ? p.a_log_b[h] : p.a_log_f[h]), bias = dir ? p.dtb_b[h] : p.dtb_f[h];
            const size_t row0 = (size_t)b * SEQ + (size_t)c * 128; const size_t ob = ((size_t)b * 32 + j) * SEQ + c * 128;
            const int l0 = dir ? 127 - 2 * lane : 2 * lane, l1 = dir ? 126 - 2 * lane : 2 * lane + 1;
            const float dt0 = softplus_f(p.dtraw[(row0 + l0) * 32 + j] + bias), dt1 = softplus_f(p.dtraw[(row0 + l1) * 32 + j] + bias);
            const float a0 = dt0 * A, a1 = dt1 * A, pr = a0 + a1; float inc = pr;
#pragma unroll
            for (int o = 1; o < 64; o <<= 1) { const float tq = __shfl_up(inc, o); if (lane >= o) inc += tq; }
            const float cs0 = inc - pr + a0, cs1 = inc, total = __shfl(inc, 63);
            p.step[(row0 + l0) * 32 + j] = dt0; p.step[(row0 + l1) * 32 + j] = dt1;
            p.stT[ob + l0] = dt0; p.stT[ob + l1] = dt1; p.csT[ob + l0] = cs0; p.csT[ob + l1] = cs1;
            p.wdT[ob + l0] = dt0 * expf(total - cs0); p.wdT[ob + l1] = dt1 * expf(total - cs1);
            if (lane == 0) p.cdec[((size_t)b * 32 + j) * NCHUNK + c] = expf(total);
        }
    }
}

typedef short s16x4 __attribute__((ext_vector_type(4)));
constexpr int VLD = 144;
DEV void ph_attn(const P& p, LAS unsigned char* lds) {
    const int wid = threadIdx.x >> 6, lane = threadIdx.x & 63, fr = lane & 15, fq = lane >> 4;
    LAS unsigned char* vt = lds + wid * (32 * VLD);
    float gq = 0.f, gk = 0.f;
    for (int c = 0; c < 64; ++c) { gq = fmaxf(gq, fabsf(p.q_norm[c])); gk = fmaxf(gk, fabsf(p.k_norm[c])); }
    const float c1 = 0.125f * 1.44269504089f, c2 = 8.0f * gq * gk * 1.44269504089f;
    const int trq = fr >> 2, trp = fr & 3;
    constexpr int NJB = SEQ / 256;
    for (int it = blockIdx.x * 8 + wid; it < BATCH * 16 * NJB * 16; it += gridDim.x * 8) {
        const int r = it & 15, jb = (it >> 4) % NJB, h = ((it >> 4) / NJB) & 15, b = ((it >> 4) / NJB) >> 4;
        const size_t rowb = (size_t)b * SEQ; const int base = r + 256 * jb;
        const bf16_t* qp = p.qkv + (rowb + base + 16 * fr) * 3072 + h * 64 + 8 * fq;
        const bf16x8 qf0 = ldg8(qp), qf1 = ldg8(qp + 32);
        const bf16_t* kbase = p.qkv + rowb * 3072 + 1024 + h * 64 + 8 * fq;
        const bf16_t* vbase = p.qkv + rowb * 3072 + 2048 + h * 64;
        f32x4 o[4];
#pragma unroll
        for (int mb = 0; mb < 4; ++mb) o[mb] = (f32x4){0.f, 0.f, 0.f, 0.f};
        float lsum = 0.f;
        bf16x8 vr[4], kf[2][2];
#define ATT_LOAD(st, VR, KF) do { const int dsh_ = (st) < 12 ? 0 : ((st) < 18 ? 2 : 4), k0_ = -64 + 32 * ((st) < 12 ? (st) : ((st) < 18 ? (st) - 12 : (st) - 18)); \
            _Pragma("unroll") for (int c4 = 0; c4 < 4; ++c4) { const int id = lane + 64 * c4, row = id >> 3, ch = id & 7; int pos = base + ((k0_ + row) << dsh_); pos = pos < 0 ? 0 : (pos > SEQ - 1 ? SEQ - 1 : pos); \
                VR[c4] = ldg8(vbase + (size_t)pos * 3072 + 8 * ch); } \
            _Pragma("unroll") for (int x = 0; x < 2; ++x) { int pos = base + ((k0_ + 8 * (fr >> 2) + 4 * x + (fr & 3)) << dsh_); pos = pos < 0 ? 0 : (pos > SEQ - 1 ? SEQ - 1 : pos); \
                KF[x][0] = ldg8(kbase + (size_t)pos * 3072); KF[x][1] = ldg8(kbase + (size_t)pos * 3072 + 32); } } while (0)
        ATT_LOAD(0, vr, kf);
#pragma unroll 1
        for (int st = 0; st < 23; ++st) {
            bf16x8 vrn[4], kfn[2][2];
            const int stn = st + 1 < 23 ? st + 1 : st;
            ATT_LOAD(stn, vrn, kfn);
            const int dsh = st < 12 ? 0 : (st < 18 ? 2 : 4), k0 = -64 + 32 * (st < 12 ? st : (st < 18 ? st - 12 : st - 18));
            const int kq = fr << (4 - dsh);
            f32x4 s0 = mfma16(kf[0][0], qf0, (f32x4){0.f, 0.f, 0.f, 0.f}); s0 = mfma16(kf[0][1], qf1, s0);
            f32x4 s1 = mfma16(kf[1][0], qf0, (f32x4){0.f, 0.f, 0.f, 0.f}); s1 = mfma16(kf[1][1], qf1, s1);
            float pv[8];
#pragma unroll
            for (int j = 0; j < 8; ++j) { const int kap = k0 + 8 * fq + j, pos = base + (kap << dsh), dk = kap - kq;
                const bool valid = dk <= 64 && dk >= -64 && pos >= 0 && pos < SEQ; const float sv = j < 4 ? s0[j & 3] : s1[j & 3];
                pv[j] = valid ? __builtin_amdgcn_exp2f(sv * c1 - c2) : 0.f; lsum += pv[j]; }
            const bf16x8 pf = pack8(pv);
            asm volatile("" ::: "memory");
#pragma unroll
            for (int c4 = 0; c4 < 4; ++c4) { const int id = lane + 64 * c4, row = id >> 3, ch = id & 7; *(LAS bf16x8*)(vt + row * VLD + ch * 16) = vr[c4]; }
            asm volatile("s_waitcnt lgkmcnt(0)" ::: "memory");
#pragma unroll
            for (int mb = 0; mb < 4; ++mb) {
                const s16x4 t0 = __builtin_amdgcn_ds_read_tr16_b64_v4i16((LAS s16x4*)(vt + (8 * fq + trq) * VLD + (16 * mb + 4 * trp) * 2));
                const s16x4 t1 = __builtin_amdgcn_ds_read_tr16_b64_v4i16((LAS s16x4*)(vt + (8 * fq + 4 + trq) * VLD + (16 * mb + 4 * trp) * 2));
                const bf16x8 vf = __builtin_shufflevector(t0, t1, 0, 1, 2, 3, 4, 5, 6, 7);
                o[mb] = mfma16(vf, pf, o[mb]);
            }
            asm volatile("" ::: "memory");
#pragma unroll
            for (int c4 = 0; c4 < 4; ++c4) vr[c4] = vrn[c4];
            kf[0][0] = kfn[0][0]; kf[0][1] = kfn[0][1]; kf[1][0] = kfn[1][0]; kf[1][1] = kfn[1][1];
        }
#undef ATT_LOAD
        lsum += __shfl_xor(lsum, 16); lsum += __shfl_xor(lsum, 32);
        const float inv = 1.0f / lsum;
#pragma unroll
        for (int mb = 0; mb < 4; ++mb) *(u32x2*)(p.mix + (rowb + base + 16 * fr) * 2048 + h * 64 + 16 * mb + 4 * fq) = pk4(o[mb] * inv);
    }
}

static_assert(SEQ % 512 == 0, "top-k: SEQ / 512 values per thread");
DEV void ph_topk(const P& p, LAS unsigned char* lds) {
    constexpr int NV_T = SEQ / 512;
    LAS unsigned* hist = (LAS unsigned*)lds; LAS unsigned* wtot = hist + 256; LAS unsigned* bcw = hist + 272;
    const int tid = threadIdx.x, lane = tid & 63, wid = tid >> 6;
    for (int be = blockIdx.x; be < BATCH * NE; be += gridDim.x) {
        const float* a = p.aff + (size_t)be * SEQ + (size_t)tid * NV_T;
        unsigned v[NV_T];
#pragma unroll
        for (int q = 0; q < NV_T / 4; ++q) { const uint4 u = *(const uint4*)(a + 4 * q); v[4 * q] = u.x; v[4 * q + 1] = u.y; v[4 * q + 2] = u.z; v[4 * q + 3] = u.w; }
        unsigned prefix = 0u, kk = CAP;
#pragma unroll 1
        for (int pass = 0; pass < 4; ++pass) {
            const int shift = 24 - 8 * pass;
            if (tid < 256) hist[tid] = 0u;
            __syncthreads();
#pragma unroll
            for (int j = 0; j < NV_T; ++j) { const bool m = pass == 0 || (v[j] >> (shift + 8)) == prefix; if (m) atomicAdd((unsigned*)&hist[(v[j] >> shift) & 255u], 1u); }
            __syncthreads();
            if (wid == 0) {
                const unsigned c0 = hist[255 - 4 * lane], c1 = hist[254 - 4 * lane], c2 = hist[253 - 4 * lane], c3 = hist[252 - 4 * lane];
                const unsigned tot = c0 + c1 + c2 + c3; unsigned inc = tot;
#pragma unroll
                for (int o = 1; o < 64; o <<= 1) { const unsigned t = __shfl_up(inc, o); if (lane >= o) inc += t; }
                const unsigned exc = inc - tot;
                if (exc < kk && kk <= inc) { const unsigned r = kk - exc; unsigned bin, before;
                    if (r <= c0) { bin = 255 - 4 * lane; before = exc; } else if (r <= c0 + c1) { bin = 254 - 4 * lane; before = exc + c0; } else if (r <= c0 + c1 + c2) { bin = 253 - 4 * lane; before = exc + c0 + c1; } else { bin = 252 - 4 * lane; before = exc + c0 + c1 + c2; }
                    bcw[0] = bin; bcw[1] = kk - before; }
            }
            __syncthreads();
            prefix = (prefix << 8) | bcw[0]; kk = bcw[1];
        }
        const unsigned Tb = prefix, need = kk, cgt = CAP - need;
        unsigned ngt = 0u, neq = 0u;
#pragma unroll
        for (int j = 0; j < NV_T; ++j) { ngt += v[j] > Tb ? 1u : 0u; neq += v[j] == Tb ? 1u : 0u; }
        const unsigned packed = ngt | (neq << 16); unsigned inc = packed;
#pragma unroll
        for (int o = 1; o < 64; o <<= 1) { const unsigned t = __shfl_up(inc, o); if (lane >= o) inc += t; }
        if (lane == 63) wtot[wid] = inc;
        __syncthreads();
        unsigned wbase = 0u;
        for (int w = 0; w < wid; ++w) wbase += wtot[w];
        const unsigned exc = wbase + inc - packed; unsigned gbase = exc & 0xffffu, ebase = exc >> 16;
        int* smp = p.slotmap + (size_t)be * SEQ + (size_t)tid * NV_T;
#pragma unroll
        for (int q = 0; q < NV_T / 4; ++q) { int sl[4];
#pragma unroll
            for (int i = 0; i < 4; ++i) { const int j = 4 * q + i; int slot = -1;
                if (v[j] > Tb) { slot = (int)gbase; ++gbase; } else if (v[j] == Tb) { if (ebase < need) slot = (int)(cgt + ebase); ++ebase; }
                if (slot >= 0) { p.idx[(size_t)be * CAP + slot] = tid * NV_T + j; p.gate[(size_t)be * CAP + slot] = __uint_as_float(v[j]); }
                sl[i] = slot; }
            *(int4*)(smp + 4 * q) = int4{sl[0], sl[1], sl[2], sl[3]}; }
        __syncthreads();
    }
}

#define XB_TMO      128
#define XB_XCNT(j)  (256  + 64 * (j))
#define XB_XSUB(j)  (1280 + 64 * (j))
#define XB_XGEN(j)  (2304 + 64 * (j))
#define XB_TOP      3328
#define XB_TOPGEN   3392
#define XCD_BAR_WORDS 3456
#define XB_SPIN_CAP (1u << 18)

__device__ __forceinline__ unsigned xb_ld(unsigned* p)              { return __hip_atomic_load(p, __ATOMIC_RELAXED, __HIP_MEMORY_SCOPE_AGENT); }
__device__ __forceinline__ unsigned xb_add(unsigned* p, unsigned v) { return __hip_atomic_fetch_add(p, v, __ATOMIC_RELAXED, __HIP_MEMORY_SCOPE_AGENT); }
__device__ __forceinline__ unsigned xb_xcc_id() { return (unsigned)__builtin_amdgcn_s_getreg((3 << 11) | 20) & 0xFu; }
#define XB_SPIN(cond, bar) do { unsigned _sp = 0; while (cond) { __builtin_amdgcn_s_sleep(1); \
    if ((++_sp & 255u) == 0u) { if (xb_ld(&(bar)[XB_TMO])) break; if (_sp > XB_SPIN_CAP) { atomicAdd(&(bar)[XB_TMO], 1u); break; } } } } while (0)

struct XcdBarrier {
    unsigned* bar; unsigned x;
    volatile LAS unsigned* st;
};

__device__ __forceinline__ XcdBarrier xcd_barrier_post(unsigned* bar, volatile LAS unsigned* st) {
    XcdBarrier b; b.bar = bar; b.x = xb_xcc_id(); b.st = st;
    if (threadIdx.x == 0) (void)xb_add(&bar[XB_XCNT(b.x)], 1u);
    return b;
}
__device__ __forceinline__ void xcd_barrier_complete(unsigned* bar, unsigned x, unsigned& nloc, unsigned& nx) {
    const unsigned G = gridDim.x * gridDim.y * gridDim.z;
    unsigned sum, cnt, mine, sp = 0u;
    for (;;) {
        sum = 0u; cnt = 0u; mine = 0u;
#pragma unroll
        for (unsigned j = 0; j < 16; ++j) { const unsigned c = xb_ld(&bar[XB_XCNT(j)]); sum += c; cnt += (c > 0u) ? 1u : 0u; mine = (j == x) ? c : mine; }
        if (sum == G) break;
        __builtin_amdgcn_s_sleep(1);
        if ((++sp & 255u) == 0u) { if (xb_ld(&bar[XB_TMO])) break; if (sp > XB_SPIN_CAP) { atomicAdd(&bar[XB_TMO], 1u); break; } }
    }
    nloc = mine > 0u ? mine : 1u; nx = cnt > 0u ? cnt : 1u;
}

__device__ __forceinline__ void xcd_barrier(const XcdBarrier& b) {
    asm volatile("s_waitcnt vmcnt(0)" ::: "memory");
    __syncthreads();
    if (threadIdx.x == 0) {
        unsigned* bar = b.bar;
        __builtin_amdgcn_s_waitcnt(0);
        unsigned nloc = b.st[0], nx = b.st[1];
        if (nloc == 0u) { xcd_barrier_complete(bar, b.x, nloc, nx); b.st[0] = nloc; b.st[1] = nx; }
        const unsigned old = xb_add(&bar[XB_XSUB(b.x)], 1u);
        const unsigned gen = old / nloc;
        if (old + 1u == (gen + 1u) * nloc) {
            __builtin_amdgcn_fence(__ATOMIC_RELEASE, "agent");
            asm volatile("s_waitcnt vmcnt(0)" ::: "memory");
            const unsigned og = xb_add(&bar[XB_TOP], 1u);
            const unsigned tg = og / nx;
            if (og + 1u == (tg + 1u) * nx) xb_add(&bar[XB_TOPGEN], 1u);
            else XB_SPIN(xb_ld(&bar[XB_TOPGEN]) == tg, bar);
            __builtin_amdgcn_fence(__ATOMIC_ACQUIRE, "agent");
            xb_add(&bar[XB_XGEN(b.x)], 1u);
            asm volatile("s_waitcnt vmcnt(0)" ::: "memory");
        } else {
            XB_SPIN(xb_ld(&bar[XB_XGEN(b.x)]) == gen, bar);
            __builtin_amdgcn_fence(__ATOMIC_ACQUIRE, "agent");
            asm volatile("s_waitcnt vmcnt(0)" ::: "memory");
        }
    }
    __syncthreads();
}


enum { PH_FIRST = 0, PH_G1, PH_PREP, PH_ATTN, PH_SSDB, PH_SSDC, PH_GNORM, PH_G2, PH_ROUTE0, PH_TOPK0, PH_GATHER0, PH_UP0, PH_DOWN0, PH_COMB0, PH_G3, PH_CONV3, PH_G4, PH_ROUTE1, PH_TOPK1, PH_GATHER1, PH_UP1, PH_DOWN1, PH_COMB1, NPH };

constexpr int LDS_BYTES = 147456;
constexpr int LDS_XB = LDS_BYTES - 16;
__global__ void __launch_bounds__(512, 2) fwd(P p, int lo, int hi) {
    extern __shared__ __attribute__((aligned(16))) unsigned char shm[];
    LAS unsigned char* lds = (LAS unsigned char*)shm;
    XcdBarrier bar; bar.bar = p.bar; bar.x = 0; bar.st = (volatile LAS unsigned*)(lds + LDS_XB);
    if (hi - lo > 1) {
        if (threadIdx.x == 0) { ((LAS unsigned*)(lds + LDS_XB))[0] = 0u; ((LAS unsigned*)(lds + LDS_XB))[1] = 0u; }
        __syncthreads();
        bar = xcd_barrier_post(p.bar, (volatile LAS unsigned*)(lds + LDS_XB));
    }
#if NAIVE_GEMM
#define GEMM_SEL(a, b) a
#else
#define GEMM_SEL(a, b) b
#endif
#if NAIVE_SSD
#define SSD_SEL(a, b) a
#else
#define SSD_SEL(a, b) b
#endif
#if NAIVE_ATTN
#define ATTN_SEL(a, b) a
#else
#define ATTN_SEL(a, b) b
#endif
#if NAIVE_TOPK
#define TOPK_SEL(a, b) a
#else
#define TOPK_SEL(a, b) b
#endif
#ifndef PROBE_DUP
#define PROBE_DUP -1
#endif
#define PHASE(i, body) if (lo <= (i) && (i) < hi) { body; if ((i) == PROBE_DUP) { xcd_barrier(bar); body; } if ((i) + 1 < hi) xcd_barrier(bar); }
    PHASE(PH_FIRST, { ph_convert_small(p); ph_rmsnorm(p.x, p.attn_norm, p.hn); ph_convert_experts_dev(p, 0, lds); })
    PHASE(PH_G1, GEMM_SEL(nv_g1(p), ph_g1(p, lds)))
    PHASE(PH_PREP, ph_prep_dev(p, lds))
    PHASE(PH_ATTN, { ATTN_SEL(nv_attn(p), ph_attn(p, lds)); SSD_SEL(nv_ssd(p), ph_ssd_states(p)); })
    PHASE(PH_SSDB, SSD_SEL((void)0, ph_ssd_scan(p)))
    PHASE(PH_SSDC, SSD_SEL((void)0, ph_ssd_out(p, lds)))
    PHASE(PH_GNORM, ph_gated_norm_dev(p))
    PHASE(PH_G2, GEMM_SEL(nv_g2(p), ph_g2(p, lds)))
    PHASE(PH_ROUTE0, ph_norm_router_dev(p, 0))
    PHASE(PH_TOPK0, TOPK_SEL(nv_topk(p), ph_topk(p, lds)))
    PHASE(PH_GATHER0, ph_gather(p))
    PHASE(PH_UP0, GEMM_SEL(nv_up(p), ph_up(p, lds)))
    PHASE(PH_DOWN0, GEMM_SEL(nv_down(p), ph_down(p, lds)))
    PHASE(PH_COMB0, { ph_combine_dev(p, p.conv_norm); ph_convert_experts_dev(p, 1, lds); })
    PHASE(PH_G3, GEMM_SEL(nv_g3(p), ph_g3(p, lds)))
    PHASE(PH_CONV3, ph_conv3(p))
    PHASE(PH_G4, GEMM_SEL(nv_g4(p), ph_g4(p, lds)))
    PHASE(PH_ROUTE1, ph_norm_router_dev(p, 1))
    PHASE(PH_TOPK1, TOPK_SEL(nv_topk(p), ph_topk(p, lds)))
    PHASE(PH_GATHER1, ph_gather(p))
    PHASE(PH_UP1, GEMM_SEL(nv_up(p), ph_up(p, lds)))
    PHASE(PH_DOWN1, GEMM_SEL(nv_down(p), ph_down(p, lds)))
    PHASE(PH_COMB1, ph_combine_dev(p, nullptr))
}

extern "C" void kernel_launch(void* const* d_in, const int* in_sizes, int n_in, void* d_out, int out_size, void* d_ws, size_t ws_size, hipStream_t stream) {
    (void)in_sizes; (void)n_in; (void)out_size; (void)ws_size;
    P p{};
    make_params(p, d_in, d_out, d_ws);
    static int grid = 0;
    if (grid == 0) {
        int dev = 0, cus = 0;
        if (hipGetDevice(&dev) != hipSuccess || hipDeviceGetAttribute(&cus, hipDeviceAttributeMultiprocessorCount, dev) != hipSuccess) cus = 256;
        (void)hipFuncSetAttribute((const void*)fwd, hipFuncAttributeMaxDynamicSharedMemorySize, LDS_BYTES);
        (void)hipGetLastError();
        grid = cus > 0 ? cus : 256;
    }
#if ONE_LAUNCH
    (void)hipMemsetAsync(p.bar, 0, XCD_BAR_WORDS * sizeof(unsigned), stream);
    hipLaunchKernelGGL(fwd, dim3(grid), dim3(512), LDS_BYTES, stream, p, 0, (int)NPH);
#else
    for (int ph = 0; ph < NPH; ++ph) hipLaunchKernelGGL(fwd, dim3(grid), dim3(512), LDS_BYTES, stream, p, ph, ph + 1);
#endif
}
#endif
```

```cpp
#ifndef HOST_EMU
#include <hip/hip_runtime.h>
#define HD __host__ __device__ __forceinline__
#define DEV __device__ __forceinline__
#else
#include <cmath>
#include <cstdio>
#include <cstdlib>
#include <cstring>
#include <cstddef>
#define HD inline
#define DEV inline
struct float4 { float x, y, z, w; };
struct uint4 { unsigned x, y, z, w; };
struct uint2 { unsigned x, y; };
static thread_local size_t emu_tid = 0; static size_t emu_nthreads = 1;
#endif

#ifndef BATCH
#define BATCH 2
#endif
#ifndef SEQ
#define SEQ 16384
#endif
#ifndef NAIVE_GEMM
#define NAIVE_GEMM 0
#endif
#ifndef NAIVE_ATTN
#define NAIVE_ATTN 0
#endif
#ifndef NAIVE_SSD
#define NAIVE_SSD 0
#endif
#ifndef NAIVE_TOPK
#define NAIVE_TOPK 0
#endif
#ifndef ONE_LAUNCH
#define ONE_LAUNCH 1
#endif

typedef unsigned short bf16_t;
constexpr int T = BATCH * SEQ;
constexpr int DM = 1024;
constexpr int NIN = 5664, NIN_PAD = 5888;
constexpr int NE = 16;
constexpr int CAP = 2 * SEQ / NE;
constexpr int NSLOT = BATCH * NE * CAP;
constexpr int DFF = 2048;
constexpr int NCHUNK = SEQ / 128;

HD float bf2f(bf16_t v) { union { unsigned u; float f; } x; x.u = ((unsigned)v) << 16; return x.f; }
HD bf16_t f2bf(float f) { union { unsigned u; float f; } x; x.f = f; unsigned u = x.u; u += 0x7fffu + ((u >> 16) & 1u); return (bf16_t)(u >> 16); }
HD unsigned pack2(float lo, float hi) { return (unsigned)f2bf(lo) | ((unsigned)f2bf(hi) << 16); }
HD float silu_f(float v) { return v / (1.0f + expf(-v)); }
HD float softplus_f(float v) { return v > 20.f ? v : log1pf(expf(v)); }

#ifndef HOST_EMU
#define LANES 64
#define GTID ((size_t)blockIdx.x * blockDim.x + threadIdx.x)
#define GSTRIDE ((size_t)gridDim.x * blockDim.x)
#define LANE ((int)(threadIdx.x & 63))
DEV float wave_sum(float v) {
#pragma unroll
    for (int o = 32; o >= 1; o >>= 1) v += __shfl_xor(v, o);
    return v;
}
#else
#define LANES 1
#define GTID (emu_tid)
#define GSTRIDE (emu_nthreads)
#define LANE 0
DEV float wave_sum(float v) { return v; }
#endif
#define GWAVE (GTID / LANES)
#define NWAVES_G (GSTRIDE / LANES)

struct P {
    const float *x, *attn_norm, *w_in, *q_norm, *k_norm, *conv_w, *conv_b, *a_log_f, *a_log_b, *dtb_f, *dtb_b, *ssd_d, *out_norm, *w_out,
        *conv_norm, *cw_in, *cw, *cw_out, *ffn_norm, *router_w, *wg, *wu, *wd;
    float* out;
    bf16_t *WinT, *WoutT, *WciT, *WcoT, *WguT, *WdT, *hn, *qkv, *z, *xbcraw, *bc, *xsT, *bmT, *states, *mix, *yssd, *xe, *hid, *ye, *pbuf, *gb, *abuf;
    float *dtraw, *step, *stT, *csT, *wdT, *cdec, *aff, *gate, *rope, *ytmp;
    int *idx, *slotmap;
    unsigned* bar;
};

constexpr size_t MiB = 1024 * 1024;
constexpr size_t al(size_t v) { return (v + 4095) & ~(size_t)4095; }
constexpr size_t WS_BAR = 0;
constexpr size_t WS_WIN = 65536;
constexpr size_t WS_WOUT = WS_WIN + al((size_t)NIN_PAD * 1024 * 2);
constexpr size_t WS_WCI = WS_WOUT + al((size_t)1024 * 2048 * 2);
constexpr size_t WS_WCO = WS_WCI + al((size_t)3072 * 1024 * 2);
constexpr size_t WS_WGU = WS_WCO + al((size_t)1024 * 1024 * 2);
constexpr size_t WS_WD = WS_WGU + al((size_t)NE * 4096 * 1024 * 2);
constexpr size_t WS_ROPE = WS_WD + al((size_t)NE * 1024 * 2048 * 2);
constexpr size_t WS_AFF = WS_ROPE + al((size_t)SEQ * 16 * 4);
constexpr size_t WS_GATE = WS_AFF + al((size_t)BATCH * NE * SEQ * 4);
constexpr size_t WS_IDX = WS_GATE + al((size_t)NSLOT * 4);
constexpr size_t WS_SMAP = WS_IDX + al((size_t)NSLOT * 4);
constexpr size_t WS_HN = WS_SMAP + al((size_t)BATCH * NE * SEQ * 4);
constexpr size_t WS_E = WS_HN + al((size_t)T * 1024 * 2);
constexpr size_t WS_XBCRAW = WS_E;
constexpr size_t WS_QKV = WS_XBCRAW + al((size_t)T * 1536 * 2);
constexpr size_t WS_Z = WS_QKV + al((size_t)T * 3072 * 2);
constexpr size_t WS_BC = WS_Z + al((size_t)T * 1024 * 2);
constexpr size_t WS_XST = WS_BC + al((size_t)T * 512 * 2);
constexpr size_t WS_BMT = WS_XST + al((size_t)T * 1024 * 2);
constexpr size_t WS_DTRAW = WS_BMT + al((size_t)T * 256 * 2);
constexpr size_t WS_STEP = WS_DTRAW + al((size_t)T * 32 * 4);
constexpr size_t WS_STT = WS_STEP + al((size_t)T * 32 * 4);
constexpr size_t WS_CST = WS_STT + al((size_t)T * 32 * 4);
constexpr size_t WS_WDT = WS_CST + al((size_t)T * 32 * 4);
constexpr size_t WS_CDEC = WS_WDT + al((size_t)T * 32 * 4);
constexpr size_t WS_MIX = WS_CDEC + al((size_t)BATCH * 32 * NCHUNK * 4);
constexpr size_t WS_YSSD = WS_MIX + al((size_t)T * 2048 * 2);
constexpr size_t WS_E_END = WS_YSSD + al((size_t)T * 1024 * 2);
constexpr size_t WS_STATES = WS_HN;
constexpr size_t WS_XE = WS_E;
constexpr size_t WS_HID = WS_XE + al((size_t)NSLOT * 1024 * 2);
constexpr size_t WS_YE = WS_HID + al((size_t)NSLOT * 2048 * 2);
constexpr size_t WS_F_END = WS_YE + al((size_t)NSLOT * 1024 * 2);
constexpr size_t WS_PBUF = WS_E;
constexpr size_t WS_GB = WS_PBUF + al((size_t)T * 1024 * 2);
constexpr size_t WS_ABUF = WS_GB + al((size_t)T * 1024 * 2);
constexpr size_t WS_END = WS_E_END > WS_F_END ? WS_E_END : WS_F_END;
static_assert((size_t)T * 1024 * 2 + (size_t)T * 1536 * 2 >= (size_t)T * 1024 * 4, "ytmp overlay");
static_assert((size_t)T * 1024 * 2 + (size_t)T * 1536 * 2 >= (size_t)BATCH * 2 * NCHUNK * 16 * 64 * 128 * 2, "states overlay");
static_assert(BATCH != 2 || SEQ != 16384 || WS_END <= 1024 * MiB, "workspace");

struct CmIdent { int nvalid; HD int operator()(int n) const { return n < nvalid ? n : -1; } };
struct CmGateUp { HD int operator()(int n) const { return n; } };
struct CmOddIn { HD int operator()(int n) const {
        if (n >= 2048) return n - 2048; const int pn = n >> 8, j = n & 255; return j < 128 ? 1024 + pn * 128 + j : 2048 + pn * 128 + (j - 128); } };

template <class CM> DEV void convT(const float* src, int ldsrc, int K, bf16_t* dst, int Ndst, CM cm) {
#ifndef HOST_EMU
    const size_t nitems = (size_t)Ndst * (K / 32);
    for (size_t i = GTID; i < nitems; i += GSTRIDE) {
        const int n = (int)(i % Ndst), k32 = (int)(i / Ndst); const int c = cm(n);
        float v[32];
#pragma unroll
        for (int j = 0; j < 32; ++j) v[j] = c >= 0 ? src[(size_t)(k32 * 32 + j) * ldsrc + c] : 0.f;
#pragma unroll
        for (int q = 0; q < 4; ++q) *(uint4*)(dst + (size_t)n * K + k32 * 32 + q * 8) = uint4{pack2(v[8 * q], v[8 * q + 1]), pack2(v[8 * q + 2], v[8 * q + 3]), pack2(v[8 * q + 4], v[8 * q + 5]), pack2(v[8 * q + 6], v[8 * q + 7])};
    }
#else
    for (size_t i = GTID; i < (size_t)Ndst * K; i += GSTRIDE) { const int n = (int)(i / K), k = (int)(i % K); const int c = cm(n); dst[i] = c >= 0 ? f2bf(src[(size_t)k * ldsrc + c]) : (bf16_t)0; }
#endif
}
struct CmGU { const float* dummy; HD int operator()(int n) const { return n; } };
template <int WHICH> struct CmHalf { HD int operator()(int n) const { const int j = n & 255; const bool isup = j >= 128; if ((int)isup != WHICH) return -2; return (n >> 8) * 128 + (j & 127); } };
DEV void conv_gateup(const float* sg, const float* su, bf16_t* dst) {
#ifndef HOST_EMU
    const size_t nitems = (size_t)4096 * 32;
    for (size_t i = GTID; i < nitems; i += GSTRIDE) {
        const int n = (int)(i % 4096), k32 = (int)(i / 4096); const int j0 = n & 255; const float* src = (j0 >= 128 ? su : sg) + (n >> 8) * 128 + (j0 & 127);
        float v[32];
#pragma unroll
        for (int j = 0; j < 32; ++j) v[j] = src[(size_t)(k32 * 32 + j) * 2048];
#pragma unroll
        for (int q = 0; q < 4; ++q) *(uint4*)(dst + (size_t)n * 1024 + k32 * 32 + q * 8) = uint4{pack2(v[8 * q], v[8 * q + 1]), pack2(v[8 * q + 2], v[8 * q + 3]), pack2(v[8 * q + 4], v[8 * q + 5]), pack2(v[8 * q + 6], v[8 * q + 7])};
    }
#else
    for (size_t i = GTID; i < (size_t)4096 * 1024; i += GSTRIDE) { const int n = (int)(i / 1024), k = (int)(i % 1024); const int j = n & 255; const float* src = j >= 128 ? su : sg; dst[i] = f2bf(src[(size_t)k * 2048 + (n >> 8) * 128 + (j & 127)]); }
#endif
}
DEV void ph_convert_small(const P& p) {
    convT(p.w_in, NIN, 1024, p.WinT, NIN_PAD, CmIdent{NIN});
    convT(p.w_out, 1024, 2048, p.WoutT, 1024, CmIdent{1024});
    convT(p.cw_in, 3072, 1024, p.WciT, 3072, CmOddIn{});
    convT(p.cw_out, 1024, 1024, p.WcoT, 1024, CmIdent{1024});
    for (size_t i = GTID; i < (size_t)SEQ * 8; i += GSTRIDE) {
        const int pos = (int)(i >> 3), j = (int)(i & 7);
        const float inv = powf(500000.0f, -((float)j * 2.0f / 16.0f)); const float ang = (float)pos * inv;
        p.rope[(size_t)pos * 16 + j] = cosf(ang); p.rope[(size_t)pos * 16 + 8 + j] = sinf(ang);
    }
}
DEV void ph_convert_experts(const P& p, int layer) {
    for (int e = 0; e < NE; ++e) {
        const size_t off = ((size_t)layer * NE + e) * 1024 * 2048;
        conv_gateup(p.wg + off, p.wu + off, p.WguT + (size_t)e * 4096 * 1024);
        convT(p.wd + off, 1024, 2048, p.WdT + (size_t)e * 1024 * 2048, 1024, CmIdent{1024});
    }
}

constexpr int NV = 256 / LANES;
DEV void ph_rmsnorm(const float* src, const float* g, bf16_t* dst) {
    for (size_t row = GWAVE; row < (size_t)T; row += NWAVES_G) {
        const float4* s4 = (const float4*)(src + row * 1024); float4 v[NV]; float ss = 0.f;
#pragma unroll
        for (int j = 0; j < NV; ++j) { v[j] = s4[j * LANES + LANE]; ss += v[j].x * v[j].x + v[j].y * v[j].y + v[j].z * v[j].z + v[j].w * v[j].w; }
        ss = wave_sum(ss); const float r = 1.0f / sqrtf(ss * (1.0f / 1024.0f) + 1e-6f);
#pragma unroll
        for (int j = 0; j < NV; ++j) { const int c4 = j * LANES + LANE; const float4 gg = ((const float4*)g)[c4];
            *(uint2*)(dst + row * 1024 + c4 * 4) = uint2{pack2(v[j].x * r * gg.x, v[j].y * r * gg.y), pack2(v[j].z * r * gg.z, v[j].w * r * gg.w)}; }
    }
}
DEV void ph_norm_router(const P& p, int layer) {
    const float* g = p.ffn_norm + (size_t)layer * 1024; const float* rw = p.router_w + (size_t)layer * 1024 * 16;
    for (size_t row = GWAVE; row < (size_t)T; row += NWAVES_G) {
        const float4* s4 = (const float4*)(p.out + row * 1024); float4 v[NV]; float ss = 0.f;
#pragma unroll
        for (int j = 0; j < NV; ++j) { v[j] = s4[j * LANES + LANE]; ss += v[j].x * v[j].x + v[j].y * v[j].y + v[j].z * v[j].z + v[j].w * v[j].w; }
        ss = wave_sum(ss); const float r = 1.0f / sqrtf(ss * (1.0f / 1024.0f) + 1e-6f);
        float lg[16];
#pragma unroll
        for (int e = 0; e < 16; ++e) lg[e] = 0.f;
#pragma unroll
        for (int j = 0; j < NV; ++j) { const int c4 = j * LANES + LANE; const float4 gg = ((const float4*)g)[c4];
            const float h0 = v[j].x * r * gg.x, h1 = v[j].y * r * gg.y, h2 = v[j].z * r * gg.z, h3 = v[j].w * r * gg.w;
            *(uint2*)(p.hn + row * 1024 + c4 * 4) = uint2{pack2(h0, h1), pack2(h2, h3)};
            const float4* w4 = (const float4*)(rw + (size_t)c4 * 4 * 16);
#pragma unroll
            for (int q = 0; q < 4; ++q) { const float4 a = w4[q], b = w4[4 + q], c = w4[8 + q], d = w4[12 + q];
                lg[4 * q + 0] += h0 * a.x + h1 * b.x + h2 * c.x + h3 * d.x; lg[4 * q + 1] += h0 * a.y + h1 * b.y + h2 * c.y + h3 * d.y;
                lg[4 * q + 2] += h0 * a.z + h1 * b.z + h2 * c.z + h3 * d.z; lg[4 * q + 3] += h0 * a.w + h1 * b.w + h2 * c.w + h3 * d.w; } }
        float mx = -1e30f;
#pragma unroll
        for (int e = 0; e < 16; ++e) { lg[e] = wave_sum(lg[e]); mx = fmaxf(mx, lg[e]); }
        float den = 0.f;
#pragma unroll
        for (int e = 0; e < 16; ++e) { lg[e] = expf(lg[e] - mx); den += lg[e]; }
        const float inv = 1.0f / den; const int b = (int)(row / SEQ), s = (int)(row % SEQ);
#pragma unroll
        for (int e = 0; e < 16; ++e) if (LANE == (e & (LANES - 1))) p.aff[((size_t)b * NE + e) * SEQ + s] = lg[e] * inv;
    }
}
DEV void ph_gated_norm(const P& p) {
    for (size_t row = GWAVE; row < (size_t)T; row += NWAVES_G) {
        float4 v[NV]; float ss = 0.f;
#pragma unroll
        for (int j = 0; j < NV; ++j) { const int c4 = j * LANES + LANE; const uint2 y = *(const uint2*)(p.yssd + row * 1024 + c4 * 4), zz = *(const uint2*)(p.z + row * 1024 + c4 * 4);
            v[j].x = bf2f((bf16_t)(y.x & 0xffff)) * silu_f(bf2f((bf16_t)(zz.x & 0xffff))); v[j].y = bf2f((bf16_t)(y.x >> 16)) * silu_f(bf2f((bf16_t)(zz.x >> 16)));
            v[j].z = bf2f((bf16_t)(y.y & 0xffff)) * silu_f(bf2f((bf16_t)(zz.y & 0xffff))); v[j].w = bf2f((bf16_t)(y.y >> 16)) * silu_f(bf2f((bf16_t)(zz.y >> 16)));
            ss += v[j].x * v[j].x + v[j].y * v[j].y + v[j].z * v[j].z + v[j].w * v[j].w; }
        ss = wave_sum(ss); const float r = 1.0f / sqrtf(ss * (1.0f / 1024.0f) + 1e-6f);
#pragma unroll
        for (int j = 0; j < NV; ++j) { const int c4 = j * LANES + LANE; const float4 gg = ((const float4*)p.out_norm)[c4];
            *(uint2*)(p.mix + row * 2048 + 1024 + c4 * 4) = uint2{pack2(v[j].x * r * gg.x, v[j].y * r * gg.y), pack2(v[j].z * r * gg.z, v[j].w * r * gg.w)}; }
    }
}
DEV void ph_combine(const P& p, const float* g) {
    for (size_t row = GWAVE; row < (size_t)T; row += NWAVES_G) {
        const int b = (int)(row / SEQ), s = (int)(row % SEQ);
        float4* o4 = (float4*)(p.out + row * 1024); float4 v[NV];
#pragma unroll
        for (int j = 0; j < NV; ++j) v[j] = o4[j * LANES + LANE];
        for (int e = 0; e < NE; ++e) {
            const int sl = p.slotmap[((size_t)b * NE + e) * SEQ + s];
            if (sl >= 0) { const size_t r = ((size_t)b * NE + e) * CAP + sl; const float gt = p.gate[r];
#pragma unroll
                for (int j = 0; j < NV; ++j) { const int c4 = j * LANES + LANE; const uint2 y = *(const uint2*)(p.ye + r * 1024 + c4 * 4);
                    v[j].x += gt * bf2f((bf16_t)(y.x & 0xffff)); v[j].y += gt * bf2f((bf16_t)(y.x >> 16)); v[j].z += gt * bf2f((bf16_t)(y.y & 0xffff)); v[j].w += gt * bf2f((bf16_t)(y.y >> 16)); } }
        }
        float ss = 0.f;
#pragma unroll
        for (int j = 0; j < NV; ++j) { o4[j * LANES + LANE] = v[j]; ss += v[j].x * v[j].x + v[j].y * v[j].y + v[j].z * v[j].z + v[j].w * v[j].w; }
        if (g) { ss = wave_sum(ss); const float r = 1.0f / sqrtf(ss * (1.0f / 1024.0f) + 1e-6f);
#pragma unroll
            for (int j = 0; j < NV; ++j) { const int c4 = j * LANES + LANE; const float4 gg = ((const float4*)g)[c4];
                *(uint2*)(p.hn + row * 1024 + c4 * 4) = uint2{pack2(v[j].x * r * gg.x, v[j].y * r * gg.y), pack2(v[j].z * r * gg.z, v[j].w * r * gg.w)}; } }
    }
}

DEV void ld8(const bf16_t* p, float (&f)[8]) { const uint4 u = *(const uint4*)p; const unsigned w[4] = {u.x, u.y, u.z, u.w};
#pragma unroll
    for (int j = 0; j < 4; ++j) { f[2 * j] = bf2f((bf16_t)(w[j] & 0xffff)); f[2 * j + 1] = bf2f((bf16_t)(w[j] >> 16)); } }
DEV void st8(bf16_t* p, const float (&f)[8]) { *(uint4*)p = uint4{pack2(f[0], f[1]), pack2(f[2], f[3]), pack2(f[4], f[5]), pack2(f[6], f[7])}; }

DEV void ph_prep(const P& p, bool doqk = true) {
    for (size_t i = GTID; doqk && i < (size_t)T * 32; i += GSTRIDE) {
        const size_t t = i >> 5; const int hh = (int)(i & 31); const int isk = hh >> 4, h = hh & 15; const int pos = (int)(t % SEQ);
        bf16_t* ptr = p.qkv + t * 3072 + isk * 1024 + h * 64; const float* gn = isk ? p.k_norm : p.q_norm;
        float v[64]; float ss = 0.f;
#pragma unroll
        for (int c = 0; c < 8; ++c) { float f[8]; ld8(ptr + c * 8, f);
#pragma unroll
            for (int j = 0; j < 8; ++j) { v[c * 8 + j] = f[j]; ss += f[j] * f[j]; } }
        const float r = 1.0f / sqrtf(ss * (1.0f / 64.0f) + 1e-6f);
#pragma unroll
        for (int c = 0; c < 64; ++c) v[c] = v[c] * r * gn[c];
#pragma unroll
        for (int j = 0; j < 8; ++j) { const float cs = p.rope[(size_t)pos * 16 + j], sn = p.rope[(size_t)pos * 16 + 8 + j]; const float x1 = v[j], x2 = v[8 + j]; v[j] = x1 * cs - x2 * sn; v[8 + j] = x2 * cs + x1 * sn; }
#pragma unroll
        for (int c = 0; c < 8; ++c) { float f[8];
#pragma unroll
            for (int j = 0; j < 8; ++j) f[j] = v[c * 8 + j];
            st8(ptr + c * 8, f); }
    }
    for (size_t i = GTID; i < (size_t)T * 192; i += GSTRIDE) {
        const size_t t = i % T; const int c8 = (int)(i / T) * 8; const int pos = (int)(t % SEQ); const int b = (int)(t / SEQ);
        float acc[8];
#pragma unroll
        for (int j = 0; j < 8; ++j) acc[j] = p.conv_b[c8 + j];
#pragma unroll
        for (int k = 0; k < 5; ++k) { const int pp = pos + k - 2; if (pp < 0 || pp >= SEQ) continue; float f[8]; ld8(p.xbcraw + (t + k - 2) * 1536 + c8, f);
#pragma unroll
            for (int j = 0; j < 8; ++j) acc[j] += f[j] * p.conv_w[k * 1536 + c8 + j]; }
#pragma unroll
        for (int j = 0; j < 8; ++j) acc[j] = silu_f(acc[j]);
        if (c8 < 1024) {
#pragma unroll
            for (int j = 0; j < 8; ++j) p.xsT[((size_t)b * 1024 + c8 + j) * SEQ + pos] = f2bf(acc[j]);
        } else {
            st8(p.bc + t * 512 + (c8 - 1024), acc);
            if (c8 < 1280) {
#pragma unroll
                for (int j = 0; j < 8; ++j) p.bmT[((size_t)b * 256 + (c8 - 1024) + j) * SEQ + pos] = f2bf(acc[j]); }
        }
    }
    for (size_t i = GTID; i < (size_t)BATCH * NCHUNK * 32; i += GSTRIDE) {
        const int j = (int)(i & 31); const int c = (int)((i >> 5) % NCHUNK), b = (int)((i >> 5) / NCHUNK); const int dir = j >> 4, h = j & 15;
        const float A = -expf(dir ? p.a_log_b[h] : p.a_log_f[h]), bias = dir ? p.dtb_b[h] : p.dtb_f[h];
        const size_t row0 = (size_t)b * SEQ + (size_t)c * 128; float* stT = p.stT + ((size_t)b * 32 + j) * SEQ + c * 128; float* csT = p.csT + ((size_t)b * 32 + j) * SEQ + c * 128; float* wdT = p.wdT + ((size_t)b * 32 + j) * SEQ + c * 128;
        float run = 0.f;
        for (int ll = 0; ll < 128; ++ll) { const int l = dir ? 127 - ll : ll; const float dt = softplus_f(p.dtraw[(row0 + l) * 32 + j] + bias); p.step[(row0 + l) * 32 + j] = dt; stT[l] = dt; run += dt * A; csT[l] = run; }
        for (int l = 0; l < 128; ++l) wdT[l] = stT[l] * expf(run - csT[l]);
        p.cdec[((size_t)b * 32 + j) * NCHUNK + c] = expf(run);
    }
}
DEV void ph_gather(const P& p) {
    for (size_t i = GTID; i < (size_t)NSLOT * 128; i += GSTRIDE) { const size_t r = i >> 7; const int j = (int)(i & 127); const int b = (int)(r / ((size_t)NE * CAP));
        *(uint4*)(p.xe + r * 1024 + j * 8) = *(const uint4*)(p.hn + ((size_t)b * SEQ + p.idx[r]) * 1024 + j * 8); }
}
DEV void ph_conv3(const P& p) {
    for (size_t i = GTID; i < (size_t)T * 128; i += GSTRIDE) {
        const size_t t = i >> 7; const int c8 = (int)(i & 127) * 8; const int pos = (int)(t % SEQ);
        float acc[8], f[8];
#pragma unroll
        for (int j = 0; j < 8; ++j) acc[j] = 0.f;
#pragma unroll
        for (int k = 0; k < 3; ++k) { const int pp = pos + k - 1; if (pp < 0 || pp >= SEQ) continue; ld8(p.pbuf + (t + k - 1) * 1024 + c8, f);
#pragma unroll
            for (int j = 0; j < 8; ++j) acc[j] += f[j] * p.cw[k * 1024 + c8 + j]; }
        ld8(p.gb + t * 1024 + c8, f);
#pragma unroll
        for (int j = 0; j < 8; ++j) acc[j] *= f[j];
        st8(p.abuf + t * 1024 + c8, acc);
    }
}

DEV float dot_bf(const bf16_t* a, const bf16_t* b, int K) { float acc = 0.f; for (int k = 0; k < K; k += 8) { float fa[8], fb[8]; ld8(a + k, fa); ld8(b + k, fb);
#pragma unroll
        for (int j = 0; j < 8; ++j) acc += fa[j] * fb[j]; } return acc; }
DEV void nv_g1(const P& p) {
    for (size_t i = GTID; i < (size_t)T * NIN; i += GSTRIDE) { const size_t m = i / NIN; const int n = (int)(i % NIN); const float acc = dot_bf(p.hn + m * 1024, p.WinT + (size_t)n * 1024, 1024);
        if (n < 3072) p.qkv[m * 3072 + n] = f2bf(acc); else if (n < 4096) p.z[m * 1024 + n - 3072] = f2bf(acc); else if (n < 5632) p.xbcraw[m * 1536 + n - 4096] = f2bf(acc); else p.dtraw[m * 32 + n - 5632] = acc; }
}
DEV void nv_g2(const P& p) {
    for (size_t i = GTID; i < (size_t)T * 1024; i += GSTRIDE) { const size_t m = i >> 10; const int n = (int)(i & 1023); p.out[i] = p.x[i] + dot_bf(p.mix + m * 2048, p.WoutT + (size_t)n * 2048, 2048); }
}
DEV void nv_up(const P& p) {
    for (size_t i = GTID; i < (size_t)NSLOT * 2048; i += GSTRIDE) { const size_t r = i >> 11; const int n = (int)(i & 2047); const int e = (int)((r / CAP) % NE);
        const bf16_t* w = p.WguT + (size_t)e * 4096 * 1024 + (size_t)((n >> 7) * 256 + (n & 127)) * 1024;
        const float g = dot_bf(p.xe + r * 1024, w, 1024), u = dot_bf(p.xe + r * 1024, w + (size_t)128 * 1024, 1024); p.hid[i] = f2bf(silu_f(g) * u); }
}
DEV void nv_down(const P& p) {
    for (size_t i = GTID; i < (size_t)NSLOT * 1024; i += GSTRIDE) { const size_t r = i >> 10; const int n = (int)(i & 1023); const int e = (int)((r / CAP) % NE);
        p.ye[i] = f2bf(dot_bf(p.hid + r * 2048, p.WdT + (size_t)e * 1024 * 2048 + (size_t)n * 2048, 2048)); }
}
DEV void nv_g3(const P& p) {
    for (size_t i = GTID; i < (size_t)T * 2048; i += GSTRIDE) { const size_t m = i >> 11; const int n = (int)(i & 2047);
        if (n < 1024) { const bf16_t* w = p.WciT + (size_t)((n >> 7) * 256 + (n & 127)) * 1024; p.pbuf[m * 1024 + n] = f2bf(dot_bf(p.hn + m * 1024, w, 1024) * dot_bf(p.hn + m * 1024, w + (size_t)128 * 1024, 1024)); }
        else p.gb[m * 1024 + n - 1024] = f2bf(dot_bf(p.hn + m * 1024, p.WciT + (size_t)(2048 + n - 1024) * 1024, 1024)); }
}
DEV void nv_g4(const P& p) {
    for (size_t i = GTID; i < (size_t)T * 1024; i += GSTRIDE) { const size_t m = i >> 10; const int n = (int)(i & 1023); p.out[i] += dot_bf(p.abuf + m * 1024, p.WcoT + (size_t)n * 1024, 1024); }
}
DEV void nv_attn(const P& p) {
    for (size_t i = GTID; i < (size_t)T * 16; i += GSTRIDE) {
        const size_t t = i >> 4; const int h = (int)(i & 15); const int pos = (int)(t % SEQ); const size_t t0 = t - pos;
        const bf16_t* qp = p.qkv + t * 3072 + h * 64;
        float o[64]; float m = -1e30f, l = 0.f;
#pragma unroll
        for (int c = 0; c < 64; ++c) o[c] = 0.f;
        for (int pat = 0; pat < 3; ++pat) { const int d = pat == 0 ? 1 : (pat == 1 ? 4 : 16);
            for (int j = -64; j <= 64; ++j) { const int kp = pos + d * j; if (kp < 0 || kp >= SEQ) continue;
                const bf16_t* kr = p.qkv + (t0 + kp) * 3072 + 1024 + h * 64; const bf16_t* vr = kr + 1024;
                const float s = dot_bf(qp, kr, 64) * 0.125f;
                const float mn = fmaxf(m, s), sc = expf(m - mn), pe = expf(s - mn); l = l * sc + pe; m = mn;
#pragma unroll
                for (int c = 0; c < 8; ++c) { float f[8]; ld8(vr + c * 8, f);
#pragma unroll
                    for (int q = 0; q < 8; ++q) o[c * 8 + q] = o[c * 8 + q] * sc + pe * f[q]; } } }
        const float inv = 1.0f / l;
#pragma unroll
        for (int c = 0; c < 8; ++c) { float f[8];
#pragma unroll
            for (int q = 0; q < 8; ++q) f[q] = o[c * 8 + q] * inv;
            st8(p.mix + t * 2048 + h * 64 + c * 8, f); }
    }
}
DEV void nv_ssd(const P& p) {
    const size_t nitem = (size_t)BATCH * 16 * 64;
#ifndef HOST_EMU
    if (LANE != 0) return;
#endif
    for (size_t it = GWAVE; it < nitem; it += NWAVES_G) {
        const int b = (int)(it / 1024), h = (int)((it >> 6) & 15), pc = (int)(it & 63), g = h >> 3;
        const float af = -expf(p.a_log_f[h]), ab = -expf(p.a_log_b[h]), dsk = p.ssd_d[h];
        float st[128];
        for (int dir = 0; dir < 2; ++dir) {
#pragma unroll
            for (int n = 0; n < 128; ++n) st[n] = 0.f;
            for (int tt = 0; tt < SEQ; ++tt) { const int s = dir ? SEQ - 1 - tt : tt; const size_t row = (size_t)b * SEQ + s;
                const float dt = p.step[row * 32 + dir * 16 + h]; const float dec = expf(dt * (dir ? ab : af)); const float xv = bf2f(p.xsT[((size_t)b * 1024 + h * 64 + pc) * SEQ + s]); const float xdt = xv * dt;
                const bf16_t* bm = p.bc + row * 512 + g * 128; const bf16_t* cm = bm + 256; float y = 0.f;
#pragma unroll
                for (int n8 = 0; n8 < 16; ++n8) { float fb[8], fc[8]; ld8(bm + n8 * 8, fb); ld8(cm + n8 * 8, fc);
#pragma unroll
                    for (int j = 0; j < 8; ++j) { st[n8 * 8 + j] = st[n8 * 8 + j] * dec + xdt * fb[j]; y += fc[j] * st[n8 * 8 + j]; } }
                if (dir == 0) p.ytmp[row * 1024 + h * 64 + pc] = y; else p.yssd[row * 1024 + h * 64 + pc] = f2bf(p.ytmp[row * 1024 + h * 64 + pc] + y + xv * dsk); }
        }
    }
}
DEV void nv_topk(const P& p) {
    for (size_t i = GTID; i < (size_t)BATCH * NE * SEQ; i += GSTRIDE) { const size_t be = i / SEQ; const int s = (int)(i % SEQ); const float* a = p.aff + be * SEQ; const float v = a[s]; int rank = 0;
        for (int j = 0; j < SEQ; ++j) { const float w = a[j]; rank += (w > v || (w == v && j < s)) ? 1 : 0; }
        if (rank < CAP) { p.idx[be * CAP + rank] = s; p.gate[be * CAP + rank] = v; p.slotmap[i] = rank; } else p.slotmap[i] = -1; }
}

static void make_params(P& p, void* const* d_in, void* d_out, void* d_ws) {
    const float** ins = (const float**)&p.x;
    for (int i = 0; i < 23; ++i) ins[i] = (const float*)d_in[i];
    p.out = (float*)d_out;
    unsigned char* ws = (unsigned char*)d_ws;
    p.WinT = (bf16_t*)(ws + WS_WIN); p.WoutT = (bf16_t*)(ws + WS_WOUT); p.WciT = (bf16_t*)(ws + WS_WCI); p.WcoT = (bf16_t*)(ws + WS_WCO); p.WguT = (bf16_t*)(ws + WS_WGU); p.WdT = (bf16_t*)(ws + WS_WD);
    p.hn = (bf16_t*)(ws + WS_HN); p.qkv = (bf16_t*)(ws + WS_QKV); p.z = (bf16_t*)(ws + WS_Z); p.xbcraw = (bf16_t*)(ws + WS_XBCRAW); p.bc = (bf16_t*)(ws + WS_BC); p.xsT = (bf16_t*)(ws + WS_XST); p.bmT = (bf16_t*)(ws + WS_BMT); p.states = (bf16_t*)(ws + WS_STATES); p.mix = (bf16_t*)(ws + WS_MIX); p.yssd = (bf16_t*)(ws + WS_YSSD);
    p.xe = (bf16_t*)(ws + WS_XE); p.hid = (bf16_t*)(ws + WS_HID); p.ye = (bf16_t*)(ws + WS_YE); p.pbuf = (bf16_t*)(ws + WS_PBUF); p.gb = (bf16_t*)(ws + WS_GB); p.abuf = (bf16_t*)(ws + WS_ABUF);
    p.dtraw = (float*)(ws + WS_DTRAW); p.step = (float*)(ws + WS_STEP); p.aff = (float*)(ws + WS_AFF); p.gate = (float*)(ws + WS_GATE); p.rope = (float*)(ws + WS_ROPE); p.ytmp = (float*)(ws + WS_STATES); p.stT = (float*)(ws + WS_STT); p.csT = (float*)(ws + WS_CST); p.wdT = (float*)(ws + WS_WDT); p.cdec = (float*)(ws + WS_CDEC);
    p.idx = (int*)(ws + WS_IDX); p.slotmap = (int*)(ws + WS_SMAP); p.bar = (unsigned*)(ws + WS_BAR);
}
#ifndef HOST_EMU
#define LAS __attribute__((address_space(3)))
typedef short bf16x8 __attribute__((ext_vector_type(8)));
typedef float f32x4 __attribute__((ext_vector_type(4)));
typedef unsigned u32x4 __attribute__((ext_vector_type(4)));
DEV void ph_norm_router_dev(const P& p, int layer) {
    const float4* g4 = (const float4*)(p.ffn_norm + (size_t)layer * 1024); const float4* rw4 = (const float4*)(p.router_w + (size_t)layer * 1024 * 16);
    const int lane = LANE;
    for (size_t row0 = GWAVE * 4; row0 < (size_t)T; row0 += NWAVES_G * 4) {
        float rinv[4];
        { float ss[4] = {0.f, 0.f, 0.f, 0.f};
#pragma unroll
          for (int j = 0; j < 4; ++j)
#pragma unroll
            for (int r = 0; r < 4; ++r) { const float4 t = ((const float4*)(p.out + (row0 + r) * 1024))[j * 64 + lane]; ss[r] += t.x * t.x + t.y * t.y + t.z * t.z + t.w * t.w; }
#pragma unroll
          for (int r = 0; r < 4; ++r) { const float q = wave_sum(ss[r]); rinv[r] = 1.0f / sqrtf(q * (1.0f / 1024.0f) + 1e-6f); } }
        float lg[4][16];
#pragma unroll
        for (int r = 0; r < 4; ++r)
#pragma unroll
            for (int e = 0; e < 16; ++e) lg[r][e] = 0.f;
#pragma unroll 1
        for (int j = 0; j < 4; ++j) { const int c4 = j * 64 + lane; const float4 gg = g4[c4]; float h[4][4];
#pragma unroll
            for (int r = 0; r < 4; ++r) { const float4 t = ((const float4*)(p.out + (row0 + r) * 1024))[c4];
                h[r][0] = t.x * rinv[r] * gg.x; h[r][1] = t.y * rinv[r] * gg.y; h[r][2] = t.z * rinv[r] * gg.z; h[r][3] = t.w * rinv[r] * gg.w;
                *(uint2*)(p.hn + (row0 + r) * 1024 + c4 * 4) = uint2{pack2(h[r][0], h[r][1]), pack2(h[r][2], h[r][3])}; }
#pragma unroll
            for (int cc = 0; cc < 4; ++cc) {
#pragma unroll
                for (int q = 0; q < 4; ++q) { const float4 w = rw4[(size_t)(c4 * 4 + cc) * 4 + q];
#pragma unroll
                    for (int r = 0; r < 4; ++r) { lg[r][4 * q] += h[r][cc] * w.x; lg[r][4 * q + 1] += h[r][cc] * w.y; lg[r][4 * q + 2] += h[r][cc] * w.z; lg[r][4 * q + 3] += h[r][cc] * w.w; } }
                asm volatile("" ::: "memory"); } }
#pragma unroll
        for (int r = 0; r < 4; ++r) { float mx = -1e30f;
#pragma unroll
            for (int e = 0; e < 16; ++e) { lg[r][e] = wave_sum(lg[r][e]); mx = fmaxf(mx, lg[r][e]); }
            float den = 0.f;
#pragma unroll
            for (int e = 0; e < 16; ++e) { lg[r][e] = expf(lg[r][e] - mx); den += lg[r][e]; }
            const float inv = 1.0f / den; const size_t row = row0 + r; const int b = (int)(row / SEQ), s = (int)(row % SEQ);
#pragma unroll
            for (int e = 0; e < 16; ++e) if (lane == e) p.aff[((size_t)b * NE + e) * SEQ + s] = lg[r][e] * inv; }
    }
}
DEV void ph_gated_norm_dev(const P& p) {
    const int lane = LANE;
    for (size_t row0 = GWAVE * 2; row0 < (size_t)T; row0 += NWAVES_G * 2) {
        uint2 yv[2][4], zv[2][4];
#pragma unroll
        for (int r = 0; r < 2; ++r)
#pragma unroll
            for (int j = 0; j < 4; ++j) { const int c4 = j * 64 + lane; yv[r][j] = *(const uint2*)(p.yssd + (row0 + r) * 1024 + c4 * 4); zv[r][j] = *(const uint2*)(p.z + (row0 + r) * 1024 + c4 * 4); }
#pragma unroll
        for (int r = 0; r < 2; ++r) { float4 v[4]; float ss = 0.f;
#pragma unroll
            for (int j = 0; j < 4; ++j) { const uint2 y = yv[r][j], zz = zv[r][j];
                const float z0 = __uint_as_float(zz.x << 16), z1 = __uint_as_float(zz.x & 0xffff0000u), z2 = __uint_as_float(zz.y << 16), z3 = __uint_as_float(zz.y & 0xffff0000u);
                v[j].x = __uint_as_float(y.x << 16) * z0 * __builtin_amdgcn_rcpf(1.0f + __expf(-z0)); v[j].y = __uint_as_float(y.x & 0xffff0000u) * z1 * __builtin_amdgcn_rcpf(1.0f + __expf(-z1));
                v[j].z = __uint_as_float(y.y << 16) * z2 * __builtin_amdgcn_rcpf(1.0f + __expf(-z2)); v[j].w = __uint_as_float(y.y & 0xffff0000u) * z3 * __builtin_amdgcn_rcpf(1.0f + __expf(-z3));
                ss += v[j].x * v[j].x + v[j].y * v[j].y + v[j].z * v[j].z + v[j].w * v[j].w; }
            ss = wave_sum(ss); const float rr = 1.0f / sqrtf(ss * (1.0f / 1024.0f) + 1e-6f);
#pragma unroll
            for (int j = 0; j < 4; ++j) { const int c4 = j * 64 + lane; const float4 gg = ((const float4*)p.out_norm)[c4];
                *(uint2*)(p.mix + (row0 + r) * 2048 + 1024 + c4 * 4) = uint2{pack2(v[j].x * rr * gg.x, v[j].y * rr * gg.y), pack2(v[j].z * rr * gg.z, v[j].w * rr * gg.w)}; } }
    }
}
DEV void ph_combine_dev(const P& p, const float* g) {
    const int lane = LANE;
    for (size_t row = GWAVE; row < (size_t)T; row += NWAVES_G) {
        const int b = (int)(row / SEQ), s = (int)(row % SEQ);
        int mysl = -1; float mygt = 0.f;
        if (lane < 16) { mysl = p.slotmap[((size_t)b * NE + lane) * SEQ + s]; if (mysl >= 0) mygt = p.gate[((size_t)b * NE + lane) * CAP + mysl]; }
        float4* o4 = (float4*)(p.out + row * 1024); float4 v[4];
#pragma unroll
        for (int j = 0; j < 4; ++j) v[j] = o4[j * 64 + lane];
        unsigned long long mask = __ballot(mysl >= 0);
        while (mask) {
            const int e = __builtin_ctzll(mask); mask &= mask - 1;
            const int sl = __shfl(mysl, e); const float gt = __shfl(mygt, e); const size_t r = ((size_t)b * NE + e) * CAP + sl;
            uint2 y[4];
#pragma unroll
            for (int j = 0; j < 4; ++j) y[j] = *(const uint2*)(p.ye + r * 1024 + (j * 64 + lane) * 4);
#pragma unroll
            for (int j = 0; j < 4; ++j) { v[j].x += gt * __uint_as_float(y[j].x << 16); v[j].y += gt * __uint_as_float(y[j].x & 0xffff0000u); v[j].z += gt * __uint_as_float(y[j].y << 16); v[j].w += gt * __uint_as_float(y[j].y & 0xffff0000u); }
        }
        float ss = 0.f;
#pragma unroll
        for (int j = 0; j < 4; ++j) { o4[j * 64 + lane] = v[j]; ss += v[j].x * v[j].x + v[j].y * v[j].y + v[j].z * v[j].z + v[j].w * v[j].w; }
        if (g) { ss = wave_sum(ss); const float rr = 1.0f / sqrtf(ss * (1.0f / 1024.0f) + 1e-6f);
#pragma unroll
            for (int j = 0; j < 4; ++j) { const int c4 = j * 64 + lane; const float4 gg = ((const float4*)g)[c4];
                *(uint2*)(p.hn + row * 1024 + c4 * 4) = uint2{pack2(v[j].x * rr * gg.x, v[j].y * rr * gg.y), pack2(v[j].z * rr * gg.z, v[j].w * rr * gg.w)}; } }
    }
}

DEV void ph_rmsnorm_dev(const float* src, const float* g, bf16_t* dst) {
    const int lane = LANE;
    for (size_t row0 = GWAVE * 4; row0 < (size_t)T; row0 += NWAVES_G * 4) {
        float4 v[4][4];
#pragma unroll
        for (int r = 0; r < 4; ++r)
#pragma unroll
            for (int j = 0; j < 4; ++j) v[r][j] = ((const float4*)(src + (row0 + r) * 1024))[j * 64 + lane];
#pragma unroll
        for (int r = 0; r < 4; ++r) { float ss = 0.f;
#pragma unroll
            for (int j = 0; j < 4; ++j) ss += v[r][j].x * v[r][j].x + v[r][j].y * v[r][j].y + v[r][j].z * v[r][j].z + v[r][j].w * v[r][j].w;
            ss = wave_sum(ss); const float rr = 1.0f / sqrtf(ss * (1.0f / 1024.0f) + 1e-6f);
#pragma unroll
            for (int j = 0; j < 4; ++j) { const int c4 = j * 64 + lane; const float4 gg = ((const float4*)g)[c4];
                *(uint2*)(dst + (row0 + r) * 1024 + c4 * 4) = uint2{pack2(v[r][j].x * rr * gg.x, v[r][j].y * rr * gg.y), pack2(v[r][j].z * rr * gg.z, v[r][j].w * rr * gg.w)}; } }
    }
}
DEV void ph_gather_dev(const P& p) {
    for (size_t i0 = GTID; i0 + 3 * GSTRIDE < (size_t)NSLOT * 128; i0 += GSTRIDE * 4) {
        const size_t i1 = i0 + GSTRIDE, i2 = i1 + GSTRIDE, i3 = i2 + GSTRIDE;
        const int t0 = p.idx[i0 >> 7], t1 = p.idx[i1 >> 7], t2 = p.idx[i2 >> 7], t3 = p.idx[i3 >> 7];
        const u32x4 v0 = *(const u32x4*)(p.hn + ((size_t)((i0 >> 7) / ((size_t)NE * CAP)) * SEQ + t0) * 1024 + (i0 & 127) * 8);
        const u32x4 v1 = *(const u32x4*)(p.hn + ((size_t)((i1 >> 7) / ((size_t)NE * CAP)) * SEQ + t1) * 1024 + (i1 & 127) * 8);
        const u32x4 v2 = *(const u32x4*)(p.hn + ((size_t)((i2 >> 7) / ((size_t)NE * CAP)) * SEQ + t2) * 1024 + (i2 & 127) * 8);
        const u32x4 v3 = *(const u32x4*)(p.hn + ((size_t)((i3 >> 7) / ((size_t)NE * CAP)) * SEQ + t3) * 1024 + (i3 & 127) * 8);
        *(u32x4*)(p.xe + (i0 >> 7) * 1024 + (i0 & 127) * 8) = v0; *(u32x4*)(p.xe + (i1 >> 7) * 1024 + (i1 & 127) * 8) = v1;
        *(u32x4*)(p.xe + (i2 >> 7) * 1024 + (i2 & 127) * 8) = v2; *(u32x4*)(p.xe + (i3 >> 7) * 1024 + (i3 & 127) * 8) = v3;
    }
}
DEV void ph_conv3_dev(const P& p) {
    for (size_t i0 = GTID; i0 < (size_t)T * 128; i0 += GSTRIDE * 4) {
        uint4 a[4][3], gbv[4];
#pragma unroll
        for (int q = 0; q < 4; ++q) { const size_t i = i0 + q * GSTRIDE; const size_t t = i >> 7; const int c8 = (int)(i & 127) * 8, pos = (int)(t % SEQ);
#pragma unroll
            for (int k = 0; k < 3; ++k) { const int pp = pos + k - 1; a[q][k] = (pp < 0 || pp >= SEQ) ? uint4{0u, 0u, 0u, 0u} : *(const uint4*)(p.pbuf + (t + k - 1) * 1024 + c8); }
            gbv[q] = *(const uint4*)(p.gb + t * 1024 + c8); }
#pragma unroll
        for (int q = 0; q < 4; ++q) { const size_t i = i0 + q * GSTRIDE; const size_t t = i >> 7; const int c8 = (int)(i & 127) * 8;
            float acc[8], f[8];
#pragma unroll
            for (int j = 0; j < 8; ++j) acc[j] = 0.f;
#pragma unroll
            for (int k = 0; k < 3; ++k) { const unsigned w[4] = {a[q][k].x, a[q][k].y, a[q][k].z, a[q][k].w};
#pragma unroll
                for (int j = 0; j < 4; ++j) { acc[2 * j] += __uint_as_float(w[j] << 16) * p.cw[k * 1024 + c8 + 2 * j]; acc[2 * j + 1] += __uint_as_float(w[j] & 0xffff0000u) * p.cw[k * 1024 + c8 + 2 * j + 1]; } }
            { const unsigned w[4] = {gbv[q].x, gbv[q].y, gbv[q].z, gbv[q].w};
#pragma unroll
              for (int j = 0; j < 4; ++j) { f[2 * j] = acc[2 * j] * __uint_as_float(w[j] << 16); f[2 * j + 1] = acc[2 * j + 1] * __uint_as_float(w[j] & 0xffff0000u); } }
            st8(p.abuf + t * 1024 + c8, f); }
    }
}
DEV void ph_combine_dev4(const P& p, const float* g) {
    const int lane = LANE, rsub = lane >> 4, e16 = lane & 15;
    for (size_t row0 = GWAVE * 4; row0 < (size_t)T; row0 += NWAVES_G * 4) {
        const int b = (int)(row0 / SEQ), s0 = (int)(row0 % SEQ);
        const int mysl = p.slotmap[((size_t)b * NE + e16) * SEQ + s0 + rsub];
        float4 v[4][4];
#pragma unroll
        for (int r = 0; r < 4; ++r)
#pragma unroll
            for (int j = 0; j < 4; ++j) v[r][j] = ((const float4*)(p.out + (row0 + r) * 1024))[j * 64 + lane];
        const float mygt = mysl >= 0 ? p.gate[((size_t)b * NE + e16) * CAP + mysl] : 0.f;
        const unsigned long long mall = __ballot(mysl >= 0);
        unsigned m[4];
#pragma unroll
        for (int r = 0; r < 4; ++r) m[r] = (unsigned)((mall >> (16 * r)) & 0xffffull);
        while (m[0] | m[1] | m[2] | m[3]) {
            uint2 y[4][4]; float gt[4];
#pragma unroll
            for (int r = 0; r < 4; ++r) { gt[r] = 0.f;
                if (m[r]) { const int e = __builtin_ctz(m[r]); m[r] &= m[r] - 1; const int sl = __shfl(mysl, 16 * r + e); gt[r] = __shfl(mygt, 16 * r + e); const size_t rr = ((size_t)b * NE + e) * CAP + sl;
#pragma unroll
                    for (int j = 0; j < 4; ++j) y[r][j] = *(const uint2*)(p.ye + rr * 1024 + (j * 64 + lane) * 4); }
                else {
#pragma unroll
                    for (int j = 0; j < 4; ++j) y[r][j] = uint2{0u, 0u}; } }
#pragma unroll
            for (int r = 0; r < 4; ++r)
#pragma unroll
                for (int j = 0; j < 4; ++j) { v[r][j].x += gt[r] * __uint_as_float(y[r][j].x << 16); v[r][j].y += gt[r] * __uint_as_float(y[r][j].x & 0xffff0000u); v[r][j].z += gt[r] * __uint_as_float(y[r][j].y << 16); v[r][j].w += gt[r] * __uint_as_float(y[r][j].y & 0xffff0000u); }
        }
#pragma unroll
        for (int r = 0; r < 4; ++r) { float ss = 0.f;
#pragma unroll
            for (int j = 0; j < 4; ++j) { ((float4*)(p.out + (row0 + r) * 1024))[j * 64 + lane] = v[r][j]; ss += v[r][j].x * v[r][j].x + v[r][j].y * v[r][j].y + v[r][j].z * v[r][j].z + v[r][j].w * v[r][j].w; }
            if (g) { ss = wave_sum(ss); const float rr = 1.0f / sqrtf(ss * (1.0f / 1024.0f) + 1e-6f);
#pragma unroll
                for (int j = 0; j < 4; ++j) { const int c4 = j * 64 + lane; const float4 gg = ((const float4*)g)[c4];
                    *(uint2*)(p.hn + (row0 + r) * 1024 + c4 * 4) = uint2{pack2(v[r][j].x * rr * gg.x, v[r][j].y * rr * gg.y), pack2(v[r][j].z * rr * gg.z, v[r][j].w * rr * gg.w)}; } } }
    }
}

namespace pg8 {
constexpr int BM = 256, BK = 64, HALF = 128, HTB = HALF * BK * 2  , STAGE_BYTES = 8 * HTB, NXCD = 8, WGM = 8;
DEV int lds_byte(int r, int c) { const int st = (r >> 4) * 2 + (c >> 5), rr = r & 15, cc = c & 31, ob = rr * 64 + cc * 2; return st * 1024 + (ob ^ (((ob >> 9) & 1) << 5)); }
DEV void stage_rc(int b, int& R, int& C) { const int st = b / 1024, sb = b % 1024, swz = sb ^ (((sb >> 9) & 1) << 5); R = (st >> 1) * 16 + swz / 64; C = (st & 1) * 32 + (swz % 64) / 2; }
DEV int perm32(int rho) { const int n = rho >> 4, i = rho & 15; return 8 * (i >> 2) + 4 * n + (i & 3); }
struct Unit { int row0, col0, brow0; };
struct StaticOrder {
    int nM, nN, nwg, G, c, brows, tpg, rev;
    DEV void init(int M, int N, int G_, int c_, int brows_, int tpg_, int rev_ = 0) { nM = M / BM; nN = N / BM; nwg = nM * nN; G = G_; c = c_; brows = brows_; tpg = tpg_; rev = rev_; }
    DEV bool next(int i, Unit& u) const {
        const int nr = (nwg + G - 1) / G; if (i >= nr) return false;
        const long L = (long)(rev ? nr - 1 - i : i) * G + c; if (L >= nwg) return false;
        int wgid = (int)L; { const int q = nwg / NXCD, r = nwg % NXCD, xcd = wgid % NXCD, off = wgid / NXCD; wgid = (xcd < r ? xcd * (q + 1) : r * (q + 1) + (xcd - r) * q) + off; }
        const int nig = WGM * nN, gid = wgid / nig, fm = gid * WGM, gsz = (nM - fm) < WGM ? (nM - fm) : WGM;
        const int pm = fm + ((wgid % nig) % gsz), pn = (wgid % nig) / gsz;
        u.row0 = pm * BM; u.col0 = pn * BM; u.brow0 = pn * BM + (brows ? ((pm / tpg) % NE) * brows : 0); return true;
    }
};
DEV unsigned cvt_pk_bf16(float lo, float hi) { unsigned r; asm volatile("v_cvt_pk_bf16_f32 %0, %1, %2" : "=v"(r) : "v"(lo), "v"(hi)); return r; }
typedef float f32x2_t __attribute__((ext_vector_type(2)));
typedef __bf16 bf16x2_t __attribute__((ext_vector_type(2)));
DEV unsigned cvt_pk_safe(float lo, float hi) { const f32x2_t v = {lo, hi}; return __builtin_bit_cast(unsigned, __builtin_convertvector(v, bf16x2_t)); }

template <class Epi, class Sched>
DEV void gemm_phase(LAS unsigned char* lds, const bf16_t* A, const bf16_t* Bt, const int K, const Sched& S, const Epi& E) {
    const int tid = threadIdx.x, wid = __builtin_amdgcn_readfirstlane(tid >> 6), lane = tid & 63, wr = wid >> 2, wc = wid & 3, fr = lane & 15, fq = lane >> 4;
    const int nt = K / BK;
    unsigned voffA[2], voffB[2];
#pragma unroll
    for (int i = 0; i < 2; ++i) { int R, C; stage_rc(tid * 16 + i * 8192, R, C); const int Rb = Epi::PERM ? ((R & ~31) + perm32(R & 31)) : R;
        voffA[i] = (unsigned)(R * K + C) * 2u; voffB[i] = (unsigned)(Rb * K + C) * 2u; }
    const size_t kstep = (size_t)(BK * 2);
    const size_t hstep = (size_t)HALF * K * 2;
    const size_t rstep = (size_t)K * 2;
    const unsigned ldsw = (unsigned)wid * 1024u;
    const int aoff = lds_byte(wr * 64 + fr, fq * 8), boff = lds_byte(wc * 32 + fr, fq * 8);
#define PG8_SA(b, h) (((b) * 2 + (h)) * HTB)
#define PG8_SB(b, h) ((4 + (b) * 2 + (h)) * HTB)
#define PG8_STAGE(bufoff, gbase, voff) do { _Pragma("unroll") for (int _i = 0; _i < 2; ++_i) \
        __builtin_amdgcn_global_load_lds((const unsigned*)((const char*)(gbase) + (voff)[_i]), (LAS unsigned*)(lds + (bufoff) + ldsw + _i * 8192), 16, 0, 0); } while (0)
#define PG8_LDA(dst, b, h) do { _Pragma("unroll") for (int m = 0; m < 4; ++m) _Pragma("unroll") for (int k = 0; k < 2; ++k) dst[m][k] = *(const LAS bf16x8*)(lds + PG8_SA(b, h) + aoff + m * 2048 + k * 1024); } while (0)
#define PG8_LDB(dst, b, h) do { _Pragma("unroll") for (int n = 0; n < 2; ++n) _Pragma("unroll") for (int k = 0; k < 2; ++k) dst[n][k] = *(const LAS bf16x8*)(lds + PG8_SB(b, h) + boff + n * 2048 + k * 1024); } while (0)
#define PG8_MMA(ai, bj, At, Bt_) do { __builtin_amdgcn_s_setprio(1); _Pragma("unroll") for (int m = 0; m < 4; ++m) _Pragma("unroll") for (int n = 0; n < 2; ++n) _Pragma("unroll") for (int k = 0; k < 2; ++k) \
        acc[ai][bj][m][n] = __builtin_amdgcn_mfma_f32_16x16x32_bf16(Bt_[n][k], At[m][k], acc[ai][bj][m][n], 0, 0, 0); __builtin_amdgcn_s_setprio(0); } while (0)
#define PG8_WAIT_V(n) asm volatile("s_waitcnt vmcnt(" #n ")" ::: "memory")
#define PG8_WAIT_L(n) asm volatile("s_waitcnt lgkmcnt(" #n ")" ::: "memory")
#define PG8_BAR __builtin_amdgcn_s_barrier()
#define PG8_SCHED __builtin_amdgcn_sched_barrier(0)
    Unit cur, nxt; int ui = 0;
    if (!S.next(0, cur)) return;
    f32x4 acc[2][2][4][2];
#pragma unroll
    for (int a = 0; a < 2; ++a)
#pragma unroll
        for (int b = 0; b < 2; ++b)
#pragma unroll
            for (int m = 0; m < 4; ++m)
#pragma unroll
                for (int n = 0; n < 2; ++n) acc[a][b][m][n] = (f32x4){0.f, 0.f, 0.f, 0.f};
    bf16x8 At[4][2], B0[2][2], B1[2][2];
    const char* cA = (const char*)A + (size_t)cur.row0 * rstep; const char* cB = (const char*)Bt + (size_t)cur.brow0 * rstep;
    PG8_STAGE(PG8_SB(0, 0), cB, voffB); PG8_STAGE(PG8_SA(0, 0), cA, voffA); PG8_STAGE(PG8_SB(0, 1), cB + hstep, voffB); PG8_STAGE(PG8_SA(0, 1), cA + hstep, voffA);
    if (wr == 1) PG8_BAR;
    PG8_WAIT_V(4); PG8_BAR;
    PG8_STAGE(PG8_SB(1, 0), cB + kstep, voffB); PG8_STAGE(PG8_SA(1, 0), cA + kstep, voffA); PG8_STAGE(PG8_SB(1, 1), cB + hstep + kstep, voffB);
    PG8_WAIT_V(6); PG8_BAR;
    for (;;) {
        const bool has_next = S.next(ui + 1, nxt);
        const char* nA = has_next ? (const char*)A + (size_t)nxt.row0 * rstep : cA; const char* nB = has_next ? (const char*)Bt + (size_t)nxt.brow0 * rstep : cB;
        for (int t = 0; t < nt; t += 2) {
            const bool last = (t == nt - 2);
            const char* a1 = cA + (size_t)(t + 1) * kstep;
            const char* a2 = last ? nA : cA + (size_t)(t + 2) * kstep; const char* b2 = last ? nB : cB + (size_t)(t + 2) * kstep;
            const char* a3 = a2 + kstep; const char* b3 = b2 + kstep;
            PG8_LDB(B0, 0, 0); PG8_SCHED; PG8_LDA(At, 0, 0); PG8_STAGE(PG8_SA(1, 1), a1 + hstep, voffA);
            PG8_WAIT_L(8); PG8_BAR; PG8_WAIT_L(0); PG8_MMA(0, 0, At, B0); PG8_BAR; PG8_SCHED;
            PG8_LDB(B1, 0, 1); PG8_STAGE(PG8_SB(0, 0), b2, voffB);
            PG8_BAR; PG8_WAIT_L(0); PG8_MMA(0, 1, At, B1); PG8_BAR;
            PG8_LDA(At, 0, 1); PG8_STAGE(PG8_SA(0, 0), a2, voffA);
            PG8_BAR; PG8_WAIT_L(0); PG8_MMA(1, 0, At, B0); PG8_BAR; PG8_SCHED;
            PG8_STAGE(PG8_SB(0, 1), b2 + hstep, voffB);
            PG8_WAIT_V(6); PG8_BAR; PG8_MMA(1, 1, At, B1); PG8_BAR;
            PG8_LDB(B0, 1, 0); PG8_SCHED; PG8_LDA(At, 1, 0); PG8_STAGE(PG8_SA(0, 1), a2 + hstep, voffA);
            PG8_WAIT_L(8); PG8_BAR; PG8_WAIT_L(0); PG8_MMA(0, 0, At, B0); PG8_BAR; PG8_SCHED;
            PG8_LDB(B1, 1, 1); PG8_STAGE(PG8_SB(1, 0), b3, voffB);
            PG8_BAR; PG8_WAIT_L(0); PG8_MMA(0, 1, At, B1); PG8_BAR;
            PG8_LDA(At, 1, 1); PG8_STAGE(PG8_SA(1, 0), a3, voffA);
            PG8_BAR; PG8_WAIT_L(0); PG8_MMA(1, 0, At, B0); PG8_BAR; PG8_SCHED;
            PG8_STAGE(PG8_SB(1, 1), b3 + hstep, voffB);
            PG8_WAIT_V(6); PG8_BAR; PG8_MMA(1, 1, At, B1); PG8_BAR;
        }
        E(acc, cur, wr, wc, fr, fq);
        if (!has_next) break;
#pragma unroll
        for (int a = 0; a < 2; ++a)
#pragma unroll
            for (int b = 0; b < 2; ++b)
#pragma unroll
                for (int m = 0; m < 4; ++m)
#pragma unroll
                    for (int n = 0; n < 2; ++n) acc[a][b][m][n] = (f32x4){0.f, 0.f, 0.f, 0.f};
        cur = nxt; cA = nA; cB = nB; ++ui;
    }
    PG8_WAIT_V(0);
    if (wr == 0) PG8_BAR;
    PG8_BAR;
#undef PG8_SA
#undef PG8_SB
#undef PG8_STAGE
#undef PG8_LDA
#undef PG8_LDB
#undef PG8_MMA
#undef PG8_WAIT_V
#undef PG8_WAIT_L
#undef PG8_BAR
#undef PG8_SCHED
}
template <class Epi, class Sched>
DEV void gemm_phase_gather(LAS unsigned char* lds, const bf16_t* A, const bf16_t* Bt, const int K, const Sched& S, const Epi& E, const int* idx, const int grp_rows, const int seq) {
    const int tid = threadIdx.x, wid = __builtin_amdgcn_readfirstlane(tid >> 6), lane = tid & 63, wr = wid >> 2, wc = wid & 3, fr = lane & 15, fq = lane >> 4;
    const int nt = K / BK;
    unsigned voffB[2]; int Ra[2]; unsigned Ca2[2];
#pragma unroll
    for (int i = 0; i < 2; ++i) { int R, C; stage_rc(tid * 16 + i * 8192, R, C); const int Rb = Epi::PERM ? ((R & ~31) + perm32(R & 31)) : R;
        Ra[i] = R; Ca2[i] = (unsigned)C * 2u; voffB[i] = (unsigned)(Rb * K + C) * 2u; }
    unsigned vAc[2][2], vAn[2][2];
#define PG8_IDXT(u) (STAGE_BYTES + 1024 * ((u) & 1))
#define PG8_SETVA(V, U, ui_) do { const LAS int* tab_ = (const LAS int*)(lds + PG8_IDXT(ui_)); const unsigned bo_ = (unsigned)((U).row0 / grp_rows) * (unsigned)seq; \
        _Pragma("unroll") for (int h_ = 0; h_ < 2; ++h_) _Pragma("unroll") for (int i_ = 0; i_ < 2; ++i_) V[h_][i_] = (bo_ + (unsigned)tab_[Ra[i_] + 128 * h_]) * (unsigned)(K * 2) + Ca2[i_]; } while (0)
    const size_t kstep = (size_t)(BK * 2);
    const size_t hstep = (size_t)HALF * K * 2;
    const size_t rstep = (size_t)K * 2;
    const unsigned ldsw = (unsigned)wid * 1024u;
    const int aoff = lds_byte(wr * 64 + fr, fq * 8), boff = lds_byte(wc * 32 + fr, fq * 8);
#define PG8_SA(b, h) (((b) * 2 + (h)) * HTB)
#define PG8_SB(b, h) ((4 + (b) * 2 + (h)) * HTB)
#define PG8_STAGE(bufoff, gbase, voff) do { _Pragma("unroll") for (int _i = 0; _i < 2; ++_i) \
        __builtin_amdgcn_global_load_lds((const unsigned*)((const char*)(gbase) + (voff)[_i]), (LAS unsigned*)(lds + (bufoff) + ldsw + _i * 8192), 16, 0, 0); } while (0)
#define PG8_LDA(dst, b, h) do { _Pragma("unroll") for (int m = 0; m < 4; ++m) _Pragma("unroll") for (int k = 0; k < 2; ++k) dst[m][k] = *(const LAS bf16x8*)(lds + PG8_SA(b, h) + aoff + m * 2048 + k * 1024); } while (0)
#define PG8_LDB(dst, b, h) do { _Pragma("unroll") for (int n = 0; n < 2; ++n) _Pragma("unroll") for (int k = 0; k < 2; ++k) dst[n][k] = *(const LAS bf16x8*)(lds + PG8_SB(b, h) + boff + n * 2048 + k * 1024); } while (0)
#define PG8_MMA(ai, bj, At, Bt_) do { __builtin_amdgcn_s_setprio(1); _Pragma("unroll") for (int m = 0; m < 4; ++m) _Pragma("unroll") for (int n = 0; n < 2; ++n) _Pragma("unroll") for (int k = 0; k < 2; ++k) \
        acc[ai][bj][m][n] = __builtin_amdgcn_mfma_f32_16x16x32_bf16(Bt_[n][k], At[m][k], acc[ai][bj][m][n], 0, 0, 0); __builtin_amdgcn_s_setprio(0); } while (0)
#define PG8_WAIT_V(n) asm volatile("s_waitcnt vmcnt(" #n ")" ::: "memory")
#define PG8_WAIT_L(n) asm volatile("s_waitcnt lgkmcnt(" #n ")" ::: "memory")
#define PG8_BAR __builtin_amdgcn_s_barrier()
#define PG8_SCHED __builtin_amdgcn_sched_barrier(0)
    Unit cur, nxt; int ui = 0;
    if (!S.next(0, cur)) return;
    f32x4 acc[2][2][4][2];
#pragma unroll
    for (int a = 0; a < 2; ++a)
#pragma unroll
        for (int b = 0; b < 2; ++b)
#pragma unroll
            for (int m = 0; m < 4; ++m)
#pragma unroll
                for (int n = 0; n < 2; ++n) acc[a][b][m][n] = (f32x4){0.f, 0.f, 0.f, 0.f};
    bf16x8 At[4][2], B0[2][2], B1[2][2];
    const char* cA = (const char*)A; const char* cB = (const char*)Bt + (size_t)cur.brow0 * rstep;
    if (wid == 0) __builtin_amdgcn_global_load_lds((const unsigned*)(idx + cur.row0 + lane * 4), (LAS unsigned*)(lds + PG8_IDXT(0)), 16, 0, 0);
    asm volatile("s_waitcnt vmcnt(0)" ::: "memory"); __syncthreads();
    PG8_SETVA(vAc, cur, 0);
    PG8_STAGE(PG8_SB(0, 0), cB, voffB); PG8_STAGE(PG8_SA(0, 0), cA, vAc[0]); PG8_STAGE(PG8_SB(0, 1), cB + hstep, voffB); PG8_STAGE(PG8_SA(0, 1), cA, vAc[1]);
    if (wr == 1) PG8_BAR;
    PG8_WAIT_V(4); PG8_BAR;
    PG8_STAGE(PG8_SB(1, 0), cB + kstep, voffB); PG8_STAGE(PG8_SA(1, 0), cA + kstep, vAc[0]); PG8_STAGE(PG8_SB(1, 1), cB + hstep + kstep, voffB);
    PG8_WAIT_V(6); PG8_BAR;
    for (;;) {
        const bool has_next = S.next(ui + 1, nxt);
        const char* nB = has_next ? (const char*)Bt + (size_t)nxt.brow0 * rstep : cB;
        if (has_next && wid == 0) __builtin_amdgcn_global_load_lds((const unsigned*)(idx + nxt.row0 + lane * 4), (LAS unsigned*)(lds + PG8_IDXT(ui + 1)), 16, 0, 0);
        for (int t = 0; t < nt; t += 2) {
            const bool last = (t == nt - 2);
            const char* a1 = cA + (size_t)(t + 1) * kstep;
            const char* a2 = last ? cA : cA + (size_t)(t + 2) * kstep; const char* b2 = last ? nB : cB + (size_t)(t + 2) * kstep;
            if (last) { if (has_next) PG8_SETVA(vAn, nxt, ui + 1); else { vAn[0][0] = vAc[0][0]; vAn[0][1] = vAc[0][1]; vAn[1][0] = vAc[1][0]; vAn[1][1] = vAc[1][1]; } }
            unsigned v2[2][2];
#pragma unroll
            for (int h_ = 0; h_ < 2; ++h_)
#pragma unroll
                for (int i_ = 0; i_ < 2; ++i_) v2[h_][i_] = last ? vAn[h_][i_] : vAc[h_][i_];
            const char* a3 = a2 + kstep; const char* b3 = b2 + kstep;
            PG8_LDB(B0, 0, 0); PG8_SCHED; PG8_LDA(At, 0, 0); PG8_STAGE(PG8_SA(1, 1), a1, vAc[1]);
            PG8_WAIT_L(8); PG8_BAR; PG8_WAIT_L(0); PG8_MMA(0, 0, At, B0); PG8_BAR; PG8_SCHED;
            PG8_LDB(B1, 0, 1); PG8_STAGE(PG8_SB(0, 0), b2, voffB);
            PG8_BAR; PG8_WAIT_L(0); PG8_MMA(0, 1, At, B1); PG8_BAR;
            PG8_LDA(At, 0, 1); PG8_STAGE(PG8_SA(0, 0), a2, v2[0]);
            PG8_BAR; PG8_WAIT_L(0); PG8_MMA(1, 0, At, B0); PG8_BAR; PG8_SCHED;
            PG8_STAGE(PG8_SB(0, 1), b2 + hstep, voffB);
            PG8_WAIT_V(6); PG8_BAR; PG8_MMA(1, 1, At, B1); PG8_BAR;
            PG8_LDB(B0, 1, 0); PG8_SCHED; PG8_LDA(At, 1, 0); PG8_STAGE(PG8_SA(0, 1), a2, v2[1]);
            PG8_WAIT_L(8); PG8_BAR; PG8_WAIT_L(0); PG8_MMA(0, 0, At, B0); PG8_BAR; PG8_SCHED;
            PG8_LDB(B1, 1, 1); PG8_STAGE(PG8_SB(1, 0), b3, voffB);
            PG8_BAR; PG8_WAIT_L(0); PG8_MMA(0, 1, At, B1); PG8_BAR;
            PG8_LDA(At, 1, 1); PG8_STAGE(PG8_SA(1, 0), a3, v2[0]);
            PG8_BAR; PG8_WAIT_L(0); PG8_MMA(1, 0, At, B0); PG8_BAR; PG8_SCHED;
            PG8_STAGE(PG8_SB(1, 1), b3 + hstep, voffB);
            PG8_WAIT_V(6); PG8_BAR; PG8_MMA(1, 1, At, B1); PG8_BAR;
        }
        E(acc, cur, wr, wc, fr, fq);
        if (!has_next) break;
#pragma unroll
        for (int a = 0; a < 2; ++a)
#pragma unroll
            for (int b = 0; b < 2; ++b)
#pragma unroll
                for (int m = 0; m < 4; ++m)
#pragma unroll
                    for (int n = 0; n < 2; ++n) acc[a][b][m][n] = (f32x4){0.f, 0.f, 0.f, 0.f};
        cur = nxt; cB = nB; ++ui; vAc[0][0] = vAn[0][0]; vAc[0][1] = vAn[0][1]; vAc[1][0] = vAn[1][0]; vAc[1][1] = vAn[1][1];
    }
    PG8_WAIT_V(0);
    if (wr == 0) PG8_BAR;
    PG8_BAR;
#undef PG8_IDXT
#undef PG8_SETVA
#undef PG8_SA
#undef PG8_SB
#undef PG8_STAGE
#undef PG8_LDA
#undef PG8_LDB
#undef PG8_MMA
#undef PG8_WAIT_V
#undef PG8_WAIT_L
#undef PG8_BAR
#undef PG8_SCHED
}
typedef const f32x4 (&AccRef)[2][2][4][2];
DEV u32x4 pk8(const f32x4 a, const f32x4 b) { u32x4 w; w.x = cvt_pk_bf16(a[0], a[1]); w.y = cvt_pk_bf16(a[2], a[3]); w.z = cvt_pk_bf16(b[0], b[1]); w.w = cvt_pk_bf16(b[2], b[3]); return w; }
DEV f32x4 silu4(const f32x4 v) { f32x4 r;
#pragma unroll
    for (int i = 0; i < 4; ++i) r[i] = v[i] * __builtin_amdgcn_rcpf(1.0f + __expf(-v[i]));
    return r; }
struct EpiG1 { static constexpr bool PERM = true; bf16_t *qkv, *z, *xbcraw; float* dtraw;
    DEV void operator()(AccRef acc, const Unit& u, int wr, int wc, int fr, int fq) const {
        const int ct = u.col0, rbase = u.row0 + wr * 64 + fr;
        if (ct < 5632) {
            bf16_t* base; int ld, cc;
            if (ct < 3072) { base = qkv; ld = 3072; cc = ct; } else if (ct < 4096) { base = z; ld = 1024; cc = ct - 3072; } else { base = xbcraw; ld = 1536; cc = ct - 4096; }
            const int col = cc + wc * 32 + 8 * fq;
#pragma unroll
            for (int ai = 0; ai < 2; ++ai)
#pragma unroll
                for (int m = 0; m < 4; ++m) { bf16_t* rowp = base + (size_t)(rbase + ai * HALF + m * 16) * ld + col;
#pragma unroll
                    for (int bj = 0; bj < 2; ++bj) *(u32x4*)(rowp + bj * HALF) = pk8(acc[ai][bj][m][0], acc[ai][bj][m][1]); }
        } else if (wc == 0) {
#pragma unroll
            for (int ai = 0; ai < 2; ++ai)
#pragma unroll
                for (int m = 0; m < 4; ++m) { float* rowp = dtraw + (size_t)(rbase + ai * HALF + m * 16) * 32 + 8 * fq; *(f32x4*)rowp = acc[ai][0][m][0]; *(f32x4*)(rowp + 4) = acc[ai][0][m][1]; }
        }
    } };
struct EpiResF32 { static constexpr bool PERM = false; float* out; const float* resid;
    DEV void operator()(AccRef acc, const Unit& u, int wr, int wc, int fr, int fq) const {
        const int rbase = u.row0 + wr * 64 + fr, col = u.col0 + wc * 32 + 4 * fq;
#pragma unroll
        for (int ai = 0; ai < 2; ++ai)
#pragma unroll
            for (int m = 0; m < 4; ++m) { const size_t ro = (size_t)(rbase + ai * HALF + m * 16) * 1024 + col;
#pragma unroll
                for (int bj = 0; bj < 2; ++bj)
#pragma unroll
                    for (int n = 0; n < 2; ++n) *(f32x4*)(out + ro + bj * HALF + n * 16) = *(const f32x4*)(resid + ro + bj * HALF + n * 16) + acc[ai][bj][m][n]; }
    } };
struct EpiSwiglu { static constexpr bool PERM = true; bf16_t* hid;
    DEV void operator()(AccRef acc, const Unit& u, int wr, int wc, int fr, int fq) const {
        const int rbase = u.row0 + wr * 64 + fr, col = (u.col0 >> 1) + wc * 32 + 8 * fq;
#pragma unroll
        for (int ai = 0; ai < 2; ++ai)
#pragma unroll
            for (int m = 0; m < 4; ++m) *(u32x4*)(hid + (size_t)(rbase + ai * HALF + m * 16) * 2048 + col) = pk8(silu4(acc[ai][0][m][0]) * acc[ai][1][m][0], silu4(acc[ai][0][m][1]) * acc[ai][1][m][1]);
    } };
struct EpiBf16Plain { static constexpr bool PERM = true; bf16_t* O; int ld;
    DEV void operator()(AccRef acc, const Unit& u, int wr, int wc, int fr, int fq) const {
        const int rbase = u.row0 + wr * 64 + fr, col = u.col0 + wc * 32 + 8 * fq;
#pragma unroll
        for (int ai = 0; ai < 2; ++ai)
#pragma unroll
            for (int m = 0; m < 4; ++m) { bf16_t* rowp = O + (size_t)(rbase + ai * HALF + m * 16) * ld + col;
#pragma unroll
                for (int bj = 0; bj < 2; ++bj) *(u32x4*)(rowp + bj * HALF) = pk8(acc[ai][bj][m][0], acc[ai][bj][m][1]); }
    } };
struct EpiG3 { static constexpr bool PERM = true; bf16_t *pbuf, *gb;
    DEV void operator()(AccRef acc, const Unit& u, int wr, int wc, int fr, int fq) const {
        const int rbase = u.row0 + wr * 64 + fr;
        if (u.col0 < 2048) { const int col = (u.col0 >> 1) + wc * 32 + 8 * fq;
#pragma unroll
            for (int ai = 0; ai < 2; ++ai)
#pragma unroll
                for (int m = 0; m < 4; ++m) *(u32x4*)(pbuf + (size_t)(rbase + ai * HALF + m * 16) * 1024 + col) = pk8(acc[ai][0][m][0] * acc[ai][1][m][0], acc[ai][0][m][1] * acc[ai][1][m][1]);
        } else { const int col = u.col0 - 2048 + wc * 32 + 8 * fq;
#pragma unroll
            for (int ai = 0; ai < 2; ++ai)
#pragma unroll
                for (int m = 0; m < 4; ++m) { bf16_t* rowp = gb + (size_t)(rbase + ai * HALF + m * 16) * 1024 + col;
#pragma unroll
                    for (int bj = 0; bj < 2; ++bj) *(u32x4*)(rowp + bj * HALF) = pk8(acc[ai][bj][m][0], acc[ai][bj][m][1]); }
        }
    } };
}
DEV void ph_g1(const P& p, LAS unsigned char* lds) { pg8::StaticOrder S; S.init(T, NIN_PAD, (int)gridDim.x, (int)blockIdx.x, 0, 1); pg8::EpiG1 E{p.qkv, p.z, p.xbcraw, p.dtraw}; pg8::gemm_phase(lds, p.hn, p.WinT, 1024, S, E); }
DEV void ph_g2(const P& p, LAS unsigned char* lds) { pg8::StaticOrder S; S.init(T, 1024, (int)gridDim.x, (int)blockIdx.x, 0, 1); pg8::EpiResF32 E{p.out, p.x}; pg8::gemm_phase(lds, p.mix, p.WoutT, 2048, S, E); }
DEV void ph_up(const P& p, LAS unsigned char* lds) { pg8::StaticOrder S; S.init(NSLOT, 4096, (int)gridDim.x, (int)blockIdx.x, 4096, CAP / 256); pg8::EpiSwiglu E{p.hid}; pg8::gemm_phase_gather(lds, p.hn, p.WguT, 1024, S, E, p.idx, NE * CAP, SEQ); }
DEV void ph_down(const P& p, LAS unsigned char* lds) { pg8::StaticOrder S; S.init(NSLOT, 1024, (int)gridDim.x, (int)blockIdx.x, 1024, CAP / 256, (NSLOT / 256 * 4) % (int)gridDim.x == 0); pg8::EpiBf16Plain E{p.ye, 1024}; pg8::gemm_phase(lds, p.hid, p.WdT, 2048, S, E); }
DEV void ph_g3(const P& p, LAS unsigned char* lds) { pg8::StaticOrder S; S.init(T, 3072, (int)gridDim.x, (int)blockIdx.x, 0, 1); pg8::EpiG3 E{p.pbuf, p.gb}; pg8::gemm_phase(lds, p.hn, p.WciT, 1024, S, E); }
DEV void ph_g4(const P& p, LAS unsigned char* lds) { pg8::StaticOrder S; S.init(T, 1024, (int)gridDim.x, (int)blockIdx.x, 0, 1); pg8::EpiResF32 E{p.out, p.out}; pg8::gemm_phase(lds, p.abuf, p.WcoT, 1024, S, E); }

DEV bf16x8 ldg8(const bf16_t* p) { return *(const bf16x8*)p; }
DEV f32x4 mfma16(bf16x8 a, bf16x8 b, f32x4 c) { return __builtin_amdgcn_mfma_f32_16x16x32_bf16(a, b, c, 0, 0, 0); }
DEV bf16x8 pack8(const float (&m)[8]) { u32x4 r; r.x = pg8::cvt_pk_safe(m[0], m[1]); r.y = pg8::cvt_pk_safe(m[2], m[3]); r.z = pg8::cvt_pk_safe(m[4], m[5]); r.w = pg8::cvt_pk_safe(m[6], m[7]); return __builtin_bit_cast(bf16x8, r); }
DEV void unpack8(bf16x8 v, float (&f)[8]) { const u32x4 u = __builtin_bit_cast(u32x4, v);
#pragma unroll
    for (int q = 0; q < 4; ++q) { f[2 * q] = __uint_as_float(u[q] << 16); f[2 * q + 1] = __uint_as_float(u[q] & 0xffff0000u); } }
typedef unsigned u32x2 __attribute__((ext_vector_type(2)));
DEV u32x2 pk4(const f32x4 a) { u32x2 r; r.x = pg8::cvt_pk_safe(a[0], a[1]); r.y = pg8::cvt_pk_safe(a[2], a[3]); return r; }
DEV void ph_ssd_states(const P& p) {
    const int wid = threadIdx.x >> 6, lane = threadIdx.x & 63, fr = lane & 15, fq = lane >> 4;
    for (int it = blockIdx.x * 8 + wid; it < BATCH * NCHUNK * 32; it += gridDim.x * 8) {
        const int dir = it & 1, h = (it >> 1) & 15, c = (it >> 5) % NCHUNK, b = (it >> 5) / NCHUNK, g = h >> 3, j = dir * 16 + h;
        const bf16_t* xT = p.xsT + ((size_t)b * 1024 + h * 64 + fr) * SEQ + c * 128 + 8 * fq;
        const bf16_t* bT = p.bmT + ((size_t)b * 256 + g * 128 + fr) * SEQ + c * 128 + 8 * fq;
        const float* w = p.wdT + ((size_t)b * 32 + j) * SEQ + c * 128 + 8 * fq;
        f32x4 acc[8][4];
#pragma unroll
        for (int nb = 0; nb < 8; ++nb)
#pragma unroll
            for (int pb = 0; pb < 4; ++pb) acc[nb][pb] = (f32x4){0.f, 0.f, 0.f, 0.f};
#pragma unroll 1
        for (int ks = 0; ks < 4; ++ks) {
            const f32x4 w0 = *(const f32x4*)(w + 32 * ks), w1 = *(const f32x4*)(w + 32 * ks + 4);
            bf16x8 xf[4];
#pragma unroll
            for (int pb = 0; pb < 4; ++pb) { float f[8]; unpack8(ldg8(xT + (size_t)pb * 16 * SEQ + 32 * ks), f);
#pragma unroll
                for (int q = 0; q < 4; ++q) { f[q] *= w0[q]; f[4 + q] *= w1[q]; }
                xf[pb] = pack8(f); }
#pragma unroll
            for (int nb = 0; nb < 8; ++nb) { const bf16x8 bfv = ldg8(bT + (size_t)nb * 16 * SEQ + 32 * ks);
#pragma unroll
                for (int pb = 0; pb < 4; ++pb) acc[nb][pb] = mfma16(bfv, xf[pb], acc[nb][pb]); }
        }
        bf16_t* st = p.states + ((((size_t)b * 2 + dir) * NCHUNK + c) * 16 + h) * 8192;
#pragma unroll
        for (int nb = 0; nb < 8; ++nb)
#pragma unroll
            for (int pb = 0; pb < 4; ++pb) *(u32x2*)(st + (16 * pb + fr) * 128 + 16 * nb + 4 * fq) = pk4(acc[nb][pb]);
    }
}
DEV void ph_ssd_scan(const P& p) {
    for (size_t i = GTID; i < (size_t)BATCH * 2 * 16 * 64 * 32; i += GSTRIDE) {
        const int n4 = (int)(i & 31), pp = (int)((i >> 5) & 63), h = (int)((i >> 11) & 15), dir = (int)((i >> 15) & 1), b = (int)(i >> 16);
        bf16_t* base = p.states + (((size_t)b * 2 + dir) * NCHUNK * 16 + h) * 8192 + pp * 128 + n4 * 4;
        const float* dec = p.cdec + ((size_t)b * 32 + dir * 16 + h) * NCHUNK;
        float r0 = 0.f, r1 = 0.f, r2 = 0.f, r3 = 0.f;
#pragma unroll 16
        for (int cc = 0; cc < NCHUNK; ++cc) { const int c = dir ? NCHUNK - 1 - cc : cc; uint2* q = (uint2*)(base + (size_t)c * 16 * 8192); const uint2 v = *q; const float d = dec[c];
            *q = uint2{pg8::cvt_pk_safe(r0, r1), pg8::cvt_pk_safe(r2, r3)};
            r0 = r0 * d + __uint_as_float(v.x << 16); r1 = r1 * d + __uint_as_float(v.x & 0xffff0000u); r2 = r2 * d + __uint_as_float(v.y << 16); r3 = r3 * d + __uint_as_float(v.y & 0xffff0000u); }
    }
}
constexpr int GLD = 136;
DEV void ph_ssd_out(const P& p, LAS unsigned char* lds) {
    const int wid = threadIdx.x >> 6, lane = threadIdx.x & 63, fr = lane & 15, fq = lane >> 4;
    LAS bf16_t* Gl = (LAS bf16_t*)lds;
    LAS float* vec = (LAS float*)(lds + 64 * GLD * 2) + wid * 512;
    for (int u = blockIdx.x; u < BATCH * NCHUNK * 4; u += gridDim.x) {
        const int lh = u & 1, g = (u >> 1) & 1, c = (u >> 2) % NCHUNK, b = (u >> 2) / NCHUNK, h = 8 * g + wid, l0 = 64 * lh; const size_t row0 = (size_t)b * SEQ + (size_t)c * 128;
        const bf16_t* bmrow = p.bc + (row0 + 16 * wid + fr) * 512 + g * 128 + 8 * fq;
        const bf16_t* cmrow = p.bc + (row0 + l0 + fr) * 512 + 256 + g * 128 + 8 * fq;
        f32x4 ag[4];
#pragma unroll
        for (int lb = 0; lb < 4; ++lb) ag[lb] = (f32x4){0.f, 0.f, 0.f, 0.f};
#pragma unroll
        for (int ks = 0; ks < 4; ++ks) { const bf16x8 a = ldg8(bmrow + 32 * ks);
#pragma unroll
            for (int lb = 0; lb < 4; ++lb) ag[lb] = mfma16(a, ldg8(cmrow + (size_t)lb * 16 * 512 + 32 * ks), ag[lb]); }
        __syncthreads();
#pragma unroll
        for (int lb = 0; lb < 4; ++lb) *(LAS u32x2*)(Gl + (16 * lb + fr) * GLD + 16 * wid + 4 * fq) = pk4(ag[lb]);
#pragma unroll
        for (int q = 0; q < 2; ++q) { const int s = lane + 64 * q; const size_t o = ((size_t)b * 32 + h) * SEQ + c * 128 + s;
            vec[s] = p.csT[o]; vec[128 + s] = p.csT[o + (size_t)16 * SEQ]; vec[256 + s] = p.stT[o]; vec[384 + s] = p.stT[o + (size_t)16 * SEQ]; }
        __syncthreads();
        f32x4 acc[4][4];
#pragma unroll
        for (int pb = 0; pb < 4; ++pb)
#pragma unroll
            for (int lb = 0; lb < 4; ++lb) acc[pb][lb] = (f32x4){0.f, 0.f, 0.f, 0.f};
        float csfl[4], cbl[4];
#pragma unroll
        for (int lb = 0; lb < 4; ++lb) { csfl[lb] = vec[l0 + 16 * lb + fr]; cbl[lb] = vec[128 + l0 + 16 * lb + fr]; }
        const bf16_t* xT = p.xsT + ((size_t)b * 1024 + h * 64 + fr) * SEQ + c * 128 + 8 * fq;
        const float Dh = p.ssd_d[h];
#pragma unroll 1
        for (int ks = 0; ks < 4; ++ks) {
            const int s0 = 32 * ks + 8 * fq;
            bf16x8 xf[4];
#pragma unroll
            for (int pb = 0; pb < 4; ++pb) xf[pb] = ldg8(xT + (size_t)pb * 16 * SEQ + 32 * ks);
            float cs_s[8], cb_s[8], df[8], db[8];
#pragma unroll
            for (int j = 0; j < 8; ++j) { cs_s[j] = vec[s0 + j]; cb_s[j] = vec[128 + s0 + j]; df[j] = vec[256 + s0 + j]; db[j] = vec[384 + s0 + j]; }
#pragma unroll
            for (int lb = 0; lb < 4; ++lb) {
                const int l = l0 + 16 * lb + fr;
                float gf[8], m[8]; unpack8(*(const LAS bf16x8*)(Gl + (16 * lb + fr) * GLD + s0), gf);
#pragma unroll
                for (int j = 0; j < 8; ++j) { const int s = s0 + j;
                    const float wf = s <= l ? df[j] * __expf(fminf(csfl[lb] - cs_s[j], 0.f)) : 0.f, wb = s >= l ? db[j] * __expf(fminf(cbl[lb] - cb_s[j], 0.f)) : 0.f;
                    m[j] = gf[j] * (wf + wb) + (s == l ? Dh : 0.f); }
                const bf16x8 mf = pack8(m);
#pragma unroll
                for (int pb = 0; pb < 4; ++pb) acc[pb][lb] = mfma16(xf[pb], mf, acc[pb][lb]);
            }
        }
#pragma unroll
        for (int dir = 0; dir < 2; ++dir) {
            const bf16_t* pv = p.states + ((((size_t)b * 2 + dir) * NCHUNK + c) * 16 + h) * 8192 + fr * 128 + 8 * fq;
            float sc[4];
#pragma unroll
            for (int lb = 0; lb < 4; ++lb) sc[lb] = __expf(dir ? cbl[lb] : csfl[lb]);
#pragma unroll 1
            for (int ks = 0; ks < 4; ++ks) {
                bf16x8 pf[4];
#pragma unroll
                for (int pb = 0; pb < 4; ++pb) pf[pb] = ldg8(pv + pb * 2048 + 32 * ks);
#pragma unroll
                for (int lb = 0; lb < 4; ++lb) { float f[8]; unpack8(ldg8(cmrow + (size_t)lb * 16 * 512 + 32 * ks), f);
#pragma unroll
                    for (int j = 0; j < 8; ++j) f[j] *= sc[lb];
                    const bf16x8 cf = pack8(f);
#pragma unroll
                    for (int pb = 0; pb < 4; ++pb) acc[pb][lb] = mfma16(pf[pb], cf, acc[pb][lb]); }
            }
        }
#pragma unroll
        for (int pb = 0; pb < 4; ++pb)
#pragma unroll
            for (int lb = 0; lb < 4; ++lb) *(u32x2*)(p.yssd + (row0 + l0 + 16 * lb + fr) * 1024 + h * 64 + 16 * pb + 4 * fq) = pk4(acc[pb][lb]);
    }
}

DEV void ph_norm_router_mfma(const P& p, int layer, LAS unsigned char* lds) {
    const float* g = p.ffn_norm + (size_t)layer * 1024; const float* rw = p.router_w + (size_t)layer * 1024 * 16;
    const int tid = threadIdx.x, wid = tid >> 6, lane = tid & 63, fr = lane & 15, fq = lane >> 4;
    __syncthreads();
    for (int f = tid; f < 2048; f += 512) { const int ks = f >> 6, ln = f & 63, e = ln & 15, kb = 32 * ks + 8 * (ln >> 4);
        float hi[8], lo[8];
#pragma unroll
        for (int j = 0; j < 8; ++j) { const float w = g[kb + j] * rw[(size_t)(kb + j) * 16 + e]; const float h = bf2f(f2bf(w)); hi[j] = h; lo[j] = w - h; }
        *(LAS bf16x8*)(lds + (size_t)f * 16) = pack8(hi); *(LAS bf16x8*)(lds + 32768 + (size_t)f * 16) = pack8(lo); }
    __syncthreads();
    for (size_t row0 = ((size_t)blockIdx.x * 8 + wid) * 16; row0 < (size_t)T; row0 += (size_t)gridDim.x * 128) {
        const float* xr = p.out + (row0 + fr) * 1024 + 8 * fq;
        f32x4 acc = (f32x4){0.f, 0.f, 0.f, 0.f}; float ss = 0.f;
#pragma unroll 4
        for (int ks = 0; ks < 32; ++ks) {
            const float4 a = *(const float4*)(xr + 32 * ks), b = *(const float4*)(xr + 32 * ks + 4);
            const float x[8] = {a.x, a.y, a.z, a.w, b.x, b.y, b.z, b.w}; float lo[8];
#pragma unroll
            for (int j = 0; j < 8; ++j) ss += x[j] * x[j];
            const bf16x8 xh = pack8(x); float xhf[8]; unpack8(xh, xhf);
#pragma unroll
            for (int j = 0; j < 8; ++j) lo[j] = x[j] - xhf[j];
            const bf16x8 xl = pack8(lo);
            const bf16x8 wh = *(const LAS bf16x8*)(lds + (size_t)(ks * 64 + lane) * 16), wl = *(const LAS bf16x8*)(lds + 32768 + (size_t)(ks * 64 + lane) * 16);
            acc = mfma16(xh, wh, acc); acc = mfma16(xl, wh, acc); acc = mfma16(xh, wl, acc);
        }
        ss += __shfl_xor(ss, 16); ss += __shfl_xor(ss, 32);
        const float rinv = 1.0f / sqrtf(ss * (1.0f / 1024.0f) + 1e-6f);
        float lg[4];
#pragma unroll
        for (int i = 0; i < 4; ++i) { lg[i] = acc[i] * __shfl(rinv, 4 * fq + i);
            float mx = lg[i]; mx = fmaxf(mx, __shfl_xor(mx, 1)); mx = fmaxf(mx, __shfl_xor(mx, 2)); mx = fmaxf(mx, __shfl_xor(mx, 4)); mx = fmaxf(mx, __shfl_xor(mx, 8));
            const float ex = expf(lg[i] - mx); float den = ex; den += __shfl_xor(den, 1); den += __shfl_xor(den, 2); den += __shfl_xor(den, 4); den += __shfl_xor(den, 8);
            lg[i] = ex / den; }
        { const size_t r4 = row0 + 4 * fq; const int b = (int)(r4 / SEQ), s = (int)(r4 % SEQ); *(float4*)(p.aff + ((size_t)b * NE + fr) * SEQ + s) = float4{lg[0], lg[1], lg[2], lg[3]}; }
#pragma unroll 4
        for (int ks = 0; ks < 32; ++ks) {
            const float4 a = *(const float4*)(xr + 32 * ks), b = *(const float4*)(xr + 32 * ks + 4); const float4 ga = *(const float4*)(g + 32 * ks + 8 * fq), gb = *(const float4*)(g + 32 * ks + 8 * fq + 4);
            const float y[8] = {a.x * rinv * ga.x, a.y * rinv * ga.y, a.z * rinv * ga.z, a.w * rinv * ga.w, b.x * rinv * gb.x, b.y * rinv * gb.y, b.z * rinv * gb.z, b.w * rinv * gb.w};
            *(bf16x8*)(p.hn + (row0 + fr) * 1024 + 32 * ks + 8 * fq) = pack8(y);
        }
    }
    __syncthreads();
}

DEV void cvx_src(const P& p, int layer, int id, int seg, const float*& src, int& ld, int& k0) {
    const int e = id / 384, r = id % 384; const size_t off = ((size_t)layer * NE + e) * 1024 * 2048;
    if (r < 256) { const int pn = r >> 4, kt = r & 15; src = (seg ? p.wu : p.wg) + off + 128 * pn; ld = 2048; k0 = 64 * kt; }
    else { const int r2 = r - 256, nt = r2 >> 5, kt = r2 & 31; src = p.wd + off + 256 * nt + 128 * seg; ld = 1024; k0 = 64 * kt; }
}
DEV void ph_convert_experts_dev(const P& p, int layer, LAS unsigned char* lds) {
    LAS unsigned* tl = (LAS unsigned*)lds;
    const int tid = threadIdx.x, n4 = tid & 31, seg = (tid >> 5) & 1, kp = tid >> 6;
    const int rrow = tid >> 1, rhalf = tid & 1, rseg = rrow >> 7, rq = (rrow >> 5) & 3, rn4 = rrow & 31;
    constexpr int NTILE = NE * 384;
    float4 cur[8], nxt[8];
#define CVX_LOAD(ID, DST) do { const float* s_; int ld_, k0_; cvx_src(p, layer, (ID), seg, s_, ld_, k0_); \
        _Pragma("unroll") for (int i = 0; i < 4; ++i) { const size_t ro = (size_t)(k0_ + 2 * (kp + 8 * i)) * ld_ + 4 * n4; DST[2 * i] = *(const float4*)(s_ + ro); DST[2 * i + 1] = *(const float4*)(s_ + ro + ld_); } } while (0)
    int id = blockIdx.x;
    if (id < NTILE) CVX_LOAD(id, cur);
    for (; id < NTILE; id += gridDim.x) {
        const int nid = id + gridDim.x;
        if (nid < NTILE) CVX_LOAD(nid, nxt);
        __syncthreads();
#pragma unroll
        for (int i = 0; i < 4; ++i) { const float4 a = cur[2 * i], b = cur[2 * i + 1]; const int kd = kp + 8 * i; const int rb = seg * 128 + n4;
            tl[(rb) * 33 + kd] = pack2(a.x, b.x); tl[(rb + 32) * 33 + kd] = pack2(a.y, b.y); tl[(rb + 64) * 33 + kd] = pack2(a.z, b.z); tl[(rb + 96) * 33 + kd] = pack2(a.w, b.w); }
        __syncthreads();
        { const int e = id / 384, r = id % 384; bf16_t* d; int K, n0, k0;
          if (r < 256) { d = p.WguT + (size_t)e * 4096 * 1024; K = 1024; n0 = 256 * (r >> 4); k0 = 64 * (r & 15); } else { const int r2 = r - 256; d = p.WdT + (size_t)e * 1024 * 2048; K = 2048; n0 = 256 * (r2 >> 5); k0 = 64 * (r2 & 31); }
          unsigned w[16];
#pragma unroll
          for (int i = 0; i < 16; ++i) w[i] = tl[rrow * 33 + 16 * rhalf + i];
          bf16_t* dp = d + (size_t)(n0 + rseg * 128 + 4 * rn4 + rq) * K + k0 + 32 * rhalf;
#pragma unroll
          for (int q = 0; q < 4; ++q) *(uint4*)(dp + 8 * q) = uint4{w[4 * q], w[4 * q + 1], w[4 * q + 2], w[4 * q + 3]}; }
#pragma unroll
        for (int i = 0; i < 8; ++i) cur[i] = nxt[i];
    }
#undef CVX_LOAD
    __syncthreads();
}

constexpr int CTLD = 136;
DEV void ph_prep_dev(const P& p, LAS unsigned char* lds) {
    for (size_t i0 = GTID; i0 + 3 * GSTRIDE < (size_t)T * 256; i0 += GSTRIDE * 4) {
        u32x4 raw[4];
#pragma unroll
        for (int q = 0; q < 4; ++q) { const size_t i = i0 + q * GSTRIDE; const size_t hrow = i >> 3; const size_t t = hrow >> 5; const int hh = (int)(hrow & 31);
            raw[q] = *(const u32x4*)(p.qkv + t * 3072 + (hh >> 4) * 1024 + (hh & 15) * 64 + (int)(i & 7) * 8); }
#pragma unroll
        for (int q = 0; q < 4; ++q) { const size_t i = i0 + q * GSTRIDE;
            const int sub = (int)(i & 7); const size_t hrow = i >> 3; const size_t t = hrow >> 5; const int hh = (int)(hrow & 31), isk = hh >> 4, h = hh & 15, pos = (int)(t % SEQ);
            bf16_t* ptr = p.qkv + t * 3072 + isk * 1024 + h * 64 + sub * 8; const float* gn = (isk ? p.k_norm : p.q_norm) + sub * 8;
            float f[8]; float ss = 0.f;
#pragma unroll
            for (int j = 0; j < 4; ++j) { f[2 * j] = __uint_as_float(raw[q][j] << 16); f[2 * j + 1] = __uint_as_float(raw[q][j] & 0xffff0000u); }
#pragma unroll
            for (int j = 0; j < 8; ++j) ss += f[j] * f[j];
            ss += __shfl_xor(ss, 1); ss += __shfl_xor(ss, 2); ss += __shfl_xor(ss, 4);
            const float r = 1.0f / sqrtf(ss * (1.0f / 64.0f) + 1e-6f);
            const float4 c0 = *(const float4*)(p.rope + (size_t)pos * 16), c1 = *(const float4*)(p.rope + (size_t)pos * 16 + 4), s0 = *(const float4*)(p.rope + (size_t)pos * 16 + 8), s1 = *(const float4*)(p.rope + (size_t)pos * 16 + 12);
            const float cs[8] = {c0.x, c0.y, c0.z, c0.w, c1.x, c1.y, c1.z, c1.w}, sn[8] = {s0.x, s0.y, s0.z, s0.w, s1.x, s1.y, s1.z, s1.w};
#pragma unroll
            for (int j = 0; j < 8; ++j) { f[j] = f[j] * r * gn[j]; const float other = __shfl_xor(f[j], 1);
                f[j] = sub == 0 ? f[j] * cs[j] - other * sn[j] : (sub == 1 ? f[j] * cs[j] + other * sn[j] : f[j]); }
            st8(ptr, f); }
    }
    {
        LAS bf16_t* tl = (LAS bf16_t*)lds;
        const int tid = threadIdx.x, c8 = tid & 7, trw = tid >> 3;
        constexpr int NTILE = (T / 128) * 24;
        u32x4 rw[2][5], rwn[2][5];
#define PREP_LOAD(TILE, DST) do { const int ct_ = (TILE) % 24, tt_ = (TILE) / 24, c0_ = ct_ * 64; const size_t t0_ = (size_t)tt_ * 128; const int pos0_ = (int)(t0_ % SEQ); \
            _Pragma("unroll") for (int half = 0; half < 2; ++half) { const int tloc = trw + 64 * half, pos = pos0_ + tloc; const size_t t = t0_ + tloc; \
                _Pragma("unroll") for (int k = 0; k < 5; ++k) { const int pp = pos + k - 2; DST[half][k] = (pp < 0 || pp >= SEQ) ? (u32x4){0u, 0u, 0u, 0u} : *(const u32x4*)(p.xbcraw + (t + k - 2) * 1536 + c0_ + c8 * 8); } } } while (0)
        int tile = blockIdx.x;
        if (tile < NTILE) PREP_LOAD(tile, rw);
        for (; tile < NTILE; tile += gridDim.x) {
            const int ntile = tile + gridDim.x;
            if (ntile < NTILE) PREP_LOAD(ntile, rwn);
            const int ct = tile % 24, tt = tile / 24, c0 = ct * 64; const size_t t0 = (size_t)tt * 128; const int b = (int)(t0 / SEQ), pos0 = (int)(t0 % SEQ);
            float wgt[5][8], bias[8];
#pragma unroll
            for (int j = 0; j < 8; ++j) { bias[j] = p.conv_b[c0 + c8 * 8 + j];
#pragma unroll
                for (int k = 0; k < 5; ++k) wgt[k][j] = p.conv_w[k * 1536 + c0 + c8 * 8 + j]; }
            __syncthreads();
#pragma unroll
            for (int half = 0; half < 2; ++half) { const int tloc = trw + 64 * half; const size_t t = t0 + tloc;
                float acc[8];
#pragma unroll
                for (int j = 0; j < 8; ++j) acc[j] = bias[j];
#pragma unroll
                for (int k = 0; k < 5; ++k) {
#pragma unroll
                    for (int j = 0; j < 4; ++j) { acc[2 * j] += __uint_as_float(rw[half][k][j] << 16) * wgt[k][2 * j]; acc[2 * j + 1] += __uint_as_float(rw[half][k][j] & 0xffff0000u) * wgt[k][2 * j + 1]; } }
#pragma unroll
                for (int j = 0; j < 8; ++j) acc[j] = acc[j] * __builtin_amdgcn_rcpf(1.0f + __expf(-acc[j]));
                if (c0 >= 1024) st8(p.bc + t * 512 + (c0 - 1024) + c8 * 8, acc);
                if (c0 < 1280) {
#pragma unroll
                    for (int j = 0; j < 8; ++j) tl[(c8 * 8 + j) * CTLD + tloc] = f2bf(acc[j]); }
            }
            __syncthreads();
            if (c0 < 1280) {
                bf16_t* dst = c0 < 1024 ? p.xsT + ((size_t)b * 1024 + c0 + trw) * SEQ + pos0 : p.bmT + ((size_t)b * 256 + (c0 - 1024) + trw) * SEQ + pos0;
#pragma unroll
                for (int half = 0; half < 2; ++half) *(u32x4*)(dst + 64 * half + 8 * c8) = *(const LAS u32x4*)(tl + trw * CTLD + 64 * half + 8 * c8);
            }
#pragma unroll
            for (int half = 0; half < 2; ++half)
#pragma unroll
                for (int k = 0; k < 5; ++k) rw[half][k] = rwn[half][k];
        }
#undef PREP_LOAD
    }
    {
        const int lane = LANE;
        for (size_t it = GWAVE; it < (size_t)BATCH * NCHUNK * 32; it += NWAVES_G) {
            const int j = (int)(it & 31), c = (int)((it >> 5) % NCHUNK), b = (int)((it >> 5) / NCHUNK), dir = j >> 4, h = j & 15;
            const float A = -expf(dir ? p.a_log_b[h] : p.a_log_f[h]), bias = dir ? p.dtb_b[h] : p.dtb_f[h];
            const size_t row0 = (size_t)b * SEQ + (size_t)c * 128; const size_t ob = ((size_t)b * 32 + j) * SEQ + c * 128;
            const int l0 = dir ? 127 - 2 * lane : 2 * lane, l1 = dir ? 126 - 2 * lane : 2 * lane + 1;
            const float dt0 = softplus_f(p.dtraw[(row0 + l0) * 32 + j] + bias), dt1 = softplus_f(p.dtraw[(row0 + l1) * 32 + j] + bias);
            const float a0 = dt0 * A, a1 = dt1 * A, pr = a0 + a1; float inc = pr;
#pragma unroll
            for (int o = 1; o < 64; o <<= 1) { const float tq = __shfl_up(inc, o); if (lane >= o) inc += tq; }
            const float cs0 = inc - pr + a0, cs1 = inc, total = __shfl(inc, 63);
            p.step[(row0 + l0) * 32 + j] = dt0; p.step[(row0 + l1) * 32 + j] = dt1;
            p.stT[ob + l0] = dt0; p.stT[ob + l1] = dt1; p.csT[ob + l0] = cs0; p.csT[ob + l1] = cs1;
            p.wdT[ob + l0] = dt0 * expf(total - cs0); p.wdT[ob + l1] = dt1 * expf(total - cs1);
            if (lane == 0) p.cdec[((size_t)b * 32 + j) * NCHUNK + c] = expf(total);
        }
    }
}

typedef short s16x4 __attribute__((ext_vector_type(4)));
constexpr int VLD = 144;
DEV void ph_attn(const P& p, LAS unsigned char* lds) {
    const int wid = threadIdx.x >> 6, lane = threadIdx.x & 63, fr = lane & 15, fq = lane >> 4;
    LAS unsigned char* vt = lds + wid * (32 * VLD);
    float gq = 0.f, gk = 0.f;
    for (int c = 0; c < 64; ++c) { gq = fmaxf(gq, fabsf(p.q_norm[c])); gk = fmaxf(gk, fabsf(p.k_norm[c])); }
    const float c1 = 0.125f * 1.44269504089f, c2 = 8.0f * gq * gk * 1.44269504089f;
    const int trq = fr >> 2, trp = fr & 3;
    constexpr int NJB = SEQ / 256;
    for (int it = blockIdx.x * 8 + wid; it < BATCH * 16 * NJB * 16; it += gridDim.x * 8) {
        const int r = it & 15, jb = (it >> 4) % NJB, h = ((it >> 4) / NJB) & 15, b = ((it >> 4) / NJB) >> 4;
        const size_t rowb = (size_t)b * SEQ; const int base = r + 256 * jb;
        const bf16_t* qp = p.qkv + (rowb + base + 16 * fr) * 3072 + h * 64 + 8 * fq;
        const bf16x8 qf0 = ldg8(qp), qf1 = ldg8(qp + 32);
        const bf16_t* kbase = p.qkv + rowb * 3072 + 1024 + h * 64 + 8 * fq;
        const bf16_t* vbase = p.qkv + rowb * 3072 + 2048 + h * 64;
        f32x4 o[4];
#pragma unroll
        for (int mb = 0; mb < 4; ++mb) o[mb] = (f32x4){0.f, 0.f, 0.f, 0.f};
        float lsum = 0.f;
        bf16x8 vr[4], kf[2][2];
#define ATT_LOAD(st, VR, KF) do { const int dsh_ = (st) < 12 ? 0 : ((st) < 18 ? 2 : 4), k0_ = -64 + 32 * ((st) < 12 ? (st) : ((st) < 18 ? (st) - 12 : (st) - 18)); \
            _Pragma("unroll") for (int c4 = 0; c4 < 4; ++c4) { const int id = lane + 64 * c4, row = id >> 3, ch = id & 7; int pos = base + ((k0_ + row) << dsh_); pos = pos < 0 ? 0 : (pos > SEQ - 1 ? SEQ - 1 : pos); \
                VR[c4] = ldg8(vbase + (size_t)pos * 3072 + 8 * ch); } \
            _Pragma("unroll") for (int x = 0; x < 2; ++x) { int pos = base + ((k0_ + 8 * (fr >> 2) + 4 * x + (fr & 3)) << dsh_); pos = pos < 0 ? 0 : (pos > SEQ - 1 ? SEQ - 1 : pos); \
                KF[x][0] = ldg8(kbase + (size_t)pos * 3072); KF[x][1] = ldg8(kbase + (size_t)pos * 3072 + 32); } } while (0)
        ATT_LOAD(0, vr, kf);
#pragma unroll 1
        for (int st = 0; st < 23; ++st) {
            bf16x8 vrn[4], kfn[2][2];
            const int stn = st + 1 < 23 ? st + 1 : st;
            ATT_LOAD(stn, vrn, kfn);
            const int dsh = st < 12 ? 0 : (st < 18 ? 2 : 4), k0 = -64 + 32 * (st < 12 ? st : (st < 18 ? st - 12 : st - 18));
            const int kq = fr << (4 - dsh);
            f32x4 s0 = mfma16(kf[0][0], qf0, (f32x4){0.f, 0.f, 0.f, 0.f}); s0 = mfma16(kf[0][1], qf1, s0);
            f32x4 s1 = mfma16(kf[1][0], qf0, (f32x4){0.f, 0.f, 0.f, 0.f}); s1 = mfma16(kf[1][1], qf1, s1);
            float pv[8];
#pragma unroll
            for (int j = 0; j < 8; ++j) { const int kap = k0 + 8 * fq + j, pos = base + (kap << dsh), dk = kap - kq;
                const bool valid = dk <= 64 && dk >= -64 && pos >= 0 && pos < SEQ; const float sv = j < 4 ? s0[j & 3] : s1[j & 3];
                pv[j] = valid ? __builtin_amdgcn_exp2f(sv * c1 - c2) : 0.f; lsum += pv[j]; }
            const bf16x8 pf = pack8(pv);
            asm volatile("" ::: "memory");
#pragma unroll
            for (int c4 = 0; c4 < 4; ++c4) { const int id = lane + 64 * c4, row = id >> 3, ch = id & 7; *(LAS bf16x8*)(vt + row * VLD + ch * 16) = vr[c4]; }
            asm volatile("s_waitcnt lgkmcnt(0)" ::: "memory");
#pragma unroll
            for (int mb = 0; mb < 4; ++mb) {
                const s16x4 t0 = __builtin_amdgcn_ds_read_tr16_b64_v4i16((LAS s16x4*)(vt + (8 * fq + trq) * VLD + (16 * mb + 4 * trp) * 2));
                const s16x4 t1 = __builtin_amdgcn_ds_read_tr16_b64_v4i16((LAS s16x4*)(vt + (8 * fq + 4 + trq) * VLD + (16 * mb + 4 * trp) * 2));
                const bf16x8 vf = __builtin_shufflevector(t0, t1, 0, 1, 2, 3, 4, 5, 6, 7);
                o[mb] = mfma16(vf, pf, o[mb]);
            }
            asm volatile("" ::: "memory");
#pragma unroll
            for (int c4 = 0; c4 < 4; ++c4) vr[c4] = vrn[c4];
            kf[0][0] = kfn[0][0]; kf[0][1] = kfn[0][1]; kf[1][0] = kfn[1][0]; kf[1][1] = kfn[1][1];
        }
#undef ATT_LOAD
        lsum += __shfl_xor(lsum, 16); lsum += __shfl_xor(lsum, 32);
        const float inv = 1.0f / lsum;
#pragma unroll
        for (int mb = 0; mb < 4; ++mb) *(u32x2*)(p.mix + (rowb + base + 16 * fr) * 2048 + h * 64 + 16 * mb + 4 * fq) = pk4(o[mb] * inv);
    }
}

constexpr int OLD = 68;
constexpr int ATT_VT = 32 * VLD;
constexpr int ATT_OPART = 8 * 2 * ATT_VT, ATT_LPART = ATT_OPART + 256 * OLD * 4;
static_assert(ATT_LPART + 1024 <= 147440, "attention LDS");
template <int MODE, bool EDGE>
DEV void attn_stream(LAS unsigned char* lds, const bf16_t* qkvb, bf16_t* outb, const int base0, const float c1, const float c2) {
    const int wid = threadIdx.x >> 6, lane = threadIdx.x & 63, fr = lane & 15, fq = lane >> 4, trq = fr >> 2, trp = fr & 3;
    LAS unsigned char* vt = lds + wid * (2 * ATT_VT); LAS float* Opart = (LAS float*)(lds + ATT_OPART); LAS float* lpart = (LAS float*)(lds + ATT_LPART);
    constexpr int NSI = MODE == 0 ? 11 : 5, NST = 2 * NSI;
#define ATT_GEOM(st, BASE, DSH, K0) do { const int it_ = (st) >= NSI ? 1 : 0, s_ = (st) - it_ * NSI; BASE = MODE == 0 ? base0 + 2 * wid + it_ : base0 + 32 * wid + 16 * it_; \
        if (MODE == 0) { if (s_ < 6) { DSH = 2; K0 = -64 + 32 * s_; } else { DSH = 4; K0 = -64 + 32 * (s_ - 6); } } else { DSH = 0; K0 = -64 + 32 * s_; } } while (0)
#define ATT_CLAMP(pos) (EDGE ? ((pos) < 0 ? 0 : ((pos) > SEQ - 1 ? SEQ - 1 : (pos))) : (pos))
#define ATT_LOADV(st, VR) do { int b_, d_, k_; ATT_GEOM(st, b_, d_, k_); _Pragma("unroll") for (int c4 = 0; c4 < 4; ++c4) { const int id = lane + 64 * c4, row = id >> 3, ch = id & 7; int pos = b_ + ((k_ + row) << d_); pos = ATT_CLAMP(pos); \
            VR[c4] = ldg8(qkvb + 2048 + (size_t)pos * 3072 + 8 * ch); } } while (0)
#define ATT_LOADK(st, KF) do { int b_, d_, k_; ATT_GEOM(st, b_, d_, k_); _Pragma("unroll") for (int x = 0; x < 2; ++x) { int pos = b_ + ((k_ + 8 * (fr >> 2) + 4 * x + (fr & 3)) << d_); pos = ATT_CLAMP(pos); \
            KF[x][0] = ldg8(qkvb + 1024 + (size_t)pos * 3072 + 8 * fq); KF[x][1] = ldg8(qkvb + 1024 + (size_t)pos * 3072 + 8 * fq + 32); } } while (0)
#define ATT_QPOS(it) ((MODE == 0 ? base0 + 2 * wid + (it) + 16 * fr : base0 + 32 * wid + 16 * (it) + fr))
    bf16x8 qf0 = ldg8(qkvb + (size_t)ATT_QPOS(0) * 3072 + 8 * fq), qf1 = ldg8(qkvb + (size_t)ATT_QPOS(0) * 3072 + 8 * fq + 32);
    const bf16x8 qn0 = ldg8(qkvb + (size_t)ATT_QPOS(1) * 3072 + 8 * fq), qn1 = ldg8(qkvb + (size_t)ATT_QPOS(1) * 3072 + 8 * fq + 32);
    bf16x8 vB[4], kf[2][2];
    { bf16x8 vA[4]; ATT_LOADV(0, vA); ATT_LOADK(0, kf); ATT_LOADV(1, vB);
#pragma unroll
      for (int c4 = 0; c4 < 4; ++c4) { const int id = lane + 64 * c4, row = id >> 3, ch = id & 7; *(LAS bf16x8*)(vt + row * VLD + ch * 16) = vA[c4]; } }
    f32x4 o[4];
#pragma unroll
    for (int mb = 0; mb < 4; ++mb) o[mb] = (f32x4){0.f, 0.f, 0.f, 0.f};
    float lsum = 0.f;
    asm volatile("" ::: "memory");
#pragma unroll 1
    for (int st = 0; st < NST; ++st) {
        bf16x8 vC[4], kfn[2][2];
        const int stn = st + 1 < NST ? st + 1 : NST - 1, st2 = st + 2 < NST ? st + 2 : NST - 1;
        ATT_LOADK(stn, kfn); ATT_LOADV(st2, vC);
        LAS unsigned char* vcur = vt + (st & 1) * ATT_VT; LAS unsigned char* vnxt = vt + ((st + 1) & 1) * ATT_VT;
        bf16x8 vf[4];
#pragma unroll
        for (int mb = 0; mb < 4; ++mb) {
            const s16x4 t0v = __builtin_amdgcn_ds_read_tr16_b64_v4i16((LAS s16x4*)(vcur + (8 * fq + trq) * VLD + (16 * mb + 4 * trp) * 2));
            const s16x4 t1v = __builtin_amdgcn_ds_read_tr16_b64_v4i16((LAS s16x4*)(vcur + (8 * fq + 4 + trq) * VLD + (16 * mb + 4 * trp) * 2));
            vf[mb] = __builtin_shufflevector(t0v, t1v, 0, 1, 2, 3, 4, 5, 6, 7); }
#pragma unroll
        for (int c4 = 0; c4 < 4; ++c4) { const int id = lane + 64 * c4, row = id >> 3, ch = id & 7; *(LAS bf16x8*)(vnxt + row * VLD + ch * 16) = vB[c4]; }
        asm volatile("" ::: "memory");
        int base, dsh, k0; ATT_GEOM(st, base, dsh, k0);
        const int kq = MODE == 0 ? (fr << (4 - dsh)) : fr;
        f32x4 s0 = mfma16(kf[0][0], qf0, (f32x4){0.f, 0.f, 0.f, 0.f}); s0 = mfma16(kf[0][1], qf1, s0);
        f32x4 s1 = mfma16(kf[1][0], qf0, (f32x4){0.f, 0.f, 0.f, 0.f}); s1 = mfma16(kf[1][1], qf1, s1);
        float pv[8]; const int t0 = k0 + 8 * fq - kq + 64;
#pragma unroll
        for (int j = 0; j < 8; ++j) { bool valid = (unsigned)(t0 + j) <= 128u;
            if (EDGE) { const int pos = base + ((k0 + 8 * fq + j) << dsh); valid = valid && pos >= 0 && pos < SEQ; }
            const float sv = j < 4 ? s0[j & 3] : s1[j & 3]; pv[j] = valid ? __builtin_amdgcn_exp2f(sv * c1 - c2) : 0.f; lsum += pv[j]; }
        const bf16x8 pf = pack8(pv);
#pragma unroll
        for (int mb = 0; mb < 4; ++mb) o[mb] = mfma16(vf[mb], pf, o[mb]);
        asm volatile("" ::: "memory");
        if (st == NSI - 1 || st == NST - 1) {
            const int it = st == NSI - 1 ? 0 : 1;
            lsum += __shfl_xor(lsum, 16); lsum += __shfl_xor(lsum, 32);
            if (MODE == 0) { const int ql = 2 * wid + it + 16 * fr;
#pragma unroll
                for (int mb = 0; mb < 4; ++mb) *(LAS f32x4*)(Opart + ql * OLD + 16 * mb + 4 * fq) = o[mb];
                if (fq == 0) lpart[ql] = lsum;
            } else { const int ql = 32 * wid + 16 * it + fr; const float inv = 1.0f / (lsum + lpart[ql]);
#pragma unroll
                for (int mb = 0; mb < 4; ++mb) { const f32x4 tot = (o[mb] + *(const LAS f32x4*)(Opart + ql * OLD + 16 * mb + 4 * fq)) * inv;
                    *(u32x2*)(outb + (size_t)(base0 + ql) * 2048 + 16 * mb + 4 * fq) = pk4(tot); } }
#pragma unroll
            for (int mb = 0; mb < 4; ++mb) o[mb] = (f32x4){0.f, 0.f, 0.f, 0.f};
            lsum = 0.f; qf0 = qn0; qf1 = qn1;
        }
#pragma unroll
        for (int c4 = 0; c4 < 4; ++c4) vB[c4] = vC[c4];
        kf[0][0] = kfn[0][0]; kf[0][1] = kfn[0][1]; kf[1][0] = kfn[1][0]; kf[1][1] = kfn[1][1];
    }
#undef ATT_GEOM
#undef ATT_CLAMP
#undef ATT_LOADV
#undef ATT_LOADK
#undef ATT_QPOS
}
DEV void ph_attn2(const P& p, LAS unsigned char* lds) {
    float gq = 0.f, gk = 0.f;
    for (int c = 0; c < 64; ++c) { gq = fmaxf(gq, fabsf(p.q_norm[c])); gk = fmaxf(gk, fabsf(p.k_norm[c])); }
    const float c1 = 0.125f * 1.44269504089f, c2 = 8.0f * gq * gk * 1.44269504089f;
    constexpr int NJB = SEQ / 256;
    const bool xmap = gridDim.x == 256 && NJB % 32 == 0;
    for (int u0 = blockIdx.x; u0 < BATCH * 16 * NJB; u0 += gridDim.x) {
        int u = u0;
        if (xmap) { const int k = u0 >> 8, xcd = blockIdx.x & 7, slot = blockIdx.x >> 3; constexpr int RPP = NJB / 32; const int pair = xcd * (BATCH * 16 / 8) + k / RPP; u = pair * NJB + (k % RPP) * 32 + slot; }
        const int jb = u % NJB, h = (u / NJB) & 15, b = (u / NJB) >> 4, base0 = 256 * jb;
        const bf16_t* qkvb = p.qkv + (size_t)b * SEQ * 3072 + h * 64; bf16_t* outb = p.mix + (size_t)b * SEQ * 2048 + h * 64;
        const bool edge = base0 < 1024 || base0 + 255 + 1520 >= SEQ;
        if (edge) attn_stream<0, true>(lds, qkvb, outb, base0, c1, c2); else attn_stream<0, false>(lds, qkvb, outb, base0, c1, c2);
        __syncthreads();
        if (edge) attn_stream<1, true>(lds, qkvb, outb, base0, c1, c2); else attn_stream<1, false>(lds, qkvb, outb, base0, c1, c2);
        __syncthreads();
    }
}

static_assert(SEQ % 512 == 0, "top-k: SEQ / 512 values per thread");
DEV void ph_topk(const P& p, LAS unsigned char* lds) {
    constexpr int NV_T = SEQ / 512;
    LAS unsigned* hist = (LAS unsigned*)lds; LAS unsigned* wtot = hist + 256; LAS unsigned* bcw = hist + 272;
    const int tid = threadIdx.x, lane = tid & 63, wid = tid >> 6;
    for (int be = blockIdx.x; be < BATCH * NE; be += gridDim.x) {
        const float* a = p.aff + (size_t)be * SEQ + (size_t)tid * NV_T;
        unsigned v[NV_T];
#pragma unroll
        for (int q = 0; q < NV_T / 4; ++q) { const uint4 u = *(const uint4*)(a + 4 * q); v[4 * q] = u.x; v[4 * q + 1] = u.y; v[4 * q + 2] = u.z; v[4 * q + 3] = u.w; }
        unsigned prefix = 0u, kk = CAP;
#pragma unroll 1
        for (int pass = 0; pass < 4; ++pass) {
            const int shift = 24 - 8 * pass;
            if (tid < 256) hist[tid] = 0u;
            __syncthreads();
#pragma unroll
            for (int j = 0; j < NV_T; ++j) { const bool m = pass == 0 || (v[j] >> (shift + 8)) == prefix; if (m) atomicAdd((unsigned*)&hist[(v[j] >> shift) & 255u], 1u); }
            __syncthreads();
            if (wid == 0) {
                const unsigned c0 = hist[255 - 4 * lane], c1 = hist[254 - 4 * lane], c2 = hist[253 - 4 * lane], c3 = hist[252 - 4 * lane];
                const unsigned tot = c0 + c1 + c2 + c3; unsigned inc = tot;
#pragma unroll
                for (int o = 1; o < 64; o <<= 1) { const unsigned t = __shfl_up(inc, o); if (lane >= o) inc += t; }
                const unsigned exc = inc - tot;
                if (exc < kk && kk <= inc) { const unsigned r = kk - exc; unsigned bin, before;
                    if (r <= c0) { bin = 255 - 4 * lane; before = exc; } else if (r <= c0 + c1) { bin = 254 - 4 * lane; before = exc + c0; } else if (r <= c0 + c1 + c2) { bin = 253 - 4 * lane; before = exc + c0 + c1; } else { bin = 252 - 4 * lane; before = exc + c0 + c1 + c2; }
                    bcw[0] = bin; bcw[1] = kk - before; }
            }
            __syncthreads();
            prefix = (prefix << 8) | bcw[0]; kk = bcw[1];
        }
        const unsigned Tb = prefix, need = kk, cgt = CAP - need;
        unsigned ngt = 0u, neq = 0u;
#pragma unroll
        for (int j = 0; j < NV_T; ++j) { ngt += v[j] > Tb ? 1u : 0u; neq += v[j] == Tb ? 1u : 0u; }
        const unsigned packed = ngt | (neq << 16); unsigned inc = packed;
#pragma unroll
        for (int o = 1; o < 64; o <<= 1) { const unsigned t = __shfl_up(inc, o); if (lane >= o) inc += t; }
        if (lane == 63) wtot[wid] = inc;
        __syncthreads();
        unsigned wbase = 0u;
        for (int w = 0; w < wid; ++w) wbase += wtot[w];
        const unsigned exc = wbase + inc - packed; unsigned gbase = exc & 0xffffu, ebase = exc >> 16;
        int* smp = p.slotmap + (size_t)be * SEQ + (size_t)tid * NV_T;
#pragma unroll
        for (int q = 0; q < NV_T / 4; ++q) { int sl[4];
#pragma unroll
            for (int i = 0; i < 4; ++i) { const int j = 4 * q + i; int slot = -1;
                if (v[j] > Tb) { slot = (int)gbase; ++gbase; } else if (v[j] == Tb) { if (ebase < need) slot = (int)(cgt + ebase); ++ebase; }
                if (slot >= 0) { p.idx[(size_t)be * CAP + slot] = tid * NV_T + j; p.gate[(size_t)be * CAP + slot] = __uint_as_float(v[j]); }
                sl[i] = slot; }
            *(int4*)(smp + 4 * q) = int4{sl[0], sl[1], sl[2], sl[3]}; }
        __syncthreads();
    }
}

#define XB_TMO      128
#define XB_XCNT(j)  (256  + 64 * (j))
#define XB_XSUB(j)  (1280 + 64 * (j))
#define XB_XGEN(j)  (2304 + 64 * (j))
#define XB_TOP      3328
#define XB_TOPGEN   3392
#define XCD_BAR_WORDS 3456
#define XB_SPIN_CAP (1u << 18)

__device__ __forceinline__ unsigned xb_ld(unsigned* p)              { return __hip_atomic_load(p, __ATOMIC_RELAXED, __HIP_MEMORY_SCOPE_AGENT); }
__device__ __forceinline__ unsigned xb_add(unsigned* p, unsigned v) { return __hip_atomic_fetch_add(p, v, __ATOMIC_RELAXED, __HIP_MEMORY_SCOPE_AGENT); }
__device__ __forceinline__ unsigned xb_xcc_id() { return (unsigned)__builtin_amdgcn_s_getreg((3 << 11) | 20) & 0xFu; }
#define XB_SPIN(cond, bar) do { unsigned _sp = 0; while (cond) { __builtin_amdgcn_s_sleep(1); \
    if ((++_sp & 255u) == 0u) { if (xb_ld(&(bar)[XB_TMO])) break; if (_sp > XB_SPIN_CAP) { atomicAdd(&(bar)[XB_TMO], 1u); break; } } } } while (0)

struct XcdBarrier {
    unsigned* bar; unsigned x;
    volatile LAS unsigned* st;
};

__device__ __forceinline__ XcdBarrier xcd_barrier_post(unsigned* bar, volatile LAS unsigned* st) {
    XcdBarrier b; b.bar = bar; b.x = xb_xcc_id(); b.st = st;
    if (threadIdx.x == 0) (void)xb_add(&bar[XB_XCNT(b.x)], 1u);
    return b;
}
__device__ __forceinline__ void xcd_barrier_complete(unsigned* bar, unsigned x, unsigned& nloc, unsigned& nx) {
    const unsigned G = gridDim.x * gridDim.y * gridDim.z;
    unsigned sum, cnt, mine, sp = 0u;
    for (;;) {
        sum = 0u; cnt = 0u; mine = 0u;
#pragma unroll
        for (unsigned j = 0; j < 16; ++j) { const unsigned c = xb_ld(&bar[XB_XCNT(j)]); sum += c; cnt += (c > 0u) ? 1u : 0u; mine = (j == x) ? c : mine; }
        if (sum == G) break;
        __builtin_amdgcn_s_sleep(1);
        if ((++sp & 255u) == 0u) { if (xb_ld(&bar[XB_TMO])) break; if (sp > XB_SPIN_CAP) { atomicAdd(&bar[XB_TMO], 1u); break; } }
    }
    nloc = mine > 0u ? mine : 1u; nx = cnt > 0u ? cnt : 1u;
}

__device__ __forceinline__ void xcd_barrier(const XcdBarrier& b) {
    asm volatile("s_waitcnt vmcnt(0)" ::: "memory");
    __syncthreads();
    if (threadIdx.x == 0) {
        unsigned* bar = b.bar;
        __builtin_amdgcn_s_waitcnt(0);
        unsigned nloc = b.st[0], nx = b.st[1];
        if (nloc == 0u) { xcd_barrier_complete(bar, b.x, nloc, nx); b.st[0] = nloc; b.st[1] = nx; }
        const unsigned old = xb_add(&bar[XB_XSUB(b.x)], 1u);
        const unsigned gen = old / nloc;
        if (old + 1u == (gen + 1u) * nloc) {
            __builtin_amdgcn_fence(__ATOMIC_RELEASE, "agent");
            asm volatile("s_waitcnt vmcnt(0)" ::: "memory");
            const unsigned og = xb_add(&bar[XB_TOP], 1u);
            const unsigned tg = og / nx;
            if (og + 1u == (tg + 1u) * nx) xb_add(&bar[XB_TOPGEN], 1u);
            else XB_SPIN(xb_ld(&bar[XB_TOPGEN]) == tg, bar);
            __builtin_amdgcn_fence(__ATOMIC_ACQUIRE, "agent");
            xb_add(&bar[XB_XGEN(b.x)], 1u);
            asm volatile("s_waitcnt vmcnt(0)" ::: "memory");
        } else {
            XB_SPIN(xb_ld(&bar[XB_XGEN(b.x)]) == gen, bar);
            __builtin_amdgcn_fence(__ATOMIC_ACQUIRE, "agent");
            asm volatile("s_waitcnt vmcnt(0)" ::: "memory");
        }
    }
    __syncthreads();
}


enum { PH_FIRST = 0, PH_G1, PH_PREP, PH_ATTN, PH_SSDB, PH_SSDC, PH_GNORM, PH_G2, PH_ROUTE0, PH_TOPK0, PH_UP0, PH_DOWN0, PH_COMB0, PH_G3, PH_CONV3, PH_G4, PH_ROUTE1, PH_TOPK1, PH_UP1, PH_DOWN1, PH_COMB1, NPH };

constexpr int LDS_BYTES = 147456;
constexpr int LDS_XB = LDS_BYTES - 16;
__global__ void __launch_bounds__(512, 2) fwd(P p, int lo, int hi) {
    extern __shared__ __attribute__((aligned(16))) unsigned char shm[];
    LAS unsigned char* lds = (LAS unsigned char*)shm;
    XcdBarrier bar; bar.bar = p.bar; bar.x = 0; bar.st = (volatile LAS unsigned*)(lds + LDS_XB);
    if (hi - lo > 1) {
        if (threadIdx.x == 0) { ((LAS unsigned*)(lds + LDS_XB))[0] = 0u; ((LAS unsigned*)(lds + LDS_XB))[1] = 0u; }
        __syncthreads();
        bar = xcd_barrier_post(p.bar, (volatile LAS unsigned*)(lds + LDS_XB));
    }
#if NAIVE_GEMM
#define GEMM_SEL(a, b) a
#else
#define GEMM_SEL(a, b) b
#endif
#if NAIVE_SSD
#define SSD_SEL(a, b) a
#else
#define SSD_SEL(a, b) b
#endif
#if NAIVE_ATTN
#define ATTN_SEL(a, b) a
#else
#define ATTN_SEL(a, b) b
#endif
#if NAIVE_TOPK
#define TOPK_SEL(a, b) a
#else
#define TOPK_SEL(a, b) b
#endif
#ifndef PROBE_DUP
#define PROBE_DUP -1
#endif
#define PHASE(i, body) if (lo <= (i) && (i) < hi) { body; if ((i) == PROBE_DUP) { xcd_barrier(bar); body; } if ((i) + 1 < hi) xcd_barrier(bar); }
    PHASE(PH_FIRST, { ph_convert_small(p); ph_rmsnorm_dev(p.x, p.attn_norm, p.hn); ph_convert_experts_dev(p, 0, lds); })
    PHASE(PH_G1, GEMM_SEL(nv_g1(p), ph_g1(p, lds)))
    PHASE(PH_PREP, ph_prep_dev(p, lds))
    PHASE(PH_ATTN, { ATTN_SEL(nv_attn(p), ph_attn2(p, lds)); SSD_SEL(nv_ssd(p), ph_ssd_states(p)); })
    PHASE(PH_SSDB, SSD_SEL((void)0, ph_ssd_scan(p)))
    PHASE(PH_SSDC, SSD_SEL((void)0, ph_ssd_out(p, lds)))
    PHASE(PH_GNORM, ph_gated_norm_dev(p))
    PHASE(PH_G2, GEMM_SEL(nv_g2(p), ph_g2(p, lds)))
    PHASE(PH_ROUTE0, ph_norm_router_mfma(p, 0, lds))
    PHASE(PH_TOPK0, TOPK_SEL(nv_topk(p), ph_topk(p, lds)))
    PHASE(PH_UP0, GEMM_SEL(nv_up(p), ph_up(p, lds)))
    PHASE(PH_DOWN0, GEMM_SEL(nv_down(p), ph_down(p, lds)))
    PHASE(PH_COMB0, { ph_combine_dev4(p, p.conv_norm); ph_convert_experts_dev(p, 1, lds); })
    PHASE(PH_G3, GEMM_SEL(nv_g3(p), ph_g3(p, lds)))
    PHASE(PH_CONV3, ph_conv3_dev(p))
    PHASE(PH_G4, GEMM_SEL(nv_g4(p), ph_g4(p, lds)))
    PHASE(PH_ROUTE1, ph_norm_router_mfma(p, 1, lds))
    PHASE(PH_TOPK1, TOPK_SEL(nv_topk(p), ph_topk(p, lds)))
    PHASE(PH_UP1, GEMM_SEL(nv_up(p), ph_up(p, lds)))
    PHASE(PH_DOWN1, GEMM_SEL(nv_down(p), ph_down(p, lds)))
    PHASE(PH_COMB1, ph_combine_dev4(p, nullptr))
}

extern "C" void kernel_launch(void* const* d_in, const int* in_sizes, int n_in, void* d_out, int out_size, void* d_ws, size_t ws_size, hipStream_t stream) {
    (void)in_sizes; (void)n_in; (void)out_size; (void)ws_size;
    P p{};
    make_params(p, d_in, d_out, d_ws);
    static int grid = 0;
    if (grid == 0) {
        int dev = 0, cus = 0;
        if (hipGetDevice(&dev) != hipSuccess || hipDeviceGetAttribute(&cus, hipDeviceAttributeMultiprocessorCount, dev) != hipSuccess) cus = 256;
        (void)hipFuncSetAttribute((const void*)fwd, hipFuncAttributeMaxDynamicSharedMemorySize, LDS_BYTES);
        (void)hipGetLastError();
        grid = cus > 0 ? cus : 256;
    }
#if ONE_LAUNCH
    (void)hipMemsetAsync(p.bar, 0, XCD_BAR_WORDS * sizeof(unsigned), stream);
    hipLaunchKernelGGL(fwd, dim3(grid), dim3(512), LDS_BYTES, stream, p, 0, (int)NPH);
#else
    for (int ph = 0; ph < NPH; ++ph) hipLaunchKernelGGL(fwd, dim3(grid), dim3(512), LDS_BYTES, stream, p, ph, ph + 1);
#endif
}
#endif
```

```cpp
#ifndef HOST_EMU
#include <hip/hip_runtime.h>
#define HD __host__ __device__ __forceinline__
#define DEV __device__ __forceinline__
#else
#include <cmath>
#include <cstdio>
#include <cstdlib>
#include <cstring>
#include <cstddef>
#define HD inline
#define DEV inline
struct float4 { float x, y, z, w; };
struct uint4 { unsigned x, y, z, w; };
struct uint2 { unsigned x, y; };
static thread_local size_t emu_tid = 0; static size_t emu_nthreads = 1;
#endif

#ifndef BATCH
#define BATCH 2
#endif
#ifndef SEQ
#define SEQ 16384
#endif
#ifndef NAIVE_GEMM
#define NAIVE_GEMM 0
#endif
#ifndef NAIVE_ATTN
#define NAIVE_ATTN 0
#endif
#ifndef NAIVE_SSD
#define NAIVE_SSD 0
#endif
#ifndef NAIVE_TOPK
#define NAIVE_TOPK 0
#endif
#ifndef FP8_MOE
#define FP8_MOE 1
#endif
#ifndef ONE_LAUNCH
#define ONE_LAUNCH 1
#endif

typedef unsigned short bf16_t;
constexpr int T = BATCH * SEQ;
constexpr int DM = 1024;
constexpr int NIN = 5664, NIN_PAD = 5888;
constexpr int NE = 16;
constexpr int CAP = 2 * SEQ / NE;
constexpr int NSLOT = BATCH * NE * CAP;
constexpr int DFF = 2048;
constexpr int NCHUNK = SEQ / 128;

HD float bf2f(bf16_t v) { union { unsigned u; float f; } x; x.u = ((unsigned)v) << 16; return x.f; }
HD bf16_t f2bf(float f) { union { unsigned u; float f; } x; x.f = f; unsigned u = x.u; u += 0x7fffu + ((u >> 16) & 1u); return (bf16_t)(u >> 16); }
HD unsigned pack2(float lo, float hi) { return (unsigned)f2bf(lo) | ((unsigned)f2bf(hi) << 16); }
HD float silu_f(float v) { return v / (1.0f + expf(-v)); }
HD float softplus_f(float v) { return v > 20.f ? v : log1pf(expf(v)); }

#ifndef HOST_EMU
#define LANES 64
#define GTID ((size_t)blockIdx.x * blockDim.x + threadIdx.x)
#define GSTRIDE ((size_t)gridDim.x * blockDim.x)
#define LANE ((int)(threadIdx.x & 63))
DEV float wave_sum(float v) {
#pragma unroll
    for (int o = 32; o >= 1; o >>= 1) v += __shfl_xor(v, o);
    return v;
}
#else
#define LANES 1
#define GTID (emu_tid)
#define GSTRIDE (emu_nthreads)
#define LANE 0
DEV float wave_sum(float v) { return v; }
#endif
#define GWAVE (GTID / LANES)
#define NWAVES_G (GSTRIDE / LANES)

struct P {
    const float *x, *attn_norm, *w_in, *q_norm, *k_norm, *conv_w, *conv_b, *a_log_f, *a_log_b, *dtb_f, *dtb_b, *ssd_d, *out_norm, *w_out,
        *conv_norm, *cw_in, *cw, *cw_out, *ffn_norm, *router_w, *wg, *wu, *wd;
    float* out;
    bf16_t *WinT, *WoutT, *WciT, *WcoT, *WguT, *WdT, *hn, *qkv, *z, *xbcraw, *bc, *xsT, *bmT, *states, *mix, *yssd, *xe, *hid, *ye, *pbuf, *gb, *abuf;
    float *dtraw, *step, *stT, *csT, *wdT, *cdec, *aff, *gate, *rope, *ytmp;
    int *idx, *slotmap;
    unsigned* bar;
};

constexpr size_t MiB = 1024 * 1024;
constexpr size_t al(size_t v) { return (v + 4095) & ~(size_t)4095; }
constexpr size_t WS_BAR = 0;
constexpr size_t WS_WIN = 65536;
constexpr size_t WS_WOUT = WS_WIN + al((size_t)NIN_PAD * 1024 * 2);
constexpr size_t WS_WCI = WS_WOUT + al((size_t)1024 * 2048 * 2);
constexpr size_t WS_WCO = WS_WCI + al((size_t)3072 * 1024 * 2);
constexpr size_t WS_WGU = WS_WCO + al((size_t)1024 * 1024 * 2);
constexpr size_t WS_WD = WS_WGU + al((size_t)NE * 4096 * 1024 * 2);
constexpr size_t WS_ROPE = WS_WD + al((size_t)NE * 1024 * 2048 * 2);
constexpr size_t WS_AFF = WS_ROPE + al((size_t)SEQ * 16 * 4);
constexpr size_t WS_GATE = WS_AFF + al((size_t)BATCH * NE * SEQ * 4);
constexpr size_t WS_IDX = WS_GATE + al((size_t)NSLOT * 4);
constexpr size_t WS_SMAP = WS_IDX + al((size_t)NSLOT * 4);
constexpr size_t WS_HN = WS_SMAP + al((size_t)BATCH * NE * SEQ * 4);
constexpr size_t WS_E = WS_HN + al((size_t)T * 1024 * 2);
constexpr size_t WS_XBCRAW = WS_E;
constexpr size_t WS_QKV = WS_XBCRAW + al((size_t)T * 1536 * 2);
constexpr size_t WS_Z = WS_QKV + al((size_t)T * 3072 * 2);
constexpr size_t WS_BC = WS_Z + al((size_t)T * 1024 * 2);
constexpr size_t WS_XST = WS_BC + al((size_t)T * 512 * 2);
constexpr size_t WS_BMT = WS_XST + al((size_t)T * 1024 * 2);
constexpr size_t WS_DTRAW = WS_BMT + al((size_t)T * 256 * 2);
constexpr size_t WS_STEP = WS_DTRAW + al((size_t)T * 32 * 4);
constexpr size_t WS_STT = WS_STEP + al((size_t)T * 32 * 4);
constexpr size_t WS_CST = WS_STT + al((size_t)T * 32 * 4);
constexpr size_t WS_WDT = WS_CST + al((size_t)T * 32 * 4);
constexpr size_t WS_CDEC = WS_WDT + al((size_t)T * 32 * 4);
constexpr size_t WS_MIX = WS_CDEC + al((size_t)BATCH * 32 * NCHUNK * 4);
constexpr size_t WS_YSSD = WS_MIX + al((size_t)T * 2048 * 2);
constexpr size_t WS_E_END = WS_YSSD + al((size_t)T * 1024 * 2);
constexpr size_t WS_STATES = WS_HN;
constexpr size_t WS_XE = WS_E;
constexpr size_t WS_HID = WS_XE + al((size_t)NSLOT * 1024 * 2);
constexpr size_t WS_YE = WS_HID + al((size_t)NSLOT * 2048 * 2);
constexpr size_t WS_F_END = WS_YE + al((size_t)NSLOT * 1024 * 2);
constexpr size_t WS_PBUF = WS_E;
constexpr size_t WS_GB = WS_PBUF + al((size_t)T * 1024 * 2);
constexpr size_t WS_ABUF = WS_GB + al((size_t)T * 1024 * 2);
constexpr size_t WS_END = WS_E_END > WS_F_END ? WS_E_END : WS_F_END;
static_assert((size_t)T * 1024 * 2 + (size_t)T * 1536 * 2 >= (size_t)T * 1024 * 4, "ytmp overlay");
static_assert((size_t)T * 1024 * 2 + (size_t)T * 1536 * 2 >= (size_t)BATCH * 2 * NCHUNK * 16 * 64 * 128 * 2, "states overlay");
static_assert(BATCH != 2 || SEQ != 16384 || WS_END <= 1024 * MiB, "workspace");

struct CmIdent { int nvalid; HD int operator()(int n) const { return n < nvalid ? n : -1; } };
struct CmGateUp { HD int operator()(int n) const { return n; } };
struct CmOddIn { HD int operator()(int n) const {
        if (n >= 2048) return n - 2048; const int pn = n >> 8, j = n & 255; return j < 128 ? 1024 + pn * 128 + j : 2048 + pn * 128 + (j - 128); } };

template <class CM> DEV void convT(const float* src, int ldsrc, int K, bf16_t* dst, int Ndst, CM cm) {
#ifndef HOST_EMU
    const size_t nitems = (size_t)Ndst * (K / 32);
    for (size_t i = GTID; i < nitems; i += GSTRIDE) {
        const int n = (int)(i % Ndst), k32 = (int)(i / Ndst); const int c = cm(n);
        float v[32];
#pragma unroll
        for (int j = 0; j < 32; ++j) v[j] = c >= 0 ? src[(size_t)(k32 * 32 + j) * ldsrc + c] : 0.f;
#pragma unroll
        for (int q = 0; q < 4; ++q) *(uint4*)(dst + (size_t)n * K + k32 * 32 + q * 8) = uint4{pack2(v[8 * q], v[8 * q + 1]), pack2(v[8 * q + 2], v[8 * q + 3]), pack2(v[8 * q + 4], v[8 * q + 5]), pack2(v[8 * q + 6], v[8 * q + 7])};
    }
#else
    for (size_t i = GTID; i < (size_t)Ndst * K; i += GSTRIDE) { const int n = (int)(i / K), k = (int)(i % K); const int c = cm(n); dst[i] = c >= 0 ? f2bf(src[(size_t)k * ldsrc + c]) : (bf16_t)0; }
#endif
}
struct CmGU { const float* dummy; HD int operator()(int n) const { return n; } };
template <int WHICH> struct CmHalf { HD int operator()(int n) const { const int j = n & 255; const bool isup = j >= 128; if ((int)isup != WHICH) return -2; return (n >> 8) * 128 + (j & 127); } };
DEV void conv_gateup(const float* sg, const float* su, bf16_t* dst) {
#ifndef HOST_EMU
    const size_t nitems = (size_t)4096 * 32;
    for (size_t i = GTID; i < nitems; i += GSTRIDE) {
        const int n = (int)(i % 4096), k32 = (int)(i / 4096); const int j0 = n & 255; const float* src = (j0 >= 128 ? su : sg) + (n >> 8) * 128 + (j0 & 127);
        float v[32];
#pragma unroll
        for (int j = 0; j < 32; ++j) v[j] = src[(size_t)(k32 * 32 + j) * 2048];
#pragma unroll
        for (int q = 0; q < 4; ++q) *(uint4*)(dst + (size_t)n * 1024 + k32 * 32 + q * 8) = uint4{pack2(v[8 * q], v[8 * q + 1]), pack2(v[8 * q + 2], v[8 * q + 3]), pack2(v[8 * q + 4], v[8 * q + 5]), pack2(v[8 * q + 6], v[8 * q + 7])};
    }
#else
    for (size_t i = GTID; i < (size_t)4096 * 1024; i += GSTRIDE) { const int n = (int)(i / 1024), k = (int)(i % 1024); const int j = n & 255; const float* src = j >= 128 ? su : sg; dst[i] = f2bf(src[(size_t)k * 2048 + (n >> 8) * 128 + (j & 127)]); }
#endif
}
DEV void ph_convert_small(const P& p) {
    convT(p.w_in, NIN, 1024, p.WinT, NIN_PAD, CmIdent{NIN});
    convT(p.w_out, 1024, 2048, p.WoutT, 1024, CmIdent{1024});
    convT(p.cw_in, 3072, 1024, p.WciT, 3072, CmOddIn{});
    convT(p.cw_out, 1024, 1024, p.WcoT, 1024, CmIdent{1024});
    for (size_t i = GTID; i < (size_t)SEQ * 8; i += GSTRIDE) {
        const int pos = (int)(i >> 3), j = (int)(i & 7);
        const float inv = powf(500000.0f, -((float)j * 2.0f / 16.0f)); const float ang = (float)pos * inv;
        p.rope[(size_t)pos * 16 + j] = cosf(ang); p.rope[(size_t)pos * 16 + 8 + j] = sinf(ang);
    }
}
DEV void ph_convert_experts(const P& p, int layer) {
    for (int e = 0; e < NE; ++e) {
        const size_t off = ((size_t)layer * NE + e) * 1024 * 2048;
        conv_gateup(p.wg + off, p.wu + off, p.WguT + (size_t)e * 4096 * 1024);
        convT(p.wd + off, 1024, 2048, p.WdT + (size_t)e * 1024 * 2048, 1024, CmIdent{1024});
    }
}

constexpr int NV = 256 / LANES;
DEV void ph_rmsnorm(const float* src, const float* g, bf16_t* dst) {
    for (size_t row = GWAVE; row < (size_t)T; row += NWAVES_G) {
        const float4* s4 = (const float4*)(src + row * 1024); float4 v[NV]; float ss = 0.f;
#pragma unroll
        for (int j = 0; j < NV; ++j) { v[j] = s4[j * LANES + LANE]; ss += v[j].x * v[j].x + v[j].y * v[j].y + v[j].z * v[j].z + v[j].w * v[j].w; }
        ss = wave_sum(ss); const float r = 1.0f / sqrtf(ss * (1.0f / 1024.0f) + 1e-6f);
#pragma unroll
        for (int j = 0; j < NV; ++j) { const int c4 = j * LANES + LANE; const float4 gg = ((const float4*)g)[c4];
            *(uint2*)(dst + row * 1024 + c4 * 4) = uint2{pack2(v[j].x * r * gg.x, v[j].y * r * gg.y), pack2(v[j].z * r * gg.z, v[j].w * r * gg.w)}; }
    }
}
DEV void ph_norm_router(const P& p, int layer) {
    const float* g = p.ffn_norm + (size_t)layer * 1024; const float* rw = p.router_w + (size_t)layer * 1024 * 16;
    for (size_t row = GWAVE; row < (size_t)T; row += NWAVES_G) {
        const float4* s4 = (const float4*)(p.out + row * 1024); float4 v[NV]; float ss = 0.f;
#pragma unroll
        for (int j = 0; j < NV; ++j) { v[j] = s4[j * LANES + LANE]; ss += v[j].x * v[j].x + v[j].y * v[j].y + v[j].z * v[j].z + v[j].w * v[j].w; }
        ss = wave_sum(ss); const float r = 1.0f / sqrtf(ss * (1.0f / 1024.0f) + 1e-6f);
        float lg[16];
#pragma unroll
        for (int e = 0; e < 16; ++e) lg[e] = 0.f;
#pragma unroll
        for (int j = 0; j < NV; ++j) { const int c4 = j * LANES + LANE; const float4 gg = ((const float4*)g)[c4];
            const float h0 = v[j].x * r * gg.x, h1 = v[j].y * r * gg.y, h2 = v[j].z * r * gg.z, h3 = v[j].w * r * gg.w;
            *(uint2*)(p.hn + row * 1024 + c4 * 4) = uint2{pack2(h0, h1), pack2(h2, h3)};
            const float4* w4 = (const float4*)(rw + (size_t)c4 * 4 * 16);
#pragma unroll
            for (int q = 0; q < 4; ++q) { const float4 a = w4[q], b = w4[4 + q], c = w4[8 + q], d = w4[12 + q];
                lg[4 * q + 0] += h0 * a.x + h1 * b.x + h2 * c.x + h3 * d.x; lg[4 * q + 1] += h0 * a.y + h1 * b.y + h2 * c.y + h3 * d.y;
                lg[4 * q + 2] += h0 * a.z + h1 * b.z + h2 * c.z + h3 * d.z; lg[4 * q + 3] += h0 * a.w + h1 * b.w + h2 * c.w + h3 * d.w; } }
        float mx = -1e30f;
#pragma unroll
        for (int e = 0; e < 16; ++e) { lg[e] = wave_sum(lg[e]); mx = fmaxf(mx, lg[e]); }
        float den = 0.f;
#pragma unroll
        for (int e = 0; e < 16; ++e) { lg[e] = expf(lg[e] - mx); den += lg[e]; }
        const float inv = 1.0f / den; const int b = (int)(row / SEQ), s = (int)(row % SEQ);
#pragma unroll
        for (int e = 0; e < 16; ++e) if (LANE == (e & (LANES - 1))) p.aff[((size_t)b * NE + e) * SEQ + s] = lg[e] * inv;
    }
}
DEV void ph_gated_norm(const P& p) {
    for (size_t row = GWAVE; row < (size_t)T; row += NWAVES_G) {
        float4 v[NV]; float ss = 0.f;
#pragma unroll
        for (int j = 0; j < NV; ++j) { const int c4 = j * LANES + LANE; const uint2 y = *(const uint2*)(p.yssd + row * 1024 + c4 * 4), zz = *(const uint2*)(p.z + row * 1024 + c4 * 4);
            v[j].x = bf2f((bf16_t)(y.x & 0xffff)) * silu_f(bf2f((bf16_t)(zz.x & 0xffff))); v[j].y = bf2f((bf16_t)(y.x >> 16)) * silu_f(bf2f((bf16_t)(zz.x >> 16)));
            v[j].z = bf2f((bf16_t)(y.y & 0xffff)) * silu_f(bf2f((bf16_t)(zz.y & 0xffff))); v[j].w = bf2f((bf16_t)(y.y >> 16)) * silu_f(bf2f((bf16_t)(zz.y >> 16)));
            ss += v[j].x * v[j].x + v[j].y * v[j].y + v[j].z * v[j].z + v[j].w * v[j].w; }
        ss = wave_sum(ss); const float r = 1.0f / sqrtf(ss * (1.0f / 1024.0f) + 1e-6f);
#pragma unroll
        for (int j = 0; j < NV; ++j) { const int c4 = j * LANES + LANE; const float4 gg = ((const float4*)p.out_norm)[c4];
            *(uint2*)(p.mix + row * 2048 + 1024 + c4 * 4) = uint2{pack2(v[j].x * r * gg.x, v[j].y * r * gg.y), pack2(v[j].z * r * gg.z, v[j].w * r * gg.w)}; }
    }
}
DEV void ph_combine(const P& p, const float* g) {
    for (size_t row = GWAVE; row < (size_t)T; row += NWAVES_G) {
        const int b = (int)(row / SEQ), s = (int)(row % SEQ);
        float4* o4 = (float4*)(p.out + row * 1024); float4 v[NV];
#pragma unroll
        for (int j = 0; j < NV; ++j) v[j] = o4[j * LANES + LANE];
        for (int e = 0; e < NE; ++e) {
            const int sl = p.slotmap[((size_t)b * NE + e) * SEQ + s];
            if (sl >= 0) { const size_t r = ((size_t)b * NE + e) * CAP + sl; const float gt = p.gate[r];
#pragma unroll
                for (int j = 0; j < NV; ++j) { const int c4 = j * LANES + LANE; const uint2 y = *(const uint2*)(p.ye + r * 1024 + c4 * 4);
                    v[j].x += gt * bf2f((bf16_t)(y.x & 0xffff)); v[j].y += gt * bf2f((bf16_t)(y.x >> 16)); v[j].z += gt * bf2f((bf16_t)(y.y & 0xffff)); v[j].w += gt * bf2f((bf16_t)(y.y >> 16)); } }
        }
        float ss = 0.f;
#pragma unroll
        for (int j = 0; j < NV; ++j) { o4[j * LANES + LANE] = v[j]; ss += v[j].x * v[j].x + v[j].y * v[j].y + v[j].z * v[j].z + v[j].w * v[j].w; }
        if (g) { ss = wave_sum(ss); const float r = 1.0f / sqrtf(ss * (1.0f / 1024.0f) + 1e-6f);
#pragma unroll
            for (int j = 0; j < NV; ++j) { const int c4 = j * LANES + LANE; const float4 gg = ((const float4*)g)[c4];
                *(uint2*)(p.hn + row * 1024 + c4 * 4) = uint2{pack2(v[j].x * r * gg.x, v[j].y * r * gg.y), pack2(v[j].z * r * gg.z, v[j].w * r * gg.w)}; } }
    }
}

DEV void ld8(const bf16_t* p, float (&f)[8]) { const uint4 u = *(const uint4*)p; const unsigned w[4] = {u.x, u.y, u.z, u.w};
#pragma unroll
    for (int j = 0; j < 4; ++j) { f[2 * j] = bf2f((bf16_t)(w[j] & 0xffff)); f[2 * j + 1] = bf2f((bf16_t)(w[j] >> 16)); } }
DEV void st8(bf16_t* p, const float (&f)[8]) { *(uint4*)p = uint4{pack2(f[0], f[1]), pack2(f[2], f[3]), pack2(f[4], f[5]), pack2(f[6], f[7])}; }

DEV void ph_prep(const P& p, bool doqk = true) {
    for (size_t i = GTID; doqk && i < (size_t)T * 32; i += GSTRIDE) {
        const size_t t = i >> 5; const int hh = (int)(i & 31); const int isk = hh >> 4, h = hh & 15; const int pos = (int)(t % SEQ);
        bf16_t* ptr = p.qkv + t * 3072 + isk * 1024 + h * 64; const float* gn = isk ? p.k_norm : p.q_norm;
        float v[64]; float ss = 0.f;
#pragma unroll
        for (int c = 0; c < 8; ++c) { float f[8]; ld8(ptr + c * 8, f);
#pragma unroll
            for (int j = 0; j < 8; ++j) { v[c * 8 + j] = f[j]; ss += f[j] * f[j]; } }
        const float r = 1.0f / sqrtf(ss * (1.0f / 64.0f) + 1e-6f);
#pragma unroll
        for (int c = 0; c < 64; ++c) v[c] = v[c] * r * gn[c];
#pragma unroll
        for (int j = 0; j < 8; ++j) { const float cs = p.rope[(size_t)pos * 16 + j], sn = p.rope[(size_t)pos * 16 + 8 + j]; const float x1 = v[j], x2 = v[8 + j]; v[j] = x1 * cs - x2 * sn; v[8 + j] = x2 * cs + x1 * sn; }
#pragma unroll
        for (int c = 0; c < 8; ++c) { float f[8];
#pragma unroll
            for (int j = 0; j < 8; ++j) f[j] = v[c * 8 + j];
            st8(ptr + c * 8, f); }
    }
    for (size_t i = GTID; i < (size_t)T * 192; i += GSTRIDE) {
        const size_t t = i % T; const int c8 = (int)(i / T) * 8; const int pos = (int)(t % SEQ); const int b = (int)(t / SEQ);
        float acc[8];
#pragma unroll
        for (int j = 0; j < 8; ++j) acc[j] = p.conv_b[c8 + j];
#pragma unroll
        for (int k = 0; k < 5; ++k) { const int pp = pos + k - 2; if (pp < 0 || pp >= SEQ) continue; float f[8]; ld8(p.xbcraw + (t + k - 2) * 1536 + c8, f);
#pragma unroll
            for (int j = 0; j < 8; ++j) acc[j] += f[j] * p.conv_w[k * 1536 + c8 + j]; }
#pragma unroll
        for (int j = 0; j < 8; ++j) acc[j] = silu_f(acc[j]);
        if (c8 < 1024) {
#pragma unroll
            for (int j = 0; j < 8; ++j) p.xsT[((size_t)b * 1024 + c8 + j) * SEQ + pos] = f2bf(acc[j]);
        } else {
            st8(p.bc + t * 512 + (c8 - 1024), acc);
            if (c8 < 1280) {
#pragma unroll
                for (int j = 0; j < 8; ++j) p.bmT[((size_t)b * 256 + (c8 - 1024) + j) * SEQ + pos] = f2bf(acc[j]); }
        }
    }
    for (size_t i = GTID; i < (size_t)BATCH * NCHUNK * 32; i += GSTRIDE) {
        const int j = (int)(i & 31); const int c = (int)((i >> 5) % NCHUNK), b = (int)((i >> 5) / NCHUNK); const int dir = j >> 4, h = j & 15;
        const float A = -expf(dir ? p.a_log_b[h] : p.a_log_f[h]), bias = dir ? p.dtb_b[h] : p.dtb_f[h];
        const size_t row0 = (size_t)b * SEQ + (size_t)c * 128; float* stT = p.stT + ((size_t)b * 32 + j) * SEQ + c * 128; float* csT = p.csT + ((size_t)b * 32 + j) * SEQ + c * 128; float* wdT = p.wdT + ((size_t)b * 32 + j) * SEQ + c * 128;
        float run = 0.f;
        for (int ll = 0; ll < 128; ++ll) { const int l = dir ? 127 - ll : ll; const float dt = softplus_f(p.dtraw[(row0 + l) * 32 + j] + bias); p.step[(row0 + l) * 32 + j] = dt; stT[l] = dt; run += dt * A; csT[l] = run; }
        for (int l = 0; l < 128; ++l) wdT[l] = stT[l] * expf(run - csT[l]);
        p.cdec[((size_t)b * 32 + j) * NCHUNK + c] = expf(run);
    }
}
DEV void ph_gather(const P& p) {
    for (size_t i = GTID; i < (size_t)NSLOT * 128; i += GSTRIDE) { const size_t r = i >> 7; const int j = (int)(i & 127); const int b = (int)(r / ((size_t)NE * CAP));
        *(uint4*)(p.xe + r * 1024 + j * 8) = *(const uint4*)(p.hn + ((size_t)b * SEQ + p.idx[r]) * 1024 + j * 8); }
}
DEV void ph_conv3(const P& p) {
    for (size_t i = GTID; i < (size_t)T * 128; i += GSTRIDE) {
        const size_t t = i >> 7; const int c8 = (int)(i & 127) * 8; const int pos = (int)(t % SEQ);
        float acc[8], f[8];
#pragma unroll
        for (int j = 0; j < 8; ++j) acc[j] = 0.f;
#pragma unroll
        for (int k = 0; k < 3; ++k) { const int pp = pos + k - 1; if (pp < 0 || pp >= SEQ) continue; ld8(p.pbuf + (t + k - 1) * 1024 + c8, f);
#pragma unroll
            for (int j = 0; j < 8; ++j) acc[j] += f[j] * p.cw[k * 1024 + c8 + j]; }
        ld8(p.gb + t * 1024 + c8, f);
#pragma unroll
        for (int j = 0; j < 8; ++j) acc[j] *= f[j];
        st8(p.abuf + t * 1024 + c8, acc);
    }
}

DEV float dot_bf(const bf16_t* a, const bf16_t* b, int K) { float acc = 0.f; for (int k = 0; k < K; k += 8) { float fa[8], fb[8]; ld8(a + k, fa); ld8(b + k, fb);
#pragma unroll
        for (int j = 0; j < 8; ++j) acc += fa[j] * fb[j]; } return acc; }
DEV void nv_g1(const P& p) {
    for (size_t i = GTID; i < (size_t)T * NIN; i += GSTRIDE) { const size_t m = i / NIN; const int n = (int)(i % NIN); const float acc = dot_bf(p.hn + m * 1024, p.WinT + (size_t)n * 1024, 1024);
        if (n < 3072) p.qkv[m * 3072 + n] = f2bf(acc); else if (n < 4096) p.z[m * 1024 + n - 3072] = f2bf(acc); else if (n < 5632) p.xbcraw[m * 1536 + n - 4096] = f2bf(acc); else p.dtraw[m * 32 + n - 5632] = acc; }
}
DEV void nv_g2(const P& p) {
    for (size_t i = GTID; i < (size_t)T * 1024; i += GSTRIDE) { const size_t m = i >> 10; const int n = (int)(i & 1023); p.out[i] = p.x[i] + dot_bf(p.mix + m * 2048, p.WoutT + (size_t)n * 2048, 2048); }
}
DEV void nv_up(const P& p) {
    for (size_t i = GTID; i < (size_t)NSLOT * 2048; i += GSTRIDE) { const size_t r = i >> 11; const int n = (int)(i & 2047); const int e = (int)((r / CAP) % NE);
        const bf16_t* w = p.WguT + (size_t)e * 4096 * 1024 + (size_t)((n >> 7) * 256 + (n & 127)) * 1024;
        const float g = dot_bf(p.xe + r * 1024, w, 1024), u = dot_bf(p.xe + r * 1024, w + (size_t)128 * 1024, 1024); p.hid[i] = f2bf(silu_f(g) * u); }
}
DEV void nv_down(const P& p) {
    for (size_t i = GTID; i < (size_t)NSLOT * 1024; i += GSTRIDE) { const size_t r = i >> 10; const int n = (int)(i & 1023); const int e = (int)((r / CAP) % NE);
        p.ye[i] = f2bf(dot_bf(p.hid + r * 2048, p.WdT + (size_t)e * 1024 * 2048 + (size_t)n * 2048, 2048)); }
}
DEV void nv_g3(const P& p) {
    for (size_t i = GTID; i < (size_t)T * 2048; i += GSTRIDE) { const size_t m = i >> 11; const int n = (int)(i & 2047);
        if (n < 1024) { const bf16_t* w = p.WciT + (size_t)((n >> 7) * 256 + (n & 127)) * 1024; p.pbuf[m * 1024 + n] = f2bf(dot_bf(p.hn + m * 1024, w, 1024) * dot_bf(p.hn + m * 1024, w + (size_t)128 * 1024, 1024)); }
        else p.gb[m * 1024 + n - 1024] = f2bf(dot_bf(p.hn + m * 1024, p.WciT + (size_t)(2048 + n - 1024) * 1024, 1024)); }
}
DEV void nv_g4(const P& p) {
    for (size_t i = GTID; i < (size_t)T * 1024; i += GSTRIDE) { const size_t m = i >> 10; const int n = (int)(i & 1023); p.out[i] += dot_bf(p.abuf + m * 1024, p.WcoT + (size_t)n * 1024, 1024); }
}
DEV void nv_attn(const P& p) {
    for (size_t i = GTID; i < (size_t)T * 16; i += GSTRIDE) {
        const size_t t = i >> 4; const int h = (int)(i & 15); const int pos = (int)(t % SEQ); const size_t t0 = t - pos;
        const bf16_t* qp = p.qkv + t * 3072 + h * 64;
        float o[64]; float m = -1e30f, l = 0.f;
#pragma unroll
        for (int c = 0; c < 64; ++c) o[c] = 0.f;
        for (int pat = 0; pat < 3; ++pat) { const int d = pat == 0 ? 1 : (pat == 1 ? 4 : 16);
            for (int j = -64; j <= 64; ++j) { const int kp = pos + d * j; if (kp < 0 || kp >= SEQ) continue;
                const bf16_t* kr = p.qkv + (t0 + kp) * 3072 + 1024 + h * 64; const bf16_t* vr = kr + 1024;
                const float s = dot_bf(qp, kr, 64) * 0.125f;
                const float mn = fmaxf(m, s), sc = expf(m - mn), pe = expf(s - mn); l = l * sc + pe; m = mn;
#pragma unroll
                for (int c = 0; c < 8; ++c) { float f[8]; ld8(vr + c * 8, f);
#pragma unroll
                    for (int q = 0; q < 8; ++q) o[c * 8 + q] = o[c * 8 + q] * sc + pe * f[q]; } } }
        const float inv = 1.0f / l;
#pragma unroll
        for (int c = 0; c < 8; ++c) { float f[8];
#pragma unroll
            for (int q = 0; q < 8; ++q) f[q] = o[c * 8 + q] * inv;
            st8(p.mix + t * 2048 + h * 64 + c * 8, f); }
    }
}
DEV void nv_ssd(const P& p) {
    const size_t nitem = (size_t)BATCH * 16 * 64;
#ifndef HOST_EMU
    if (LANE != 0) return;
#endif
    for (size_t it = GWAVE; it < nitem; it += NWAVES_G) {
        const int b = (int)(it / 1024), h = (int)((it >> 6) & 15), pc = (int)(it & 63), g = h >> 3;
        const float af = -expf(p.a_log_f[h]), ab = -expf(p.a_log_b[h]), dsk = p.ssd_d[h];
        float st[128];
        for (int dir = 0; dir < 2; ++dir) {
#pragma unroll
            for (int n = 0; n < 128; ++n) st[n] = 0.f;
            for (int tt = 0; tt < SEQ; ++tt) { const int s = dir ? SEQ - 1 - tt : tt; const size_t row = (size_t)b * SEQ + s;
                const float dt = p.step[row * 32 + dir * 16 + h]; const float dec = expf(dt * (dir ? ab : af)); const float xv = bf2f(p.xsT[((size_t)b * 1024 + h * 64 + pc) * SEQ + s]); const float xdt = xv * dt;
                const bf16_t* bm = p.bc + row * 512 + g * 128; const bf16_t* cm = bm + 256; float y = 0.f;
#pragma unroll
                for (int n8 = 0; n8 < 16; ++n8) { float fb[8], fc[8]; ld8(bm + n8 * 8, fb); ld8(cm + n8 * 8, fc);
#pragma unroll
                    for (int j = 0; j < 8; ++j) { st[n8 * 8 + j] = st[n8 * 8 + j] * dec + xdt * fb[j]; y += fc[j] * st[n8 * 8 + j]; } }
                if (dir == 0) p.ytmp[row * 1024 + h * 64 + pc] = y; else p.yssd[row * 1024 + h * 64 + pc] = f2bf(p.ytmp[row * 1024 + h * 64 + pc] + y + xv * dsk); }
        }
    }
}
DEV void nv_topk(const P& p) {
    for (size_t i = GTID; i < (size_t)BATCH * NE * SEQ; i += GSTRIDE) { const size_t be = i / SEQ; const int s = (int)(i % SEQ); const float* a = p.aff + be * SEQ; const float v = a[s]; int rank = 0;
        for (int j = 0; j < SEQ; ++j) { const float w = a[j]; rank += (w > v || (w == v && j < s)) ? 1 : 0; }
        if (rank < CAP) { p.idx[be * CAP + rank] = s; p.gate[be * CAP + rank] = v; p.slotmap[i] = rank; } else p.slotmap[i] = -1; }
}

static void make_params(P& p, void* const* d_in, void* d_out, void* d_ws) {
    const float** ins = (const float**)&p.x;
    for (int i = 0; i < 23; ++i) ins[i] = (const float*)d_in[i];
    p.out = (float*)d_out;
    unsigned char* ws = (unsigned char*)d_ws;
    p.WinT = (bf16_t*)(ws + WS_WIN); p.WoutT = (bf16_t*)(ws + WS_WOUT); p.WciT = (bf16_t*)(ws + WS_WCI); p.WcoT = (bf16_t*)(ws + WS_WCO); p.WguT = (bf16_t*)(ws + WS_WGU); p.WdT = (bf16_t*)(ws + WS_WD);
    p.hn = (bf16_t*)(ws + WS_HN); p.qkv = (bf16_t*)(ws + WS_QKV); p.z = (bf16_t*)(ws + WS_Z); p.xbcraw = (bf16_t*)(ws + WS_XBCRAW); p.bc = (bf16_t*)(ws + WS_BC); p.xsT = (bf16_t*)(ws + WS_XST); p.bmT = (bf16_t*)(ws + WS_BMT); p.states = (bf16_t*)(ws + WS_STATES); p.mix = (bf16_t*)(ws + WS_MIX); p.yssd = (bf16_t*)(ws + WS_YSSD);
    p.xe = (bf16_t*)(ws + WS_XE); p.hid = (bf16_t*)(ws + WS_HID); p.ye = (bf16_t*)(ws + WS_YE); p.pbuf = (bf16_t*)(ws + WS_PBUF); p.gb = (bf16_t*)(ws + WS_GB); p.abuf = (bf16_t*)(ws + WS_ABUF);
    p.dtraw = (float*)(ws + WS_DTRAW); p.step = (float*)(ws + WS_STEP); p.aff = (float*)(ws + WS_AFF); p.gate = (float*)(ws + WS_GATE); p.rope = (float*)(ws + WS_ROPE); p.ytmp = (float*)(ws + WS_STATES); p.stT = (float*)(ws + WS_STT); p.csT = (float*)(ws + WS_CST); p.wdT = (float*)(ws + WS_WDT); p.cdec = (float*)(ws + WS_CDEC);
    p.idx = (int*)(ws + WS_IDX); p.slotmap = (int*)(ws + WS_SMAP); p.bar = (unsigned*)(ws + WS_BAR);
}
#ifndef HOST_EMU
#define LAS __attribute__((address_space(3)))
typedef short bf16x8 __attribute__((ext_vector_type(8)));
typedef float f32x4 __attribute__((ext_vector_type(4)));
typedef unsigned u32x4 __attribute__((ext_vector_type(4)));
DEV void ph_norm_router_dev(const P& p, int layer) {
    const float4* g4 = (const float4*)(p.ffn_norm + (size_t)layer * 1024); const float4* rw4 = (const float4*)(p.router_w + (size_t)layer * 1024 * 16);
    const int lane = LANE;
    for (size_t row0 = GWAVE * 4; row0 < (size_t)T; row0 += NWAVES_G * 4) {
        float rinv[4];
        { float ss[4] = {0.f, 0.f, 0.f, 0.f};
#pragma unroll
          for (int j = 0; j < 4; ++j)
#pragma unroll
            for (int r = 0; r < 4; ++r) { const float4 t = ((const float4*)(p.out + (row0 + r) * 1024))[j * 64 + lane]; ss[r] += t.x * t.x + t.y * t.y + t.z * t.z + t.w * t.w; }
#pragma unroll
          for (int r = 0; r < 4; ++r) { const float q = wave_sum(ss[r]); rinv[r] = 1.0f / sqrtf(q * (1.0f / 1024.0f) + 1e-6f); } }
        float lg[4][16];
#pragma unroll
        for (int r = 0; r < 4; ++r)
#pragma unroll
            for (int e = 0; e < 16; ++e) lg[r][e] = 0.f;
#pragma unroll 1
        for (int j = 0; j < 4; ++j) { const int c4 = j * 64 + lane; const float4 gg = g4[c4]; float h[4][4];
#pragma unroll
            for (int r = 0; r < 4; ++r) { const float4 t = ((const float4*)(p.out + (row0 + r) * 1024))[c4];
                h[r][0] = t.x * rinv[r] * gg.x; h[r][1] = t.y * rinv[r] * gg.y; h[r][2] = t.z * rinv[r] * gg.z; h[r][3] = t.w * rinv[r] * gg.w;
                *(uint2*)(p.hn + (row0 + r) * 1024 + c4 * 4) = uint2{pack2(h[r][0], h[r][1]), pack2(h[r][2], h[r][3])}; }
#pragma unroll
            for (int cc = 0; cc < 4; ++cc) {
#pragma unroll
                for (int q = 0; q < 4; ++q) { const float4 w = rw4[(size_t)(c4 * 4 + cc) * 4 + q];
#pragma unroll
                    for (int r = 0; r < 4; ++r) { lg[r][4 * q] += h[r][cc] * w.x; lg[r][4 * q + 1] += h[r][cc] * w.y; lg[r][4 * q + 2] += h[r][cc] * w.z; lg[r][4 * q + 3] += h[r][cc] * w.w; } }
                asm volatile("" ::: "memory"); } }
#pragma unroll
        for (int r = 0; r < 4; ++r) { float mx = -1e30f;
#pragma unroll
            for (int e = 0; e < 16; ++e) { lg[r][e] = wave_sum(lg[r][e]); mx = fmaxf(mx, lg[r][e]); }
            float den = 0.f;
#pragma unroll
            for (int e = 0; e < 16; ++e) { lg[r][e] = expf(lg[r][e] - mx); den += lg[r][e]; }
            const float inv = 1.0f / den; const size_t row = row0 + r; const int b = (int)(row / SEQ), s = (int)(row % SEQ);
#pragma unroll
            for (int e = 0; e < 16; ++e) if (lane == e) p.aff[((size_t)b * NE + e) * SEQ + s] = lg[r][e] * inv; }
    }
}
DEV void ph_gated_norm_dev(const P& p) {
    const int lane = LANE;
    for (size_t row0 = GWAVE * 2; row0 < (size_t)T; row0 += NWAVES_G * 2) {
        uint2 yv[2][4], zv[2][4];
#pragma unroll
        for (int r = 0; r < 2; ++r)
#pragma unroll
            for (int j = 0; j < 4; ++j) { const int c4 = j * 64 + lane; yv[r][j] = *(const uint2*)(p.yssd + (row0 + r) * 1024 + c4 * 4); zv[r][j] = *(const uint2*)(p.z + (row0 + r) * 1024 + c4 * 4); }
#pragma unroll
        for (int r = 0; r < 2; ++r) { float4 v[4]; float ss = 0.f;
#pragma unroll
            for (int j = 0; j < 4; ++j) { const uint2 y = yv[r][j], zz = zv[r][j];
                const float z0 = __uint_as_float(zz.x << 16), z1 = __uint_as_float(zz.x & 0xffff0000u), z2 = __uint_as_float(zz.y << 16), z3 = __uint_as_float(zz.y & 0xffff0000u);
                v[j].x = __uint_as_float(y.x << 16) * z0 * __builtin_amdgcn_rcpf(1.0f + __expf(-z0)); v[j].y = __uint_as_float(y.x & 0xffff0000u) * z1 * __builtin_amdgcn_rcpf(1.0f + __expf(-z1));
                v[j].z = __uint_as_float(y.y << 16) * z2 * __builtin_amdgcn_rcpf(1.0f + __expf(-z2)); v[j].w = __uint_as_float(y.y & 0xffff0000u) * z3 * __builtin_amdgcn_rcpf(1.0f + __expf(-z3));
                ss += v[j].x * v[j].x + v[j].y * v[j].y + v[j].z * v[j].z + v[j].w * v[j].w; }
            ss = wave_sum(ss); const float rr = 1.0f / sqrtf(ss * (1.0f / 1024.0f) + 1e-6f);
#pragma unroll
            for (int j = 0; j < 4; ++j) { const int c4 = j * 64 + lane; const float4 gg = ((const float4*)p.out_norm)[c4];
                *(uint2*)(p.mix + (row0 + r) * 2048 + 1024 + c4 * 4) = uint2{pack2(v[j].x * rr * gg.x, v[j].y * rr * gg.y), pack2(v[j].z * rr * gg.z, v[j].w * rr * gg.w)}; } }
    }
}
DEV void ph_combine_dev(const P& p, const float* g) {
    const int lane = LANE;
    for (size_t row = GWAVE; row < (size_t)T; row += NWAVES_G) {
        const int b = (int)(row / SEQ), s = (int)(row % SEQ);
        int mysl = -1; float mygt = 0.f;
        if (lane < 16) { mysl = p.slotmap[((size_t)b * NE + lane) * SEQ + s]; if (mysl >= 0) mygt = p.gate[((size_t)b * NE + lane) * CAP + mysl]; }
        float4* o4 = (float4*)(p.out + row * 1024); float4 v[4];
#pragma unroll
        for (int j = 0; j < 4; ++j) v[j] = o4[j * 64 + lane];
        unsigned long long mask = __ballot(mysl >= 0);
        while (mask) {
            const int e = __builtin_ctzll(mask); mask &= mask - 1;
            const int sl = __shfl(mysl, e); const float gt = __shfl(mygt, e); const size_t r = ((size_t)b * NE + e) * CAP + sl;
            uint2 y[4];
#pragma unroll
            for (int j = 0; j < 4; ++j) y[j] = *(const uint2*)(p.ye + r * 1024 + (j * 64 + lane) * 4);
#pragma unroll
            for (int j = 0; j < 4; ++j) { v[j].x += gt * __uint_as_float(y[j].x << 16); v[j].y += gt * __uint_as_float(y[j].x & 0xffff0000u); v[j].z += gt * __uint_as_float(y[j].y << 16); v[j].w += gt * __uint_as_float(y[j].y & 0xffff0000u); }
        }
        float ss = 0.f;
#pragma unroll
        for (int j = 0; j < 4; ++j) { o4[j * 64 + lane] = v[j]; ss += v[j].x * v[j].x + v[j].y * v[j].y + v[j].z * v[j].z + v[j].w * v[j].w; }
        if (g) { ss = wave_sum(ss); const float rr = 1.0f / sqrtf(ss * (1.0f / 1024.0f) + 1e-6f);
#pragma unroll
            for (int j = 0; j < 4; ++j) { const int c4 = j * 64 + lane; const float4 gg = ((const float4*)g)[c4];
                *(uint2*)(p.hn + row * 1024 + c4 * 4) = uint2{pack2(v[j].x * rr * gg.x, v[j].y * rr * gg.y), pack2(v[j].z * rr * gg.z, v[j].w * rr * gg.w)}; } }
    }
}

DEV void ph_rmsnorm_dev(const float* src, const float* g, bf16_t* dst) {
    const int lane = LANE;
    for (size_t row0 = GWAVE * 4; row0 < (size_t)T; row0 += NWAVES_G * 4) {
        float4 v[4][4];
#pragma unroll
        for (int r = 0; r < 4; ++r)
#pragma unroll
            for (int j = 0; j < 4; ++j) v[r][j] = ((const float4*)(src + (row0 + r) * 1024))[j * 64 + lane];
#pragma unroll
        for (int r = 0; r < 4; ++r) { float ss = 0.f;
#pragma unroll
            for (int j = 0; j < 4; ++j) ss += v[r][j].x * v[r][j].x + v[r][j].y * v[r][j].y + v[r][j].z * v[r][j].z + v[r][j].w * v[r][j].w;
            ss = wave_sum(ss); const float rr = 1.0f / sqrtf(ss * (1.0f / 1024.0f) + 1e-6f);
#pragma unroll
            for (int j = 0; j < 4; ++j) { const int c4 = j * 64 + lane; const float4 gg = ((const float4*)g)[c4];
                *(uint2*)(dst + (row0 + r) * 1024 + c4 * 4) = uint2{pack2(v[r][j].x * rr * gg.x, v[r][j].y * rr * gg.y), pack2(v[r][j].z * rr * gg.z, v[r][j].w * rr * gg.w)}; } }
    }
}
DEV void ph_gather_dev(const P& p) {
    for (size_t i0 = GTID; i0 + 3 * GSTRIDE < (size_t)NSLOT * 128; i0 += GSTRIDE * 4) {
        const size_t i1 = i0 + GSTRIDE, i2 = i1 + GSTRIDE, i3 = i2 + GSTRIDE;
        const int t0 = p.idx[i0 >> 7], t1 = p.idx[i1 >> 7], t2 = p.idx[i2 >> 7], t3 = p.idx[i3 >> 7];
        const u32x4 v0 = *(const u32x4*)(p.hn + ((size_t)((i0 >> 7) / ((size_t)NE * CAP)) * SEQ + t0) * 1024 + (i0 & 127) * 8);
        const u32x4 v1 = *(const u32x4*)(p.hn + ((size_t)((i1 >> 7) / ((size_t)NE * CAP)) * SEQ + t1) * 1024 + (i1 & 127) * 8);
        const u32x4 v2 = *(const u32x4*)(p.hn + ((size_t)((i2 >> 7) / ((size_t)NE * CAP)) * SEQ + t2) * 1024 + (i2 & 127) * 8);
        const u32x4 v3 = *(const u32x4*)(p.hn + ((size_t)((i3 >> 7) / ((size_t)NE * CAP)) * SEQ + t3) * 1024 + (i3 & 127) * 8);
        *(u32x4*)(p.xe + (i0 >> 7) * 1024 + (i0 & 127) * 8) = v0; *(u32x4*)(p.xe + (i1 >> 7) * 1024 + (i1 & 127) * 8) = v1;
        *(u32x4*)(p.xe + (i2 >> 7) * 1024 + (i2 & 127) * 8) = v2; *(u32x4*)(p.xe + (i3 >> 7) * 1024 + (i3 & 127) * 8) = v3;
    }
}
DEV void ph_conv3_dev(const P& p) {
    for (size_t i0 = GTID; i0 < (size_t)T * 128; i0 += GSTRIDE * 4) {
        uint4 a[4][3], gbv[4];
#pragma unroll
        for (int q = 0; q < 4; ++q) { const size_t i = i0 + q * GSTRIDE; const size_t t = i >> 7; const int c8 = (int)(i & 127) * 8, pos = (int)(t % SEQ);
#pragma unroll
            for (int k = 0; k < 3; ++k) { const int pp = pos + k - 1; a[q][k] = (pp < 0 || pp >= SEQ) ? uint4{0u, 0u, 0u, 0u} : *(const uint4*)(p.pbuf + (t + k - 1) * 1024 + c8); }
            gbv[q] = *(const uint4*)(p.gb + t * 1024 + c8); }
#pragma unroll
        for (int q = 0; q < 4; ++q) { const size_t i = i0 + q * GSTRIDE; const size_t t = i >> 7; const int c8 = (int)(i & 127) * 8;
            float acc[8], f[8];
#pragma unroll
            for (int j = 0; j < 8; ++j) acc[j] = 0.f;
#pragma unroll
            for (int k = 0; k < 3; ++k) { const unsigned w[4] = {a[q][k].x, a[q][k].y, a[q][k].z, a[q][k].w};
#pragma unroll
                for (int j = 0; j < 4; ++j) { acc[2 * j] += __uint_as_float(w[j] << 16) * p.cw[k * 1024 + c8 + 2 * j]; acc[2 * j + 1] += __uint_as_float(w[j] & 0xffff0000u) * p.cw[k * 1024 + c8 + 2 * j + 1]; } }
            { const unsigned w[4] = {gbv[q].x, gbv[q].y, gbv[q].z, gbv[q].w};
#pragma unroll
              for (int j = 0; j < 4; ++j) { f[2 * j] = acc[2 * j] * __uint_as_float(w[j] << 16); f[2 * j + 1] = acc[2 * j + 1] * __uint_as_float(w[j] & 0xffff0000u); } }
            st8(p.abuf + t * 1024 + c8, f); }
    }
}
DEV void ph_combine_dev4(const P& p, const float* g) {
    const int lane = LANE, rsub = lane >> 4, e16 = lane & 15;
    for (size_t row0 = GWAVE * 4; row0 < (size_t)T; row0 += NWAVES_G * 4) {
        const int b = (int)(row0 / SEQ), s0 = (int)(row0 % SEQ);
        const int mysl = p.slotmap[((size_t)b * NE + e16) * SEQ + s0 + rsub];
        float4 v[4][4];
#pragma unroll
        for (int r = 0; r < 4; ++r)
#pragma unroll
            for (int j = 0; j < 4; ++j) v[r][j] = ((const float4*)(p.out + (row0 + r) * 1024))[j * 64 + lane];
        const float mygt = mysl >= 0 ? p.gate[((size_t)b * NE + e16) * CAP + mysl] : 0.f;
        const unsigned long long mall = __ballot(mysl >= 0);
        unsigned m[4];
#pragma unroll
        for (int r = 0; r < 4; ++r) m[r] = (unsigned)((mall >> (16 * r)) & 0xffffull);
        while (m[0] | m[1] | m[2] | m[3]) {
            uint2 y[4][4]; float gt[4];
#pragma unroll
            for (int r = 0; r < 4; ++r) { gt[r] = 0.f;
                if (m[r]) { const int e = __builtin_ctz(m[r]); m[r] &= m[r] - 1; const int sl = __shfl(mysl, 16 * r + e); gt[r] = __shfl(mygt, 16 * r + e); const size_t rr = ((size_t)b * NE + e) * CAP + sl;
#pragma unroll
                    for (int j = 0; j < 4; ++j) y[r][j] = *(const uint2*)(p.ye + rr * 1024 + (j * 64 + lane) * 4); }
                else {
#pragma unroll
                    for (int j = 0; j < 4; ++j) y[r][j] = uint2{0u, 0u}; } }
#pragma unroll
            for (int r = 0; r < 4; ++r)
#pragma unroll
                for (int j = 0; j < 4; ++j) { v[r][j].x += gt[r] * __uint_as_float(y[r][j].x << 16); v[r][j].y += gt[r] * __uint_as_float(y[r][j].x & 0xffff0000u); v[r][j].z += gt[r] * __uint_as_float(y[r][j].y << 16); v[r][j].w += gt[r] * __uint_as_float(y[r][j].y & 0xffff0000u); }
        }
#pragma unroll
        for (int r = 0; r < 4; ++r) { float ss = 0.f;
#pragma unroll
            for (int j = 0; j < 4; ++j) { ((float4*)(p.out + (row0 + r) * 1024))[j * 64 + lane] = v[r][j]; ss += v[r][j].x * v[r][j].x + v[r][j].y * v[r][j].y + v[r][j].z * v[r][j].z + v[r][j].w * v[r][j].w; }
            if (g) { ss = wave_sum(ss); const float rr = 1.0f / sqrtf(ss * (1.0f / 1024.0f) + 1e-6f);
#pragma unroll
                for (int j = 0; j < 4; ++j) { const int c4 = j * 64 + lane; const float4 gg = ((const float4*)g)[c4];
                    *(uint2*)(p.hn + (row0 + r) * 1024 + c4 * 4) = uint2{pack2(v[r][j].x * rr * gg.x, v[r][j].y * rr * gg.y), pack2(v[r][j].z * rr * gg.z, v[r][j].w * rr * gg.w)}; } } }
    }
}

namespace pg8 {
constexpr int BM = 256, BK = 64, HALF = 128, HTB = HALF * BK * 2  , STAGE_BYTES = 8 * HTB, NXCD = 8, WGM = 8;
DEV int lds_byte(int r, int c) { const int st = (r >> 4) * 2 + (c >> 5), rr = r & 15, cc = c & 31, ob = rr * 64 + cc * 2; return st * 1024 + (ob ^ (((ob >> 9) & 1) << 5)); }
DEV void stage_rc(int b, int& R, int& C) { const int st = b / 1024, sb = b % 1024, swz = sb ^ (((sb >> 9) & 1) << 5); R = (st >> 1) * 16 + swz / 64; C = (st & 1) * 32 + (swz % 64) / 2; }
DEV int perm32(int rho) { const int n = rho >> 4, i = rho & 15; return 8 * (i >> 2) + 4 * n + (i & 3); }
struct Unit { int row0, col0, brow0; };
struct StaticOrder {
    int nM, nN, nwg, G, c, brows, tpg, rev;
    DEV void init(int M, int N, int G_, int c_, int brows_, int tpg_, int rev_ = 0) { nM = M / BM; nN = N / BM; nwg = nM * nN; G = G_; c = c_; brows = brows_; tpg = tpg_; rev = rev_; }
    DEV bool next(int i, Unit& u) const {
        const int nr = (nwg + G - 1) / G; if (i >= nr) return false;
        const long L = (long)(rev ? nr - 1 - i : i) * G + c; if (L >= nwg) return false;
        int wgid = (int)L; { const int q = nwg / NXCD, r = nwg % NXCD, xcd = wgid % NXCD, off = wgid / NXCD; wgid = (xcd < r ? xcd * (q + 1) : r * (q + 1) + (xcd - r) * q) + off; }
        const int nig = WGM * nN, gid = wgid / nig, fm = gid * WGM, gsz = (nM - fm) < WGM ? (nM - fm) : WGM;
        const int pm = fm + ((wgid % nig) % gsz), pn = (wgid % nig) / gsz;
        u.row0 = pm * BM; u.col0 = pn * BM; u.brow0 = pn * BM + (brows ? ((pm / tpg) % NE) * brows : 0); return true;
    }
};
DEV unsigned cvt_pk_bf16(float lo, float hi) { unsigned r; asm volatile("v_cvt_pk_bf16_f32 %0, %1, %2" : "=v"(r) : "v"(lo), "v"(hi)); return r; }
typedef float f32x2_t __attribute__((ext_vector_type(2)));
typedef __bf16 bf16x2_t __attribute__((ext_vector_type(2)));
DEV unsigned cvt_pk_safe(float lo, float hi) { const f32x2_t v = {lo, hi}; return __builtin_bit_cast(unsigned, __builtin_convertvector(v, bf16x2_t)); }

typedef int i32x8 __attribute__((ext_vector_type(8)));
typedef int i32x4 __attribute__((ext_vector_type(4)));
template <bool F8> DEV void pg8_mma(f32x4 (&acc)[4][2], const i32x8 (&At)[4], const i32x8 (&Bq)[2]) {
    __builtin_amdgcn_s_setprio(1);
    if constexpr (F8) {
        const int one = 127;
#pragma unroll
        for (int m = 0; m < 4; ++m)
#pragma unroll
            for (int n = 0; n < 2; ++n) asm volatile("v_mfma_scale_f32_16x16x128_f8f6f4 %0, %1, %2, %0, %3, %3 op_sel_hi:[0,0,0]" : "+v"(acc[m][n]) : "v"(Bq[n]), "v"(At[m]), "v"(one));
    } else {
#pragma unroll
        for (int m = 0; m < 4; ++m)
#pragma unroll
            for (int n = 0; n < 2; ++n) {
                acc[m][n] = __builtin_amdgcn_mfma_f32_16x16x32_bf16(__builtin_bit_cast(bf16x8, __builtin_shufflevector(Bq[n], Bq[n], 0, 1, 2, 3)), __builtin_bit_cast(bf16x8, __builtin_shufflevector(At[m], At[m], 0, 1, 2, 3)), acc[m][n], 0, 0, 0);
                acc[m][n] = __builtin_amdgcn_mfma_f32_16x16x32_bf16(__builtin_bit_cast(bf16x8, __builtin_shufflevector(Bq[n], Bq[n], 4, 5, 6, 7)), __builtin_bit_cast(bf16x8, __builtin_shufflevector(At[m], At[m], 4, 5, 6, 7)), acc[m][n], 0, 0, 0); }
    }
    __builtin_amdgcn_s_setprio(0);
}
template <class Epi, class Sched, bool F8 = false>
DEV void gemm_phase(LAS unsigned char* lds, const bf16_t* A, const bf16_t* Bt, const int K, const Sched& S, const Epi& E) {
    const int tid = threadIdx.x, wid = __builtin_amdgcn_readfirstlane(tid >> 6), lane = tid & 63, wr = wid >> 2, wc = wid & 3, fr = lane & 15, fq = lane >> 4;
    const int nt = K / BK;
    unsigned voffA[2], voffB[2];
#pragma unroll
    for (int i = 0; i < 2; ++i) { int R, C; stage_rc(tid * 16 + i * 8192, R, C); const int Rb = Epi::PERM ? ((R & ~31) + perm32(R & 31)) : R;
        voffA[i] = (unsigned)(R * K + C) * 2u; voffB[i] = (unsigned)(Rb * K + C) * 2u; }
    const size_t kstep = (size_t)(BK * 2);
    const size_t hstep = (size_t)HALF * K * 2;
    const size_t rstep = (size_t)K * 2;
    const unsigned ldsw = (unsigned)wid * 1024u;
    const int aoff = lds_byte(wr * 64 + fr, fq * 8), boff = lds_byte(wc * 32 + fr, fq * 8);
#define PG8_SA(b, h) (((b) * 2 + (h)) * HTB)
#define PG8_SB(b, h) ((4 + (b) * 2 + (h)) * HTB)
#define PG8_STAGE(bufoff, gbase, voff) do { _Pragma("unroll") for (int _i = 0; _i < 2; ++_i) \
        __builtin_amdgcn_global_load_lds((const unsigned*)((const char*)(gbase) + (voff)[_i]), (LAS unsigned*)(lds + (bufoff) + ldsw + _i * 8192), 16, 0, 0); } while (0)
#define PG8_LDA(dst, b, h) do { _Pragma("unroll") for (int m = 0; m < 4; ++m) dst[m] = __builtin_shufflevector(*(const LAS i32x4*)(lds + PG8_SA(b, h) + aoff + m * 2048), *(const LAS i32x4*)(lds + PG8_SA(b, h) + aoff + m * 2048 + 1024), 0, 1, 2, 3, 4, 5, 6, 7); } while (0)
#define PG8_LDB(dst, b, h) do { _Pragma("unroll") for (int n = 0; n < 2; ++n) dst[n] = __builtin_shufflevector(*(const LAS i32x4*)(lds + PG8_SB(b, h) + boff + n * 2048), *(const LAS i32x4*)(lds + PG8_SB(b, h) + boff + n * 2048 + 1024), 0, 1, 2, 3, 4, 5, 6, 7); } while (0)
#define PG8_MMA(ai, bj, At, Bt_) pg8_mma<F8>(acc[ai][bj], At, Bt_)
#define PG8_WAIT_V(n) asm volatile("s_waitcnt vmcnt(" #n ")" ::: "memory")
#define PG8_WAIT_L(n) asm volatile("s_waitcnt lgkmcnt(" #n ")" ::: "memory")
#define PG8_BAR __builtin_amdgcn_s_barrier()
#define PG8_SCHED __builtin_amdgcn_sched_barrier(0)
    Unit cur, nxt; int ui = 0;
    if (!S.next(0, cur)) return;
    f32x4 acc[2][2][4][2];
#pragma unroll
    for (int a = 0; a < 2; ++a)
#pragma unroll
        for (int b = 0; b < 2; ++b)
#pragma unroll
            for (int m = 0; m < 4; ++m)
#pragma unroll
                for (int n = 0; n < 2; ++n) acc[a][b][m][n] = (f32x4){0.f, 0.f, 0.f, 0.f};
    i32x8 At[4], B0[2], B1[2];
    const char* cA = (const char*)A + (size_t)cur.row0 * rstep; const char* cB = (const char*)Bt + (size_t)cur.brow0 * rstep;
    PG8_STAGE(PG8_SB(0, 0), cB, voffB); PG8_STAGE(PG8_SA(0, 0), cA, voffA); PG8_STAGE(PG8_SB(0, 1), cB + hstep, voffB); PG8_STAGE(PG8_SA(0, 1), cA + hstep, voffA);
    if (wr == 1) PG8_BAR;
    PG8_WAIT_V(4); PG8_BAR;
    PG8_STAGE(PG8_SB(1, 0), cB + kstep, voffB); PG8_STAGE(PG8_SA(1, 0), cA + kstep, voffA); PG8_STAGE(PG8_SB(1, 1), cB + hstep + kstep, voffB);
    PG8_WAIT_V(6); PG8_BAR;
    for (;;) {
        const bool has_next = S.next(ui + 1, nxt);
        const char* nA = has_next ? (const char*)A + (size_t)nxt.row0 * rstep : cA; const char* nB = has_next ? (const char*)Bt + (size_t)nxt.brow0 * rstep : cB;
        for (int t = 0; t < nt; t += 2) {
            const bool last = (t == nt - 2);
            const char* a1 = cA + (size_t)(t + 1) * kstep;
            const char* a2 = last ? nA : cA + (size_t)(t + 2) * kstep; const char* b2 = last ? nB : cB + (size_t)(t + 2) * kstep;
            const char* a3 = a2 + kstep; const char* b3 = b2 + kstep;
            PG8_LDB(B0, 0, 0); PG8_SCHED; PG8_LDA(At, 0, 0); PG8_STAGE(PG8_SA(1, 1), a1 + hstep, voffA);
            PG8_WAIT_L(8); PG8_BAR; PG8_WAIT_L(0); PG8_MMA(0, 0, At, B0); PG8_BAR; PG8_SCHED;
            PG8_LDB(B1, 0, 1); PG8_STAGE(PG8_SB(0, 0), b2, voffB);
            PG8_BAR; PG8_WAIT_L(0); PG8_MMA(0, 1, At, B1); PG8_BAR;
            PG8_LDA(At, 0, 1); PG8_STAGE(PG8_SA(0, 0), a2, voffA);
            PG8_BAR; PG8_WAIT_L(0); PG8_MMA(1, 0, At, B0); PG8_BAR; PG8_SCHED;
            PG8_STAGE(PG8_SB(0, 1), b2 + hstep, voffB);
            PG8_WAIT_V(6); PG8_BAR; PG8_MMA(1, 1, At, B1); PG8_BAR;
            PG8_LDB(B0, 1, 0); PG8_SCHED; PG8_LDA(At, 1, 0); PG8_STAGE(PG8_SA(0, 1), a2 + hstep, voffA);
            PG8_WAIT_L(8); PG8_BAR; PG8_WAIT_L(0); PG8_MMA(0, 0, At, B0); PG8_BAR; PG8_SCHED;
            PG8_LDB(B1, 1, 1); PG8_STAGE(PG8_SB(1, 0), b3, voffB);
            PG8_BAR; PG8_WAIT_L(0); PG8_MMA(0, 1, At, B1); PG8_BAR;
            PG8_LDA(At, 1, 1); PG8_STAGE(PG8_SA(1, 0), a3, voffA);
            PG8_BAR; PG8_WAIT_L(0); PG8_MMA(1, 0, At, B0); PG8_BAR; PG8_SCHED;
            PG8_STAGE(PG8_SB(1, 1), b3 + hstep, voffB);
            PG8_WAIT_V(6); PG8_BAR; PG8_MMA(1, 1, At, B1); PG8_BAR;
        }
        if constexpr (F8) asm volatile("s_nop 15\n\ts_nop 15" ::: "memory");
        E(acc, cur, wr, wc, fr, fq);
        if (!has_next) break;
#pragma unroll
        for (int a = 0; a < 2; ++a)
#pragma unroll
            for (int b = 0; b < 2; ++b)
#pragma unroll
                for (int m = 0; m < 4; ++m)
#pragma unroll
                    for (int n = 0; n < 2; ++n) acc[a][b][m][n] = (f32x4){0.f, 0.f, 0.f, 0.f};
        cur = nxt; cA = nA; cB = nB; ++ui;
    }
    PG8_WAIT_V(0);
    if (wr == 0) PG8_BAR;
    PG8_BAR;
#undef PG8_SA
#undef PG8_SB
#undef PG8_STAGE
#undef PG8_LDA
#undef PG8_LDB
#undef PG8_MMA
#undef PG8_WAIT_V
#undef PG8_WAIT_L
#undef PG8_BAR
#undef PG8_SCHED
}
template <class Epi, class Sched, bool F8 = false>
DEV void gemm_phase_gather(LAS unsigned char* lds, const bf16_t* A, const bf16_t* Bt, const int K, const Sched& S, const Epi& E, const int* idx, const int grp_rows, const int seq) {
    const int tid = threadIdx.x, wid = __builtin_amdgcn_readfirstlane(tid >> 6), lane = tid & 63, wr = wid >> 2, wc = wid & 3, fr = lane & 15, fq = lane >> 4;
    const int nt = K / BK;
    unsigned voffB[2]; int Ra[2]; unsigned Ca2[2];
#pragma unroll
    for (int i = 0; i < 2; ++i) { int R, C; stage_rc(tid * 16 + i * 8192, R, C); const int Rb = Epi::PERM ? ((R & ~31) + perm32(R & 31)) : R;
        Ra[i] = R; Ca2[i] = (unsigned)C * 2u; voffB[i] = (unsigned)(Rb * K + C) * 2u; }
    unsigned vAc[2][2], vAn[2][2];
#define PG8_IDXT(u) (STAGE_BYTES + 1024 * ((u) & 1))
#define PG8_SETVA(V, U, ui_) do { const LAS int* tab_ = (const LAS int*)(lds + PG8_IDXT(ui_)); const unsigned bo_ = (unsigned)((U).row0 / grp_rows) * (unsigned)seq; \
        _Pragma("unroll") for (int h_ = 0; h_ < 2; ++h_) _Pragma("unroll") for (int i_ = 0; i_ < 2; ++i_) V[h_][i_] = (bo_ + (unsigned)tab_[Ra[i_] + 128 * h_]) * (unsigned)(K * 2) + Ca2[i_]; } while (0)
    const size_t kstep = (size_t)(BK * 2);
    const size_t hstep = (size_t)HALF * K * 2;
    const size_t rstep = (size_t)K * 2;
    const unsigned ldsw = (unsigned)wid * 1024u;
    const int aoff = lds_byte(wr * 64 + fr, fq * 8), boff = lds_byte(wc * 32 + fr, fq * 8);
#define PG8_SA(b, h) (((b) * 2 + (h)) * HTB)
#define PG8_SB(b, h) ((4 + (b) * 2 + (h)) * HTB)
#define PG8_STAGE(bufoff, gbase, voff) do { _Pragma("unroll") for (int _i = 0; _i < 2; ++_i) \
        __builtin_amdgcn_global_load_lds((const unsigned*)((const char*)(gbase) + (voff)[_i]), (LAS unsigned*)(lds + (bufoff) + ldsw + _i * 8192), 16, 0, 0); } while (0)
#define PG8_LDA(dst, b, h) do { _Pragma("unroll") for (int m = 0; m < 4; ++m) dst[m] = __builtin_shufflevector(*(const LAS i32x4*)(lds + PG8_SA(b, h) + aoff + m * 2048), *(const LAS i32x4*)(lds + PG8_SA(b, h) + aoff + m * 2048 + 1024), 0, 1, 2, 3, 4, 5, 6, 7); } while (0)
#define PG8_LDB(dst, b, h) do { _Pragma("unroll") for (int n = 0; n < 2; ++n) dst[n] = __builtin_shufflevector(*(const LAS i32x4*)(lds + PG8_SB(b, h) + boff + n * 2048), *(const LAS i32x4*)(lds + PG8_SB(b, h) + boff + n * 2048 + 1024), 0, 1, 2, 3, 4, 5, 6, 7); } while (0)
#define PG8_MMA(ai, bj, At, Bt_) pg8_mma<F8>(acc[ai][bj], At, Bt_)
#define PG8_WAIT_V(n) asm volatile("s_waitcnt vmcnt(" #n ")" ::: "memory")
#define PG8_WAIT_L(n) asm volatile("s_waitcnt lgkmcnt(" #n ")" ::: "memory")
#define PG8_BAR __builtin_amdgcn_s_barrier()
#define PG8_SCHED __builtin_amdgcn_sched_barrier(0)
    Unit cur, nxt; int ui = 0;
    if (!S.next(0, cur)) return;
    f32x4 acc[2][2][4][2];
#pragma unroll
    for (int a = 0; a < 2; ++a)
#pragma unroll
        for (int b = 0; b < 2; ++b)
#pragma unroll
            for (int m = 0; m < 4; ++m)
#pragma unroll
                for (int n = 0; n < 2; ++n) acc[a][b][m][n] = (f32x4){0.f, 0.f, 0.f, 0.f};
    i32x8 At[4], B0[2], B1[2];
    const char* cA = (const char*)A; const char* cB = (const char*)Bt + (size_t)cur.brow0 * rstep;
    if (wid == 0) __builtin_amdgcn_global_load_lds((const unsigned*)(idx + cur.row0 + lane * 4), (LAS unsigned*)(lds + PG8_IDXT(0)), 16, 0, 0);
    asm volatile("s_waitcnt vmcnt(0)" ::: "memory"); __syncthreads();
    PG8_SETVA(vAc, cur, 0);
    PG8_STAGE(PG8_SB(0, 0), cB, voffB); PG8_STAGE(PG8_SA(0, 0), cA, vAc[0]); PG8_STAGE(PG8_SB(0, 1), cB + hstep, voffB); PG8_STAGE(PG8_SA(0, 1), cA, vAc[1]);
    if (wr == 1) PG8_BAR;
    PG8_WAIT_V(4); PG8_BAR;
    PG8_STAGE(PG8_SB(1, 0), cB + kstep, voffB); PG8_STAGE(PG8_SA(1, 0), cA + kstep, vAc[0]); PG8_STAGE(PG8_SB(1, 1), cB + hstep + kstep, voffB);
    PG8_WAIT_V(6); PG8_BAR;
    for (;;) {
        const bool has_next = S.next(ui + 1, nxt);
        const char* nB = has_next ? (const char*)Bt + (size_t)nxt.brow0 * rstep : cB;
        if (has_next && wid == 0) __builtin_amdgcn_global_load_lds((const unsigned*)(idx + nxt.row0 + lane * 4), (LAS unsigned*)(lds + PG8_IDXT(ui + 1)), 16, 0, 0);
        for (int t = 0; t < nt; t += 2) {
            const bool last = (t == nt - 2);
            const char* a1 = cA + (size_t)(t + 1) * kstep;
            const char* a2 = last ? cA : cA + (size_t)(t + 2) * kstep; const char* b2 = last ? nB : cB + (size_t)(t + 2) * kstep;
            if (last) { if (has_next) PG8_SETVA(vAn, nxt, ui + 1); else { vAn[0][0] = vAc[0][0]; vAn[0][1] = vAc[0][1]; vAn[1][0] = vAc[1][0]; vAn[1][1] = vAc[1][1]; } }
            unsigned v2[2][2];
#pragma unroll
            for (int h_ = 0; h_ < 2; ++h_)
#pragma unroll
                for (int i_ = 0; i_ < 2; ++i_) v2[h_][i_] = last ? vAn[h_][i_] : vAc[h_][i_];
            const char* a3 = a2 + kstep; const char* b3 = b2 + kstep;
            PG8_LDB(B0, 0, 0); PG8_SCHED; PG8_LDA(At, 0, 0); PG8_STAGE(PG8_SA(1, 1), a1, vAc[1]);
            PG8_WAIT_L(8); PG8_BAR; PG8_WAIT_L(0); PG8_MMA(0, 0, At, B0); PG8_BAR; PG8_SCHED;
            PG8_LDB(B1, 0, 1); PG8_STAGE(PG8_SB(0, 0), b2, voffB);
            PG8_BAR; PG8_WAIT_L(0); PG8_MMA(0, 1, At, B1); PG8_BAR;
            PG8_LDA(At, 0, 1); PG8_STAGE(PG8_SA(0, 0), a2, v2[0]);
            PG8_BAR; PG8_WAIT_L(0); PG8_MMA(1, 0, At, B0); PG8_BAR; PG8_SCHED;
            PG8_STAGE(PG8_SB(0, 1), b2 + hstep, voffB);
            PG8_WAIT_V(6); PG8_BAR; PG8_MMA(1, 1, At, B1); PG8_BAR;
            PG8_LDB(B0, 1, 0); PG8_SCHED; PG8_LDA(At, 1, 0); PG8_STAGE(PG8_SA(0, 1), a2, v2[1]);
            PG8_WAIT_L(8); PG8_BAR; PG8_WAIT_L(0); PG8_MMA(0, 0, At, B0); PG8_BAR; PG8_SCHED;
            PG8_LDB(B1, 1, 1); PG8_STAGE(PG8_SB(1, 0), b3, voffB);
            PG8_BAR; PG8_WAIT_L(0); PG8_MMA(0, 1, At, B1); PG8_BAR;
            PG8_LDA(At, 1, 1); PG8_STAGE(PG8_SA(1, 0), a3, v2[0]);
            PG8_BAR; PG8_WAIT_L(0); PG8_MMA(1, 0, At, B0); PG8_BAR; PG8_SCHED;
            PG8_STAGE(PG8_SB(1, 1), b3 + hstep, voffB);
            PG8_WAIT_V(6); PG8_BAR; PG8_MMA(1, 1, At, B1); PG8_BAR;
        }
        if constexpr (F8) asm volatile("s_nop 15\n\ts_nop 15" ::: "memory");
        E(acc, cur, wr, wc, fr, fq);
        if (!has_next) break;
#pragma unroll
        for (int a = 0; a < 2; ++a)
#pragma unroll
            for (int b = 0; b < 2; ++b)
#pragma unroll
                for (int m = 0; m < 4; ++m)
#pragma unroll
                    for (int n = 0; n < 2; ++n) acc[a][b][m][n] = (f32x4){0.f, 0.f, 0.f, 0.f};
        cur = nxt; cB = nB; ++ui; vAc[0][0] = vAn[0][0]; vAc[0][1] = vAn[0][1]; vAc[1][0] = vAn[1][0]; vAc[1][1] = vAn[1][1];
    }
    PG8_WAIT_V(0);
    if (wr == 0) PG8_BAR;
    PG8_BAR;
#undef PG8_IDXT
#undef PG8_SETVA
#undef PG8_SA
#undef PG8_SB
#undef PG8_STAGE
#undef PG8_LDA
#undef PG8_LDB
#undef PG8_MMA
#undef PG8_WAIT_V
#undef PG8_WAIT_L
#undef PG8_BAR
#undef PG8_SCHED
}
typedef const f32x4 (&AccRef)[2][2][4][2];
DEV u32x4 pk8(const f32x4 a, const f32x4 b) { u32x4 w; w.x = cvt_pk_bf16(a[0], a[1]); w.y = cvt_pk_bf16(a[2], a[3]); w.z = cvt_pk_bf16(b[0], b[1]); w.w = cvt_pk_bf16(b[2], b[3]); return w; }
DEV f32x4 silu4(const f32x4 v) { f32x4 r;
#pragma unroll
    for (int i = 0; i < 4; ++i) r[i] = v[i] * __builtin_amdgcn_rcpf(1.0f + __expf(-v[i]));
    return r; }
struct EpiG1 { static constexpr bool PERM = true; bf16_t *qkv, *z, *xbcraw; float* dtraw;
    DEV void operator()(AccRef acc, const Unit& u, int wr, int wc, int fr, int fq) const {
        const int ct = u.col0, rbase = u.row0 + wr * 64 + fr;
        if (ct < 5632) {
            bf16_t* base; int ld, cc;
            if (ct < 3072) { base = qkv; ld = 3072; cc = ct; } else if (ct < 4096) { base = z; ld = 1024; cc = ct - 3072; } else { base = xbcraw; ld = 1536; cc = ct - 4096; }
            const int col = cc + wc * 32 + 8 * fq;
#pragma unroll
            for (int ai = 0; ai < 2; ++ai)
#pragma unroll
                for (int m = 0; m < 4; ++m) { bf16_t* rowp = base + (size_t)(rbase + ai * HALF + m * 16) * ld + col;
#pragma unroll
                    for (int bj = 0; bj < 2; ++bj) *(u32x4*)(rowp + bj * HALF) = pk8(acc[ai][bj][m][0], acc[ai][bj][m][1]); }
        } else if (wc == 0) {
#pragma unroll
            for (int ai = 0; ai < 2; ++ai)
#pragma unroll
                for (int m = 0; m < 4; ++m) { float* rowp = dtraw + (size_t)(rbase + ai * HALF + m * 16) * 32 + 8 * fq; *(f32x4*)rowp = acc[ai][0][m][0]; *(f32x4*)(rowp + 4) = acc[ai][0][m][1]; }
        }
    } };
struct EpiResF32 { static constexpr bool PERM = false; float* out; const float* resid;
    DEV void operator()(AccRef acc, const Unit& u, int wr, int wc, int fr, int fq) const {
        const int rbase = u.row0 + wr * 64 + fr, col = u.col0 + wc * 32 + 4 * fq;
#pragma unroll
        for (int ai = 0; ai < 2; ++ai)
#pragma unroll
            for (int m = 0; m < 4; ++m) { const size_t ro = (size_t)(rbase + ai * HALF + m * 16) * 1024 + col;
#pragma unroll
                for (int bj = 0; bj < 2; ++bj)
#pragma unroll
                    for (int n = 0; n < 2; ++n) *(f32x4*)(out + ro + bj * HALF + n * 16) = *(const f32x4*)(resid + ro + bj * HALF + n * 16) + acc[ai][bj][m][n]; }
    } };
struct EpiSwiglu { static constexpr bool PERM = true; bf16_t* hid;
    DEV void operator()(AccRef acc, const Unit& u, int wr, int wc, int fr, int fq) const {
        const int rbase = u.row0 + wr * 64 + fr, col = (u.col0 >> 1) + wc * 32 + 8 * fq;
#pragma unroll
        for (int ai = 0; ai < 2; ++ai)
#pragma unroll
            for (int m = 0; m < 4; ++m) *(u32x4*)(hid + (size_t)(rbase + ai * HALF + m * 16) * 2048 + col) = pk8(silu4(acc[ai][0][m][0]) * acc[ai][1][m][0], silu4(acc[ai][0][m][1]) * acc[ai][1][m][1]);
    } };
struct EpiBf16Plain { static constexpr bool PERM = true; bf16_t* O; int ld;
    DEV void operator()(AccRef acc, const Unit& u, int wr, int wc, int fr, int fq) const {
        const int rbase = u.row0 + wr * 64 + fr, col = u.col0 + wc * 32 + 8 * fq;
#pragma unroll
        for (int ai = 0; ai < 2; ++ai)
#pragma unroll
            for (int m = 0; m < 4; ++m) { bf16_t* rowp = O + (size_t)(rbase + ai * HALF + m * 16) * ld + col;
#pragma unroll
                for (int bj = 0; bj < 2; ++bj) *(u32x4*)(rowp + bj * HALF) = pk8(acc[ai][bj][m][0], acc[ai][bj][m][1]); }
    } };
struct EpiG3 { static constexpr bool PERM = true; bf16_t *pbuf, *gb;
    DEV void operator()(AccRef acc, const Unit& u, int wr, int wc, int fr, int fq) const {
        const int rbase = u.row0 + wr * 64 + fr;
        if (u.col0 < 2048) { const int col = (u.col0 >> 1) + wc * 32 + 8 * fq;
#pragma unroll
            for (int ai = 0; ai < 2; ++ai)
#pragma unroll
                for (int m = 0; m < 4; ++m) *(u32x4*)(pbuf + (size_t)(rbase + ai * HALF + m * 16) * 1024 + col) = pk8(acc[ai][0][m][0] * acc[ai][1][m][0], acc[ai][0][m][1] * acc[ai][1][m][1]);
        } else { const int col = u.col0 - 2048 + wc * 32 + 8 * fq;
#pragma unroll
            for (int ai = 0; ai < 2; ++ai)
#pragma unroll
                for (int m = 0; m < 4; ++m) { bf16_t* rowp = gb + (size_t)(rbase + ai * HALF + m * 16) * 1024 + col;
#pragma unroll
                    for (int bj = 0; bj < 2; ++bj) *(u32x4*)(rowp + bj * HALF) = pk8(acc[ai][bj][m][0], acc[ai][bj][m][1]); }
        }
    } };
typedef unsigned u32x2 __attribute__((ext_vector_type(2)));
DEV unsigned pk4_fp8(float a, float b, float c, float d) { int w = 0; w = __builtin_amdgcn_cvt_pk_fp8_f32(a, b, w, false); w = __builtin_amdgcn_cvt_pk_fp8_f32(c, d, w, true); return (unsigned)w; }
constexpr float F8_SA = 8.0f, F8_SW = 256.0f, F8_INV = 1.0f / (F8_SA * F8_SW);
DEV float f8clamp(float v) { return __builtin_amdgcn_fmed3f(v, -448.0f, 448.0f); }
struct EpiSwiglu8 { static constexpr bool PERM = true; unsigned char* hid8;
    DEV void operator()(AccRef acc, const Unit& u, int wr, int wc, int fr, int fq) const {
        const int rbase = u.row0 + wr * 64 + fr, col = (u.col0 >> 1) + wc * 32 + 8 * fq;
#pragma unroll
        for (int ai = 0; ai < 2; ++ai)
#pragma unroll
            for (int m = 0; m < 4; ++m) { const f32x4 h0 = silu4(acc[ai][0][m][0] * F8_INV) * acc[ai][1][m][0] * (F8_INV * F8_SA), h1 = silu4(acc[ai][0][m][1] * F8_INV) * acc[ai][1][m][1] * (F8_INV * F8_SA);
                u32x2 w; w.x = pk4_fp8(f8clamp(h0[0]), f8clamp(h0[1]), f8clamp(h0[2]), f8clamp(h0[3])); w.y = pk4_fp8(f8clamp(h1[0]), f8clamp(h1[1]), f8clamp(h1[2]), f8clamp(h1[3]));
                *(u32x2*)(hid8 + (size_t)(rbase + ai * HALF + m * 16) * 2048 + col) = w; }
    } };
struct EpiBf16Scaled { static constexpr bool PERM = true; bf16_t* O; int ld; float sc;
    DEV void operator()(AccRef acc, const Unit& u, int wr, int wc, int fr, int fq) const {
        const int rbase = u.row0 + wr * 64 + fr, col = u.col0 + wc * 32 + 8 * fq;
#pragma unroll
        for (int ai = 0; ai < 2; ++ai)
#pragma unroll
            for (int m = 0; m < 4; ++m) { bf16_t* rowp = O + (size_t)(rbase + ai * HALF + m * 16) * ld + col;
#pragma unroll
                for (int bj = 0; bj < 2; ++bj) *(u32x4*)(rowp + bj * HALF) = pk8(acc[ai][bj][m][0] * sc, acc[ai][bj][m][1] * sc); }
    } };
}
DEV void ph_g1(const P& p, LAS unsigned char* lds) { pg8::StaticOrder S; S.init(T, NIN_PAD, (int)gridDim.x, (int)blockIdx.x, 0, 1); pg8::EpiG1 E{p.qkv, p.z, p.xbcraw, p.dtraw}; pg8::gemm_phase(lds, p.hn, p.WinT, 1024, S, E); }
DEV void ph_g2(const P& p, LAS unsigned char* lds) { pg8::StaticOrder S; S.init(T, 1024, (int)gridDim.x, (int)blockIdx.x, 0, 1); pg8::EpiResF32 E{p.out, p.x}; pg8::gemm_phase(lds, p.mix, p.WoutT, 2048, S, E); }
DEV void ph_up(const P& p, LAS unsigned char* lds) { pg8::StaticOrder S; S.init(NSLOT, 4096, (int)gridDim.x, (int)blockIdx.x, 4096, CAP / 256);
#if FP8_MOE
    pg8::EpiSwiglu8 E{(unsigned char*)p.hid}; pg8::gemm_phase_gather<pg8::EpiSwiglu8, pg8::StaticOrder, true>(lds, p.hn, p.WguT, 512, S, E, p.idx, NE * CAP, SEQ); }
#else
    pg8::EpiSwiglu E{p.hid}; pg8::gemm_phase_gather(lds, p.hn, p.WguT, 1024, S, E, p.idx, NE * CAP, SEQ); }
#endif

DEV void ph_down(const P& p, LAS unsigned char* lds) { pg8::StaticOrder S; S.init(NSLOT, 1024, (int)gridDim.x, (int)blockIdx.x, 1024, CAP / 256, (NSLOT / 256 * 4) % (int)gridDim.x == 0);
#if FP8_MOE
    pg8::EpiBf16Scaled E{p.ye, 1024, pg8::F8_INV}; pg8::gemm_phase<pg8::EpiBf16Scaled, pg8::StaticOrder, true>(lds, p.hid, p.WdT, 1024, S, E); }
#else
    pg8::EpiBf16Plain E{p.ye, 1024}; pg8::gemm_phase(lds, p.hid, p.WdT, 2048, S, E); }
#endif
DEV void ph_g3(const P& p, LAS unsigned char* lds) { pg8::StaticOrder S; S.init(T, 3072, (int)gridDim.x, (int)blockIdx.x, 0, 1); pg8::EpiG3 E{p.pbuf, p.gb}; pg8::gemm_phase(lds, p.hn, p.WciT, 1024, S, E); }
DEV void ph_g4(const P& p, LAS unsigned char* lds) { pg8::StaticOrder S; S.init(T, 1024, (int)gridDim.x, (int)blockIdx.x, 0, 1); pg8::EpiResF32 E{p.out, p.out}; pg8::gemm_phase(lds, p.abuf, p.WcoT, 1024, S, E); }

DEV bf16x8 ldg8(const bf16_t* p) { return *(const bf16x8*)p; }
DEV f32x4 mfma16(bf16x8 a, bf16x8 b, f32x4 c) { return __builtin_amdgcn_mfma_f32_16x16x32_bf16(a, b, c, 0, 0, 0); }
DEV bf16x8 pack8(const float (&m)[8]) { u32x4 r; r.x = pg8::cvt_pk_safe(m[0], m[1]); r.y = pg8::cvt_pk_safe(m[2], m[3]); r.z = pg8::cvt_pk_safe(m[4], m[5]); r.w = pg8::cvt_pk_safe(m[6], m[7]); return __builtin_bit_cast(bf16x8, r); }
DEV void unpack8(bf16x8 v, float (&f)[8]) { const u32x4 u = __builtin_bit_cast(u32x4, v);
#pragma unroll
    for (int q = 0; q < 4; ++q) { f[2 * q] = __uint_as_float(u[q] << 16); f[2 * q + 1] = __uint_as_float(u[q] & 0xffff0000u); } }
typedef unsigned u32x2 __attribute__((ext_vector_type(2)));
DEV u32x2 pk4(const f32x4 a) { u32x2 r; r.x = pg8::cvt_pk_safe(a[0], a[1]); r.y = pg8::cvt_pk_safe(a[2], a[3]); return r; }
DEV void ph_ssd_states(const P& p) {
    const int wid = threadIdx.x >> 6, lane = threadIdx.x & 63, fr = lane & 15, fq = lane >> 4;
    for (int it = blockIdx.x * 8 + wid; it < BATCH * NCHUNK * 32; it += gridDim.x * 8) {
        const int dir = it & 1, h = (it >> 1) & 15, c = (it >> 5) % NCHUNK, b = (it >> 5) / NCHUNK, g = h >> 3, j = dir * 16 + h;
        const bf16_t* xT = p.xsT + ((size_t)b * 1024 + h * 64 + fr) * SEQ + c * 128 + 8 * fq;
        const bf16_t* bT = p.bmT + ((size_t)b * 256 + g * 128 + fr) * SEQ + c * 128 + 8 * fq;
        const float* w = p.wdT + ((size_t)b * 32 + j) * SEQ + c * 128 + 8 * fq;
        f32x4 acc[8][4];
#pragma unroll
        for (int nb = 0; nb < 8; ++nb)
#pragma unroll
            for (int pb = 0; pb < 4; ++pb) acc[nb][pb] = (f32x4){0.f, 0.f, 0.f, 0.f};
#pragma unroll 1
        for (int ks = 0; ks < 4; ++ks) {
            const f32x4 w0 = *(const f32x4*)(w + 32 * ks), w1 = *(const f32x4*)(w + 32 * ks + 4);
            bf16x8 xf[4];
#pragma unroll
            for (int pb = 0; pb < 4; ++pb) { float f[8]; unpack8(ldg8(xT + (size_t)pb * 16 * SEQ + 32 * ks), f);
#pragma unroll
                for (int q = 0; q < 4; ++q) { f[q] *= w0[q]; f[4 + q] *= w1[q]; }
                xf[pb] = pack8(f); }
#pragma unroll
            for (int nb = 0; nb < 8; ++nb) { const bf16x8 bfv = ldg8(bT + (size_t)nb * 16 * SEQ + 32 * ks);
#pragma unroll
                for (int pb = 0; pb < 4; ++pb) acc[nb][pb] = mfma16(bfv, xf[pb], acc[nb][pb]); }
        }
        bf16_t* st = p.states + ((((size_t)b * 2 + dir) * NCHUNK + c) * 16 + h) * 8192;
#pragma unroll
        for (int nb = 0; nb < 8; ++nb)
#pragma unroll
            for (int pb = 0; pb < 4; ++pb) *(u32x2*)(st + (16 * pb + fr) * 128 + 16 * nb + 4 * fq) = pk4(acc[nb][pb]);
    }
}
DEV void ph_ssd_scan(const P& p) {
    for (size_t i = GTID; i < (size_t)BATCH * 2 * 16 * 64 * 32; i += GSTRIDE) {
        const int n4 = (int)(i & 31), pp = (int)((i >> 5) & 63), h = (int)((i >> 11) & 15), dir = (int)((i >> 15) & 1), b = (int)(i >> 16);
        bf16_t* base = p.states + (((size_t)b * 2 + dir) * NCHUNK * 16 + h) * 8192 + pp * 128 + n4 * 4;
        const float* dec = p.cdec + ((size_t)b * 32 + dir * 16 + h) * NCHUNK;
        float r0 = 0.f, r1 = 0.f, r2 = 0.f, r3 = 0.f;
#pragma unroll 16
        for (int cc = 0; cc < NCHUNK; ++cc) { const int c = dir ? NCHUNK - 1 - cc : cc; uint2* q = (uint2*)(base + (size_t)c * 16 * 8192); const uint2 v = *q; const float d = dec[c];
            *q = uint2{pg8::cvt_pk_safe(r0, r1), pg8::cvt_pk_safe(r2, r3)};
            r0 = r0 * d + __uint_as_float(v.x << 16); r1 = r1 * d + __uint_as_float(v.x & 0xffff0000u); r2 = r2 * d + __uint_as_float(v.y << 16); r3 = r3 * d + __uint_as_float(v.y & 0xffff0000u); }
    }
}
constexpr int GLD = 136;
DEV void ph_ssd_out(const P& p, LAS unsigned char* lds) {
    const int wid = threadIdx.x >> 6, lane = threadIdx.x & 63, fr = lane & 15, fq = lane >> 4;
    LAS bf16_t* Gl = (LAS bf16_t*)lds;
    LAS float* vec = (LAS float*)(lds + 64 * GLD * 2) + wid * 512;
    for (int u = blockIdx.x; u < BATCH * NCHUNK * 4; u += gridDim.x) {
        const int lh = u & 1, g = (u >> 1) & 1, c = (u >> 2) % NCHUNK, b = (u >> 2) / NCHUNK, h = 8 * g + wid, l0 = 64 * lh; const size_t row0 = (size_t)b * SEQ + (size_t)c * 128;
        const bf16_t* bmrow = p.bc + (row0 + 16 * wid + fr) * 512 + g * 128 + 8 * fq;
        const bf16_t* cmrow = p.bc + (row0 + l0 + fr) * 512 + 256 + g * 128 + 8 * fq;
        f32x4 ag[4];
#pragma unroll
        for (int lb = 0; lb < 4; ++lb) ag[lb] = (f32x4){0.f, 0.f, 0.f, 0.f};
#pragma unroll
        for (int ks = 0; ks < 4; ++ks) { const bf16x8 a = ldg8(bmrow + 32 * ks);
#pragma unroll
            for (int lb = 0; lb < 4; ++lb) ag[lb] = mfma16(a, ldg8(cmrow + (size_t)lb * 16 * 512 + 32 * ks), ag[lb]); }
        __syncthreads();
#pragma unroll
        for (int lb = 0; lb < 4; ++lb) *(LAS u32x2*)(Gl + (16 * lb + fr) * GLD + 16 * wid + 4 * fq) = pk4(ag[lb]);
#pragma unroll
        for (int q = 0; q < 2; ++q) { const int s = lane + 64 * q; const size_t o = ((size_t)b * 32 + h) * SEQ + c * 128 + s;
            vec[s] = p.csT[o]; vec[128 + s] = p.csT[o + (size_t)16 * SEQ]; vec[256 + s] = p.stT[o]; vec[384 + s] = p.stT[o + (size_t)16 * SEQ]; }
        __syncthreads();
        f32x4 acc[4][4];
#pragma unroll
        for (int pb = 0; pb < 4; ++pb)
#pragma unroll
            for (int lb = 0; lb < 4; ++lb) acc[pb][lb] = (f32x4){0.f, 0.f, 0.f, 0.f};
        float csfl[4], cbl[4];
#pragma unroll
        for (int lb = 0; lb < 4; ++lb) { csfl[lb] = vec[l0 + 16 * lb + fr]; cbl[lb] = vec[128 + l0 + 16 * lb + fr]; }
        const bf16_t* xT = p.xsT + ((size_t)b * 1024 + h * 64 + fr) * SEQ + c * 128 + 8 * fq;
        const float Dh = p.ssd_d[h];
#pragma unroll 2
        for (int ks = 0; ks < 4; ++ks) {
            const int s0 = 32 * ks + 8 * fq;
            bf16x8 xf[4];
#pragma unroll
            for (int pb = 0; pb < 4; ++pb) xf[pb] = ldg8(xT + (size_t)pb * 16 * SEQ + 32 * ks);
            float cs_s[8], cb_s[8], df[8], db[8];
#pragma unroll
            for (int j = 0; j < 8; ++j) { cs_s[j] = vec[s0 + j]; cb_s[j] = vec[128 + s0 + j]; df[j] = vec[256 + s0 + j]; db[j] = vec[384 + s0 + j]; }
#pragma unroll
            for (int lb = 0; lb < 4; ++lb) {
                const int l = l0 + 16 * lb + fr;
                float gf[8], m[8]; unpack8(*(const LAS bf16x8*)(Gl + (16 * lb + fr) * GLD + s0), gf);
#pragma unroll
                for (int j = 0; j < 8; ++j) { const int s = s0 + j;
                    const float wf = s <= l ? df[j] * __expf(fminf(csfl[lb] - cs_s[j], 0.f)) : 0.f, wb = s >= l ? db[j] * __expf(fminf(cbl[lb] - cb_s[j], 0.f)) : 0.f;
                    m[j] = gf[j] * (wf + wb) + (s == l ? Dh : 0.f); }
                const bf16x8 mf = pack8(m);
#pragma unroll
                for (int pb = 0; pb < 4; ++pb) acc[pb][lb] = mfma16(xf[pb], mf, acc[pb][lb]);
            }
        }
#pragma unroll
        for (int dir = 0; dir < 2; ++dir) {
            const bf16_t* pv = p.states + ((((size_t)b * 2 + dir) * NCHUNK + c) * 16 + h) * 8192 + fr * 128 + 8 * fq;
            float sc[4];
#pragma unroll
            for (int lb = 0; lb < 4; ++lb) sc[lb] = __expf(dir ? cbl[lb] : csfl[lb]);
#pragma unroll 2
            for (int ks = 0; ks < 4; ++ks) {
                bf16x8 pf[4];
#pragma unroll
                for (int pb = 0; pb < 4; ++pb) pf[pb] = ldg8(pv + pb * 2048 + 32 * ks);
#pragma unroll
                for (int lb = 0; lb < 4; ++lb) { float f[8]; unpack8(ldg8(cmrow + (size_t)lb * 16 * 512 + 32 * ks), f);
#pragma unroll
                    for (int j = 0; j < 8; ++j) f[j] *= sc[lb];
                    const bf16x8 cf = pack8(f);
#pragma unroll
                    for (int pb = 0; pb < 4; ++pb) acc[pb][lb] = mfma16(pf[pb], cf, acc[pb][lb]); }
            }
        }
#pragma unroll
        for (int pb = 0; pb < 4; ++pb)
#pragma unroll
            for (int lb = 0; lb < 4; ++lb) *(u32x2*)(p.yssd + (row0 + l0 + 16 * lb + fr) * 1024 + h * 64 + 16 * pb + 4 * fq) = pk4(acc[pb][lb]);
    }
}

DEV void ph_norm_router_mfma(const P& p, int layer, LAS unsigned char* lds) {
    const float* g = p.ffn_norm + (size_t)layer * 1024; const float* rw = p.router_w + (size_t)layer * 1024 * 16;
    const int tid = threadIdx.x, wid = tid >> 6, lane = tid & 63, fr = lane & 15, fq = lane >> 4;
    __syncthreads();
    for (int f = tid; f < 2048; f += 512) { const int ks = f >> 6, ln = f & 63, e = ln & 15, kb = 32 * ks + 8 * (ln >> 4);
        float hi[8], lo[8];
#pragma unroll
        for (int j = 0; j < 8; ++j) { const float w = g[kb + j] * rw[(size_t)(kb + j) * 16 + e]; const float h = bf2f(f2bf(w)); hi[j] = h; lo[j] = w - h; }
        *(LAS bf16x8*)(lds + (size_t)f * 16) = pack8(hi); *(LAS bf16x8*)(lds + 32768 + (size_t)f * 16) = pack8(lo); }
    __syncthreads();
    for (size_t row0 = ((size_t)blockIdx.x * 8 + wid) * 16; row0 < (size_t)T; row0 += (size_t)gridDim.x * 128) {
        const float* xr = p.out + (row0 + fr) * 1024 + 8 * fq;
        f32x4 acc = (f32x4){0.f, 0.f, 0.f, 0.f}; float ss = 0.f;
#pragma unroll 4
        for (int ks = 0; ks < 32; ++ks) {
            const float4 a = *(const float4*)(xr + 32 * ks), b = *(const float4*)(xr + 32 * ks + 4);
            const float x[8] = {a.x, a.y, a.z, a.w, b.x, b.y, b.z, b.w}; float lo[8];
#pragma unroll
            for (int j = 0; j < 8; ++j) ss += x[j] * x[j];
            const bf16x8 xh = pack8(x); float xhf[8]; unpack8(xh, xhf);
#pragma unroll
            for (int j = 0; j < 8; ++j) lo[j] = x[j] - xhf[j];
            const bf16x8 xl = pack8(lo);
            const bf16x8 wh = *(const LAS bf16x8*)(lds + (size_t)(ks * 64 + lane) * 16), wl = *(const LAS bf16x8*)(lds + 32768 + (size_t)(ks * 64 + lane) * 16);
            acc = mfma16(xh, wh, acc); acc = mfma16(xl, wh, acc); acc = mfma16(xh, wl, acc);
        }
        ss += __shfl_xor(ss, 16); ss += __shfl_xor(ss, 32);
        const float rinv = 1.0f / sqrtf(ss * (1.0f / 1024.0f) + 1e-6f);
        float lg[4];
#pragma unroll
        for (int i = 0; i < 4; ++i) { lg[i] = acc[i] * __shfl(rinv, 4 * fq + i);
            float mx = lg[i]; mx = fmaxf(mx, __shfl_xor(mx, 1)); mx = fmaxf(mx, __shfl_xor(mx, 2)); mx = fmaxf(mx, __shfl_xor(mx, 4)); mx = fmaxf(mx, __shfl_xor(mx, 8));
            const float ex = expf(lg[i] - mx); float den = ex; den += __shfl_xor(den, 1); den += __shfl_xor(den, 2); den += __shfl_xor(den, 4); den += __shfl_xor(den, 8);
            lg[i] = ex / den; }
        { const size_t r4 = row0 + 4 * fq; const int b = (int)(r4 / SEQ), s = (int)(r4 % SEQ); *(float4*)(p.aff + ((size_t)b * NE + fr) * SEQ + s) = float4{lg[0], lg[1], lg[2], lg[3]}; }
#pragma unroll 4
        for (int ks = 0; ks < 32; ++ks) {
            const float4 a = *(const float4*)(xr + 32 * ks), b = *(const float4*)(xr + 32 * ks + 4); const float4 ga = *(const float4*)(g + 32 * ks + 8 * fq), gb = *(const float4*)(g + 32 * ks + 8 * fq + 4);
            const float y[8] = {a.x * rinv * ga.x, a.y * rinv * ga.y, a.z * rinv * ga.z, a.w * rinv * ga.w, b.x * rinv * gb.x, b.y * rinv * gb.y, b.z * rinv * gb.z, b.w * rinv * gb.w};
#if FP8_MOE
            { u32x2 w8; w8.x = pg8::pk4_fp8(pg8::f8clamp(y[0] * pg8::F8_SA), pg8::f8clamp(y[1] * pg8::F8_SA), pg8::f8clamp(y[2] * pg8::F8_SA), pg8::f8clamp(y[3] * pg8::F8_SA));
              w8.y = pg8::pk4_fp8(pg8::f8clamp(y[4] * pg8::F8_SA), pg8::f8clamp(y[5] * pg8::F8_SA), pg8::f8clamp(y[6] * pg8::F8_SA), pg8::f8clamp(y[7] * pg8::F8_SA));
              *(u32x2*)((unsigned char*)p.hn + (row0 + fr) * 1024 + 32 * ks + 8 * fq) = w8; }
#else
            *(bf16x8*)(p.hn + (row0 + fr) * 1024 + 32 * ks + 8 * fq) = pack8(y);
#endif
        }
    }
    __syncthreads();
}

DEV void cvx_src(const P& p, int layer, int id, int seg, const float*& src, int& ld, int& k0) {
    const int e = id / 384, r = id % 384; const size_t off = ((size_t)layer * NE + e) * 1024 * 2048;
    if (r < 256) { const int pn = r >> 4, kt = r & 15; src = (seg ? p.wu : p.wg) + off + 128 * pn; ld = 2048; k0 = 64 * kt; }
    else { const int r2 = r - 256, nt = r2 >> 5, kt = r2 & 31; src = p.wd + off + 256 * nt + 128 * seg; ld = 1024; k0 = 64 * kt; }
}
DEV void ph_convert_experts_dev(const P& p, int layer, LAS unsigned char* lds) {
    LAS unsigned* tl = (LAS unsigned*)lds;
    const int tid = threadIdx.x, n4 = tid & 31, seg = (tid >> 5) & 1, kp = tid >> 6;
    const int rrow = tid >> 1, rhalf = tid & 1, rseg = rrow >> 7, rq = (rrow >> 5) & 3, rn4 = rrow & 31;
    constexpr int NTILE = NE * 384;
    float4 cur[8], nxt[8];
#define CVX_LOAD(ID, DST) do { const float* s_; int ld_, k0_; cvx_src(p, layer, (ID), seg, s_, ld_, k0_); \
        _Pragma("unroll") for (int i = 0; i < 4; ++i) { const size_t ro = (size_t)(k0_ + 2 * (kp + 8 * i)) * ld_ + 4 * n4; DST[2 * i] = *(const float4*)(s_ + ro); DST[2 * i + 1] = *(const float4*)(s_ + ro + ld_); } } while (0)
    int id = blockIdx.x;
    if (id < NTILE) CVX_LOAD(id, cur);
    for (; id < NTILE; id += gridDim.x) {
        const int nid = id + gridDim.x;
        if (nid < NTILE) CVX_LOAD(nid, nxt);
        __syncthreads();
#pragma unroll
        for (int i = 0; i < 4; ++i) { const float4 a = cur[2 * i], b = cur[2 * i + 1]; const int kd = kp + 8 * i; const int rb = seg * 128 + n4;
            tl[(rb) * 33 + kd] = pack2(a.x, b.x); tl[(rb + 32) * 33 + kd] = pack2(a.y, b.y); tl[(rb + 64) * 33 + kd] = pack2(a.z, b.z); tl[(rb + 96) * 33 + kd] = pack2(a.w, b.w); }
        __syncthreads();
        { const int e = id / 384, r = id % 384; bf16_t* d; int K, n0, k0;
          if (r < 256) { d = p.WguT + (size_t)e * 4096 * 1024; K = 1024; n0 = 256 * (r >> 4); k0 = 64 * (r & 15); } else { const int r2 = r - 256; d = p.WdT + (size_t)e * 1024 * 2048; K = 2048; n0 = 256 * (r2 >> 5); k0 = 64 * (r2 & 31); }
          unsigned w[16];
#pragma unroll
          for (int i = 0; i < 16; ++i) w[i] = tl[rrow * 33 + 16 * rhalf + i];
          bf16_t* dp = d + (size_t)(n0 + rseg * 128 + 4 * rn4 + rq) * K + k0 + 32 * rhalf;
#pragma unroll
          for (int q = 0; q < 4; ++q) *(uint4*)(dp + 8 * q) = uint4{w[4 * q], w[4 * q + 1], w[4 * q + 2], w[4 * q + 3]}; }
#pragma unroll
        for (int i = 0; i < 8; ++i) cur[i] = nxt[i];
    }
#undef CVX_LOAD
    __syncthreads();
}

DEV void ph_convert_experts_f8(const P& p, int layer, LAS unsigned char* lds) {
    LAS unsigned* tl = (LAS unsigned*)lds;
    const int tid = threadIdx.x, n4 = tid & 31, seg = (tid >> 5) & 1, kp = tid >> 6;
    const int rrow = tid >> 1, rhalf = tid & 1, rseg = rrow >> 7, rq = (rrow >> 5) & 3, rn4 = rrow & 31;
    constexpr int NTILE = NE * 384;
    float4 cur[8], nxt[8];
#define CVX8_LOAD(ID, DST) do { const float* s_; int ld_, k0_; cvx_src(p, layer, (ID), seg, s_, ld_, k0_); \
        _Pragma("unroll") for (int i = 0; i < 2; ++i) _Pragma("unroll") for (int r = 0; r < 4; ++r) DST[4 * i + r] = *(const float4*)(s_ + (size_t)(k0_ + 4 * (kp + 8 * i) + r) * ld_ + 4 * n4); } while (0)
    int id = blockIdx.x;
    if (id < NTILE) CVX8_LOAD(id, cur);
    for (; id < NTILE; id += gridDim.x) {
        const int nid = id + gridDim.x;
        if (nid < NTILE) CVX8_LOAD(nid, nxt);
        __syncthreads();
#pragma unroll
        for (int i = 0; i < 2; ++i) { const float4 a = cur[4 * i], b = cur[4 * i + 1], c = cur[4 * i + 2], d = cur[4 * i + 3]; const int kd = kp + 8 * i, rb = seg * 128 + n4; const float sw = pg8::F8_SW;
            tl[(rb) * 17 + kd] = pg8::pk4_fp8(a.x * sw, b.x * sw, c.x * sw, d.x * sw); tl[(rb + 32) * 17 + kd] = pg8::pk4_fp8(a.y * sw, b.y * sw, c.y * sw, d.y * sw);
            tl[(rb + 64) * 17 + kd] = pg8::pk4_fp8(a.z * sw, b.z * sw, c.z * sw, d.z * sw); tl[(rb + 96) * 17 + kd] = pg8::pk4_fp8(a.w * sw, b.w * sw, c.w * sw, d.w * sw); }
        __syncthreads();
        { const int e = id / 384, r = id % 384; unsigned char* d; int K, n0, k0;
          if (r < 256) { d = (unsigned char*)p.WguT + (size_t)e * 4096 * 1024; K = 1024; n0 = 256 * (r >> 4); k0 = 64 * (r & 15); } else { const int r2 = r - 256; d = (unsigned char*)p.WdT + (size_t)e * 1024 * 2048; K = 2048; n0 = 256 * (r2 >> 5); k0 = 64 * (r2 & 31); }
          unsigned w[8];
#pragma unroll
          for (int i = 0; i < 8; ++i) w[i] = tl[rrow * 17 + 8 * rhalf + i];
          unsigned char* dp = d + (size_t)(n0 + rseg * 128 + 4 * rn4 + rq) * K + k0 + 32 * rhalf;
          *(uint4*)dp = uint4{w[0], w[1], w[2], w[3]}; *(uint4*)(dp + 16) = uint4{w[4], w[5], w[6], w[7]}; }
#pragma unroll
        for (int i = 0; i < 8; ++i) cur[i] = nxt[i];
    }
#undef CVX8_LOAD
    __syncthreads();
}
constexpr int CTLD = 136;
DEV void ph_prep_dev(const P& p, LAS unsigned char* lds) {
    for (size_t i0 = GTID; i0 + 3 * GSTRIDE < (size_t)T * 256; i0 += GSTRIDE * 4) {
        u32x4 raw[4];
#pragma unroll
        for (int q = 0; q < 4; ++q) { const size_t i = i0 + q * GSTRIDE; const size_t hrow = i >> 3; const size_t t = hrow >> 5; const int hh = (int)(hrow & 31);
            raw[q] = *(const u32x4*)(p.qkv + t * 3072 + (hh >> 4) * 1024 + (hh & 15) * 64 + (int)(i & 7) * 8); }
#pragma unroll
        for (int q = 0; q < 4; ++q) { const size_t i = i0 + q * GSTRIDE;
            const int sub = (int)(i & 7); const size_t hrow = i >> 3; const size_t t = hrow >> 5; const int hh = (int)(hrow & 31), isk = hh >> 4, h = hh & 15, pos = (int)(t % SEQ);
            bf16_t* ptr = p.qkv + t * 3072 + isk * 1024 + h * 64 + sub * 8; const float* gn = (isk ? p.k_norm : p.q_norm) + sub * 8;
            float f[8]; float ss = 0.f;
#pragma unroll
            for (int j = 0; j < 4; ++j) { f[2 * j] = __uint_as_float(raw[q][j] << 16); f[2 * j + 1] = __uint_as_float(raw[q][j] & 0xffff0000u); }
#pragma unroll
            for (int j = 0; j < 8; ++j) ss += f[j] * f[j];
            ss += __shfl_xor(ss, 1); ss += __shfl_xor(ss, 2); ss += __shfl_xor(ss, 4);
            const float r = 1.0f / sqrtf(ss * (1.0f / 64.0f) + 1e-6f);
            const float4 c0 = *(const float4*)(p.rope + (size_t)pos * 16), c1 = *(const float4*)(p.rope + (size_t)pos * 16 + 4), s0 = *(const float4*)(p.rope + (size_t)pos * 16 + 8), s1 = *(const float4*)(p.rope + (size_t)pos * 16 + 12);
            const float cs[8] = {c0.x, c0.y, c0.z, c0.w, c1.x, c1.y, c1.z, c1.w}, sn[8] = {s0.x, s0.y, s0.z, s0.w, s1.x, s1.y, s1.z, s1.w};
#pragma unroll
            for (int j = 0; j < 8; ++j) { f[j] = f[j] * r * gn[j]; const float other = __shfl_xor(f[j], 1);
                f[j] = sub == 0 ? f[j] * cs[j] - other * sn[j] : (sub == 1 ? f[j] * cs[j] + other * sn[j] : f[j]); }
            st8(ptr, f); }
    }
    {
        LAS bf16_t* tl = (LAS bf16_t*)lds;
        const int tid = threadIdx.x, c8 = tid & 7, trw = tid >> 3;
        constexpr int NTILE = (T / 128) * 24;
        u32x4 rw[2][5], rwn[2][5];
#define PREP_LOAD(TILE, DST) do { const int ct_ = (TILE) % 24, tt_ = (TILE) / 24, c0_ = ct_ * 64; const size_t t0_ = (size_t)tt_ * 128; const int pos0_ = (int)(t0_ % SEQ); \
            _Pragma("unroll") for (int half = 0; half < 2; ++half) { const int tloc = trw + 64 * half, pos = pos0_ + tloc; const size_t t = t0_ + tloc; \
                _Pragma("unroll") for (int k = 0; k < 5; ++k) { const int pp = pos + k - 2; DST[half][k] = (pp < 0 || pp >= SEQ) ? (u32x4){0u, 0u, 0u, 0u} : *(const u32x4*)(p.xbcraw + (t + k - 2) * 1536 + c0_ + c8 * 8); } } } while (0)
        int tile = blockIdx.x;
        if (tile < NTILE) PREP_LOAD(tile, rw);
        for (; tile < NTILE; tile += gridDim.x) {
            const int ntile = tile + gridDim.x;
            if (ntile < NTILE) PREP_LOAD(ntile, rwn);
            const int ct = tile % 24, tt = tile / 24, c0 = ct * 64; const size_t t0 = (size_t)tt * 128; const int b = (int)(t0 / SEQ), pos0 = (int)(t0 % SEQ);
            float wgt[5][8], bias[8];
#pragma unroll
            for (int j = 0; j < 8; ++j) { bias[j] = p.conv_b[c0 + c8 * 8 + j];
#pragma unroll
                for (int k = 0; k < 5; ++k) wgt[k][j] = p.conv_w[k * 1536 + c0 + c8 * 8 + j]; }
            __syncthreads();
#pragma unroll
            for (int half = 0; half < 2; ++half) { const int tloc = trw + 64 * half; const size_t t = t0 + tloc;
                float acc[8];
#pragma unroll
                for (int j = 0; j < 8; ++j) acc[j] = bias[j];
#pragma unroll
                for (int k = 0; k < 5; ++k) {
#pragma unroll
                    for (int j = 0; j < 4; ++j) { acc[2 * j] += __uint_as_float(rw[half][k][j] << 16) * wgt[k][2 * j]; acc[2 * j + 1] += __uint_as_float(rw[half][k][j] & 0xffff0000u) * wgt[k][2 * j + 1]; } }
#pragma unroll
                for (int j = 0; j < 8; ++j) acc[j] = acc[j] * __builtin_amdgcn_rcpf(1.0f + __expf(-acc[j]));
                if (c0 >= 1024) st8(p.bc + t * 512 + (c0 - 1024) + c8 * 8, acc);
                if (c0 < 1280) {
#pragma unroll
                    for (int j = 0; j < 8; ++j) tl[(c8 * 8 + j) * CTLD + tloc] = f2bf(acc[j]); }
            }
            __syncthreads();
            if (c0 < 1280) {
                bf16_t* dst = c0 < 1024 ? p.xsT + ((size_t)b * 1024 + c0 + trw) * SEQ + pos0 : p.bmT + ((size_t)b * 256 + (c0 - 1024) + trw) * SEQ + pos0;
#pragma unroll
                for (int half = 0; half < 2; ++half) *(u32x4*)(dst + 64 * half + 8 * c8) = *(const LAS u32x4*)(tl + trw * CTLD + 64 * half + 8 * c8);
            }
#pragma unroll
            for (int half = 0; half < 2; ++half)
#pragma unroll
                for (int k = 0; k < 5; ++k) rw[half][k] = rwn[half][k];
        }
#undef PREP_LOAD
    }
    {
        const int lane = LANE;
        for (size_t it = GWAVE; it < (size_t)BATCH * NCHUNK * 32; it += NWAVES_G) {
            const int j = (int)(it & 31), c = (int)((it >> 5) % NCHUNK), b = (int)((it >> 5) / NCHUNK), dir = j >> 4, h = j & 15;
            const float A = -expf(dir ? p.a_log_b[h] : p.a_log_f[h]), bias = dir ? p.dtb_b[h] : p.dtb_f[h];
            const size_t row0 = (size_t)b * SEQ + (size_t)c * 128; const size_t ob = ((size_t)b * 32 + j) * SEQ + c * 128;
            const int l0 = dir ? 127 - 2 * lane : 2 * lane, l1 = dir ? 126 - 2 * lane : 2 * lane + 1;
            const float dt0 = softplus_f(p.dtraw[(row0 + l0) * 32 + j] + bias), dt1 = softplus_f(p.dtraw[(row0 + l1) * 32 + j] + bias);
            const float a0 = dt0 * A, a1 = dt1 * A, pr = a0 + a1; float inc = pr;
#pragma unroll
            for (int o = 1; o < 64; o <<= 1) { const float tq = __shfl_up(inc, o); if (lane >= o) inc += tq; }
            const float cs0 = inc - pr + a0, cs1 = inc, total = __shfl(inc, 63);
            p.step[(row0 + l0) * 32 + j] = dt0; p.step[(row0 + l1) * 32 + j] = dt1;
            p.stT[ob + l0] = dt0; p.stT[ob + l1] = dt1; p.csT[ob + l0] = cs0; p.csT[ob + l1] = cs1;
            p.wdT[ob + l0] = dt0 * expf(total - cs0); p.wdT[ob + l1] = dt1 * expf(total - cs1);
            if (lane == 0) p.cdec[((size_t)b * 32 + j) * NCHUNK + c] = expf(total);
        }
    }
}

typedef short s16x4 __attribute__((ext_vector_type(4)));
constexpr int VLD = 144;
DEV void ph_attn(const P& p, LAS unsigned char* lds) {
    const int wid = threadIdx.x >> 6, lane = threadIdx.x & 63, fr = lane & 15, fq = lane >> 4;
    LAS unsigned char* vt = lds + wid * (32 * VLD);
    float gq = 0.f, gk = 0.f;
    for (int c = 0; c < 64; ++c) { gq = fmaxf(gq, fabsf(p.q_norm[c])); gk = fmaxf(gk, fabsf(p.k_norm[c])); }
    const float c1 = 0.125f * 1.44269504089f, c2 = 8.0f * gq * gk * 1.44269504089f;
    const int trq = fr >> 2, trp = fr & 3;
    constexpr int NJB = SEQ / 256;
    for (int it = blockIdx.x * 8 + wid; it < BATCH * 16 * NJB * 16; it += gridDim.x * 8) {
        const int r = it & 15, jb = (it >> 4) % NJB, h = ((it >> 4) / NJB) & 15, b = ((it >> 4) / NJB) >> 4;
        const size_t rowb = (size_t)b * SEQ; const int base = r + 256 * jb;
        const bf16_t* qp = p.qkv + (rowb + base + 16 * fr) * 3072 + h * 64 + 8 * fq;
        const bf16x8 qf0 = ldg8(qp), qf1 = ldg8(qp + 32);
        const bf16_t* kbase = p.qkv + rowb * 3072 + 1024 + h * 64 + 8 * fq;
        const bf16_t* vbase = p.qkv + rowb * 3072 + 2048 + h * 64;
        f32x4 o[4];
#pragma unroll
        for (int mb = 0; mb < 4; ++mb) o[mb] = (f32x4){0.f, 0.f, 0.f, 0.f};
        float lsum = 0.f;
        bf16x8 vr[4], kf[2][2];
#define ATT_LOAD(st, VR, KF) do { const int dsh_ = (st) < 12 ? 0 : ((st) < 18 ? 2 : 4), k0_ = -64 + 32 * ((st) < 12 ? (st) : ((st) < 18 ? (st) - 12 : (st) - 18)); \
            _Pragma("unroll") for (int c4 = 0; c4 < 4; ++c4) { const int id = lane + 64 * c4, row = id >> 3, ch = id & 7; int pos = base + ((k0_ + row) << dsh_); pos = pos < 0 ? 0 : (pos > SEQ - 1 ? SEQ - 1 : pos); \
                VR[c4] = ldg8(vbase + (size_t)pos * 3072 + 8 * ch); } \
            _Pragma("unroll") for (int x = 0; x < 2; ++x) { int pos = base + ((k0_ + 8 * (fr >> 2) + 4 * x + (fr & 3)) << dsh_); pos = pos < 0 ? 0 : (pos > SEQ - 1 ? SEQ - 1 : pos); \
                KF[x][0] = ldg8(kbase + (size_t)pos * 3072); KF[x][1] = ldg8(kbase + (size_t)pos * 3072 + 32); } } while (0)
        ATT_LOAD(0, vr, kf);
#pragma unroll 1
        for (int st = 0; st < 23; ++st) {
            bf16x8 vrn[4], kfn[2][2];
            const int stn = st + 1 < 23 ? st + 1 : st;
            ATT_LOAD(stn, vrn, kfn);
            const int dsh = st < 12 ? 0 : (st < 18 ? 2 : 4), k0 = -64 + 32 * (st < 12 ? st : (st < 18 ? st - 12 : st - 18));
            const int kq = fr << (4 - dsh);
            f32x4 s0 = mfma16(kf[0][0], qf0, (f32x4){0.f, 0.f, 0.f, 0.f}); s0 = mfma16(kf[0][1], qf1, s0);
            f32x4 s1 = mfma16(kf[1][0], qf0, (f32x4){0.f, 0.f, 0.f, 0.f}); s1 = mfma16(kf[1][1], qf1, s1);
            float pv[8];
#pragma unroll
            for (int j = 0; j < 8; ++j) { const int kap = k0 + 8 * fq + j, pos = base + (kap << dsh), dk = kap - kq;
                const bool valid = dk <= 64 && dk >= -64 && pos >= 0 && pos < SEQ; const float sv = j < 4 ? s0[j & 3] : s1[j & 3];
                pv[j] = valid ? __builtin_amdgcn_exp2f(sv * c1 - c2) : 0.f; lsum += pv[j]; }
            const bf16x8 pf = pack8(pv);
            asm volatile("" ::: "memory");
#pragma unroll
            for (int c4 = 0; c4 < 4; ++c4) { const int id = lane + 64 * c4, row = id >> 3, ch = id & 7; *(LAS bf16x8*)(vt + row * VLD + ch * 16) = vr[c4]; }
            asm volatile("s_waitcnt lgkmcnt(0)" ::: "memory");
#pragma unroll
            for (int mb = 0; mb < 4; ++mb) {
                const s16x4 t0 = __builtin_amdgcn_ds_read_tr16_b64_v4i16((LAS s16x4*)(vt + (8 * fq + trq) * VLD + (16 * mb + 4 * trp) * 2));
                const s16x4 t1 = __builtin_amdgcn_ds_read_tr16_b64_v4i16((LAS s16x4*)(vt + (8 * fq + 4 + trq) * VLD + (16 * mb + 4 * trp) * 2));
                const bf16x8 vf = __builtin_shufflevector(t0, t1, 0, 1, 2, 3, 4, 5, 6, 7);
                o[mb] = mfma16(vf, pf, o[mb]);
            }
            asm volatile("" ::: "memory");
#pragma unroll
            for (int c4 = 0; c4 < 4; ++c4) vr[c4] = vrn[c4];
            kf[0][0] = kfn[0][0]; kf[0][1] = kfn[0][1]; kf[1][0] = kfn[1][0]; kf[1][1] = kfn[1][1];
        }
#undef ATT_LOAD
        lsum += __shfl_xor(lsum, 16); lsum += __shfl_xor(lsum, 32);
        const float inv = 1.0f / lsum;
#pragma unroll
        for (int mb = 0; mb < 4; ++mb) *(u32x2*)(p.mix + (rowb + base + 16 * fr) * 2048 + h * 64 + 16 * mb + 4 * fq) = pk4(o[mb] * inv);
    }
}

constexpr int OLD = 68;
constexpr int ATT_VT = 32 * VLD;
constexpr int ATT_OPART = 8 * 2 * ATT_VT, ATT_LPART = ATT_OPART + 256 * OLD * 4;
static_assert(ATT_LPART + 1024 <= 147440, "attention LDS");
template <int MODE, bool EDGE>
DEV void attn_stream(LAS unsigned char* lds, const bf16_t* qkvb, bf16_t* outb, const int base0, const float c1, const float c2) {
    const int wid = threadIdx.x >> 6, lane = threadIdx.x & 63, fr = lane & 15, fq = lane >> 4, trq = fr >> 2, trp = fr & 3;
    LAS unsigned char* vt = lds + wid * (2 * ATT_VT); LAS float* Opart = (LAS float*)(lds + ATT_OPART); LAS float* lpart = (LAS float*)(lds + ATT_LPART);
    constexpr int NSI = MODE == 0 ? 11 : 5, NST = 2 * NSI;
#define ATT_GEOM(st, BASE, DSH, K0) do { const int it_ = (st) >= NSI ? 1 : 0, s_ = (st) - it_ * NSI; BASE = MODE == 0 ? base0 + 2 * wid + it_ : base0 + 32 * wid + 16 * it_; \
        if (MODE == 0) { if (s_ < 6) { DSH = 2; K0 = -64 + 32 * s_; } else { DSH = 4; K0 = -64 + 32 * (s_ - 6); } } else { DSH = 0; K0 = -64 + 32 * s_; } } while (0)
#define ATT_CLAMP(pos) (EDGE ? ((pos) < 0 ? 0 : ((pos) > SEQ - 1 ? SEQ - 1 : (pos))) : (pos))
#define ATT_LOADV(st, VR) do { int b_, d_, k_; ATT_GEOM(st, b_, d_, k_); _Pragma("unroll") for (int c4 = 0; c4 < 4; ++c4) { const int id = lane + 64 * c4, row = id >> 3, ch = id & 7; int pos = b_ + ((k_ + row) << d_); pos = ATT_CLAMP(pos); \
            VR[c4] = ldg8(qkvb + 2048 + (size_t)pos * 3072 + 8 * ch); } } while (0)
#define ATT_LOADK(st, KF) do { int b_, d_, k_; ATT_GEOM(st, b_, d_, k_); _Pragma("unroll") for (int x = 0; x < 2; ++x) { int pos = b_ + ((k_ + 8 * (fr >> 2) + 4 * x + (fr & 3)) << d_); pos = ATT_CLAMP(pos); \
            KF[x][0] = ldg8(qkvb + 1024 + (size_t)pos * 3072 + 8 * fq); KF[x][1] = ldg8(qkvb + 1024 + (size_t)pos * 3072 + 8 * fq + 32); } } while (0)
#define ATT_QPOS(it) ((MODE == 0 ? base0 + 2 * wid + (it) + 16 * fr : base0 + 32 * wid + 16 * (it) + fr))
    bf16x8 qf0 = ldg8(qkvb + (size_t)ATT_QPOS(0) * 3072 + 8 * fq), qf1 = ldg8(qkvb + (size_t)ATT_QPOS(0) * 3072 + 8 * fq + 32);
    const bf16x8 qn0 = ldg8(qkvb + (size_t)ATT_QPOS(1) * 3072 + 8 * fq), qn1 = ldg8(qkvb + (size_t)ATT_QPOS(1) * 3072 + 8 * fq + 32);
    bf16x8 vB[4], kf[2][2];
    { bf16x8 vA[4]; ATT_LOADV(0, vA); ATT_LOADK(0, kf); ATT_LOADV(1, vB);
#pragma unroll
      for (int c4 = 0; c4 < 4; ++c4) { const int id = lane + 64 * c4, row = id >> 3, ch = id & 7; *(LAS bf16x8*)(vt + row * VLD + ch * 16) = vA[c4]; } }
    f32x4 o[4];
#pragma unroll
    for (int mb = 0; mb < 4; ++mb) o[mb] = (f32x4){0.f, 0.f, 0.f, 0.f};
    float lsum = 0.f;
    asm volatile("" ::: "memory");
#pragma unroll 1
    for (int st = 0; st < NST; ++st) {
        bf16x8 vC[4], kfn[2][2];
        const int stn = st + 1 < NST ? st + 1 : NST - 1, st2 = st + 2 < NST ? st + 2 : NST - 1;
        ATT_LOADK(stn, kfn); ATT_LOADV(st2, vC);
        LAS unsigned char* vcur = vt + (st & 1) * ATT_VT; LAS unsigned char* vnxt = vt + ((st + 1) & 1) * ATT_VT;
        bf16x8 vf[4];
#pragma unroll
        for (int mb = 0; mb < 4; ++mb) {
            const s16x4 t0v = __builtin_amdgcn_ds_read_tr16_b64_v4i16((LAS s16x4*)(vcur + (8 * fq + trq) * VLD + (16 * mb + 4 * trp) * 2));
            const s16x4 t1v = __builtin_amdgcn_ds_read_tr16_b64_v4i16((LAS s16x4*)(vcur + (8 * fq + 4 + trq) * VLD + (16 * mb + 4 * trp) * 2));
            vf[mb] = __builtin_shufflevector(t0v, t1v, 0, 1, 2, 3, 4, 5, 6, 7); }
#pragma unroll
        for (int c4 = 0; c4 < 4; ++c4) { const int id = lane + 64 * c4, row = id >> 3, ch = id & 7; *(LAS bf16x8*)(vnxt + row * VLD + ch * 16) = vB[c4]; }
        asm volatile("" ::: "memory");
        int base, dsh, k0; ATT_GEOM(st, base, dsh, k0);
        const int kq = MODE == 0 ? (fr << (4 - dsh)) : fr;
        f32x4 s0 = mfma16(kf[0][0], qf0, (f32x4){0.f, 0.f, 0.f, 0.f}); s0 = mfma16(kf[0][1], qf1, s0);
        f32x4 s1 = mfma16(kf[1][0], qf0, (f32x4){0.f, 0.f, 0.f, 0.f}); s1 = mfma16(kf[1][1], qf1, s1);
        float pv[8]; const int t0 = k0 + 8 * fq - kq + 64;
#pragma unroll
        for (int j = 0; j < 8; ++j) { bool valid = (unsigned)(t0 + j) <= 128u;
            if (EDGE) { const int pos = base + ((k0 + 8 * fq + j) << dsh); valid = valid && pos >= 0 && pos < SEQ; }
            const float sv = j < 4 ? s0[j & 3] : s1[j & 3]; pv[j] = valid ? __builtin_amdgcn_exp2f(sv * c1 - c2) : 0.f; lsum += pv[j]; }
        const bf16x8 pf = pack8(pv);
#pragma unroll
        for (int mb = 0; mb < 4; ++mb) o[mb] = mfma16(vf[mb], pf, o[mb]);
        asm volatile("" ::: "memory");
        if (st == NSI - 1 || st == NST - 1) {
            const int it = st == NSI - 1 ? 0 : 1;
            lsum += __shfl_xor(lsum, 16); lsum += __shfl_xor(lsum, 32);
            if (MODE == 0) { const int ql = 2 * wid + it + 16 * fr;
#pragma unroll
                for (int mb = 0; mb < 4; ++mb) *(LAS f32x4*)(Opart + ql * OLD + 16 * mb + 4 * fq) = o[mb];
                if (fq == 0) lpart[ql] = lsum;
            } else { const int ql = 32 * wid + 16 * it + fr; const float inv = 1.0f / (lsum + lpart[ql]);
#pragma unroll
                for (int mb = 0; mb < 4; ++mb) { const f32x4 tot = (o[mb] + *(const LAS f32x4*)(Opart + ql * OLD + 16 * mb + 4 * fq)) * inv;
                    *(u32x2*)(outb + (size_t)(base0 + ql) * 2048 + 16 * mb + 4 * fq) = pk4(tot); } }
#pragma unroll
            for (int mb = 0; mb < 4; ++mb) o[mb] = (f32x4){0.f, 0.f, 0.f, 0.f};
            lsum = 0.f; qf0 = qn0; qf1 = qn1;
        }
#pragma unroll
        for (int c4 = 0; c4 < 4; ++c4) vB[c4] = vC[c4];
        kf[0][0] = kfn[0][0]; kf[0][1] = kfn[0][1]; kf[1][0] = kfn[1][0]; kf[1][1] = kfn[1][1];
    }
#undef ATT_GEOM
#undef ATT_CLAMP
#undef ATT_LOADV
#undef ATT_LOADK
#undef ATT_QPOS
}
DEV void ph_attn2(const P& p, LAS unsigned char* lds) {
    float gq = 0.f, gk = 0.f;
    for (int c = 0; c < 64; ++c) { gq = fmaxf(gq, fabsf(p.q_norm[c])); gk = fmaxf(gk, fabsf(p.k_norm[c])); }
    const float c1 = 0.125f * 1.44269504089f, c2 = 8.0f * gq * gk * 1.44269504089f;
    constexpr int NJB = SEQ / 256;
    const bool xmap = gridDim.x == 256 && NJB % 32 == 0;
    for (int u0 = blockIdx.x; u0 < BATCH * 16 * NJB; u0 += gridDim.x) {
        int u = u0;
        if (xmap) { const int k = u0 >> 8, xcd = blockIdx.x & 7, slot = blockIdx.x >> 3; constexpr int RPP = NJB / 32; const int pair = xcd * (BATCH * 16 / 8) + k / RPP; u = pair * NJB + (k % RPP) * 32 + slot; }
        const int jb = u % NJB, h = (u / NJB) & 15, b = (u / NJB) >> 4, base0 = 256 * jb;
        const bf16_t* qkvb = p.qkv + (size_t)b * SEQ * 3072 + h * 64; bf16_t* outb = p.mix + (size_t)b * SEQ * 2048 + h * 64;
        const bool edge = base0 < 1024 || base0 + 255 + 1520 >= SEQ;
        if (edge) attn_stream<0, true>(lds, qkvb, outb, base0, c1, c2); else attn_stream<0, false>(lds, qkvb, outb, base0, c1, c2);
        __syncthreads();
        if (edge) attn_stream<1, true>(lds, qkvb, outb, base0, c1, c2); else attn_stream<1, false>(lds, qkvb, outb, base0, c1, c2);
        __syncthreads();
    }
}

static_assert(SEQ % 512 == 0, "top-k: SEQ / 512 values per thread");
DEV void ph_topk(const P& p, LAS unsigned char* lds) {
    constexpr int NV_T = SEQ / 512;
    LAS unsigned* hist = (LAS unsigned*)lds; LAS unsigned* wtot = hist + 256; LAS unsigned* bcw = hist + 272;
    const int tid = threadIdx.x, lane = tid & 63, wid = tid >> 6;
    for (int be = blockIdx.x; be < BATCH * NE; be += gridDim.x) {
        const float* a = p.aff + (size_t)be * SEQ + (size_t)tid * NV_T;
        unsigned v[NV_T];
#pragma unroll
        for (int q = 0; q < NV_T / 4; ++q) { const uint4 u = *(const uint4*)(a + 4 * q); v[4 * q] = u.x; v[4 * q + 1] = u.y; v[4 * q + 2] = u.z; v[4 * q + 3] = u.w; }
        unsigned prefix = 0u;
#pragma unroll 1
        for (int bit = 30; bit >= 0; --bit) {
            const unsigned cand = prefix | (1u << bit); unsigned cnt = 0u;
#pragma unroll
            for (int j = 0; j < NV_T; ++j) cnt += v[j] >= cand ? 1u : 0u;
#pragma unroll
            for (int o = 32; o >= 1; o >>= 1) cnt += __shfl_xor(cnt, o);
            LAS unsigned* slot = wtot + 16 * (bit & 1);
            if (lane == 0) slot[wid] = cnt;
            __syncthreads();
            unsigned tot = 0u;
#pragma unroll
            for (int w = 0; w < 8; ++w) tot += slot[w];
            if (tot >= (unsigned)CAP) prefix = cand;
        }
        unsigned cgtl = 0u;
#pragma unroll
        for (int j = 0; j < NV_T; ++j) cgtl += v[j] > prefix ? 1u : 0u;
#pragma unroll
        for (int o = 32; o >= 1; o >>= 1) cgtl += __shfl_xor(cgtl, o);
        __syncthreads();
        if (lane == 0) hist[wid] = cgtl;
        __syncthreads();
        unsigned cgt_tot = 0u;
#pragma unroll
        for (int w = 0; w < 8; ++w) cgt_tot += hist[w];
        const unsigned kk = CAP - cgt_tot;
        __syncthreads();
        const unsigned Tb = prefix, need = kk, cgt = CAP - need;
        unsigned ngt = 0u, neq = 0u;
#pragma unroll
        for (int j = 0; j < NV_T; ++j) { ngt += v[j] > Tb ? 1u : 0u; neq += v[j] == Tb ? 1u : 0u; }
        const unsigned packed = ngt | (neq << 16); unsigned inc = packed;
#pragma unroll
        for (int o = 1; o < 64; o <<= 1) { const unsigned t = __shfl_up(inc, o); if (lane >= o) inc += t; }
        if (lane == 63) wtot[wid] = inc;
        __syncthreads();
        unsigned wbase = 0u;
        for (int w = 0; w < wid; ++w) wbase += wtot[w];
        const unsigned exc = wbase + inc - packed; unsigned gbase = exc & 0xffffu, ebase = exc >> 16;
        int* smp = p.slotmap + (size_t)be * SEQ + (size_t)tid * NV_T;
#pragma unroll
        for (int q = 0; q < NV_T / 4; ++q) { int sl[4];
#pragma unroll
            for (int i = 0; i < 4; ++i) { const int j = 4 * q + i; int slot = -1;
                if (v[j] > Tb) { slot = (int)gbase; ++gbase; } else if (v[j] == Tb) { if (ebase < need) slot = (int)(cgt + ebase); ++ebase; }
                if (slot >= 0) { p.idx[(size_t)be * CAP + slot] = tid * NV_T + j; p.gate[(size_t)be * CAP + slot] = __uint_as_float(v[j]); }
                sl[i] = slot; }
            *(int4*)(smp + 4 * q) = int4{sl[0], sl[1], sl[2], sl[3]}; }
        __syncthreads();
    }
}

#define XB_TMO      128
#define XB_XCNT(j)  (256  + 64 * (j))
#define XB_XSUB(j)  (1280 + 64 * (j))
#define XB_XGEN(j)  (2304 + 64 * (j))
#define XB_TOP      3328
#define XB_TOPGEN   3392
#define XCD_BAR_WORDS 3456
#define XB_SPIN_CAP (1u << 18)

__device__ __forceinline__ unsigned xb_ld(unsigned* p)              { return __hip_atomic_load(p, __ATOMIC_RELAXED, __HIP_MEMORY_SCOPE_AGENT); }
__device__ __forceinline__ unsigned xb_add(unsigned* p, unsigned v) { return __hip_atomic_fetch_add(p, v, __ATOMIC_RELAXED, __HIP_MEMORY_SCOPE_AGENT); }
__device__ __forceinline__ unsigned xb_xcc_id() { return (unsigned)__builtin_amdgcn_s_getreg((3 << 11) | 20) & 0xFu; }
#define XB_SPIN(cond, bar) do { unsigned _sp = 0; while (cond) { __builtin_amdgcn_s_sleep(1); \
    if ((++_sp & 255u) == 0u) { if (xb_ld(&(bar)[XB_TMO])) break; if (_sp > XB_SPIN_CAP) { atomicAdd(&(bar)[XB_TMO], 1u); break; } } } } while (0)

struct XcdBarrier {
    unsigned* bar; unsigned x;
    volatile LAS unsigned* st;
};

__device__ __forceinline__ XcdBarrier xcd_barrier_post(unsigned* bar, volatile LAS unsigned* st) {
    XcdBarrier b; b.bar = bar; b.x = xb_xcc_id(); b.st = st;
    if (threadIdx.x == 0) (void)xb_add(&bar[XB_XCNT(b.x)], 1u);
    return b;
}
__device__ __forceinline__ void xcd_barrier_complete(unsigned* bar, unsigned x, unsigned& nloc, unsigned& nx) {
    const unsigned G = gridDim.x * gridDim.y * gridDim.z;
    unsigned sum, cnt, mine, sp = 0u;
    for (;;) {
        sum = 0u; cnt = 0u; mine = 0u;
#pragma unroll
        for (unsigned j = 0; j < 16; ++j) { const unsigned c = xb_ld(&bar[XB_XCNT(j)]); sum += c; cnt += (c > 0u) ? 1u : 0u; mine = (j == x) ? c : mine; }
        if (sum == G) break;
        __builtin_amdgcn_s_sleep(1);
        if ((++sp & 255u) == 0u) { if (xb_ld(&bar[XB_TMO])) break; if (sp > XB_SPIN_CAP) { atomicAdd(&bar[XB_TMO], 1u); break; } }
    }
    nloc = mine > 0u ? mine : 1u; nx = cnt > 0u ? cnt : 1u;
}

__device__ __forceinline__ void xcd_barrier(const XcdBarrier& b) {
    asm volatile("s_waitcnt vmcnt(0)" ::: "memory");
    __syncthreads();
    if (threadIdx.x == 0) {
        unsigned* bar = b.bar;
        __builtin_amdgcn_s_waitcnt(0);
        unsigned nloc = b.st[0], nx = b.st[1];
        if (nloc == 0u) { xcd_barrier_complete(bar, b.x, nloc, nx); b.st[0] = nloc; b.st[1] = nx; }
        const unsigned old = xb_add(&bar[XB_XSUB(b.x)], 1u);
        const unsigned gen = old / nloc;
        if (old + 1u == (gen + 1u) * nloc) {
            __builtin_amdgcn_fence(__ATOMIC_RELEASE, "agent");
            asm volatile("s_waitcnt vmcnt(0)" ::: "memory");
            const unsigned og = xb_add(&bar[XB_TOP], 1u);
            const unsigned tg = og / nx;
            if (og + 1u == (tg + 1u) * nx) xb_add(&bar[XB_TOPGEN], 1u);
            else XB_SPIN(xb_ld(&bar[XB_TOPGEN]) == tg, bar);
            __builtin_amdgcn_fence(__ATOMIC_ACQUIRE, "agent");
            xb_add(&bar[XB_XGEN(b.x)], 1u);
            asm volatile("s_waitcnt vmcnt(0)" ::: "memory");
        } else {
            XB_SPIN(xb_ld(&bar[XB_XGEN(b.x)]) == gen, bar);
            __builtin_amdgcn_fence(__ATOMIC_ACQUIRE, "agent");
            asm volatile("s_waitcnt vmcnt(0)" ::: "memory");
        }
    }
    __syncthreads();
}


enum { PH_FIRST = 0, PH_G1, PH_PREP, PH_ATTN, PH_SSDB, PH_SSDC, PH_GNORM, PH_G2, PH_ROUTE0, PH_TOPK0, PH_UP0, PH_DOWN0, PH_COMB0, PH_G3, PH_CONV3, PH_G4, PH_ROUTE1, PH_TOPK1, PH_UP1, PH_DOWN1, PH_COMB1, NPH };

constexpr int LDS_BYTES = 147456;
constexpr int LDS_XB = LDS_BYTES - 16;
__global__ void __launch_bounds__(512, 2) fwd(P p, int lo, int hi) {
    extern __shared__ __attribute__((aligned(16))) unsigned char shm[];
    LAS unsigned char* lds = (LAS unsigned char*)shm;
    XcdBarrier bar; bar.bar = p.bar; bar.x = 0; bar.st = (volatile LAS unsigned*)(lds + LDS_XB);
    if (hi - lo > 1) {
        if (threadIdx.x == 0) { ((LAS unsigned*)(lds + LDS_XB))[0] = 0u; ((LAS unsigned*)(lds + LDS_XB))[1] = 0u; }
        __syncthreads();
        bar = xcd_barrier_post(p.bar, (volatile LAS unsigned*)(lds + LDS_XB));
    }
#if NAIVE_GEMM
#define GEMM_SEL(a, b) a
#else
#define GEMM_SEL(a, b) b
#endif
#if NAIVE_SSD
#define SSD_SEL(a, b) a
#else
#define SSD_SEL(a, b) b
#endif
#if NAIVE_ATTN
#define ATTN_SEL(a, b) a
#else
#define ATTN_SEL(a, b) b
#endif
#if NAIVE_TOPK
#define TOPK_SEL(a, b) a
#else
#define TOPK_SEL(a, b) b
#endif
#if FP8_MOE
#define CVX_SEL(layer) ph_convert_experts_f8(p, layer, lds)
#else
#define CVX_SEL(layer) ph_convert_experts_dev(p, layer, lds)
#endif
#ifndef PROBE_DUP
#define PROBE_DUP -1
#endif
#define PHASE(i, body) if (lo <= (i) && (i) < hi) { body; if ((i) == PROBE_DUP) { xcd_barrier(bar); body; } if ((i) + 1 < hi) xcd_barrier(bar); }
    PHASE(PH_FIRST, { ph_convert_small(p); ph_rmsnorm_dev(p.x, p.attn_norm, p.hn); CVX_SEL(0); })
    PHASE(PH_G1, GEMM_SEL(nv_g1(p), ph_g1(p, lds)))
    PHASE(PH_PREP, ph_prep_dev(p, lds))
    PHASE(PH_ATTN, { ATTN_SEL(nv_attn(p), ph_attn2(p, lds)); SSD_SEL(nv_ssd(p), ph_ssd_states(p)); })
    PHASE(PH_SSDB, SSD_SEL((void)0, ph_ssd_scan(p)))
    PHASE(PH_SSDC, SSD_SEL((void)0, ph_ssd_out(p, lds)))
    PHASE(PH_GNORM, ph_gated_norm_dev(p))
    PHASE(PH_G2, GEMM_SEL(nv_g2(p), ph_g2(p, lds)))
    PHASE(PH_ROUTE0, ph_norm_router_mfma(p, 0, lds))
    PHASE(PH_TOPK0, TOPK_SEL(nv_topk(p), ph_topk(p, lds)))
    PHASE(PH_UP0, GEMM_SEL(nv_up(p), ph_up(p, lds)))
    PHASE(PH_DOWN0, GEMM_SEL(nv_down(p), ph_down(p, lds)))
    PHASE(PH_COMB0, { ph_combine_dev4(p, p.conv_norm); CVX_SEL(1); })
    PHASE(PH_G3, GEMM_SEL(nv_g3(p), ph_g3(p, lds)))
    PHASE(PH_CONV3, ph_conv3_dev(p))
    PHASE(PH_G4, GEMM_SEL(nv_g4(p), ph_g4(p, lds)))
    PHASE(PH_ROUTE1, ph_norm_router_mfma(p, 1, lds))
    PHASE(PH_TOPK1, TOPK_SEL(nv_topk(p), ph_topk(p, lds)))
    PHASE(PH_UP1, GEMM_SEL(nv_up(p), ph_up(p, lds)))
    PHASE(PH_DOWN1, GEMM_SEL(nv_down(p), ph_down(p, lds)))
    PHASE(PH_COMB1, ph_combine_dev4(p, nullptr))
}

extern "C" void kernel_launch(void* const* d_in, const int* in_sizes, int n_in, void* d_out, int out_size, void* d_ws, size_t ws_size, hipStream_t stream) {
    (void)in_sizes; (void)n_in; (void)out_size; (void)ws_size;
    P p{};
    make_params(p, d_in, d_out, d_ws);
    static int grid = 0;
    if (grid == 0) {
        int dev = 0, cus = 0;
        if (hipGetDevice(&dev) != hipSuccess || hipDeviceGetAttribute(&cus, hipDeviceAttributeMultiprocessorCount, dev) != hipSuccess) cus = 256;
        (void)hipFuncSetAttribute((const void*)fwd, hipFuncAttributeMaxDynamicSharedMemorySize, LDS_BYTES);
        (void)hipGetLastError();
        grid = cus > 0 ? cus : 256;
    }
#if ONE_LAUNCH
    (void)hipMemsetAsync(p.bar, 0, XCD_BAR_WORDS * sizeof(unsigned), stream);
    hipLaunchKernelGGL(fwd, dim3(grid), dim3(512), LDS_BYTES, stream, p, 0, (int)NPH);
#else
    for (int ph = 0; ph < NPH; ++ph) hipLaunchKernelGGL(fwd, dim3(grid), dim3(512), LDS_BYTES, stream, p, ph, ph + 1);
#endif
}
#endif
```

```cpp
#ifndef HOST_EMU
#include <hip/hip_runtime.h>
#define HD __host__ __device__ __forceinline__
#define DEV __device__ __forceinline__
#else
#include <cmath>
#include <cstdio>
#include <cstdlib>
#include <cstring>
#include <cstddef>
#define HD inline
#define DEV inline
struct float4 { float x, y, z, w; };
struct uint4 { unsigned x, y, z, w; };
struct uint2 { unsigned x, y; };
static thread_local size_t emu_tid = 0; static size_t emu_nthreads = 1;
#endif

#ifndef BATCH
#define BATCH 2
#endif
#ifndef SEQ
#define SEQ 16384
#endif
#define XST_OFF(b, ch, pos) ((((size_t)(b) * NCHUNK + ((pos) >> 7)) * 1024 + (ch)) * 128 + ((pos) & 127))
#define BMT_OFF(b, n, pos) ((((size_t)(b) * NCHUNK + ((pos) >> 7)) * 256 + (n)) * 128 + ((pos) & 127))
#ifndef NAIVE_GEMM
#define NAIVE_GEMM 0
#endif
#ifndef NAIVE_ATTN
#define NAIVE_ATTN 0
#endif
#ifndef NAIVE_SSD
#define NAIVE_SSD 0
#endif
#ifndef NAIVE_TOPK
#define NAIVE_TOPK 0
#endif
#ifndef FP8_MOE
#define FP8_MOE 1
#endif
#ifndef PROF_A
#define PROF_A -1
#endif
#ifndef PROF_X
#define PROF_X 0
#endif
#ifndef PROF_B
#define PROF_B -1
#endif
#ifndef ONE_LAUNCH
#define ONE_LAUNCH 1
#endif

typedef unsigned short bf16_t;
constexpr int T = BATCH * SEQ;
constexpr int DM = 1024;
constexpr int NIN = 5664, NIN_PAD = 5888;
constexpr int NE = 16;
constexpr int CAP = 2 * SEQ / NE;
constexpr int NSLOT = BATCH * NE * CAP;
constexpr int DFF = 2048;
constexpr int NCHUNK = SEQ / 128;

HD float bf2f(bf16_t v) { union { unsigned u; float f; } x; x.u = ((unsigned)v) << 16; return x.f; }
HD bf16_t f2bf(float f) { union { unsigned u; float f; } x; x.f = f; unsigned u = x.u; u += 0x7fffu + ((u >> 16) & 1u); return (bf16_t)(u >> 16); }
HD unsigned pack2(float lo, float hi) { return (unsigned)f2bf(lo) | ((unsigned)f2bf(hi) << 16); }
HD float silu_f(float v) { return v / (1.0f + expf(-v)); }
HD float softplus_f(float v) { return v > 20.f ? v : log1pf(expf(v)); }

#ifndef HOST_EMU
#define LANES 64
#define GTID ((size_t)blockIdx.x * blockDim.x + threadIdx.x)
#define GSTRIDE ((size_t)gridDim.x * blockDim.x)
#define LANE ((int)(threadIdx.x & 63))
DEV float wave_sum(float v) {
#pragma unroll
    for (int o = 32; o >= 1; o >>= 1) v += __shfl_xor(v, o);
    return v;
}
#else
#define LANES 1
#define GTID (emu_tid)
#define GSTRIDE (emu_nthreads)
#define LANE 0
DEV float wave_sum(float v) { return v; }
#endif
#define GWAVE (GTID / LANES)
#define NWAVES_G (GSTRIDE / LANES)

struct P {
    const float *x, *attn_norm, *w_in, *q_norm, *k_norm, *conv_w, *conv_b, *a_log_f, *a_log_b, *dtb_f, *dtb_b, *ssd_d, *out_norm, *w_out,
        *conv_norm, *cw_in, *cw, *cw_out, *ffn_norm, *router_w, *wg, *wu, *wd;
    float* out;
    bf16_t *WinT, *WoutT, *WciT, *WcoT, *WguT, *WdT, *hn, *qkv, *z, *xbcraw, *bc, *xsT, *bmT, *states, *mix, *yssd, *xe, *hid, *ye, *pbuf, *gb, *abuf, *dlt, *xb2;
    float *dtraw, *step, *stT, *csT, *wdT, *cdec, *aff, *gate, *rope, *ytmp, *rinv, *rinvs;
    int *idx, *slotmap;
    unsigned* bar;
};

constexpr size_t MiB = 1024 * 1024;
constexpr size_t al(size_t v) { return (v + 4095) & ~(size_t)4095; }
constexpr size_t WS_BAR = 0;
constexpr size_t WS_WIN = 65536;
constexpr size_t WS_WOUT = WS_WIN + al((size_t)NIN_PAD * 1024 * 2);
constexpr size_t WS_WCI = WS_WOUT + al((size_t)1024 * 2048 * 2);
constexpr size_t WS_WCO = WS_WCI + al((size_t)3072 * 1024 * 2);
constexpr size_t WS_WGU = WS_WCO + al((size_t)1024 * 1024 * 2);
constexpr size_t WS_WD = WS_WGU + al((size_t)NE * 4096 * 1024 * 2);
constexpr size_t WS_ROPE = WS_WD + al((size_t)NE * 1024 * 2048 * 2);
constexpr size_t WS_AFF = WS_ROPE + al((size_t)SEQ * 16 * 4);
constexpr size_t WS_GATE = WS_AFF + al((size_t)BATCH * NE * SEQ * 4);
constexpr size_t WS_IDX = WS_GATE + al((size_t)NSLOT * 4);
constexpr size_t WS_SMAP = WS_IDX + al((size_t)NSLOT * 4);
constexpr size_t WS_RINV = WS_SMAP + al((size_t)BATCH * NE * SEQ * 4);
constexpr size_t WS_RINVS = WS_RINV + al((size_t)T * 4);
constexpr size_t WS_HN = WS_RINVS + al((size_t)NSLOT * 4);
constexpr size_t WS_E = WS_HN + al((size_t)T * 1024 * 2);
constexpr size_t WS_XBCRAW = WS_E;
constexpr size_t WS_QKV = WS_XBCRAW + al((size_t)T * 1536 * 2);
constexpr size_t WS_Z = WS_QKV + al((size_t)T * 3072 * 2);
constexpr size_t WS_BC = WS_Z + al((size_t)T * 1024 * 2);
constexpr size_t WS_XST = WS_BC + al((size_t)T * 512 * 2);
constexpr size_t WS_BMT = WS_XST + al((size_t)T * 1024 * 2);
constexpr size_t WS_DTRAW = WS_BMT + al((size_t)T * 256 * 2);
constexpr size_t WS_STEP = WS_DTRAW + al((size_t)T * 32 * 4);
constexpr size_t WS_STT = WS_STEP + al((size_t)T * 32 * 4);
constexpr size_t WS_CST = WS_STT + al((size_t)T * 32 * 4);
constexpr size_t WS_WDT = WS_CST + al((size_t)T * 32 * 4);
constexpr size_t WS_CDEC = WS_WDT + al((size_t)T * 32 * 4);
constexpr size_t WS_MIX = WS_CDEC + al((size_t)BATCH * 32 * NCHUNK * 4);
constexpr size_t WS_YSSD = WS_MIX + al((size_t)T * 2048 * 2);
constexpr size_t WS_E_END = WS_YSSD + al((size_t)T * 1024 * 2);
constexpr size_t WS_STATES = WS_HN;
constexpr size_t WS_XE = WS_E;
constexpr size_t WS_HID = WS_XE + al((size_t)NSLOT * 1024 * 2);
constexpr size_t WS_YE = WS_HID + al((size_t)NSLOT * 2048 * 2);
constexpr size_t WS_F_END = WS_YE + al((size_t)NSLOT * 1024 * 2);
constexpr size_t WS_PBUF = WS_E;
constexpr size_t WS_GB = WS_PBUF + al((size_t)T * 1024 * 2);
constexpr size_t WS_ABUF = WS_GB + al((size_t)T * 1024 * 2);
constexpr size_t WS_END = WS_E_END > WS_F_END ? WS_E_END : WS_F_END;
static_assert((size_t)T * 1024 * 2 + (size_t)T * 1536 * 2 >= (size_t)T * 1024 * 4, "ytmp overlay");
static_assert((size_t)T * 1024 * 2 + (size_t)T * 1536 * 2 >= (size_t)BATCH * 2 * NCHUNK * 16 * 64 * 128 * 2, "states overlay");
static_assert(BATCH != 2 || SEQ != 16384 || WS_END <= 1024 * MiB, "workspace");

struct CmIdent { int nvalid; HD int operator()(int n) const { return n < nvalid ? n : -1; } };
struct CmGateUp { HD int operator()(int n) const { return n; } };
struct CmOddIn { HD int operator()(int n) const {
        if (n >= 2048) return n - 2048; const int pn = n >> 8, j = n & 255; return j < 128 ? 1024 + pn * 128 + j : 2048 + pn * 128 + (j - 128); } };

template <class CM> DEV void convT(const float* src, int ldsrc, int K, bf16_t* dst, int Ndst, CM cm, size_t gtid = GTID, size_t gstride = GSTRIDE) {
#ifndef HOST_EMU
    const size_t nitems = (size_t)Ndst * (K / 32);
    for (size_t i = gtid; i < nitems; i += gstride) {
        const int n = (int)(i % Ndst), k32 = (int)(i / Ndst); const int c = cm(n);
        float v[32];
#pragma unroll
        for (int j = 0; j < 32; ++j) v[j] = c >= 0 ? src[(size_t)(k32 * 32 + j) * ldsrc + c] : 0.f;
#pragma unroll
        for (int q = 0; q < 4; ++q) *(uint4*)(dst + (size_t)n * K + k32 * 32 + q * 8) = uint4{pack2(v[8 * q], v[8 * q + 1]), pack2(v[8 * q + 2], v[8 * q + 3]), pack2(v[8 * q + 4], v[8 * q + 5]), pack2(v[8 * q + 6], v[8 * q + 7])};
    }
#else
    for (size_t i = gtid; i < (size_t)Ndst * K; i += gstride) { const int n = (int)(i / K), k = (int)(i % K); const int c = cm(n); dst[i] = c >= 0 ? f2bf(src[(size_t)k * ldsrc + c]) : (bf16_t)0; }
#endif
}
struct CmGU { const float* dummy; HD int operator()(int n) const { return n; } };
template <int WHICH> struct CmHalf { HD int operator()(int n) const { const int j = n & 255; const bool isup = j >= 128; if ((int)isup != WHICH) return -2; return (n >> 8) * 128 + (j & 127); } };
DEV void conv_gateup(const float* sg, const float* su, bf16_t* dst) {
#ifndef HOST_EMU
    const size_t nitems = (size_t)4096 * 32;
    for (size_t i = GTID; i < nitems; i += GSTRIDE) {
        const int n = (int)(i % 4096), k32 = (int)(i / 4096); const int j0 = n & 255; const float* src = (j0 >= 128 ? su : sg) + (n >> 8) * 128 + (j0 & 127);
        float v[32];
#pragma unroll
        for (int j = 0; j < 32; ++j) v[j] = src[(size_t)(k32 * 32 + j) * 2048];
#pragma unroll
        for (int q = 0; q < 4; ++q) *(uint4*)(dst + (size_t)n * 1024 + k32 * 32 + q * 8) = uint4{pack2(v[8 * q], v[8 * q + 1]), pack2(v[8 * q + 2], v[8 * q + 3]), pack2(v[8 * q + 4], v[8 * q + 5]), pack2(v[8 * q + 6], v[8 * q + 7])};
    }
#else
    for (size_t i = GTID; i < (size_t)4096 * 1024; i += GSTRIDE) { const int n = (int)(i / 1024), k = (int)(i % 1024); const int j = n & 255; const float* src = j >= 128 ? su : sg; dst[i] = f2bf(src[(size_t)k * 2048 + (n >> 8) * 128 + (j & 127)]); }
#endif
}
DEV void ph_convert_small_late(const P& p, size_t gtid, size_t gstride) {
    convT(p.cw_in, 3072, 1024, p.WciT, 3072, CmOddIn{}, gtid, gstride);
    convT(p.cw_out, 1024, 1024, p.WcoT, 1024, CmIdent{1024}, gtid, gstride);
}
DEV void ph_rope_table(const P& p, size_t gtid = GTID, size_t gstride = GSTRIDE) {
    for (size_t i = gtid; i < (size_t)SEQ * 8; i += gstride) {
        const int pos = (int)(i >> 3), j = (int)(i & 7);
        const float inv = powf(500000.0f, -((float)j * 2.0f / 16.0f)); const float ang = (float)pos * inv;
        p.rope[(size_t)pos * 16 + j] = cosf(ang); p.rope[(size_t)pos * 16 + 8 + j] = sinf(ang);
    }
}
DEV void ph_convert_small(const P& p) {
    convT(p.w_in, NIN, 1024, p.WinT, NIN_PAD, CmIdent{NIN});
    convT(p.w_out, 1024, 2048, p.WoutT, 1024, CmIdent{1024});
#ifdef HOST_EMU
    ph_convert_small_late(p, GTID, GSTRIDE);
#endif
    ph_rope_table(p);
}
DEV void ph_convert_experts(const P& p, int layer) {
    for (int e = 0; e < NE; ++e) {
        const size_t off = ((size_t)layer * NE + e) * 1024 * 2048;
        conv_gateup(p.wg + off, p.wu + off, p.WguT + (size_t)e * 4096 * 1024);
        convT(p.wd + off, 1024, 2048, p.WdT + (size_t)e * 1024 * 2048, 1024, CmIdent{1024});
    }
}

constexpr int NV = 256 / LANES;
DEV void ph_rmsnorm(const float* src, const float* g, bf16_t* dst) {
    for (size_t row = GWAVE; row < (size_t)T; row += NWAVES_G) {
        const float4* s4 = (const float4*)(src + row * 1024); float4 v[NV]; float ss = 0.f;
#pragma unroll
        for (int j = 0; j < NV; ++j) { v[j] = s4[j * LANES + LANE]; ss += v[j].x * v[j].x + v[j].y * v[j].y + v[j].z * v[j].z + v[j].w * v[j].w; }
        ss = wave_sum(ss); const float r = 1.0f / sqrtf(ss * (1.0f / 1024.0f) + 1e-6f);
#pragma unroll
        for (int j = 0; j < NV; ++j) { const int c4 = j * LANES + LANE; const float4 gg = ((const float4*)g)[c4];
            *(uint2*)(dst + row * 1024 + c4 * 4) = uint2{pack2(v[j].x * r * gg.x, v[j].y * r * gg.y), pack2(v[j].z * r * gg.z, v[j].w * r * gg.w)}; }
    }
}
DEV void ph_norm_router(const P& p, int layer) {
    const float* g = p.ffn_norm + (size_t)layer * 1024; const float* rw = p.router_w + (size_t)layer * 1024 * 16;
    for (size_t row = GWAVE; row < (size_t)T; row += NWAVES_G) {
        const float4* s4 = (const float4*)(p.out + row * 1024); float4 v[NV]; float ss = 0.f;
#pragma unroll
        for (int j = 0; j < NV; ++j) { v[j] = s4[j * LANES + LANE]; ss += v[j].x * v[j].x + v[j].y * v[j].y + v[j].z * v[j].z + v[j].w * v[j].w; }
        ss = wave_sum(ss); const float r = 1.0f / sqrtf(ss * (1.0f / 1024.0f) + 1e-6f);
        float lg[16];
#pragma unroll
        for (int e = 0; e < 16; ++e) lg[e] = 0.f;
#pragma unroll
        for (int j = 0; j < NV; ++j) { const int c4 = j * LANES + LANE; const float4 gg = ((const float4*)g)[c4];
            const float h0 = v[j].x * r * gg.x, h1 = v[j].y * r * gg.y, h2 = v[j].z * r * gg.z, h3 = v[j].w * r * gg.w;
            *(uint2*)(p.hn + row * 1024 + c4 * 4) = uint2{pack2(h0, h1), pack2(h2, h3)};
            const float4* w4 = (const float4*)(rw + (size_t)c4 * 4 * 16);
#pragma unroll
            for (int q = 0; q < 4; ++q) { const float4 a = w4[q], b = w4[4 + q], c = w4[8 + q], d = w4[12 + q];
                lg[4 * q + 0] += h0 * a.x + h1 * b.x + h2 * c.x + h3 * d.x; lg[4 * q + 1] += h0 * a.y + h1 * b.y + h2 * c.y + h3 * d.y;
                lg[4 * q + 2] += h0 * a.z + h1 * b.z + h2 * c.z + h3 * d.z; lg[4 * q + 3] += h0 * a.w + h1 * b.w + h2 * c.w + h3 * d.w; } }
        float mx = -1e30f;
#pragma unroll
        for (int e = 0; e < 16; ++e) { lg[e] = wave_sum(lg[e]); mx = fmaxf(mx, lg[e]); }
        float den = 0.f;
#pragma unroll
        for (int e = 0; e < 16; ++e) { lg[e] = expf(lg[e] - mx); den += lg[e]; }
        const float inv = 1.0f / den; const int b = (int)(row / SEQ), s = (int)(row % SEQ);
#pragma unroll
        for (int e = 0; e < 16; ++e) if (LANE == (e & (LANES - 1))) p.aff[((size_t)b * NE + e) * SEQ + s] = lg[e] * inv;
    }
}
DEV void ph_gated_norm(const P& p) {
    for (size_t row = GWAVE; row < (size_t)T; row += NWAVES_G) {
        float4 v[NV]; float ss = 0.f;
#pragma unroll
        for (int j = 0; j < NV; ++j) { const int c4 = j * LANES + LANE; const uint2 y = *(const uint2*)(p.yssd + row * 1024 + c4 * 4), zz = *(const uint2*)(p.z + row * 1024 + c4 * 4);
            v[j].x = bf2f((bf16_t)(y.x & 0xffff)) * silu_f(bf2f((bf16_t)(zz.x & 0xffff))); v[j].y = bf2f((bf16_t)(y.x >> 16)) * silu_f(bf2f((bf16_t)(zz.x >> 16)));
            v[j].z = bf2f((bf16_t)(y.y & 0xffff)) * silu_f(bf2f((bf16_t)(zz.y & 0xffff))); v[j].w = bf2f((bf16_t)(y.y >> 16)) * silu_f(bf2f((bf16_t)(zz.y >> 16)));
            ss += v[j].x * v[j].x + v[j].y * v[j].y + v[j].z * v[j].z + v[j].w * v[j].w; }
        ss = wave_sum(ss); const float r = 1.0f / sqrtf(ss * (1.0f / 1024.0f) + 1e-6f);
#pragma unroll
        for (int j = 0; j < NV; ++j) { const int c4 = j * LANES + LANE; const float4 gg = ((const float4*)p.out_norm)[c4];
            *(uint2*)(p.mix + row * 2048 + 1024 + c4 * 4) = uint2{pack2(v[j].x * r * gg.x, v[j].y * r * gg.y), pack2(v[j].z * r * gg.z, v[j].w * r * gg.w)}; }
    }
}
DEV void ph_combine(const P& p, const float* g) {
    for (size_t row = GWAVE; row < (size_t)T; row += NWAVES_G) {
        const int b = (int)(row / SEQ), s = (int)(row % SEQ);
        float4* o4 = (float4*)(p.out + row * 1024); float4 v[NV];
#pragma unroll
        for (int j = 0; j < NV; ++j) v[j] = o4[j * LANES + LANE];
        for (int e = 0; e < NE; ++e) {
            const int sl = p.slotmap[((size_t)b * NE + e) * SEQ + s];
            if (sl >= 0) { const size_t r = ((size_t)b * NE + e) * CAP + sl; const float gt = p.gate[r];
#pragma unroll
                for (int j = 0; j < NV; ++j) { const int c4 = j * LANES + LANE; const uint2 y = *(const uint2*)(p.ye + r * 1024 + c4 * 4);
                    v[j].x += gt * bf2f((bf16_t)(y.x & 0xffff)); v[j].y += gt * bf2f((bf16_t)(y.x >> 16)); v[j].z += gt * bf2f((bf16_t)(y.y & 0xffff)); v[j].w += gt * bf2f((bf16_t)(y.y >> 16)); } }
        }
        float ss = 0.f;
#pragma unroll
        for (int j = 0; j < NV; ++j) { o4[j * LANES + LANE] = v[j]; ss += v[j].x * v[j].x + v[j].y * v[j].y + v[j].z * v[j].z + v[j].w * v[j].w; }
        if (g) { ss = wave_sum(ss); const float r = 1.0f / sqrtf(ss * (1.0f / 1024.0f) + 1e-6f);
#pragma unroll
            for (int j = 0; j < NV; ++j) { const int c4 = j * LANES + LANE; const float4 gg = ((const float4*)g)[c4];
                *(uint2*)(p.hn + row * 1024 + c4 * 4) = uint2{pack2(v[j].x * r * gg.x, v[j].y * r * gg.y), pack2(v[j].z * r * gg.z, v[j].w * r * gg.w)}; } }
    }
}

DEV void ld8(const bf16_t* p, float (&f)[8]) { const uint4 u = *(const uint4*)p; const unsigned w[4] = {u.x, u.y, u.z, u.w};
#pragma unroll
    for (int j = 0; j < 4; ++j) { f[2 * j] = bf2f((bf16_t)(w[j] & 0xffff)); f[2 * j + 1] = bf2f((bf16_t)(w[j] >> 16)); } }
DEV void st8(bf16_t* p, const float (&f)[8]) { *(uint4*)p = uint4{pack2(f[0], f[1]), pack2(f[2], f[3]), pack2(f[4], f[5]), pack2(f[6], f[7])}; }

DEV void ph_prep(const P& p, bool doqk = true) {
    for (size_t i = GTID; doqk && i < (size_t)T * 32; i += GSTRIDE) {
        const size_t t = i >> 5; const int hh = (int)(i & 31); const int isk = hh >> 4, h = hh & 15; const int pos = (int)(t % SEQ);
        bf16_t* ptr = p.qkv + t * 3072 + isk * 1024 + h * 64; const float* gn = isk ? p.k_norm : p.q_norm;
        float v[64]; float ss = 0.f;
#pragma unroll
        for (int c = 0; c < 8; ++c) { float f[8]; ld8(ptr + c * 8, f);
#pragma unroll
            for (int j = 0; j < 8; ++j) { v[c * 8 + j] = f[j]; ss += f[j] * f[j]; } }
        const float r = 1.0f / sqrtf(ss * (1.0f / 64.0f) + 1e-6f);
#pragma unroll
        for (int c = 0; c < 64; ++c) v[c] = v[c] * r * gn[c];
#pragma unroll
        for (int j = 0; j < 8; ++j) { const float cs = p.rope[(size_t)pos * 16 + j], sn = p.rope[(size_t)pos * 16 + 8 + j]; const float x1 = v[j], x2 = v[8 + j]; v[j] = x1 * cs - x2 * sn; v[8 + j] = x2 * cs + x1 * sn; }
#pragma unroll
        for (int c = 0; c < 8; ++c) { float f[8];
#pragma unroll
            for (int j = 0; j < 8; ++j) f[j] = v[c * 8 + j];
            st8(ptr + c * 8, f); }
    }
    for (size_t i = GTID; i < (size_t)T * 192; i += GSTRIDE) {
        const size_t t = i % T; const int c8 = (int)(i / T) * 8; const int pos = (int)(t % SEQ); const int b = (int)(t / SEQ);
        float acc[8];
#pragma unroll
        for (int j = 0; j < 8; ++j) acc[j] = p.conv_b[c8 + j];
#pragma unroll
        for (int k = 0; k < 5; ++k) { const int pp = pos + k - 2; if (pp < 0 || pp >= SEQ) continue; float f[8]; ld8(p.xbcraw + (t + k - 2) * 1536 + c8, f);
#pragma unroll
            for (int j = 0; j < 8; ++j) acc[j] += f[j] * p.conv_w[k * 1536 + c8 + j]; }
#pragma unroll
        for (int j = 0; j < 8; ++j) acc[j] = silu_f(acc[j]);
        if (c8 < 1024) {
#pragma unroll
            for (int j = 0; j < 8; ++j) p.xsT[XST_OFF(b, c8 + j, pos)] = f2bf(acc[j]);
        } else {
            st8(p.bc + t * 512 + (c8 - 1024), acc);
            if (c8 < 1280) {
#pragma unroll
                for (int j = 0; j < 8; ++j) p.bmT[BMT_OFF(b, (c8 - 1024) + j, pos)] = f2bf(acc[j]); }
        }
    }
    for (size_t i = GTID; i < (size_t)BATCH * NCHUNK * 32; i += GSTRIDE) {
        const int j = (int)(i & 31); const int c = (int)((i >> 5) % NCHUNK), b = (int)((i >> 5) / NCHUNK); const int dir = j >> 4, h = j & 15;
        const float A = -expf(dir ? p.a_log_b[h] : p.a_log_f[h]), bias = dir ? p.dtb_b[h] : p.dtb_f[h];
        const size_t row0 = (size_t)b * SEQ + (size_t)c * 128; float* stT = p.stT + ((size_t)b * 32 + j) * SEQ + c * 128; float* csT = p.csT + ((size_t)b * 32 + j) * SEQ + c * 128; float* wdT = p.wdT + ((size_t)b * 32 + j) * SEQ + c * 128;
        float run = 0.f;
        for (int ll = 0; ll < 128; ++ll) { const int l = dir ? 127 - ll : ll; const float dt = softplus_f(p.dtraw[(row0 + l) * 32 + j] + bias); p.step[(row0 + l) * 32 + j] = dt; stT[l] = dt; run += dt * A; csT[l] = run; }
        for (int l = 0; l < 128; ++l) wdT[l] = stT[l] * expf(run - csT[l]);
        p.cdec[((size_t)b * 32 + j) * NCHUNK + c] = expf(run);
    }
}
DEV void ph_gather(const P& p) {
    for (size_t i = GTID; i < (size_t)NSLOT * 128; i += GSTRIDE) { const size_t r = i >> 7; const int j = (int)(i & 127); const int b = (int)(r / ((size_t)NE * CAP));
        *(uint4*)(p.xe + r * 1024 + j * 8) = *(const uint4*)(p.hn + ((size_t)b * SEQ + p.idx[r]) * 1024 + j * 8); }
}
DEV void ph_conv3(const P& p) {
    for (size_t i = GTID; i < (size_t)T * 128; i += GSTRIDE) {
        const size_t t = i >> 7; const int c8 = (int)(i & 127) * 8; const int pos = (int)(t % SEQ);
        float acc[8], f[8];
#pragma unroll
        for (int j = 0; j < 8; ++j) acc[j] = 0.f;
#pragma unroll
        for (int k = 0; k < 3; ++k) { const int pp = pos + k - 1; if (pp < 0 || pp >= SEQ) continue; ld8(p.pbuf + (t + k - 1) * 1024 + c8, f);
#pragma unroll
            for (int j = 0; j < 8; ++j) acc[j] += f[j] * p.cw[k * 1024 + c8 + j]; }
        ld8(p.gb + t * 1024 + c8, f);
#pragma unroll
        for (int j = 0; j < 8; ++j) acc[j] *= f[j];
        st8(p.abuf + t * 1024 + c8, acc);
    }
}

DEV float dot_bf(const bf16_t* a, const bf16_t* b, int K) { float acc = 0.f; for (int k = 0; k < K; k += 8) { float fa[8], fb[8]; ld8(a + k, fa); ld8(b + k, fb);
#pragma unroll
        for (int j = 0; j < 8; ++j) acc += fa[j] * fb[j]; } return acc; }
DEV void nv_g1(const P& p) {
    for (size_t i = GTID; i < (size_t)T * NIN; i += GSTRIDE) { const size_t m = i / NIN; const int n = (int)(i % NIN); const float acc = dot_bf(p.hn + m * 1024, p.WinT + (size_t)n * 1024, 1024);
        if (n < 3072) p.qkv[m * 3072 + n] = f2bf(acc); else if (n < 4096) p.z[m * 1024 + n - 3072] = f2bf(acc); else if (n < 5632) p.xbcraw[m * 1536 + n - 4096] = f2bf(acc); else p.dtraw[m * 32 + n - 5632] = acc; }
}
DEV void nv_g2(const P& p) {
    for (size_t i = GTID; i < (size_t)T * 1024; i += GSTRIDE) { const size_t m = i >> 10; const int n = (int)(i & 1023); p.out[i] = p.x[i] + dot_bf(p.mix + m * 2048, p.WoutT + (size_t)n * 2048, 2048); }
}
DEV void nv_up(const P& p) {
    for (size_t i = GTID; i < (size_t)NSLOT * 2048; i += GSTRIDE) { const size_t r = i >> 11; const int n = (int)(i & 2047); const int e = (int)((r / CAP) % NE);
        const bf16_t* w = p.WguT + (size_t)e * 4096 * 1024 + (size_t)((n >> 7) * 256 + (n & 127)) * 1024;
        const float g = dot_bf(p.xe + r * 1024, w, 1024), u = dot_bf(p.xe + r * 1024, w + (size_t)128 * 1024, 1024); p.hid[i] = f2bf(silu_f(g) * u); }
}
DEV void nv_down(const P& p) {
    for (size_t i = GTID; i < (size_t)NSLOT * 1024; i += GSTRIDE) { const size_t r = i >> 10; const int n = (int)(i & 1023); const int e = (int)((r / CAP) % NE);
        p.ye[i] = f2bf(dot_bf(p.hid + r * 2048, p.WdT + (size_t)e * 1024 * 2048 + (size_t)n * 2048, 2048)); }
}
DEV void nv_g3(const P& p) {
    for (size_t i = GTID; i < (size_t)T * 2048; i += GSTRIDE) { const size_t m = i >> 11; const int n = (int)(i & 2047);
        if (n < 1024) { const bf16_t* w = p.WciT + (size_t)((n >> 7) * 256 + (n & 127)) * 1024; p.pbuf[m * 1024 + n] = f2bf(dot_bf(p.hn + m * 1024, w, 1024) * dot_bf(p.hn + m * 1024, w + (size_t)128 * 1024, 1024)); }
        else p.gb[m * 1024 + n - 1024] = f2bf(dot_bf(p.hn + m * 1024, p.WciT + (size_t)(2048 + n - 1024) * 1024, 1024)); }
}
DEV void nv_g4(const P& p) {
    for (size_t i = GTID; i < (size_t)T * 1024; i += GSTRIDE) { const size_t m = i >> 10; const int n = (int)(i & 1023); p.out[i] += dot_bf(p.abuf + m * 1024, p.WcoT + (size_t)n * 1024, 1024); }
}
DEV void nv_attn(const P& p) {
    for (size_t i = GTID; i < (size_t)T * 16; i += GSTRIDE) {
        const size_t t = i >> 4; const int h = (int)(i & 15); const int pos = (int)(t % SEQ); const size_t t0 = t - pos;
        const bf16_t* qp = p.qkv + t * 3072 + h * 64;
        float o[64]; float m = -1e30f, l = 0.f;
#pragma unroll
        for (int c = 0; c < 64; ++c) o[c] = 0.f;
        for (int pat = 0; pat < 3; ++pat) { const int d = pat == 0 ? 1 : (pat == 1 ? 4 : 16);
            for (int j = -64; j <= 64; ++j) { const int kp = pos + d * j; if (kp < 0 || kp >= SEQ) continue;
                const bf16_t* kr = p.qkv + (t0 + kp) * 3072 + 1024 + h * 64; const bf16_t* vr = kr + 1024;
                const float s = dot_bf(qp, kr, 64) * 0.125f;
                const float mn = fmaxf(m, s), sc = expf(m - mn), pe = expf(s - mn); l = l * sc + pe; m = mn;
#pragma unroll
                for (int c = 0; c < 8; ++c) { float f[8]; ld8(vr + c * 8, f);
#pragma unroll
                    for (int q = 0; q < 8; ++q) o[c * 8 + q] = o[c * 8 + q] * sc + pe * f[q]; } } }
        const float inv = 1.0f / l;
#pragma unroll
        for (int c = 0; c < 8; ++c) { float f[8];
#pragma unroll
            for (int q = 0; q < 8; ++q) f[q] = o[c * 8 + q] * inv;
            st8(p.mix + t * 2048 + h * 64 + c * 8, f); }
    }
}
DEV void nv_ssd(const P& p) {
    const size_t nitem = (size_t)BATCH * 16 * 64;
#ifndef HOST_EMU
    if (LANE != 0) return;
#endif
    for (size_t it = GWAVE; it < nitem; it += NWAVES_G) {
        const int b = (int)(it / 1024), h = (int)((it >> 6) & 15), pc = (int)(it & 63), g = h >> 3;
        const float af = -expf(p.a_log_f[h]), ab = -expf(p.a_log_b[h]), dsk = p.ssd_d[h];
        float st[128];
        for (int dir = 0; dir < 2; ++dir) {
#pragma unroll
            for (int n = 0; n < 128; ++n) st[n] = 0.f;
            for (int tt = 0; tt < SEQ; ++tt) { const int s = dir ? SEQ - 1 - tt : tt; const size_t row = (size_t)b * SEQ + s;
                const float dt = p.step[row * 32 + dir * 16 + h]; const float dec = expf(dt * (dir ? ab : af)); const float xv = bf2f(p.xsT[XST_OFF(b, h * 64 + pc, s)]); const float xdt = xv * dt;
                const bf16_t* bm = p.bc + row * 512 + g * 128; const bf16_t* cm = bm + 256; float y = 0.f;
#pragma unroll
                for (int n8 = 0; n8 < 16; ++n8) { float fb[8], fc[8]; ld8(bm + n8 * 8, fb); ld8(cm + n8 * 8, fc);
#pragma unroll
                    for (int j = 0; j < 8; ++j) { st[n8 * 8 + j] = st[n8 * 8 + j] * dec + xdt * fb[j]; y += fc[j] * st[n8 * 8 + j]; } }
                if (dir == 0) p.ytmp[row * 1024 + h * 64 + pc] = y; else p.yssd[row * 1024 + h * 64 + pc] = f2bf(p.ytmp[row * 1024 + h * 64 + pc] + y + xv * dsk); }
        }
    }
}
DEV void nv_topk(const P& p) {
    for (size_t i = GTID; i < (size_t)BATCH * NE * SEQ; i += GSTRIDE) { const size_t be = i / SEQ; const int s = (int)(i % SEQ); const float* a = p.aff + be * SEQ; const float v = a[s]; int rank = 0;
        for (int j = 0; j < SEQ; ++j) { const float w = a[j]; rank += (w > v || (w == v && j < s)) ? 1 : 0; }
        if (rank < CAP) { p.idx[be * CAP + rank] = s; p.gate[be * CAP + rank] = v; p.slotmap[i] = rank; } else p.slotmap[i] = -1; }
}

static void make_params(P& p, void* const* d_in, void* d_out, void* d_ws) {
    const float** ins = (const float**)&p.x;
    for (int i = 0; i < 23; ++i) ins[i] = (const float*)d_in[i];
    p.out = (float*)d_out;
    unsigned char* ws = (unsigned char*)d_ws;
    p.WinT = (bf16_t*)(ws + WS_WIN); p.WoutT = (bf16_t*)(ws + WS_WOUT); p.WciT = (bf16_t*)(ws + WS_WCI); p.WcoT = (bf16_t*)(ws + WS_WCO); p.WguT = (bf16_t*)(ws + WS_WGU); p.WdT = (bf16_t*)(ws + WS_WD);
    p.hn = (bf16_t*)(ws + WS_HN); p.qkv = (bf16_t*)(ws + WS_QKV); p.z = (bf16_t*)(ws + WS_Z); p.xbcraw = (bf16_t*)(ws + WS_XBCRAW); p.bc = (bf16_t*)(ws + WS_BC); p.xsT = (bf16_t*)(ws + WS_XST); p.bmT = (bf16_t*)(ws + WS_BMT); p.states = (bf16_t*)(ws + WS_STATES); p.mix = (bf16_t*)(ws + WS_MIX); p.yssd = (bf16_t*)(ws + WS_YSSD);
    p.xe = (bf16_t*)(ws + WS_XE); p.hid = (bf16_t*)(ws + WS_HID); p.ye = (bf16_t*)(ws + WS_YE); p.pbuf = (bf16_t*)(ws + WS_PBUF); p.gb = (bf16_t*)(ws + WS_GB); p.abuf = (bf16_t*)(ws + WS_ABUF); p.dlt = (bf16_t*)(ws + WS_Z); p.xb2 = (bf16_t*)(ws + WS_MIX);
    p.dtraw = (float*)(ws + WS_DTRAW); p.step = (float*)(ws + WS_STEP); p.aff = (float*)(ws + WS_AFF); p.gate = (float*)(ws + WS_GATE); p.rope = (float*)(ws + WS_ROPE); p.ytmp = (float*)(ws + WS_STATES); p.stT = (float*)(ws + WS_STT); p.csT = (float*)(ws + WS_CST); p.wdT = (float*)(ws + WS_WDT); p.cdec = (float*)(ws + WS_CDEC); p.rinv = (float*)(ws + WS_RINV); p.rinvs = (float*)(ws + WS_RINVS);
    p.idx = (int*)(ws + WS_IDX); p.slotmap = (int*)(ws + WS_SMAP); p.bar = (unsigned*)(ws + WS_BAR);
}
#ifndef HOST_EMU
#define LAS __attribute__((address_space(3)))
typedef short bf16x8 __attribute__((ext_vector_type(8)));
typedef float f32x4 __attribute__((ext_vector_type(4)));
typedef unsigned u32x4 __attribute__((ext_vector_type(4)));
typedef unsigned u32x2 __attribute__((ext_vector_type(2)));
DEV void ph_norm_router_dev(const P& p, int layer) {
    const float4* g4 = (const float4*)(p.ffn_norm + (size_t)layer * 1024); const float4* rw4 = (const float4*)(p.router_w + (size_t)layer * 1024 * 16);
    const int lane = LANE;
    for (size_t row0 = GWAVE * 4; row0 < (size_t)T; row0 += NWAVES_G * 4) {
        float rinv[4];
        { float ss[4] = {0.f, 0.f, 0.f, 0.f};
#pragma unroll
          for (int j = 0; j < 4; ++j)
#pragma unroll
            for (int r = 0; r < 4; ++r) { const float4 t = ((const float4*)(p.out + (row0 + r) * 1024))[j * 64 + lane]; ss[r] += t.x * t.x + t.y * t.y + t.z * t.z + t.w * t.w; }
#pragma unroll
          for (int r = 0; r < 4; ++r) { const float q = wave_sum(ss[r]); rinv[r] = 1.0f / sqrtf(q * (1.0f / 1024.0f) + 1e-6f); } }
        float lg[4][16];
#pragma unroll
        for (int r = 0; r < 4; ++r)
#pragma unroll
            for (int e = 0; e < 16; ++e) lg[r][e] = 0.f;
#pragma unroll 1
        for (int j = 0; j < 4; ++j) { const int c4 = j * 64 + lane; const float4 gg = g4[c4]; float h[4][4];
#pragma unroll
            for (int r = 0; r < 4; ++r) { const float4 t = ((const float4*)(p.out + (row0 + r) * 1024))[c4];
                h[r][0] = t.x * rinv[r] * gg.x; h[r][1] = t.y * rinv[r] * gg.y; h[r][2] = t.z * rinv[r] * gg.z; h[r][3] = t.w * rinv[r] * gg.w;
                *(uint2*)(p.hn + (row0 + r) * 1024 + c4 * 4) = uint2{pack2(h[r][0], h[r][1]), pack2(h[r][2], h[r][3])}; }
#pragma unroll
            for (int cc = 0; cc < 4; ++cc) {
#pragma unroll
                for (int q = 0; q < 4; ++q) { const float4 w = rw4[(size_t)(c4 * 4 + cc) * 4 + q];
#pragma unroll
                    for (int r = 0; r < 4; ++r) { lg[r][4 * q] += h[r][cc] * w.x; lg[r][4 * q + 1] += h[r][cc] * w.y; lg[r][4 * q + 2] += h[r][cc] * w.z; lg[r][4 * q + 3] += h[r][cc] * w.w; } }
                asm volatile("" ::: "memory"); } }
#pragma unroll
        for (int r = 0; r < 4; ++r) { float mx = -1e30f;
#pragma unroll
            for (int e = 0; e < 16; ++e) { lg[r][e] = wave_sum(lg[r][e]); mx = fmaxf(mx, lg[r][e]); }
            float den = 0.f;
#pragma unroll
            for (int e = 0; e < 16; ++e) { lg[r][e] = expf(lg[r][e] - mx); den += lg[r][e]; }
            const float inv = 1.0f / den; const size_t row = row0 + r; const int b = (int)(row / SEQ), s = (int)(row % SEQ);
#pragma unroll
            for (int e = 0; e < 16; ++e) if (lane == e) p.aff[((size_t)b * NE + e) * SEQ + s] = lg[r][e] * inv; }
    }
}
#define GN_LOAD(Y, Z, R0) do { _Pragma("unroll") for (int r = 0; r < 4; ++r) { _Pragma("unroll") for (int j = 0; j < 4; ++j) { const int c4 = j * 64 + lane; \
        Y[r][j] = *(const uint2*)(p.yssd + ((R0) + r) * 1024 + c4 * 4); Z[r][j] = *(const uint2*)(p.z + ((R0) + r) * 1024 + c4 * 4); } } } while (0)
#define GN_DO(Y, Z, R0) do { _Pragma("unroll") for (int r = 0; r < 4; ++r) { float4 v[4]; float ss = 0.f; \
        _Pragma("unroll") for (int j = 0; j < 4; ++j) { const uint2 y = Y[r][j], zz = Z[r][j]; \
            const float z0 = __uint_as_float(zz.x << 16), z1 = __uint_as_float(zz.x & 0xffff0000u), z2 = __uint_as_float(zz.y << 16), z3 = __uint_as_float(zz.y & 0xffff0000u); \
            v[j].x = __uint_as_float(y.x << 16) * z0 * __builtin_amdgcn_rcpf(1.0f + __expf(-z0)); v[j].y = __uint_as_float(y.x & 0xffff0000u) * z1 * __builtin_amdgcn_rcpf(1.0f + __expf(-z1)); \
            v[j].z = __uint_as_float(y.y << 16) * z2 * __builtin_amdgcn_rcpf(1.0f + __expf(-z2)); v[j].w = __uint_as_float(y.y & 0xffff0000u) * z3 * __builtin_amdgcn_rcpf(1.0f + __expf(-z3)); \
            ss += v[j].x * v[j].x + v[j].y * v[j].y + v[j].z * v[j].z + v[j].w * v[j].w; } \
        ss = wave_sum(ss); const float rr = 1.0f / sqrtf(ss * (1.0f / 1024.0f) + 1e-6f); \
        _Pragma("unroll") for (int j = 0; j < 4; ++j) { const int c4 = j * 64 + lane; const float4 gg = gv[j]; \
            *(uint2*)(p.mix + ((R0) + r) * 2048 + 1024 + c4 * 4) = uint2{pack2(v[j].x * rr * gg.x, v[j].y * rr * gg.y), pack2(v[j].z * rr * gg.z, v[j].w * rr * gg.w)}; } } } while (0)
DEV void ph_gated_norm_dev(const P& p) {
    const int lane = LANE; const size_t ST = (size_t)NWAVES_G * 4;
    float4 gv[4];
#pragma unroll
    for (int j = 0; j < 4; ++j) gv[j] = ((const float4*)p.out_norm)[j * 64 + lane];
    uint2 ya[4][4], za[4][4], yb[4][4], zb[4][4];
    size_t row0 = (size_t)GWAVE * 4;
    if (row0 < (size_t)T) GN_LOAD(ya, za, row0);
    for (; row0 < (size_t)T; row0 += 2 * ST) {
        const bool hb = row0 + ST < (size_t)T;
        if (hb) GN_LOAD(yb, zb, row0 + ST);
        GN_DO(ya, za, row0);
        if (row0 + 2 * ST < (size_t)T) GN_LOAD(ya, za, row0 + 2 * ST);
        if (hb) GN_DO(yb, zb, row0 + ST);
    }
}
DEV void ph_combine_dev(const P& p, const float* g) {
    const int lane = LANE;
    for (size_t row = GWAVE; row < (size_t)T; row += NWAVES_G) {
        const int b = (int)(row / SEQ), s = (int)(row % SEQ);
        int mysl = -1; float mygt = 0.f;
        if (lane < 16) { mysl = p.slotmap[((size_t)b * NE + lane) * SEQ + s]; if (mysl >= 0) mygt = p.gate[((size_t)b * NE + lane) * CAP + mysl]; }
        float4* o4 = (float4*)(p.out + row * 1024); float4 v[4];
#pragma unroll
        for (int j = 0; j < 4; ++j) v[j] = o4[j * 64 + lane];
        unsigned long long mask = __ballot(mysl >= 0);
        while (mask) {
            const int e = __builtin_ctzll(mask); mask &= mask - 1;
            const int sl = __shfl(mysl, e); const float gt = __shfl(mygt, e); const size_t r = ((size_t)b * NE + e) * CAP + sl;
            uint2 y[4];
#pragma unroll
            for (int j = 0; j < 4; ++j) y[j] = *(const uint2*)(p.ye + r * 1024 + (j * 64 + lane) * 4);
#pragma unroll
            for (int j = 0; j < 4; ++j) { v[j].x += gt * __uint_as_float(y[j].x << 16); v[j].y += gt * __uint_as_float(y[j].x & 0xffff0000u); v[j].z += gt * __uint_as_float(y[j].y << 16); v[j].w += gt * __uint_as_float(y[j].y & 0xffff0000u); }
        }
        float ss = 0.f;
#pragma unroll
        for (int j = 0; j < 4; ++j) { o4[j * 64 + lane] = v[j]; ss += v[j].x * v[j].x + v[j].y * v[j].y + v[j].z * v[j].z + v[j].w * v[j].w; }
        if (g) { ss = wave_sum(ss); const float rr = 1.0f / sqrtf(ss * (1.0f / 1024.0f) + 1e-6f);
#pragma unroll
            for (int j = 0; j < 4; ++j) { const int c4 = j * 64 + lane; const float4 gg = ((const float4*)g)[c4];
                *(uint2*)(p.hn + row * 1024 + c4 * 4) = uint2{pack2(v[j].x * rr * gg.x, v[j].y * rr * gg.y), pack2(v[j].z * rr * gg.z, v[j].w * rr * gg.w)}; } }
    }
}

#define RMS_LOAD(V, R0) do { _Pragma("unroll") for (int r = 0; r < 4; ++r) { _Pragma("unroll") for (int j = 0; j < 4; ++j) V[r][j] = ((const float4*)(src + ((R0) + r) * 1024))[j * 64 + lane]; } } while (0)
#define RMS_DO(V, R0) do { _Pragma("unroll") for (int r = 0; r < 4; ++r) { float ss = 0.f; \
        _Pragma("unroll") for (int j = 0; j < 4; ++j) ss += V[r][j].x * V[r][j].x + V[r][j].y * V[r][j].y + V[r][j].z * V[r][j].z + V[r][j].w * V[r][j].w; \
        ss = wave_sum(ss); const float rr = 1.0f / sqrtf(ss * (1.0f / 1024.0f) + 1e-6f); \
        _Pragma("unroll") for (int j = 0; j < 4; ++j) { const int c4 = j * 64 + lane; const float4 gg = gv[j]; \
            *(uint2*)(dst + ((R0) + r) * 1024 + c4 * 4) = uint2{pack2(V[r][j].x * rr * gg.x, V[r][j].y * rr * gg.y), pack2(V[r][j].z * rr * gg.z, V[r][j].w * rr * gg.w)}; } } } while (0)
DEV void ph_rmsnorm_dev(const float* src, const float* g, bf16_t* dst) {
    const int lane = LANE; const size_t ST = (size_t)NWAVES_G * 4;
    float4 gv[4];
#pragma unroll
    for (int j = 0; j < 4; ++j) gv[j] = ((const float4*)g)[j * 64 + lane];
    float4 va[4][4], vb[4][4];
    size_t row0 = (size_t)GWAVE * 4;
    if (row0 < (size_t)T) RMS_LOAD(va, row0);
    for (; row0 < (size_t)T; row0 += 2 * ST) {
        const bool hb = row0 + ST < (size_t)T;
        if (hb) RMS_LOAD(vb, row0 + ST);
        RMS_DO(va, row0);
        if (row0 + 2 * ST < (size_t)T) RMS_LOAD(va, row0 + 2 * ST);
        if (hb) RMS_DO(vb, row0 + ST);
    }
}
DEV void ph_gather_dev(const P& p) {
    for (size_t i0 = GTID; i0 + 3 * GSTRIDE < (size_t)NSLOT * 128; i0 += GSTRIDE * 4) {
        const size_t i1 = i0 + GSTRIDE, i2 = i1 + GSTRIDE, i3 = i2 + GSTRIDE;
        const int t0 = p.idx[i0 >> 7], t1 = p.idx[i1 >> 7], t2 = p.idx[i2 >> 7], t3 = p.idx[i3 >> 7];
        const u32x4 v0 = *(const u32x4*)(p.hn + ((size_t)((i0 >> 7) / ((size_t)NE * CAP)) * SEQ + t0) * 1024 + (i0 & 127) * 8);
        const u32x4 v1 = *(const u32x4*)(p.hn + ((size_t)((i1 >> 7) / ((size_t)NE * CAP)) * SEQ + t1) * 1024 + (i1 & 127) * 8);
        const u32x4 v2 = *(const u32x4*)(p.hn + ((size_t)((i2 >> 7) / ((size_t)NE * CAP)) * SEQ + t2) * 1024 + (i2 & 127) * 8);
        const u32x4 v3 = *(const u32x4*)(p.hn + ((size_t)((i3 >> 7) / ((size_t)NE * CAP)) * SEQ + t3) * 1024 + (i3 & 127) * 8);
        *(u32x4*)(p.xe + (i0 >> 7) * 1024 + (i0 & 127) * 8) = v0; *(u32x4*)(p.xe + (i1 >> 7) * 1024 + (i1 & 127) * 8) = v1;
        *(u32x4*)(p.xe + (i2 >> 7) * 1024 + (i2 & 127) * 8) = v2; *(u32x4*)(p.xe + (i3 >> 7) * 1024 + (i3 & 127) * 8) = v3;
    }
}
#define C3_LOAD(A, G, I0) do { _Pragma("unroll") for (int q = 0; q < 4; ++q) { const size_t t = ((I0) + q * GSTRIDE) >> 7; const int pos = (int)(t % SEQ); \
        _Pragma("unroll") for (int k = 0; k < 3; ++k) { const int pp = pos + k - 1; A[q][k] = (pp < 0 || pp >= SEQ) ? uint4{0u, 0u, 0u, 0u} : *(const uint4*)(p.pbuf + (t + k - 1) * 1024 + c8); } \
        G[q] = *(const uint4*)(p.gb + t * 1024 + c8); } } while (0)
#define C3_DO(A, G, I0) do { _Pragma("unroll") for (int q = 0; q < 4; ++q) { const size_t t = ((I0) + q * GSTRIDE) >> 7; float acc[8], f[8]; \
        _Pragma("unroll") for (int j = 0; j < 8; ++j) acc[j] = 0.f; \
        _Pragma("unroll") for (int k = 0; k < 3; ++k) { const unsigned w[4] = {A[q][k].x, A[q][k].y, A[q][k].z, A[q][k].w}; \
            _Pragma("unroll") for (int j = 0; j < 4; ++j) { acc[2 * j] += __uint_as_float(w[j] << 16) * cw[k][2 * j]; acc[2 * j + 1] += __uint_as_float(w[j] & 0xffff0000u) * cw[k][2 * j + 1]; } } \
        { const unsigned w[4] = {G[q].x, G[q].y, G[q].z, G[q].w}; \
          _Pragma("unroll") for (int j = 0; j < 4; ++j) { f[2 * j] = acc[2 * j] * __uint_as_float(w[j] << 16); f[2 * j + 1] = acc[2 * j + 1] * __uint_as_float(w[j] & 0xffff0000u); } } \
        st8(p.abuf + t * 1024 + c8, f); } } while (0)
DEV void ph_conv3_dev(const P& p) {
    const size_t NI = (size_t)T * 128, ST = (size_t)GSTRIDE * 4;
    size_t i0 = GTID; const int c8 = (int)(i0 & 127) * 8;
    float cw[3][8];
#pragma unroll
    for (int k = 0; k < 3; ++k)
#pragma unroll
        for (int j = 0; j < 8; ++j) cw[k][j] = p.cw[k * 1024 + c8 + j];
    uint4 aa[4][3], ga[4], ab[4][3], gb_[4];
    if (i0 < NI) C3_LOAD(aa, ga, i0);
    for (; i0 < NI; i0 += 2 * ST) {
        const bool hb = i0 + ST < NI;
        if (hb) C3_LOAD(ab, gb_, i0 + ST);
        C3_DO(aa, ga, i0);
        if (i0 + 2 * ST < NI) C3_LOAD(aa, ga, i0 + 2 * ST);
        if (hb) C3_DO(ab, gb_, i0 + ST);
    }
}
#define CB_RAW(X, R0) do { _Pragma("unroll") for (int r = 0; r < 4; ++r) { _Pragma("unroll") for (int j = 0; j < 4; ++j) { \
        if constexpr (XF32) X[r][j] = ((const f32x4*)(xin + ((R0) + r) * 1024))[j * 64 + lane]; \
        else { const u32x2 t_ = *(const u32x2*)(xinb + ((R0) + r) * 1024 + (j * 64 + lane) * 4); X[r][j] = (f32x4){__uint_as_float(t_.x), __uint_as_float(t_.y), 0.f, 0.f}; } } } } while (0)
#define CB_ISSUE(Y, SRC) do { _Pragma("unroll") for (int r = 0; r < 4; ++r) { SRC[r] = -1; \
        if (m[r]) { const int e = __builtin_ctz(m[r]); m[r] &= m[r] - 1; const int sl = __shfl(mysl, 16 * r + e); SRC[r] = 16 * r + e; const size_t rr = ((size_t)b * NE + e) * CAP + sl; \
            _Pragma("unroll") for (int j = 0; j < 4; ++j) Y[r][j] = *(const unsigned*)((const unsigned char*)p.ye + rr * 1024 + (j * 64 + lane) * 4); } \
        else { _Pragma("unroll") for (int j = 0; j < 4; ++j) Y[r][j] = 0u; } } } while (0)
#define CB_ACC(Y, SRC) do { _Pragma("unroll") for (int r = 0; r < 4; ++r) { const float gt = SRC[r] >= 0 ? __shfl(mygt, SRC[r] & 63) * (1.0f / 16.0f) : 0.f; \
        _Pragma("unroll") for (int j = 0; j < 4; ++j) { const auto lo = __builtin_amdgcn_cvt_pk_f32_fp8((int)Y[r][j], false), hi = __builtin_amdgcn_cvt_pk_f32_fp8((int)Y[r][j], true); \
            v[r][j].x += gt * lo[0]; v[r][j].y += gt * lo[1]; v[r][j].z += gt * hi[0]; v[r][j].w += gt * hi[1]; } } } while (0)
template <bool XF32>
DEV void ph_combine_dev4(const P& p, const float* g, const float* xin, const bf16_t* xinb, bf16_t* xoutb) {
    static_assert(FP8_MOE, "expert outputs are e4m3 x 16");
    const int lane = LANE, rsub = lane >> 4, e16 = lane & 15; const size_t ST = (size_t)NWAVES_G * 4;
    size_t row0 = (size_t)GWAVE * 4;
    f32x4 xa[4][4]; int sl_n = -1;
    float4 gv[4];
#pragma unroll
    for (int j = 0; j < 4; ++j) gv[j] = g ? ((const float4*)g)[j * 64 + lane] : float4{0.f, 0.f, 0.f, 0.f};
    if (row0 < (size_t)T) { sl_n = p.slotmap[((size_t)(row0 / SEQ) * NE + e16) * SEQ + (row0 % SEQ) + rsub]; CB_RAW(xa, row0); }
    for (; row0 < (size_t)T; row0 += ST) {
        const int b = (int)(row0 / SEQ);
        const int mysl = sl_n;
        const float mygt = mysl >= 0 ? p.gate[((size_t)b * NE + e16) * CAP + mysl] : 0.f;
        const unsigned long long mall = __ballot(mysl >= 0);
        unsigned m[4];
#pragma unroll
        for (int r = 0; r < 4; ++r) m[r] = (unsigned)((mall >> (16 * r)) & 0xffffull);
        u32x2 da[4][4];
#pragma unroll
        for (int r = 0; r < 4; ++r)
#pragma unroll
            for (int j = 0; j < 4; ++j) da[r][j] = *(const u32x2*)(p.dlt + (row0 + r) * 1024 + (j * 64 + lane) * 4);
        if (row0 + ST < (size_t)T) { const size_t rn = row0 + ST; sl_n = p.slotmap[((size_t)(rn / SEQ) * NE + e16) * SEQ + (rn % SEQ) + rsub]; }
        unsigned y0[4][4], y1[4][4]; int s0_[4], s1_[4];
        CB_ISSUE(y0, s0_); if constexpr (!XF32) CB_ISSUE(y1, s1_);
        float4 v[4][4];
#pragma unroll
        for (int r = 0; r < 4; ++r)
#pragma unroll
            for (int j = 0; j < 4; ++j) { const u32x2 dd = da[r][j];
                if constexpr (XF32) v[r][j] = float4{xa[r][j][0], xa[r][j][1], xa[r][j][2], xa[r][j][3]};
                else { const unsigned x0 = __float_as_uint(xa[r][j][0]), x1 = __float_as_uint(xa[r][j][1]); v[r][j] = float4{__uint_as_float(x0 << 16), __uint_as_float(x0 & 0xffff0000u), __uint_as_float(x1 << 16), __uint_as_float(x1 & 0xffff0000u)}; }
                v[r][j].x += __uint_as_float(dd.x << 16); v[r][j].y += __uint_as_float(dd.x & 0xffff0000u); v[r][j].z += __uint_as_float(dd.y << 16); v[r][j].w += __uint_as_float(dd.y & 0xffff0000u); }
        CB_ACC(y0, s0_); if constexpr (!XF32) CB_ACC(y1, s1_);
        if constexpr (!XF32) { if (row0 + ST < (size_t)T) CB_RAW(xa, row0 + ST); }
        while (m[0] | m[1] | m[2] | m[3]) { CB_ISSUE(y0, s0_); CB_ACC(y0, s0_); }
        if constexpr (XF32) { if (row0 + ST < (size_t)T) CB_RAW(xa, row0 + ST); }
#pragma unroll
        for (int r = 0; r < 4; ++r) { float ss = 0.f;
#pragma unroll
            for (int j = 0; j < 4; ++j) { if (xoutb) *(uint2*)(xoutb + (row0 + r) * 1024 + (j * 64 + lane) * 4) = uint2{pack2(v[r][j].x, v[r][j].y), pack2(v[r][j].z, v[r][j].w)}; else __builtin_nontemporal_store((f32x4){v[r][j].x, v[r][j].y, v[r][j].z, v[r][j].w}, (f32x4*)(p.out + (row0 + r) * 1024) + j * 64 + lane); ss += v[r][j].x * v[r][j].x + v[r][j].y * v[r][j].y + v[r][j].z * v[r][j].z + v[r][j].w * v[r][j].w; }
            if (g) { ss = wave_sum(ss); const float rr = 1.0f / sqrtf(ss * (1.0f / 1024.0f) + 1e-6f);
#pragma unroll
                for (int j = 0; j < 4; ++j) { const int c4 = j * 64 + lane; const float4 gg = gv[j];
                    *(uint2*)(p.hn + (row0 + r) * 1024 + c4 * 4) = uint2{pack2(v[r][j].x * rr * gg.x, v[r][j].y * rr * gg.y), pack2(v[r][j].z * rr * gg.z, v[r][j].w * rr * gg.w)}; } } }
    }
}

namespace pg8 {
constexpr int BM = 256, BK = 64, HALF = 128, HTB = HALF * BK * 2  , STAGE_BYTES = 8 * HTB, NXCD = 8, WGM = 8;
DEV int lds_byte(int r, int c) { const int st = (r >> 4) * 2 + (c >> 5), rr = r & 15, cc = c & 31, ob = rr * 64 + cc * 2; return st * 1024 + (ob ^ (((ob >> 9) & 1) << 5)); }
DEV void stage_rc(int b, int& R, int& C) { const int st = b / 1024, sb = b % 1024, swz = sb ^ (((sb >> 9) & 1) << 5); R = (st >> 1) * 16 + swz / 64; C = (st & 1) * 32 + (swz % 64) / 2; }
DEV int perm32(int rho) { const int n = rho >> 4, i = rho & 15; return 8 * (i >> 2) + 4 * n + (i & 3); }
struct Unit { int row0, col0, brow0; };
struct StaticOrder {
    int nM, nN, nwg, G, c, brows, tpg, rev;
    DEV void init(int M, int N, int G_, int c_, int brows_, int tpg_, int rev_ = 0) { nM = M / BM; nN = N / BM; nwg = nM * nN; G = G_; c = c_; brows = brows_; tpg = tpg_; rev = rev_; }
    DEV bool next(int i, Unit& u) const {
        const int nr = (nwg + G - 1) / G; if (i >= nr) return false;
        const long L = (long)(rev ? nr - 1 - i : i) * G + c; if (L >= nwg) return false;
        int wgid = (int)L; { const int q = nwg / NXCD, r = nwg % NXCD, xcd = wgid % NXCD, off = wgid / NXCD; wgid = (xcd < r ? xcd * (q + 1) : r * (q + 1) + (xcd - r) * q) + off; }
        const int nig = WGM * nN, gid = wgid / nig, fm = gid * WGM, gsz = (nM - fm) < WGM ? (nM - fm) : WGM;
        const int pm = fm + ((wgid % nig) % gsz), pn = (wgid % nig) / gsz;
        u.row0 = pm * BM; u.col0 = pn * BM; u.brow0 = pn * BM + (brows ? ((pm / tpg) % NE) * brows : 0); return true;
    }
};
DEV unsigned cvt_pk_bf16(float lo, float hi) { unsigned r; asm volatile("v_cvt_pk_bf16_f32 %0, %1, %2" : "=v"(r) : "v"(lo), "v"(hi)); return r; }
typedef float f32x2_t __attribute__((ext_vector_type(2)));
typedef __bf16 bf16x2_t __attribute__((ext_vector_type(2)));
DEV unsigned cvt_pk_safe(float lo, float hi) { const f32x2_t v = {lo, hi}; return __builtin_bit_cast(unsigned, __builtin_convertvector(v, bf16x2_t)); }

typedef int i32x8 __attribute__((ext_vector_type(8)));
typedef int i32x4 __attribute__((ext_vector_type(4)));
template <bool F8> DEV void pg8_mma(f32x4 (&acc)[4][2], const i32x8 (&At)[4], const i32x8 (&Bq)[2]) {
    __builtin_amdgcn_s_setprio(1);
    if constexpr (F8) {
        const int one = 127;
#pragma unroll
        for (int m = 0; m < 4; ++m)
#pragma unroll
            for (int n = 0; n < 2; ++n) asm volatile("v_mfma_scale_f32_16x16x128_f8f6f4 %0, %1, %2, %0, %3, %3 op_sel_hi:[0,0,0]" : "+v"(acc[m][n]) : "v"(Bq[n]), "v"(At[m]), "v"(one));
    } else {
#pragma unroll
        for (int m = 0; m < 4; ++m)
#pragma unroll
            for (int n = 0; n < 2; ++n)
                acc[m][n] = __builtin_amdgcn_mfma_f32_16x16x32_bf16(__builtin_bit_cast(bf16x8, __builtin_shufflevector(Bq[n], Bq[n], 0, 1, 2, 3)), __builtin_bit_cast(bf16x8, __builtin_shufflevector(At[m], At[m], 0, 1, 2, 3)), acc[m][n], 0, 0, 0);
#pragma unroll
        for (int m = 0; m < 4; ++m)
#pragma unroll
            for (int n = 0; n < 2; ++n)
                acc[m][n] = __builtin_amdgcn_mfma_f32_16x16x32_bf16(__builtin_bit_cast(bf16x8, __builtin_shufflevector(Bq[n], Bq[n], 4, 5, 6, 7)), __builtin_bit_cast(bf16x8, __builtin_shufflevector(At[m], At[m], 4, 5, 6, 7)), acc[m][n], 0, 0, 0);
    }
    __builtin_amdgcn_s_setprio(0);
}
template <class Epi, class Sched, bool F8 = false>
DEV void gemm_phase(LAS unsigned char* lds, const bf16_t* A, const bf16_t* Bt, const int K, const Sched& S, const Epi& E) {
    const int tid = threadIdx.x, wid = __builtin_amdgcn_readfirstlane(tid >> 6), lane = tid & 63, wr = wid >> 2, wc = wid & 3, fr = lane & 15, fq = lane >> 4;
    const int nt = K / BK;
    unsigned voffA[2], voffB[2];
#pragma unroll
    for (int i = 0; i < 2; ++i) { int R, C; stage_rc(tid * 16 + i * 8192, R, C); const int Rb = Epi::PERM ? ((R & ~31) + perm32(R & 31)) : R;
        voffA[i] = (unsigned)(R * K + C) * 2u; voffB[i] = (unsigned)(Rb * K + C) * 2u; }
    const size_t kstep = (size_t)(BK * 2);
    const size_t hstep = (size_t)HALF * K * 2;
    const size_t rstep = (size_t)K * 2;
    const unsigned ldsw = (unsigned)wid * 1024u;
    const int aoff = lds_byte(wr * 64 + fr, fq * 8), boff = lds_byte(wc * 32 + fr, fq * 8);
#define PG8_SA(b, h) (((b) * 2 + (h)) * HTB)
#define PG8_SB(b, h) ((4 + (b) * 2 + (h)) * HTB)
#define PG8_STAGE(bufoff, gbase, voff) do { _Pragma("unroll") for (int _i = 0; _i < 2; ++_i) \
        __builtin_amdgcn_global_load_lds((const unsigned*)((const char*)(gbase) + (voff)[_i]), (LAS unsigned*)(lds + (bufoff) + ldsw + _i * 8192), 16, 0, 0); } while (0)
#define PG8_LDA(dst, b, h) do { _Pragma("unroll") for (int m = 0; m < 4; ++m) dst[m] = __builtin_shufflevector(*(const LAS i32x4*)(lds + PG8_SA(b, h) + aoff + m * 2048), *(const LAS i32x4*)(lds + PG8_SA(b, h) + aoff + m * 2048 + 1024), 0, 1, 2, 3, 4, 5, 6, 7); } while (0)
#define PG8_LDB(dst, b, h) do { _Pragma("unroll") for (int n = 0; n < 2; ++n) dst[n] = __builtin_shufflevector(*(const LAS i32x4*)(lds + PG8_SB(b, h) + boff + n * 2048), *(const LAS i32x4*)(lds + PG8_SB(b, h) + boff + n * 2048 + 1024), 0, 1, 2, 3, 4, 5, 6, 7); } while (0)
#define PG8_MMA(ai, bj, At, Bt_) pg8_mma<F8>(acc[ai][bj], At, Bt_)
#define PG8_WAIT_V(n) asm volatile("s_waitcnt vmcnt(" #n ")" ::: "memory")
#define PG8_WAIT_L(n) asm volatile("s_waitcnt lgkmcnt(" #n ")" ::: "memory")
#define PG8_BAR __builtin_amdgcn_s_barrier()
#define PG8_SCHED __builtin_amdgcn_sched_barrier(0)
    Unit cur, nxt; int ui = 0;
    if (!S.next(0, cur)) return;
    f32x4 acc[2][2][4][2];
#pragma unroll
    for (int a = 0; a < 2; ++a)
#pragma unroll
        for (int b = 0; b < 2; ++b)
#pragma unroll
            for (int m = 0; m < 4; ++m)
#pragma unroll
                for (int n = 0; n < 2; ++n) acc[a][b][m][n] = (f32x4){0.f, 0.f, 0.f, 0.f};
    i32x8 At[4], B0[2], B1[2];
    const char* cA = (const char*)A + (size_t)cur.row0 * rstep; const char* cB = (const char*)Bt + (size_t)cur.brow0 * rstep;
    PG8_STAGE(PG8_SB(0, 0), cB, voffB); PG8_STAGE(PG8_SA(0, 0), cA, voffA); PG8_STAGE(PG8_SB(0, 1), cB + hstep, voffB); PG8_STAGE(PG8_SA(0, 1), cA + hstep, voffA);
    if (wr == 1) PG8_BAR;
    PG8_WAIT_V(4); PG8_BAR;
    PG8_STAGE(PG8_SB(1, 0), cB + kstep, voffB); PG8_STAGE(PG8_SA(1, 0), cA + kstep, voffA); PG8_STAGE(PG8_SB(1, 1), cB + hstep + kstep, voffB);
    PG8_WAIT_V(6); PG8_BAR;
    for (;;) {
        const bool has_next = S.next(ui + 1, nxt);
        const char* nA = has_next ? (const char*)A + (size_t)nxt.row0 * rstep : cA; const char* nB = has_next ? (const char*)Bt + (size_t)nxt.brow0 * rstep : cB;
        for (int t = 0; t < nt; t += 2) {
            const bool last = (t == nt - 2);
            const char* a1 = cA + (size_t)(t + 1) * kstep;
            const char* a2 = last ? nA : cA + (size_t)(t + 2) * kstep; const char* b2 = last ? nB : cB + (size_t)(t + 2) * kstep;
            const char* a3 = a2 + kstep; const char* b3 = b2 + kstep;
            PG8_LDB(B0, 0, 0); PG8_SCHED; PG8_LDA(At, 0, 0); PG8_STAGE(PG8_SA(1, 1), a1 + hstep, voffA);
            PG8_WAIT_L(8); PG8_BAR; PG8_WAIT_L(0); PG8_MMA(0, 0, At, B0); PG8_BAR; PG8_SCHED;
            PG8_LDB(B1, 0, 1); PG8_STAGE(PG8_SB(0, 0), b2, voffB);
            PG8_BAR; PG8_WAIT_L(0); PG8_MMA(0, 1, At, B1); PG8_BAR;
            PG8_LDA(At, 0, 1); PG8_STAGE(PG8_SA(0, 0), a2, voffA);
            PG8_BAR; PG8_WAIT_L(0); PG8_MMA(1, 0, At, B0); PG8_BAR; PG8_SCHED;
            PG8_STAGE(PG8_SB(0, 1), b2 + hstep, voffB);
            PG8_WAIT_V(6); PG8_BAR; PG8_MMA(1, 1, At, B1); PG8_BAR;
            PG8_LDB(B0, 1, 0); PG8_SCHED; PG8_LDA(At, 1, 0); PG8_STAGE(PG8_SA(0, 1), a2 + hstep, voffA);
            PG8_WAIT_L(8); PG8_BAR; PG8_WAIT_L(0); PG8_MMA(0, 0, At, B0); PG8_BAR; PG8_SCHED;
            PG8_LDB(B1, 1, 1); PG8_STAGE(PG8_SB(1, 0), b3, voffB);
            PG8_BAR; PG8_WAIT_L(0); PG8_MMA(0, 1, At, B1); PG8_BAR;
            PG8_LDA(At, 1, 1); PG8_STAGE(PG8_SA(1, 0), a3, voffA);
            PG8_BAR; PG8_WAIT_L(0); PG8_MMA(1, 0, At, B0); PG8_BAR; PG8_SCHED;
            PG8_STAGE(PG8_SB(1, 1), b3 + hstep, voffB);
            PG8_WAIT_V(6); PG8_BAR; PG8_MMA(1, 1, At, B1); PG8_BAR;
        }
        if constexpr (F8) asm volatile("s_nop 15\n\ts_nop 15" ::: "memory");
        E(acc, cur, wr, wc, fr, fq);
        if (!has_next) break;
#pragma unroll
        for (int a = 0; a < 2; ++a)
#pragma unroll
            for (int b = 0; b < 2; ++b)
#pragma unroll
                for (int m = 0; m < 4; ++m)
#pragma unroll
                    for (int n = 0; n < 2; ++n) acc[a][b][m][n] = (f32x4){0.f, 0.f, 0.f, 0.f};
        cur = nxt; cA = nA; cB = nB; ++ui;
    }
    PG8_WAIT_V(0);
    if (wr == 0) PG8_BAR;
    PG8_BAR;
#undef PG8_SA
#undef PG8_SB
#undef PG8_STAGE
#undef PG8_LDA
#undef PG8_LDB
#undef PG8_MMA
#undef PG8_WAIT_V
#undef PG8_WAIT_L
#undef PG8_BAR
#undef PG8_SCHED
}
template <class Epi, class Sched, bool F8 = false>
DEV void gemm_phase_gather(LAS unsigned char* lds, const bf16_t* A, const bf16_t* Bt, const int K, const Sched& S, const Epi& E, const int* idx, const int grp_rows, const int seq, const float* rowf) {
    const int tid = threadIdx.x, wid = __builtin_amdgcn_readfirstlane(tid >> 6), lane = tid & 63, wr = wid >> 2, wc = wid & 3, fr = lane & 15, fq = lane >> 4;
    const int nt = K / BK;
    unsigned voffB[2]; int Ra[2]; unsigned Ca2[2];
#pragma unroll
    for (int i = 0; i < 2; ++i) { int R, C; stage_rc(tid * 16 + i * 8192, R, C); const int Rb = Epi::PERM ? ((R & ~31) + perm32(R & 31)) : R;
        Ra[i] = R; Ca2[i] = (unsigned)C * 2u; voffB[i] = (unsigned)(Rb * K + C) * 2u; }
    unsigned vAc[2][2], vAn[2][2];
#define PG8_IDXT(u) (STAGE_BYTES + 1024 * ((u) & 1))
#define PG8_RFT(u) (STAGE_BYTES + 2048 + 1024 * ((u) % 3))
#define PG8_SETVA(V, U, ui_) do { const LAS int* tab_ = (const LAS int*)(lds + PG8_IDXT(ui_)); const unsigned bo_ = (unsigned)((U).row0 / grp_rows) * (unsigned)seq; \
        _Pragma("unroll") for (int h_ = 0; h_ < 2; ++h_) _Pragma("unroll") for (int i_ = 0; i_ < 2; ++i_) V[h_][i_] = (bo_ + (unsigned)tab_[Ra[i_] + 128 * h_]) * (unsigned)(K * 2) + Ca2[i_]; } while (0)
    const size_t kstep = (size_t)(BK * 2);
    const size_t hstep = (size_t)HALF * K * 2;
    const size_t rstep = (size_t)K * 2;
    const unsigned ldsw = (unsigned)wid * 1024u;
    const int aoff = lds_byte(wr * 64 + fr, fq * 8), boff = lds_byte(wc * 32 + fr, fq * 8);
#define PG8_SA(b, h) (((b) * 2 + (h)) * HTB)
#define PG8_SB(b, h) ((4 + (b) * 2 + (h)) * HTB)
#define PG8_STAGE(bufoff, gbase, voff) do { _Pragma("unroll") for (int _i = 0; _i < 2; ++_i) \
        __builtin_amdgcn_global_load_lds((const unsigned*)((const char*)(gbase) + (voff)[_i]), (LAS unsigned*)(lds + (bufoff) + ldsw + _i * 8192), 16, 0, 0); } while (0)
#define PG8_LDA(dst, b, h) do { _Pragma("unroll") for (int m = 0; m < 4; ++m) dst[m] = __builtin_shufflevector(*(const LAS i32x4*)(lds + PG8_SA(b, h) + aoff + m * 2048), *(const LAS i32x4*)(lds + PG8_SA(b, h) + aoff + m * 2048 + 1024), 0, 1, 2, 3, 4, 5, 6, 7); } while (0)
#define PG8_LDB(dst, b, h) do { _Pragma("unroll") for (int n = 0; n < 2; ++n) dst[n] = __builtin_shufflevector(*(const LAS i32x4*)(lds + PG8_SB(b, h) + boff + n * 2048), *(const LAS i32x4*)(lds + PG8_SB(b, h) + boff + n * 2048 + 1024), 0, 1, 2, 3, 4, 5, 6, 7); } while (0)
#define PG8_MMA(ai, bj, At, Bt_) pg8_mma<F8>(acc[ai][bj], At, Bt_)
#define PG8_WAIT_V(n) asm volatile("s_waitcnt vmcnt(" #n ")" ::: "memory")
#define PG8_WAIT_L(n) asm volatile("s_waitcnt lgkmcnt(" #n ")" ::: "memory")
#define PG8_BAR __builtin_amdgcn_s_barrier()
#define PG8_SCHED __builtin_amdgcn_sched_barrier(0)
    Unit cur, nxt; int ui = 0;
    if (!S.next(0, cur)) return;
    f32x4 acc[2][2][4][2];
#pragma unroll
    for (int a = 0; a < 2; ++a)
#pragma unroll
        for (int b = 0; b < 2; ++b)
#pragma unroll
            for (int m = 0; m < 4; ++m)
#pragma unroll
                for (int n = 0; n < 2; ++n) acc[a][b][m][n] = (f32x4){0.f, 0.f, 0.f, 0.f};
    i32x8 At[4], B0[2], B1[2];
    const char* cA = (const char*)A; const char* cB = (const char*)Bt + (size_t)cur.brow0 * rstep;
    if (wid == 0) { __builtin_amdgcn_global_load_lds((const unsigned*)(idx + cur.row0 + lane * 4), (LAS unsigned*)(lds + PG8_IDXT(0)), 16, 0, 0);
        __builtin_amdgcn_global_load_lds((const unsigned*)(rowf + cur.row0 + lane * 4), (LAS unsigned*)(lds + PG8_RFT(0)), 16, 0, 0); }
    asm volatile("s_waitcnt vmcnt(0)" ::: "memory"); __syncthreads();
    PG8_SETVA(vAc, cur, 0);
    PG8_STAGE(PG8_SB(0, 0), cB, voffB); PG8_STAGE(PG8_SA(0, 0), cA, vAc[0]); PG8_STAGE(PG8_SB(0, 1), cB + hstep, voffB); PG8_STAGE(PG8_SA(0, 1), cA, vAc[1]);
    if (wr == 1) PG8_BAR;
    PG8_WAIT_V(4); PG8_BAR;
    PG8_STAGE(PG8_SB(1, 0), cB + kstep, voffB); PG8_STAGE(PG8_SA(1, 0), cA + kstep, vAc[0]); PG8_STAGE(PG8_SB(1, 1), cB + hstep + kstep, voffB);
    PG8_WAIT_V(6); PG8_BAR;
    for (;;) {
        const bool has_next = S.next(ui + 1, nxt);
        const char* nB = has_next ? (const char*)Bt + (size_t)nxt.brow0 * rstep : cB;
        if (has_next && wid == 0) { __builtin_amdgcn_global_load_lds((const unsigned*)(idx + nxt.row0 + lane * 4), (LAS unsigned*)(lds + PG8_IDXT(ui + 1)), 16, 0, 0);
            __builtin_amdgcn_global_load_lds((const unsigned*)(rowf + nxt.row0 + lane * 4), (LAS unsigned*)(lds + PG8_RFT(ui + 1)), 16, 0, 0); }
        for (int t = 0; t < nt; t += 2) {
            const bool last = (t == nt - 2);
            const char* a1 = cA + (size_t)(t + 1) * kstep;
            const char* a2 = last ? cA : cA + (size_t)(t + 2) * kstep; const char* b2 = last ? nB : cB + (size_t)(t + 2) * kstep;
            if (last) { if (has_next) PG8_SETVA(vAn, nxt, ui + 1); else { vAn[0][0] = vAc[0][0]; vAn[0][1] = vAc[0][1]; vAn[1][0] = vAc[1][0]; vAn[1][1] = vAc[1][1]; } }
            unsigned v2[2][2];
#pragma unroll
            for (int h_ = 0; h_ < 2; ++h_)
#pragma unroll
                for (int i_ = 0; i_ < 2; ++i_) v2[h_][i_] = last ? vAn[h_][i_] : vAc[h_][i_];
            const char* a3 = a2 + kstep; const char* b3 = b2 + kstep;
            PG8_LDB(B0, 0, 0); PG8_SCHED; PG8_LDA(At, 0, 0); PG8_STAGE(PG8_SA(1, 1), a1, vAc[1]);
            PG8_WAIT_L(8); PG8_BAR; PG8_WAIT_L(0); PG8_MMA(0, 0, At, B0); PG8_BAR; PG8_SCHED;
            PG8_LDB(B1, 0, 1); PG8_STAGE(PG8_SB(0, 0), b2, voffB);
            PG8_BAR; PG8_WAIT_L(0); PG8_MMA(0, 1, At, B1); PG8_BAR;
            PG8_LDA(At, 0, 1); PG8_STAGE(PG8_SA(0, 0), a2, v2[0]);
            PG8_BAR; PG8_WAIT_L(0); PG8_MMA(1, 0, At, B0); PG8_BAR; PG8_SCHED;
            PG8_STAGE(PG8_SB(0, 1), b2 + hstep, voffB);
            PG8_WAIT_V(6); PG8_BAR; PG8_MMA(1, 1, At, B1); PG8_BAR;
            PG8_LDB(B0, 1, 0); PG8_SCHED; PG8_LDA(At, 1, 0); PG8_STAGE(PG8_SA(0, 1), a2, v2[1]);
            PG8_WAIT_L(8); PG8_BAR; PG8_WAIT_L(0); PG8_MMA(0, 0, At, B0); PG8_BAR; PG8_SCHED;
            PG8_LDB(B1, 1, 1); PG8_STAGE(PG8_SB(1, 0), b3, voffB);
            PG8_BAR; PG8_WAIT_L(0); PG8_MMA(0, 1, At, B1); PG8_BAR;
            PG8_LDA(At, 1, 1); PG8_STAGE(PG8_SA(1, 0), a3, v2[0]);
            PG8_BAR; PG8_WAIT_L(0); PG8_MMA(1, 0, At, B0); PG8_BAR; PG8_SCHED;
            PG8_STAGE(PG8_SB(1, 1), b3 + hstep, voffB);
            PG8_WAIT_V(6); PG8_BAR; PG8_MMA(1, 1, At, B1); PG8_BAR;
        }
        if constexpr (F8) asm volatile("s_nop 15\n\ts_nop 15" ::: "memory");
        E(acc, cur, wr, wc, fr, fq, (const LAS float*)(lds + PG8_RFT(ui)));
        if (!has_next) break;
#pragma unroll
        for (int a = 0; a < 2; ++a)
#pragma unroll
            for (int b = 0; b < 2; ++b)
#pragma unroll
                for (int m = 0; m < 4; ++m)
#pragma unroll
                    for (int n = 0; n < 2; ++n) acc[a][b][m][n] = (f32x4){0.f, 0.f, 0.f, 0.f};
        cur = nxt; cB = nB; ++ui; vAc[0][0] = vAn[0][0]; vAc[0][1] = vAn[0][1]; vAc[1][0] = vAn[1][0]; vAc[1][1] = vAn[1][1];
    }
    PG8_WAIT_V(0);
    if (wr == 0) PG8_BAR;
    PG8_BAR;
#undef PG8_IDXT
#undef PG8_RFT
#undef PG8_SETVA
#undef PG8_SA
#undef PG8_SB
#undef PG8_STAGE
#undef PG8_LDA
#undef PG8_LDB
#undef PG8_MMA
#undef PG8_WAIT_V
#undef PG8_WAIT_L
#undef PG8_BAR
#undef PG8_SCHED
}
typedef const f32x4 (&AccRef)[2][2][4][2];
DEV u32x4 pk8(const f32x4 a, const f32x4 b) { u32x4 w; w.x = cvt_pk_bf16(a[0], a[1]); w.y = cvt_pk_bf16(a[2], a[3]); w.z = cvt_pk_bf16(b[0], b[1]); w.w = cvt_pk_bf16(b[2], b[3]); return w; }
DEV f32x4 silu4(const f32x4 v) { f32x4 r;
#pragma unroll
    for (int i = 0; i < 4; ++i) r[i] = v[i] * __builtin_amdgcn_rcpf(1.0f + __expf(-v[i]));
    return r; }
struct EpiG1 { static constexpr bool PERM = true; bf16_t *qkv, *z, *xbcraw; float* dtraw;
    DEV void operator()(AccRef acc, const Unit& u, int wr, int wc, int fr, int fq) const {
        const int ct = u.col0, rbase = u.row0 + wr * 64 + fr;
        if (ct < 5632) {
            bf16_t* base; int ld, cc;
            if (ct < 3072) {
                const int which = ct >> 10, b = u.row0 / SEQ, s0 = u.row0 - b * SEQ + wr * 64 + fr;
#pragma unroll
                for (int bj = 0; bj < 2; ++bj) { const int cw = (ct & 1023) + bj * HALF + wc * 32 + 8 * fq, hd = cw >> 6, dd = cw & 63;
                    bf16_t* hb = qkv + ((size_t)which * BATCH * 16 + (size_t)b * 16 + hd) * SEQ * 64 + dd;
#pragma unroll
                    for (int ai = 0; ai < 2; ++ai)
#pragma unroll
                        for (int m = 0; m < 4; ++m) *(u32x4*)(hb + (size_t)(s0 + ai * HALF + m * 16) * 64) = pk8(acc[ai][bj][m][0], acc[ai][bj][m][1]); }
                return; }
            if (ct < 4096) { base = z; ld = 1024; cc = ct - 3072; } else { base = xbcraw; ld = 1536; cc = ct - 4096; }
            const int col = cc + wc * 32 + 8 * fq;
#pragma unroll
            for (int ai = 0; ai < 2; ++ai)
#pragma unroll
                for (int m = 0; m < 4; ++m) { bf16_t* rowp = base + (size_t)(rbase + ai * HALF + m * 16) * ld + col;
#pragma unroll
                    for (int bj = 0; bj < 2; ++bj) *(u32x4*)(rowp + bj * HALF) = pk8(acc[ai][bj][m][0], acc[ai][bj][m][1]); }
        } else if (wc == 0) {
#pragma unroll
            for (int ai = 0; ai < 2; ++ai)
#pragma unroll
                for (int m = 0; m < 4; ++m) { float* rowp = dtraw + (size_t)(rbase + ai * HALF + m * 16) * 32 + 8 * fq; *(f32x4*)rowp = acc[ai][0][m][0]; *(f32x4*)(rowp + 4) = acc[ai][0][m][1]; }
        }
    } };
struct EpiResF32 { static constexpr bool PERM = false; float* out; const float* resid;
    DEV void operator()(AccRef acc, const Unit& u, int wr, int wc, int fr, int fq) const {
        const int rbase = u.row0 + wr * 64 + fr, col = u.col0 + wc * 32 + 4 * fq;
#pragma unroll
        for (int ai = 0; ai < 2; ++ai)
#pragma unroll
            for (int m = 0; m < 4; ++m) { const size_t ro = (size_t)(rbase + ai * HALF + m * 16) * 1024 + col;
#pragma unroll
                for (int bj = 0; bj < 2; ++bj)
#pragma unroll
                    for (int n = 0; n < 2; ++n) *(f32x4*)(out + ro + bj * HALF + n * 16) = *(const f32x4*)(resid + ro + bj * HALF + n * 16) + acc[ai][bj][m][n]; }
    } };
struct EpiSwiglu { static constexpr bool PERM = true; bf16_t* hid;
    DEV void operator()(AccRef acc, const Unit& u, int wr, int wc, int fr, int fq) const {
        const int rbase = u.row0 + wr * 64 + fr, col = (u.col0 >> 1) + wc * 32 + 8 * fq;
#pragma unroll
        for (int ai = 0; ai < 2; ++ai)
#pragma unroll
            for (int m = 0; m < 4; ++m) *(u32x4*)(hid + (size_t)(rbase + ai * HALF + m * 16) * 2048 + col) = pk8(silu4(acc[ai][0][m][0]) * acc[ai][1][m][0], silu4(acc[ai][0][m][1]) * acc[ai][1][m][1]);
    } };
struct EpiBf16Plain { static constexpr bool PERM = true; bf16_t* O; int ld;
    DEV void operator()(AccRef acc, const Unit& u, int wr, int wc, int fr, int fq) const {
        const int rbase = u.row0 + wr * 64 + fr, col = u.col0 + wc * 32 + 8 * fq;
#pragma unroll
        for (int ai = 0; ai < 2; ++ai)
#pragma unroll
            for (int m = 0; m < 4; ++m) { bf16_t* rowp = O + (size_t)(rbase + ai * HALF + m * 16) * ld + col;
#pragma unroll
                for (int bj = 0; bj < 2; ++bj) *(u32x4*)(rowp + bj * HALF) = pk8(acc[ai][bj][m][0], acc[ai][bj][m][1]); }
    } };
struct EpiG3 { static constexpr bool PERM = true; bf16_t *pbuf, *gb;
    DEV void operator()(AccRef acc, const Unit& u, int wr, int wc, int fr, int fq) const {
        const int rbase = u.row0 + wr * 64 + fr;
        if (u.col0 < 2048) { const int col = (u.col0 >> 1) + wc * 32 + 8 * fq;
#pragma unroll
            for (int ai = 0; ai < 2; ++ai)
#pragma unroll
                for (int m = 0; m < 4; ++m) *(u32x4*)(pbuf + (size_t)(rbase + ai * HALF + m * 16) * 1024 + col) = pk8(acc[ai][0][m][0] * acc[ai][1][m][0], acc[ai][0][m][1] * acc[ai][1][m][1]);
        } else { const int col = u.col0 - 2048 + wc * 32 + 8 * fq;
#pragma unroll
            for (int ai = 0; ai < 2; ++ai)
#pragma unroll
                for (int m = 0; m < 4; ++m) { bf16_t* rowp = gb + (size_t)(rbase + ai * HALF + m * 16) * 1024 + col;
#pragma unroll
                    for (int bj = 0; bj < 2; ++bj) *(u32x4*)(rowp + bj * HALF) = pk8(acc[ai][bj][m][0], acc[ai][bj][m][1]); }
        }
    } };
typedef unsigned u32x2 __attribute__((ext_vector_type(2)));
DEV unsigned pk4_fp8(float a, float b, float c, float d) { int w = 0; w = __builtin_amdgcn_cvt_pk_fp8_f32(a, b, w, false); w = __builtin_amdgcn_cvt_pk_fp8_f32(c, d, w, true); return (unsigned)w; }
constexpr float F8_SA = 8.0f, F8_SW = 256.0f, F8_INV = 1.0f / (F8_SA * F8_SW);
DEV float f8clamp(float v) { return __builtin_amdgcn_fmed3f(v, -448.0f, 448.0f); }
DEV f32x4 swiglu8(const f32x4 a0, const f32x4 a1, const float rs) {
    const f32x4 t = a0 * (rs * (-F8_INV * 1.44269504089f)); f32x4 e;
#pragma unroll
    for (int i = 0; i < 4; ++i) e[i] = __builtin_amdgcn_exp2f(t[i]);
    const f32x4 d = e + 1.0f; f32x4 r;
#pragma unroll
    for (int i = 0; i < 4; ++i) r[i] = __builtin_amdgcn_rcpf(d[i]);
    return (a0 * (rs * rs * (F8_INV * F8_INV * F8_SA))) * a1 * r;
}
struct EpiSwiglu8 { static constexpr bool PERM = true; unsigned char* hid8;
    DEV void operator()(AccRef acc, const Unit& u, int wr, int wc, int fr, int fq, const LAS float* rtab) const {
        const int rbase = u.row0 + wr * 64 + fr, col = (u.col0 >> 1) + wc * 32 + 8 * fq;
#pragma unroll
        for (int ai = 0; ai < 2; ++ai)
#pragma unroll
            for (int m = 0; m < 4; ++m) { const float rs = rtab[wr * 64 + fr + ai * HALF + m * 16];
                const f32x4 h0 = swiglu8(acc[ai][0][m][0], acc[ai][1][m][0], rs), h1 = swiglu8(acc[ai][0][m][1], acc[ai][1][m][1], rs);
                u32x2 w; w.x = pk4_fp8(f8clamp(h0[0]), f8clamp(h0[1]), f8clamp(h0[2]), f8clamp(h0[3])); w.y = pk4_fp8(f8clamp(h1[0]), f8clamp(h1[1]), f8clamp(h1[2]), f8clamp(h1[3]));
                *(u32x2*)(hid8 + (size_t)(rbase + ai * HALF + m * 16) * 2048 + col) = w; }
    } };
struct EpiFp8Scaled { static constexpr bool PERM = true; unsigned char* O; int ld; float sc;
    DEV void operator()(AccRef acc, const Unit& u, int wr, int wc, int fr, int fq) const {
        const int rbase = u.row0 + wr * 64 + fr, col = u.col0 + wc * 32 + 8 * fq;
#pragma unroll
        for (int ai = 0; ai < 2; ++ai)
#pragma unroll
            for (int m = 0; m < 4; ++m) { unsigned char* rowp = O + (size_t)(rbase + ai * HALF + m * 16) * ld + col;
#pragma unroll
                for (int bj = 0; bj < 2; ++bj) { const f32x4 a = acc[ai][bj][m][0] * sc, b = acc[ai][bj][m][1] * sc; u32x2 w;
                    w.x = pk4_fp8(f8clamp(a[0]), f8clamp(a[1]), f8clamp(a[2]), f8clamp(a[3])); w.y = pk4_fp8(f8clamp(b[0]), f8clamp(b[1]), f8clamp(b[2]), f8clamp(b[3]));
                    *(u32x2*)(rowp + bj * HALF) = w; } }
    } };
constexpr float F8_SY = 16.0f;
struct EpiBf16Scaled { static constexpr bool PERM = true; bf16_t* O; int ld; float sc;
    DEV void operator()(AccRef acc, const Unit& u, int wr, int wc, int fr, int fq) const {
        const int rbase = u.row0 + wr * 64 + fr, col = u.col0 + wc * 32 + 8 * fq;
#pragma unroll
        for (int ai = 0; ai < 2; ++ai)
#pragma unroll
            for (int m = 0; m < 4; ++m) { bf16_t* rowp = O + (size_t)(rbase + ai * HALF + m * 16) * ld + col;
#pragma unroll
                for (int bj = 0; bj < 2; ++bj) *(u32x4*)(rowp + bj * HALF) = pk8(acc[ai][bj][m][0] * sc, acc[ai][bj][m][1] * sc); }
    } };
}
DEV void ph_g1(const P& p, LAS unsigned char* lds) { pg8::StaticOrder S; S.init(T, NIN_PAD, (int)gridDim.x, (int)blockIdx.x, 0, 1); pg8::EpiG1 E{p.qkv, p.z, p.xbcraw, p.dtraw}; pg8::gemm_phase(lds, p.hn, p.WinT, 1024, S, E); }
DEV void ph_g2(const P& p, LAS unsigned char* lds) { pg8::StaticOrder S; S.init(T, 1024, (int)gridDim.x, (int)blockIdx.x, 0, 1); pg8::EpiBf16Plain E{p.dlt, 1024}; pg8::gemm_phase(lds, p.mix, p.WoutT, 2048, S, E); }
DEV void ph_up(const P& p, LAS unsigned char* lds) { pg8::StaticOrder S; S.init(NSLOT, 4096, (int)gridDim.x, (int)blockIdx.x, 4096, CAP / 256);
#if FP8_MOE
    pg8::EpiSwiglu8 E{(unsigned char*)p.hid}; pg8::gemm_phase_gather<pg8::EpiSwiglu8, pg8::StaticOrder, true>(lds, p.hn, p.WguT, 512, S, E, p.idx, NE * CAP, SEQ, p.rinvs); }
#else
    pg8::EpiSwiglu E{p.hid}; pg8::gemm_phase_gather(lds, p.hn, p.WguT, 1024, S, E, p.idx, NE * CAP, SEQ); }
#endif

DEV void ph_down(const P& p, LAS unsigned char* lds) { pg8::StaticOrder S; S.init(NSLOT, 1024, (int)gridDim.x, (int)blockIdx.x, 1024, CAP / 256, (NSLOT / 256 * 4) % (int)gridDim.x == 0);
#if FP8_MOE
    pg8::EpiFp8Scaled E{(unsigned char*)p.ye, 1024, pg8::F8_INV * pg8::F8_SY}; pg8::gemm_phase<pg8::EpiFp8Scaled, pg8::StaticOrder, true>(lds, p.hid, p.WdT, 1024, S, E); }
#else
    pg8::EpiBf16Plain E{p.ye, 1024}; pg8::gemm_phase(lds, p.hid, p.WdT, 2048, S, E); }
#endif
DEV void ph_g3(const P& p, LAS unsigned char* lds) { pg8::StaticOrder S; S.init(T, 3072, (int)gridDim.x, (int)blockIdx.x, 0, 1); pg8::EpiG3 E{p.pbuf, p.gb}; pg8::gemm_phase(lds, p.hn, p.WciT, 1024, S, E); }
DEV void ph_g4(const P& p, LAS unsigned char* lds) { pg8::StaticOrder S; S.init(T, 1024, (int)gridDim.x, (int)blockIdx.x, 0, 1); pg8::EpiBf16Plain E{p.dlt, 1024}; pg8::gemm_phase(lds, p.abuf, p.WcoT, 1024, S, E); }

DEV bf16x8 ldg8(const bf16_t* p) { return *(const bf16x8*)p; }
DEV f32x4 mfma16(bf16x8 a, bf16x8 b, f32x4 c) { return __builtin_amdgcn_mfma_f32_16x16x32_bf16(a, b, c, 0, 0, 0); }
DEV bf16x8 pack8(const float (&m)[8]) { u32x4 r; r.x = pg8::cvt_pk_safe(m[0], m[1]); r.y = pg8::cvt_pk_safe(m[2], m[3]); r.z = pg8::cvt_pk_safe(m[4], m[5]); r.w = pg8::cvt_pk_safe(m[6], m[7]); return __builtin_bit_cast(bf16x8, r); }
DEV void unpack8(bf16x8 v, float (&f)[8]) { const u32x4 u = __builtin_bit_cast(u32x4, v);
#pragma unroll
    for (int q = 0; q < 4; ++q) { f[2 * q] = __uint_as_float(u[q] << 16); f[2 * q + 1] = __uint_as_float(u[q] & 0xffff0000u); } }
typedef unsigned u32x2 __attribute__((ext_vector_type(2)));
DEV u32x2 pk4(const f32x4 a) { u32x2 r; r.x = pg8::cvt_pk_safe(a[0], a[1]); r.y = pg8::cvt_pk_safe(a[2], a[3]); return r; }
DEV void ph_ssd_states(const P& p, LAS unsigned char* lds) {
    const int tid = threadIdx.x, wid = __builtin_amdgcn_readfirstlane(tid >> 6), lane = tid & 63, fr = lane & 15, fq = lane >> 4;
    const int hh = wid >> 2, dir = (wid >> 1) & 1, nh = wid & 1;
    constexpr int NSTEP = BATCH * NCHUNK * 8; const int G = (int)gridDim.x;
#define SAL_DMA(STP, BUF) do { const int hp_ = (STP) & 7, c_ = ((STP) >> 3) % NCHUNK, b_ = ((STP) >> 3) / NCHUNK; \
        const bf16_t* bsrc_ = p.bmT + BMT_OFF(b_, (hp_ >> 2) * 128, c_ * 128); const bf16_t* xsrc_ = p.xsT + XST_OFF(b_, hp_ * 128, c_ * 128); \
        _Pragma("unroll") for (int n_ = 0; n_ < 8; ++n_) { const int r_ = (tid >> 4) + 32 * n_, sl_ = tid & 15; \
            const bf16_t* src_ = (n_ < 4 ? bsrc_ + r_ * 128 : xsrc_ + (r_ - 128) * 128) + ((sl_ ^ (r_ & 15)) * 8); \
            __builtin_amdgcn_global_load_lds((const unsigned*)src_, (LAS unsigned*)(lds + (BUF) * 65536 + n_ * 8192 + wid * 1024), 16, 0, 0); } } while (0)
    int stp = blockIdx.x, k = 0;
    __syncthreads();
    if (stp < NSTEP) SAL_DMA(stp, 0);
    for (; stp < NSTEP; stp += G, k ^= 1) {
        const int hp = stp & 7, c = (stp >> 3) % NCHUNK, b = (stp >> 3) / NCHUNK, h = 2 * hp + hh, j = dir * 16 + h;
        const float* w = p.wdT + ((size_t)b * 32 + j) * SEQ + c * 128 + 8 * fq;
        f32x4 wv[4][2];
#pragma unroll
        for (int ks = 0; ks < 4; ++ks) { wv[ks][0] = *(const f32x4*)(w + 32 * ks); wv[ks][1] = *(const f32x4*)(w + 32 * ks + 4); }
        __syncthreads();
        const bool more = stp + G < NSTEP;
        if (more) { SAL_DMA(stp + G, k ^ 1); asm volatile("s_waitcnt vmcnt(8)" ::: "memory"); }
        else asm volatile("s_waitcnt vmcnt(0)" ::: "memory");
        __syncthreads();
        f32x4 acc[4][4];
#pragma unroll
        for (int nb = 0; nb < 4; ++nb)
#pragma unroll
            for (int pb = 0; pb < 4; ++pb) acc[nb][pb] = (f32x4){0.f, 0.f, 0.f, 0.f};
        const LAS unsigned char* xrow = lds + k * 65536 + (128 + hh * 64 + fr) * 256; const LAS unsigned char* brow = lds + k * 65536 + (nh * 64 + fr) * 256;
#pragma unroll
        for (int ks = 0; ks < 4; ++ks) {
            const int po = ((4 * ks + fq) ^ fr) * 16;
            bf16x8 xf[4];
#pragma unroll
            for (int pb = 0; pb < 4; ++pb) { float f[8]; unpack8(*(const LAS bf16x8*)(xrow + pb * 4096 + po), f);
#pragma unroll
                for (int q = 0; q < 4; ++q) { f[q] *= wv[ks][0][q]; f[4 + q] *= wv[ks][1][q]; }
                xf[pb] = pack8(f); }
#pragma unroll
            for (int nb = 0; nb < 4; ++nb) { const bf16x8 bfv = *(const LAS bf16x8*)(brow + nb * 4096 + po);
#pragma unroll
                for (int pb = 0; pb < 4; ++pb) acc[nb][pb] = mfma16(bfv, xf[pb], acc[nb][pb]); }
        }
        bf16_t* st = p.states + ((((size_t)b * 2 + dir) * NCHUNK + c) * 16 + h) * 8192 + 64 * nh;
#pragma unroll
        for (int nb = 0; nb < 4; ++nb)
#pragma unroll
            for (int pb = 0; pb < 4; ++pb) *(u32x2*)(st + (16 * pb + fr) * 128 + 16 * nb + 4 * fq) = pk4(acc[nb][pb]);
    }
    asm volatile("s_waitcnt vmcnt(0)" ::: "memory"); __syncthreads();
#undef SAL_DMA
}
#define SCAN_LOAD(V, D, CC0) do { _Pragma("unroll") for (int u_ = 0; u_ < 16; ++u_) { const int c = c0 + cstep * ((CC0) + u_); V[u_] = *(const u32x2*)(base + (long)c * (16 * 8192)); D[u_] = dec[c]; } } while (0)
#define SCAN_DO(V, D, CC0) do { _Pragma("unroll") for (int u_ = 0; u_ < 16; ++u_) { const int c = c0 + cstep * ((CC0) + u_); const float d = D[u_]; \
        *(u32x2*)(base + (long)c * (16 * 8192)) = (u32x2){pg8::cvt_pk_safe(r0, r1), pg8::cvt_pk_safe(r2, r3)}; \
        r0 = r0 * d + __uint_as_float(V[u_].x << 16); r1 = r1 * d + __uint_as_float(V[u_].x & 0xffff0000u); r2 = r2 * d + __uint_as_float(V[u_].y << 16); r3 = r3 * d + __uint_as_float(V[u_].y & 0xffff0000u); } } while (0)
DEV void ph_ssd_scan(const P& p) {
    static_assert(NCHUNK % 32 == 0, "chunk groups of 16 come in pairs");
    for (size_t i = GTID; i < (size_t)BATCH * 2 * 16 * 64 * 32; i += GSTRIDE) {
        const int n4 = (int)(i & 31), pp = (int)((i >> 5) & 63), hsel = __builtin_amdgcn_readfirstlane((int)(i >> 11)), h = hsel & 15, dir = (hsel >> 4) & 1, b = hsel >> 5;
        bf16_t* base = p.states + (((size_t)b * 2 + dir) * NCHUNK * 16 + h) * 8192 + pp * 128 + n4 * 4;
        const float* dec = p.cdec + ((size_t)b * 32 + dir * 16 + h) * NCHUNK;
        const int c0 = dir ? NCHUNK - 1 : 0, cstep = dir ? -1 : 1;
        float r0 = 0.f, r1 = 0.f, r2 = 0.f, r3 = 0.f;
        u32x2 va[16], vb[16]; float da[16], db[16];
        SCAN_LOAD(va, da, 0);
#pragma unroll 1
        for (int cc = 0; cc < NCHUNK; cc += 32) {
            SCAN_LOAD(vb, db, cc + 16);
            SCAN_DO(va, da, cc);
            if (cc + 32 < NCHUNK) SCAN_LOAD(va, da, cc + 32);
            SCAN_DO(vb, db, cc + 16);
        }
    }
}
constexpr int GLD = 136;
#define SC_XLOAD(XF, KS) do { _Pragma("unroll") for (int pb = 0; pb < 4; ++pb) XF[pb] = ldg8(xT + pb * 16 * 128 + 32 * (KS)); } while (0)
#define SC_DIAG(XF, KS) do { const int s0 = 32 * (KS) + 8 * fq; float cs_s[8], cb_s[8], df[8], db[8]; \
        _Pragma("unroll") for (int j = 0; j < 8; ++j) { cs_s[j] = vec[s0 + j]; cb_s[j] = vec[128 + s0 + j]; df[j] = vec[256 + s0 + j]; db[j] = vec[384 + s0 + j]; } \
        _Pragma("unroll") for (int lb = 0; lb < 4; ++lb) { const int l = l0 + 16 * lb + fr; \
            float gf[8], m[8]; unpack8(*(const LAS bf16x8*)(Gl + (16 * lb + fr) * GLD + s0), gf); \
            _Pragma("unroll") for (int j = 0; j < 8; ++j) { const int s = s0 + j; \
                const float wf = s <= l ? df[j] * __expf(fminf(csfl[lb] - cs_s[j], 0.f)) : 0.f, wb = s >= l ? db[j] * __expf(fminf(cbl[lb] - cb_s[j], 0.f)) : 0.f; \
                m[j] = gf[j] * (wf + wb) + (s == l ? Dh : 0.f); } \
            const bf16x8 mf = pack8(m); \
            _Pragma("unroll") for (int pb = 0; pb < 4; ++pb) acc[pb][lb] = mfma16(XF[pb], mf, acc[pb][lb]); __builtin_amdgcn_sched_barrier(0); } } while (0)
#define SC_CFRAG(LB, KS) (*(const LAS bf16x8*)(Cl + (16 * (LB) + fr) * 256 + (((4 * (KS) + fq) ^ fr) * 16)))
#define SC_PLOAD(PF, T_) do { const bf16_t* pv_ = ((T_) >> 2) ? pv1 : pv0; _Pragma("unroll") for (int pb = 0; pb < 4; ++pb) PF[pb] = ldg8(pv_ + pb * 2048 + 32 * ((T_) & 3)); } while (0)
#define SC_YOFF(PF, T_) do { _Pragma("unroll") for (int lb = 0; lb < 4; ++lb) { float f[8]; unpack8(SC_CFRAG(lb, (T_) & 3), f); const float sc_ = ((T_) >> 2) ? scb[lb] : scf[lb]; \
            _Pragma("unroll") for (int j = 0; j < 8; ++j) f[j] *= sc_; \
            const bf16x8 cf = pack8(f); \
            _Pragma("unroll") for (int pb = 0; pb < 4; ++pb) acc[pb][lb] = mfma16(PF[pb], cf, acc[pb][lb]); } } while (0)
DEV void ph_ssd_out(const P& p, LAS unsigned char* lds) {
    const int wid = threadIdx.x >> 6, lane = threadIdx.x & 63, fr = lane & 15, fq = lane >> 4;
    LAS bf16_t* Gl = (LAS bf16_t*)lds;
    LAS float* vec = (LAS float*)(lds + 64 * GLD * 2) + wid * 512;
    int ub = 0;
    for (int up = blockIdx.x; up < BATCH * NCHUNK * 2; up += gridDim.x) {
      const int lh = up & 1, c = (up >> 1) % NCHUNK, b = (up >> 1) / NCHUNK, l0 = 64 * lh; const size_t row0 = (size_t)b * SEQ + (size_t)c * 128;
#pragma unroll 1
      for (int g = 0; g < 2; ++g) {
        const int h = 8 * g + wid;
        const bf16_t* bmrow = p.bc + (row0 + 16 * wid + fr) * 512 + g * 128 + 8 * fq;
        const LAS unsigned char* Cl = lds + 34816 + ub * 16384; ub ^= 1;
#pragma unroll
        for (int n_ = 0; n_ < 2; ++n_) { const int r_ = ((int)threadIdx.x >> 4) + 32 * n_, sl_ = (int)threadIdx.x & 15;
            __builtin_amdgcn_global_load_lds((const unsigned*)(p.bc + (row0 + l0 + r_) * 512 + 256 + g * 128 + ((sl_ ^ (r_ & 15)) * 8)), (LAS unsigned*)(lds + 34816 + (ub ^ 1) * 16384 + n_ * 8192 + wid * 1024), 16, 0, 0); }
        float vr[8];
        f32x4 ag[4];
        { bf16x8 bm[4];
#pragma unroll
        for (int ks = 0; ks < 4; ++ks) bm[ks] = ldg8(bmrow + 32 * ks);
#pragma unroll
        for (int q = 0; q < 2; ++q) { const size_t o = ((size_t)b * 32 + h) * SEQ + c * 128 + lane + 64 * q;
            vr[4 * q] = p.csT[o]; vr[4 * q + 1] = p.csT[o + (size_t)16 * SEQ]; vr[4 * q + 2] = p.stT[o]; vr[4 * q + 3] = p.stT[o + (size_t)16 * SEQ]; }
#pragma unroll
        for (int lb = 0; lb < 4; ++lb) ag[lb] = (f32x4){0.f, 0.f, 0.f, 0.f};
        asm volatile("s_waitcnt vmcnt(0)" ::: "memory"); __syncthreads();
#pragma unroll
        for (int ks = 0; ks < 4; ++ks)
#pragma unroll
            for (int lb = 0; lb < 4; ++lb) ag[lb] = mfma16(bm[ks], SC_CFRAG(lb, ks), ag[lb]); }
        const float Dh = p.ssd_d[h];
#pragma unroll
        for (int lb = 0; lb < 4; ++lb) *(LAS u32x2*)(Gl + (16 * lb + fr) * GLD + 16 * wid + 4 * fq) = pk4(ag[lb]);
#pragma unroll
        for (int q = 0; q < 2; ++q) { const int s = lane + 64 * q; vec[s] = vr[4 * q]; vec[128 + s] = vr[4 * q + 1]; vec[256 + s] = vr[4 * q + 2]; vec[384 + s] = vr[4 * q + 3]; }
        const bf16_t* xT = p.xsT + XST_OFF(b, h * 64 + fr, c * 128) + 8 * fq;
        const bf16_t* pv0 = p.states + ((((size_t)b * 2 + 0) * NCHUNK + c) * 16 + h) * 8192 + fr * 128 + 8 * fq;
        const bf16_t* pv1 = p.states + ((((size_t)b * 2 + 1) * NCHUNK + c) * 16 + h) * 8192 + fr * 128 + 8 * fq;
        bf16x8 xfa[4], xfb[4], pfa[4], pfb[4];
        SC_XLOAD(xfa, 0);
        __syncthreads();
        f32x4 acc[4][4];
#pragma unroll
        for (int pb = 0; pb < 4; ++pb)
#pragma unroll
            for (int lb = 0; lb < 4; ++lb) acc[pb][lb] = (f32x4){0.f, 0.f, 0.f, 0.f};
        float csfl[4], cbl[4], scf[4], scb[4];
#pragma unroll
        for (int lb = 0; lb < 4; ++lb) { csfl[lb] = vec[l0 + 16 * lb + fr]; cbl[lb] = vec[128 + l0 + 16 * lb + fr]; scf[lb] = __expf(csfl[lb]); scb[lb] = __expf(cbl[lb]); }
#pragma unroll 1
        for (int ks = 0; ks < 4; ks += 2) {
            SC_XLOAD(xfb, ks + 1); SC_DIAG(xfa, ks);
            if (ks + 2 < 4) SC_XLOAD(xfa, ks + 2);
            SC_DIAG(xfb, ks + 1);
        }
        SC_PLOAD(pfa, 0);
#pragma unroll 1
        for (int t = 0; t < 8; t += 2) {
            SC_PLOAD(pfb, t + 1); SC_YOFF(pfa, t);
            if (t + 2 < 8) SC_PLOAD(pfa, t + 2);
            SC_YOFF(pfb, t + 1);
        }
#pragma unroll
        for (int pb = 0; pb < 4; ++pb)
#pragma unroll
            for (int lb = 0; lb < 4; ++lb) *(u32x2*)(p.yssd + (row0 + l0 + 16 * lb + fr) * 1024 + h * 64 + 16 * pb + 4 * fq) = pk4(acc[pb][lb]);
      }
      asm volatile("s_waitcnt vmcnt(0)" ::: "memory"); __syncthreads();
      { const size_t rb = row0 + l0 + 8 * wid; float4 gv[4]; uint2 ya[4][4], za[4][4], yb[4][4], zb[4][4];
#pragma unroll
        for (int j = 0; j < 4; ++j) gv[j] = ((const float4*)p.out_norm)[j * 64 + lane];
        GN_LOAD(ya, za, rb); GN_LOAD(yb, zb, rb + 4); GN_DO(ya, za, rb); GN_DO(yb, zb, rb + 4); }
    }
}

#define RT_LOAD(X, D, KS0) do { _Pragma("unroll") for (int u_ = 0; u_ < 4; ++u_) { D[u_] = ldg8(dr + 32 * ((KS0) + u_)); \
        if constexpr (XF32) { X[2 * u_] = *(const f32x4*)(xr + 32 * ((KS0) + u_)); X[2 * u_ + 1] = *(const f32x4*)(xr + 32 * ((KS0) + u_) + 4); } \
        else X[u_] = __builtin_bit_cast(f32x4, ldg8(xbr + 32 * ((KS0) + u_))); } } while (0)
#define RT_DO(X, D, KS0) do { _Pragma("unroll") for (int u_ = 0; u_ < 4; ++u_) { const int ks = (KS0) + u_; \
        float dv[8]; unpack8(D[u_], dv); float x[8]; \
        if constexpr (XF32) { _Pragma("unroll") for (int j = 0; j < 4; ++j) { x[j] = X[2 * u_][j]; x[4 + j] = X[2 * u_ + 1][j]; } } \
        else unpack8(__builtin_bit_cast(bf16x8, X[u_]), x); \
        const f32x4 ga = *(const LAS f32x4*)(lds + 65536 + (32 * ks + 8 * fq) * 4), gb = *(const LAS f32x4*)(lds + 65536 + (32 * ks + 8 * fq) * 4 + 16); \
        _Pragma("unroll") for (int j = 0; j < 8; ++j) { x[j] += dv[j]; ss += x[j] * x[j]; } \
        { u32x2 w8; const float sa = pg8::F8_SA; \
          w8.x = pg8::pk4_fp8(pg8::f8clamp(x[0] * ga.x * sa), pg8::f8clamp(x[1] * ga.y * sa), pg8::f8clamp(x[2] * ga.z * sa), pg8::f8clamp(x[3] * ga.w * sa)); \
          w8.y = pg8::pk4_fp8(pg8::f8clamp(x[4] * gb.x * sa), pg8::f8clamp(x[5] * gb.y * sa), pg8::f8clamp(x[6] * gb.z * sa), pg8::f8clamp(x[7] * gb.w * sa)); \
          *(u32x2*)(h8 + 32 * ks) = w8; } \
        const bf16x8 xh = pack8(x); float xhf[8], lo[8]; unpack8(xh, xhf); \
        _Pragma("unroll") for (int j = 0; j < 8; ++j) lo[j] = x[j] - xhf[j]; \
        const bf16x8 xl = pack8(lo); \
        const bf16x8 wh = *(const LAS bf16x8*)(lds + (size_t)(ks * 64 + lane) * 16), wl = *(const LAS bf16x8*)(lds + 32768 + (size_t)(ks * 64 + lane) * 16); \
        acc = mfma16(xh, wh, acc); acc = mfma16(xl, wh, acc); acc = mfma16(xh, wl, acc); } } while (0)
template <bool XF32>
DEV void ph_norm_router_mfma(const P& p, int layer, LAS unsigned char* lds, const float* xin, const bf16_t* xinb) {
    const float* g = p.ffn_norm + (size_t)layer * 1024; const float* rw = p.router_w + (size_t)layer * 1024 * 16;
    const int tid = threadIdx.x, wid = tid >> 6, lane = tid & 63, fr = lane & 15, fq = lane >> 4;
    __syncthreads();
    for (int f = tid; f < 2048; f += 512) { const int ks = f >> 6, ln = f & 63, e = ln & 15, kb = 32 * ks + 8 * (ln >> 4);
        float hi[8], lo[8];
#pragma unroll
        for (int j = 0; j < 8; ++j) { const float w = g[kb + j] * rw[(size_t)(kb + j) * 16 + e]; const float h = bf2f(f2bf(w)); hi[j] = h; lo[j] = w - h; }
        *(LAS bf16x8*)(lds + (size_t)f * 16) = pack8(hi); *(LAS bf16x8*)(lds + 32768 + (size_t)f * 16) = pack8(lo); }
    if (tid < 256) *(LAS f32x4*)(lds + 65536 + tid * 16) = ((const f32x4*)g)[tid];
    __syncthreads();
    for (size_t row0 = ((size_t)blockIdx.x * 8 + wid) * 16; row0 < (size_t)T; row0 += (size_t)gridDim.x * 128) {
        const float* xr = xin + (row0 + fr) * 1024 + 8 * fq; const bf16_t* xbr = xinb + (row0 + fr) * 1024 + 8 * fq; const bf16_t* dr = p.dlt + (row0 + fr) * 1024 + 8 * fq;
        unsigned char* h8 = (unsigned char*)p.hn + (row0 + fr) * 1024 + 8 * fq;
        f32x4 acc = (f32x4){0.f, 0.f, 0.f, 0.f}; float ss = 0.f;
        f32x4 xa[8], xb[8]; bf16x8 da[4], db[4];
        RT_LOAD(xa, da, 0);
#pragma unroll 1
        for (int kg = 0; kg < 8; kg += 2) {
            RT_LOAD(xb, db, 4 * kg + 4);
            RT_DO(xa, da, 4 * kg);
            if (kg + 2 < 8) RT_LOAD(xa, da, 4 * kg + 8);
            RT_DO(xb, db, 4 * kg + 4);
        }
        ss += __shfl_xor(ss, 16); ss += __shfl_xor(ss, 32);
        const float rinv = 1.0f / sqrtf(ss * (1.0f / 1024.0f) + 1e-6f);
        if (fq == 0) p.rinv[row0 + fr] = rinv;
        float lg[4];
#pragma unroll
        for (int i = 0; i < 4; ++i) { lg[i] = acc[i] * __shfl(rinv, 4 * fq + i);
            float mx = lg[i]; mx = fmaxf(mx, __shfl_xor(mx, 1)); mx = fmaxf(mx, __shfl_xor(mx, 2)); mx = fmaxf(mx, __shfl_xor(mx, 4)); mx = fmaxf(mx, __shfl_xor(mx, 8));
            const float ex = expf(lg[i] - mx); float den = ex; den += __shfl_xor(den, 1); den += __shfl_xor(den, 2); den += __shfl_xor(den, 4); den += __shfl_xor(den, 8);
            lg[i] = ex / den; }
        { const size_t r4 = row0 + 4 * fq; const int b = (int)(r4 / SEQ), s = (int)(r4 % SEQ); *(float4*)(p.aff + ((size_t)b * NE + fr) * SEQ + s) = float4{lg[0], lg[1], lg[2], lg[3]}; }
    }
    __syncthreads();
}

DEV void ph_convert_small_tiles(const P& p, LAS unsigned char* lds) {
    LAS unsigned* tl = (LAS unsigned*)lds;
    const int tid = threadIdx.x, n4 = tid & 31, seg = (tid >> 5) & 1, kp = tid >> 6;
    const int rrow = tid >> 1, rhalf = tid & 1, rseg = rrow >> 7, rq = (rrow >> 5) & 3, rn4 = rrow & 31;
    constexpr int NT_IN = (NIN_PAD / 256) * 16, NTILE = NT_IN + 4 * 32;
#define CS_SRC(ID, S_, LD_, NV_, N0_, K0_, D_, KK_) const float* S_; int LD_, NV_, N0_, K0_, KK_; bf16_t* D_; \
        if ((ID) < NT_IN) { S_ = p.w_in; LD_ = NIN; NV_ = NIN; N0_ = 256 * ((ID) >> 4); K0_ = 64 * ((ID) & 15); D_ = p.WinT; KK_ = 1024; } \
        else { const int r_ = (ID) - NT_IN; S_ = p.w_out; LD_ = 1024; NV_ = 1024; N0_ = 256 * (r_ >> 5); K0_ = 64 * (r_ & 31); D_ = p.WoutT; KK_ = 2048; }
#define CS_LOAD(ID, DST) do { CS_SRC(ID, s_, ld_, nv_, n0_, k0_, d_, kk_) (void)d_; (void)kk_; const int c_ = n0_ + 128 * seg + 4 * n4; \
        _Pragma("unroll") for (int i = 0; i < 4; ++i) { const size_t ro = (size_t)(k0_ + 2 * (kp + 8 * i)) * ld_ + c_; \
            if (c_ < nv_) { DST[2 * i] = *(const float4*)(s_ + ro); DST[2 * i + 1] = *(const float4*)(s_ + ro + ld_); } else { DST[2 * i] = float4{0.f, 0.f, 0.f, 0.f}; DST[2 * i + 1] = float4{0.f, 0.f, 0.f, 0.f}; } } } while (0)
#define CS_TILE(ID, SRC) do { __syncthreads(); \
        _Pragma("unroll") for (int i = 0; i < 4; ++i) { const float4 a = SRC[2 * i], b = SRC[2 * i + 1]; const int kd = kp + 8 * i; const int rb = seg * 128 + n4; \
            tl[(rb) * 33 + kd] = pack2(a.x, b.x); tl[(rb + 32) * 33 + kd] = pack2(a.y, b.y); tl[(rb + 64) * 33 + kd] = pack2(a.z, b.z); tl[(rb + 96) * 33 + kd] = pack2(a.w, b.w); } \
        __syncthreads(); \
        { CS_SRC(ID, s_, ld_, nv_, n0_, k0_, d_, kk_) (void)s_; (void)ld_; (void)nv_; unsigned w[16]; \
          _Pragma("unroll") for (int i = 0; i < 16; ++i) w[i] = tl[rrow * 33 + 16 * rhalf + i]; \
          bf16_t* dp = d_ + (size_t)(n0_ + rseg * 128 + 4 * rn4 + rq) * kk_ + k0_ + 32 * rhalf; \
          _Pragma("unroll") for (int q = 0; q < 4; ++q) *(uint4*)(dp + 8 * q) = uint4{w[4 * q], w[4 * q + 1], w[4 * q + 2], w[4 * q + 3]}; } } while (0)
    float4 ca[8], cb[8];
    int id = blockIdx.x; const int G = (int)gridDim.x;
    if (id < NTILE) CS_LOAD(id, ca);
    for (; id < NTILE; id += 2 * G) {
        const bool hb = id + G < NTILE;
        if (hb) CS_LOAD(id + G, cb);
        CS_TILE(id, ca);
        if (id + 2 * G < NTILE) CS_LOAD(id + 2 * G, ca);
        if (hb) CS_TILE(id + G, cb);
    }
    __syncthreads();
#undef CS_SRC
#undef CS_LOAD
#undef CS_TILE
}

DEV void ph_convert_late_tiles(const P& p, LAS unsigned char* lds, const int bid, const int nb) {
    LAS unsigned* tl = (LAS unsigned*)lds;
    const int tid = threadIdx.x, n4 = tid & 31, seg = (tid >> 5) & 1, kp = tid >> 6;
    const int rrow = tid >> 1, rhalf = tid & 1, rseg = rrow >> 7, rq = (rrow >> 5) & 3, rn4 = rrow & 31;
    constexpr int NT_IN = 12 * 16, NTILE = NT_IN + 4 * 16;
#define CL_SRC(ID, S_, LD_, CB_, N0_, K0_, D_) const float* S_; int LD_, CB_, N0_, K0_; bf16_t* D_; \
        if ((ID) < NT_IN) { const int nt_ = (ID) >> 4; S_ = p.cw_in; LD_ = 3072; N0_ = 256 * nt_; K0_ = 64 * ((ID) & 15); D_ = p.WciT; CB_ = nt_ < 8 ? (seg ? 2048 + 128 * nt_ : 1024 + 128 * nt_) : (256 * nt_ - 2048 + 128 * seg); } \
        else { const int r_ = (ID) - NT_IN; S_ = p.cw_out; LD_ = 1024; N0_ = 256 * (r_ >> 4); K0_ = 64 * (r_ & 15); D_ = p.WcoT; CB_ = N0_ + 128 * seg; }
#define CL_LOAD(ID, DST) do { CL_SRC(ID, s_, ld_, cb_, n0_, k0_, d_) (void)d_; (void)n0_; \
        _Pragma("unroll") for (int i = 0; i < 4; ++i) { const size_t ro = (size_t)(k0_ + 2 * (kp + 8 * i)) * ld_ + cb_ + 4 * n4; DST[2 * i] = *(const float4*)(s_ + ro); DST[2 * i + 1] = *(const float4*)(s_ + ro + ld_); } } while (0)
#define CL_TILE(ID, SRC) do { __syncthreads(); \
        _Pragma("unroll") for (int i = 0; i < 4; ++i) { const float4 a = SRC[2 * i], b = SRC[2 * i + 1]; const int kd = kp + 8 * i; const int rb = seg * 128 + n4; \
            tl[(rb) * 33 + kd] = pack2(a.x, b.x); tl[(rb + 32) * 33 + kd] = pack2(a.y, b.y); tl[(rb + 64) * 33 + kd] = pack2(a.z, b.z); tl[(rb + 96) * 33 + kd] = pack2(a.w, b.w); } \
        __syncthreads(); \
        { const int sv_ = seg; (void)sv_; CL_SRC(ID, s_, ld_, cb_, n0_, k0_, d_) (void)s_; (void)ld_; (void)cb_; unsigned w[16]; \
          _Pragma("unroll") for (int i = 0; i < 16; ++i) w[i] = tl[rrow * 33 + 16 * rhalf + i]; \
          bf16_t* dp = d_ + (size_t)(n0_ + rseg * 128 + 4 * rn4 + rq) * 1024 + k0_ + 32 * rhalf; \
          _Pragma("unroll") for (int q = 0; q < 4; ++q) *(uint4*)(dp + 8 * q) = uint4{w[4 * q], w[4 * q + 1], w[4 * q + 2], w[4 * q + 3]}; } } while (0)
    float4 ca[8], cb[8];
    int id = bid;
    if (id < NTILE) CL_LOAD(id, ca);
    for (; id < NTILE; id += 2 * nb) {
        const bool hb = id + nb < NTILE;
        if (hb) CL_LOAD(id + nb, cb);
        CL_TILE(id, ca);
        if (id + 2 * nb < NTILE) CL_LOAD(id + 2 * nb, ca);
        if (hb) CL_TILE(id + nb, cb);
    }
    __syncthreads();
#undef CL_SRC
#undef CL_LOAD
#undef CL_TILE
}

DEV void cvx_src(const P& p, int layer, int id, int seg, const float*& src, int& ld, int& k0) {
    const int e = id / 384, r = id % 384; const size_t off = ((size_t)layer * NE + e) * 1024 * 2048;
    if (r < 256) { const int pn = r >> 4, kt = r & 15; src = (seg ? p.wu : p.wg) + off + 128 * pn; ld = 2048; k0 = 64 * kt; }
    else { const int r2 = r - 256, nt = r2 >> 5, kt = r2 & 31; src = p.wd + off + 256 * nt + 128 * seg; ld = 1024; k0 = 64 * kt; }
}
DEV void ph_convert_experts_dev(const P& p, int layer, LAS unsigned char* lds) {
    LAS unsigned* tl = (LAS unsigned*)lds;
    const int tid = threadIdx.x, n4 = tid & 31, seg = (tid >> 5) & 1, kp = tid >> 6;
    const int rrow = tid >> 1, rhalf = tid & 1, rseg = rrow >> 7, rq = (rrow >> 5) & 3, rn4 = rrow & 31;
    constexpr int NTILE = NE * 384;
    float4 cur[8], nxt[8];
#define CVX_LOAD(ID, DST) do { const float* s_; int ld_, k0_; cvx_src(p, layer, (ID), seg, s_, ld_, k0_); \
        _Pragma("unroll") for (int i = 0; i < 4; ++i) { const size_t ro = (size_t)(k0_ + 2 * (kp + 8 * i)) * ld_ + 4 * n4; DST[2 * i] = *(const float4*)(s_ + ro); DST[2 * i + 1] = *(const float4*)(s_ + ro + ld_); } } while (0)
    int id = blockIdx.x;
    if (id < NTILE) CVX_LOAD(id, cur);
    for (; id < NTILE; id += gridDim.x) {
        const int nid = id + gridDim.x;
        if (nid < NTILE) CVX_LOAD(nid, nxt);
        __syncthreads();
#pragma unroll
        for (int i = 0; i < 4; ++i) { const float4 a = cur[2 * i], b = cur[2 * i + 1]; const int kd = kp + 8 * i; const int rb = seg * 128 + n4;
            tl[(rb) * 33 + kd] = pack2(a.x, b.x); tl[(rb + 32) * 33 + kd] = pack2(a.y, b.y); tl[(rb + 64) * 33 + kd] = pack2(a.z, b.z); tl[(rb + 96) * 33 + kd] = pack2(a.w, b.w); }
        __syncthreads();
        { const int e = id / 384, r = id % 384; bf16_t* d; int K, n0, k0;
          if (r < 256) { d = p.WguT + (size_t)e * 4096 * 1024; K = 1024; n0 = 256 * (r >> 4); k0 = 64 * (r & 15); } else { const int r2 = r - 256; d = p.WdT + (size_t)e * 1024 * 2048; K = 2048; n0 = 256 * (r2 >> 5); k0 = 64 * (r2 & 31); }
          unsigned w[16];
#pragma unroll
          for (int i = 0; i < 16; ++i) w[i] = tl[rrow * 33 + 16 * rhalf + i];
          bf16_t* dp = d + (size_t)(n0 + rseg * 128 + 4 * rn4 + rq) * K + k0 + 32 * rhalf;
#pragma unroll
          for (int q = 0; q < 4; ++q) *(uint4*)(dp + 8 * q) = uint4{w[4 * q], w[4 * q + 1], w[4 * q + 2], w[4 * q + 3]}; }
#pragma unroll
        for (int i = 0; i < 8; ++i) cur[i] = nxt[i];
    }
#undef CVX_LOAD
    __syncthreads();
}

DEV void ph_convert_experts_f8(const P& p, int layer, LAS unsigned char* lds, const int bid, const int nb) {
    LAS unsigned* tl = (LAS unsigned*)lds;
    const int tid = threadIdx.x, n4 = tid & 31, seg = (tid >> 5) & 1, kp = tid >> 6;
    const int rrow = tid >> 1, rhalf = tid & 1, rseg = rrow >> 7, rq = (rrow >> 5) & 3, rn4 = rrow & 31;
    constexpr int NTILE = NE * 384;
    float4 cur[8], nxt[8];
#define CVX8_LOAD(ID, DST) do { const float* s_; int ld_, k0_; cvx_src(p, layer, (ID), seg, s_, ld_, k0_); \
        _Pragma("unroll") for (int i = 0; i < 2; ++i) _Pragma("unroll") for (int r = 0; r < 4; ++r) { const f32x4 t_ = __builtin_nontemporal_load((const f32x4*)(s_ + (size_t)(k0_ + 4 * (kp + 8 * i) + r) * ld_ + 4 * n4)); DST[4 * i + r] = float4{t_[0], t_[1], t_[2], t_[3]}; } } while (0)
    int id = bid; const int G2 = 2 * nb;
    if (id < NTILE) CVX8_LOAD(id, cur);
    for (; id < NTILE; id += G2) {
        const int id1 = id + nb, id2 = id + G2;
        if (id1 < NTILE) CVX8_LOAD(id1, nxt);
        {
        __syncthreads();
#pragma unroll
        for (int i = 0; i < 2; ++i) { const float4 a = cur[4 * i], b = cur[4 * i + 1], c = cur[4 * i + 2], d = cur[4 * i + 3]; const int kd = kp + 8 * i, rb = seg * 128 + n4; const float sw = pg8::F8_SW;
#define F8W(v) pg8::f8clamp((v) * sw)
            tl[(rb) * 17 + kd] = pg8::pk4_fp8(F8W(a.x), F8W(b.x), F8W(c.x), F8W(d.x)); tl[(rb + 32) * 17 + kd] = pg8::pk4_fp8(F8W(a.y), F8W(b.y), F8W(c.y), F8W(d.y));
            tl[(rb + 64) * 17 + kd] = pg8::pk4_fp8(F8W(a.z), F8W(b.z), F8W(c.z), F8W(d.z)); tl[(rb + 96) * 17 + kd] = pg8::pk4_fp8(F8W(a.w), F8W(b.w), F8W(c.w), F8W(d.w)); }
#undef F8W
        __syncthreads();
        { const int e = id / 384, r = id % 384; unsigned char* d; int K, n0, k0;
          if (r < 256) { d = (unsigned char*)p.WguT + (size_t)e * 4096 * 1024; K = 1024; n0 = 256 * (r >> 4); k0 = 64 * (r & 15); } else { const int r2 = r - 256; d = (unsigned char*)p.WdT + (size_t)e * 1024 * 2048; K = 2048; n0 = 256 * (r2 >> 5); k0 = 64 * (r2 & 31); }
          unsigned w[8];
#pragma unroll
          for (int i = 0; i < 8; ++i) w[i] = tl[rrow * 17 + 8 * rhalf + i];
          unsigned char* dp = d + (size_t)(n0 + rseg * 128 + 4 * rn4 + rq) * K + k0 + 32 * rhalf;
          *(uint4*)dp = uint4{w[0], w[1], w[2], w[3]}; *(uint4*)(dp + 16) = uint4{w[4], w[5], w[6], w[7]}; }
        }
        if (id1 < NTILE) {
            if (id2 < NTILE) CVX8_LOAD(id2, cur);
        __syncthreads();
#pragma unroll
        for (int i = 0; i < 2; ++i) { const float4 a = nxt[4 * i], b = nxt[4 * i + 1], c = nxt[4 * i + 2], d = nxt[4 * i + 3]; const int kd = kp + 8 * i, rb = seg * 128 + n4; const float sw = pg8::F8_SW;
#define F8W(v) pg8::f8clamp((v) * sw)
            tl[(rb) * 17 + kd] = pg8::pk4_fp8(F8W(a.x), F8W(b.x), F8W(c.x), F8W(d.x)); tl[(rb + 32) * 17 + kd] = pg8::pk4_fp8(F8W(a.y), F8W(b.y), F8W(c.y), F8W(d.y));
            tl[(rb + 64) * 17 + kd] = pg8::pk4_fp8(F8W(a.z), F8W(b.z), F8W(c.z), F8W(d.z)); tl[(rb + 96) * 17 + kd] = pg8::pk4_fp8(F8W(a.w), F8W(b.w), F8W(c.w), F8W(d.w)); }
#undef F8W
        __syncthreads();
        { const int e = id1 / 384, r = id1 % 384; unsigned char* d; int K, n0, k0;
          if (r < 256) { d = (unsigned char*)p.WguT + (size_t)e * 4096 * 1024; K = 1024; n0 = 256 * (r >> 4); k0 = 64 * (r & 15); } else { const int r2 = r - 256; d = (unsigned char*)p.WdT + (size_t)e * 1024 * 2048; K = 2048; n0 = 256 * (r2 >> 5); k0 = 64 * (r2 & 31); }
          unsigned w[8];
#pragma unroll
          for (int i = 0; i < 8; ++i) w[i] = tl[rrow * 17 + 8 * rhalf + i];
          unsigned char* dp = d + (size_t)(n0 + rseg * 128 + 4 * rn4 + rq) * K + k0 + 32 * rhalf;
          *(uint4*)dp = uint4{w[0], w[1], w[2], w[3]}; *(uint4*)(dp + 16) = uint4{w[4], w[5], w[6], w[7]}; }
        }
    }
#undef CVX8_LOAD
    __syncthreads();
}
constexpr int CTLD = 136;
DEV void ph_prep_dev(const P& p, LAS unsigned char* lds) {
    {
        const int sub = (int)(GTID & 7);
        float gnq[8], gnk[8];
#pragma unroll
        for (int j = 0; j < 8; ++j) { gnq[j] = p.q_norm[sub * 8 + j]; gnk[j] = p.k_norm[sub * 8 + j]; }
        constexpr size_t NPIECE = (size_t)T * 128; const size_t BSTEP = GSTRIDE * 4;
        u32x4 rawA[4], rawB[4]; bf16_t* kreg = p.qkv + (size_t)T * 1024;
        float cs[8], sn[8];
        { const int pos = (int)((GTID >> 3) % SEQ); const float4 c0 = *(const float4*)(p.rope + (size_t)pos * 16), c1 = *(const float4*)(p.rope + (size_t)pos * 16 + 4), s0 = *(const float4*)(p.rope + (size_t)pos * 16 + 8), s1 = *(const float4*)(p.rope + (size_t)pos * 16 + 12);
          cs[0] = c0.x; cs[1] = c0.y; cs[2] = c0.z; cs[3] = c0.w; cs[4] = c1.x; cs[5] = c1.y; cs[6] = c1.z; cs[7] = c1.w; sn[0] = s0.x; sn[1] = s0.y; sn[2] = s0.z; sn[3] = s0.w; sn[4] = s1.x; sn[5] = s1.y; sn[6] = s1.z; sn[7] = s1.w; }
#define QK_LOAD(I0, DST) do { _Pragma("unroll") for (int q = 0; q < 4; ++q) DST[q] = *(const u32x4*)(kreg + ((I0) + q * GSTRIDE) * 8); } while (0)
        size_t i0 = GTID;
        if (i0 + 3 * GSTRIDE < NPIECE) QK_LOAD(i0, rawA);
        for (; PROF_X != 11 && i0 + 3 * GSTRIDE < NPIECE; i0 += 2 * BSTEP) {
            const size_t i1 = i0 + BSTEP, i2 = i0 + 2 * BSTEP;
            if (i1 + 3 * GSTRIDE < NPIECE) QK_LOAD(i1, rawB);
            {
#pragma unroll
            for (int q = 0; q < 4; ++q) { const size_t i = i0 + q * GSTRIDE;
                const bool isk = true;
                float f[8]; float ss = 0.f;
#pragma unroll
                for (int j = 0; j < 4; ++j) { f[2 * j] = __uint_as_float(rawA[q][j] << 16); f[2 * j + 1] = __uint_as_float(rawA[q][j] & 0xffff0000u); }
#pragma unroll
                for (int j = 0; j < 8; ++j) ss += f[j] * f[j];
                ss += __shfl_xor(ss, 1); ss += __shfl_xor(ss, 2); ss += __shfl_xor(ss, 4);
                const float r = 1.0f / sqrtf(ss * (1.0f / 64.0f) + 1e-6f);
#pragma unroll
                for (int j = 0; j < 8; ++j) f[j] = f[j] * r * (isk ? gnk[j] : gnq[j]);
                float oth[8];
#pragma unroll
                for (int j = 0; j < 8; ++j) oth[j] = __shfl_xor(f[j], 1);
                if (sub < 2) {
#pragma unroll
                    for (int j = 0; j < 8; ++j) f[j] = sub == 0 ? f[j] * cs[j] - oth[j] * sn[j] : f[j] * cs[j] + oth[j] * sn[j];
                }
                st8(kreg + i * 8, f); }
            }
            if (i1 + 3 * GSTRIDE < NPIECE) {
                if (i2 + 3 * GSTRIDE < NPIECE) QK_LOAD(i2, rawA);
#pragma unroll
            for (int q = 0; q < 4; ++q) { const size_t i = i1 + q * GSTRIDE;
                const bool isk = true;
                float f[8]; float ss = 0.f;
#pragma unroll
                for (int j = 0; j < 4; ++j) { f[2 * j] = __uint_as_float(rawB[q][j] << 16); f[2 * j + 1] = __uint_as_float(rawB[q][j] & 0xffff0000u); }
#pragma unroll
                for (int j = 0; j < 8; ++j) ss += f[j] * f[j];
                ss += __shfl_xor(ss, 1); ss += __shfl_xor(ss, 2); ss += __shfl_xor(ss, 4);
                const float r = 1.0f / sqrtf(ss * (1.0f / 64.0f) + 1e-6f);
#pragma unroll
                for (int j = 0; j < 8; ++j) f[j] = f[j] * r * (isk ? gnk[j] : gnq[j]);
                float oth[8];
#pragma unroll
                for (int j = 0; j < 8; ++j) oth[j] = __shfl_xor(f[j], 1);
                if (sub < 2) {
#pragma unroll
                    for (int j = 0; j < 8; ++j) f[j] = sub == 0 ? f[j] * cs[j] - oth[j] * sn[j] : f[j] * cs[j] + oth[j] * sn[j];
                }
                st8(kreg + i * 8, f); }
            }
        }
#undef QK_LOAD
    }
    {
        constexpr int CT2 = 264;
        LAS bf16_t* tl = (LAS bf16_t*)lds;
        const int tid = threadIdx.x, c8 = tid & 7, tq = tid >> 3;
        LAS float* wl = (LAS float*)(lds + 34816);
        __syncthreads();
        for (int f = tid; f < 6 * 1536 / 4; f += 512) *(LAS f32x4*)(wl + 4 * f) = f < 5 * 384 ? ((const f32x4*)p.conv_w)[f] : ((const f32x4*)p.conv_b)[f - 5 * 384];
        __syncthreads();
        constexpr int NTILE = (T / 256) * 24;
        u32x4 ra[8], rb[8];
#define PREP_LOAD(TILE, DST) do { const int ct_ = (TILE) % 24, tt_ = (TILE) / 24, c0_ = ct_ * 64; const size_t t0_ = (size_t)tt_ * 256; const int pos0_ = (int)(t0_ % SEQ) + 4 * tq; \
            _Pragma("unroll") for (int r = 0; r < 8; ++r) { const int pp = pos0_ + r - 2; DST[r] = (pp < 0 || pp >= SEQ) ? (u32x4){0u, 0u, 0u, 0u} : *(const u32x4*)(p.xbcraw + (t0_ + 4 * tq + r - 2) * 1536 + c0_ + c8 * 8); } } while (0)
#define PREP_TILE(TILE, BUF) do { const int ct = (TILE) % 24, tt = (TILE) / 24, c0 = ct * 64; const size_t t0 = (size_t)tt * 256; const int b = (int)(t0 / SEQ), pos0 = (int)(t0 % SEQ); \
            float wgt[5][8], bias[8]; \
            _Pragma("unroll") for (int j = 0; j < 8; ++j) { bias[j] = wl[5 * 1536 + c0 + c8 * 8 + j]; _Pragma("unroll") for (int k = 0; k < 5; ++k) wgt[k][j] = wl[k * 1536 + c0 + c8 * 8 + j]; } \
            float rowf[8][8]; \
            _Pragma("unroll") for (int r = 0; r < 8; ++r) _Pragma("unroll") for (int j = 0; j < 4; ++j) { rowf[r][2 * j] = __uint_as_float(BUF[r][j] << 16); rowf[r][2 * j + 1] = __uint_as_float(BUF[r][j] & 0xffff0000u); } \
            unsigned pk[8][2]; \
            _Pragma("unroll") for (int o = 0; o < 4; ++o) { float acc[8]; \
                _Pragma("unroll") for (int j = 0; j < 8; ++j) { acc[j] = bias[j]; _Pragma("unroll") for (int k = 0; k < 5; ++k) acc[j] += rowf[o + k][j] * wgt[k][j]; acc[j] = acc[j] * __builtin_amdgcn_rcpf(1.0f + __expf(-acc[j])); } \
                if (c0 >= 1024) st8(p.bc + (t0 + 4 * tq + o) * 512 + (c0 - 1024) + c8 * 8, acc); \
                _Pragma("unroll") for (int j = 0; j < 8; ++j) { const unsigned hv = (unsigned)f2bf(acc[j]); if (o & 1) pk[j][o >> 1] |= hv << 16; else pk[j][o >> 1] = hv; } } \
            __syncthreads(); \
            if (c0 < 1280) { _Pragma("unroll") for (int j = 0; j < 8; ++j) { u32x2 w; w.x = pk[j][0]; w.y = pk[j][1]; *(LAS u32x2*)(tl + (c8 * 8 + j) * CT2 + ((4 * tq) ^ (c8 << 3))) = w; } } \
            __syncthreads(); \
            if (c0 < 1280) { _Pragma("unroll") for (int q = 0; q < 4; ++q) { const int pq = pos0 + 8 * (c8 + 8 * q); bf16_t* dst = c0 < 1024 ? p.xsT + XST_OFF(b, c0 + tq, pq) : p.bmT + BMT_OFF(b, (c0 - 1024) + tq, pq); \
                *(u32x4*)dst = *(const LAS u32x4*)(tl + tq * CT2 + ((8 * (c8 + 8 * q)) ^ ((tq >> 3) << 3))); } } } while (0)
        int tile = blockIdx.x; const int G2 = 2 * (int)gridDim.x;
        if (tile < NTILE) PREP_LOAD(tile, ra);
        for (; PROF_X != 12 && tile < NTILE; tile += G2) {
            const int tile1 = tile + (int)gridDim.x, tile2 = tile + G2;
            if (tile1 < NTILE) PREP_LOAD(tile1, rb);
            PREP_TILE(tile, ra);
            if (tile1 < NTILE) { if (tile2 < NTILE) PREP_LOAD(tile2, ra); PREP_TILE(tile1, rb); }
        }
#undef PREP_LOAD
#undef PREP_TILE
    }
    {
        const int tid = threadIdx.x, lane = tid & 63, wid = tid >> 6;
        LAS float* dl = (LAS float*)(lds + 73728);
        float Aj[4], bj[4];
#pragma unroll
        for (int i = 0; i < 4; ++i) { const int j = wid * 4 + i, dir = j >> 4, h = j & 15; Aj[i] = -expf(dir ? p.a_log_b[h] : p.a_log_f[h]); bj[i] = dir ? p.dtb_b[h] : p.dtb_f[h]; }
        for (int blk = blockIdx.x; PROF_X != 13 && blk < BATCH * NCHUNK; blk += gridDim.x) {
            const int c = blk % NCHUNK, b = blk / NCHUNK; const size_t row0 = (size_t)b * SEQ + (size_t)c * 128;
            __syncthreads();
#pragma unroll
            for (int q = 0; q < 2; ++q) { const int f = tid + 512 * q, tok = f >> 3, j4 = f & 7; const float4 v = ((const float4*)(p.dtraw + (row0 + tok) * 32))[j4];
                dl[tok * 33 + 4 * j4] = v.x; dl[tok * 33 + 4 * j4 + 1] = v.y; dl[tok * 33 + 4 * j4 + 2] = v.z; dl[tok * 33 + 4 * j4 + 3] = v.w; }
            __syncthreads();
#pragma unroll
            for (int i = 0; i < 4; ++i) { const int j = wid * 4 + i, dir = j >> 4; const float A = Aj[i], bias = bj[i];
                const int l0 = dir ? 127 - 2 * lane : 2 * lane, l1 = dir ? 126 - 2 * lane : 2 * lane + 1;
                const size_t ob = ((size_t)b * 32 + j) * SEQ + c * 128;
                const float dt0 = softplus_f(dl[l0 * 33 + j] + bias), dt1 = softplus_f(dl[l1 * 33 + j] + bias);
                const float a0 = dt0 * A, a1 = dt1 * A, pr = a0 + a1; float inc = pr;
#pragma unroll
                for (int o = 1; o < 64; o <<= 1) { const float tq = __shfl_up(inc, o); if (lane >= o) inc += tq; }
                const float cs0 = inc - pr + a0, cs1 = inc, total = __shfl(inc, 63);
                if (NAIVE_SSD) { p.step[(row0 + l0) * 32 + j] = dt0; p.step[(row0 + l1) * 32 + j] = dt1; }
                p.stT[ob + l0] = dt0; p.stT[ob + l1] = dt1; p.csT[ob + l0] = cs0; p.csT[ob + l1] = cs1;
                p.wdT[ob + l0] = dt0 * expf(total - cs0); p.wdT[ob + l1] = dt1 * expf(total - cs1);
                if (lane == 0) p.cdec[((size_t)b * 32 + j) * NCHUNK + c] = expf(total); }
        }
        __syncthreads();
    }
}

typedef short s16x4 __attribute__((ext_vector_type(4)));
constexpr int VLD = 144;
DEV void ph_attn(const P& p, LAS unsigned char* lds) {
    const int wid = threadIdx.x >> 6, lane = threadIdx.x & 63, fr = lane & 15, fq = lane >> 4;
    LAS unsigned char* vt = lds + wid * (32 * VLD);
    float gq = 0.f, gk = 0.f;
    for (int c = 0; c < 64; ++c) { gq = fmaxf(gq, fabsf(p.q_norm[c])); gk = fmaxf(gk, fabsf(p.k_norm[c])); }
    const float c1 = 0.125f * 1.44269504089f, c2 = 8.0f * gq * gk * 1.44269504089f;
    const int trq = fr >> 2, trp = fr & 3;
    constexpr int NJB = SEQ / 256;
    for (int it = blockIdx.x * 8 + wid; it < BATCH * 16 * NJB * 16; it += gridDim.x * 8) {
        const int r = it & 15, jb = (it >> 4) % NJB, h = ((it >> 4) / NJB) & 15, b = ((it >> 4) / NJB) >> 4;
        const size_t rowb = (size_t)b * SEQ; const int base = r + 256 * jb;
        const bf16_t* qp = p.qkv + (rowb + base + 16 * fr) * 3072 + h * 64 + 8 * fq;
        const bf16x8 qf0 = ldg8(qp), qf1 = ldg8(qp + 32);
        const bf16_t* kbase = p.qkv + rowb * 3072 + 1024 + h * 64 + 8 * fq;
        const bf16_t* vbase = p.qkv + rowb * 3072 + 2048 + h * 64;
        f32x4 o[4];
#pragma unroll
        for (int mb = 0; mb < 4; ++mb) o[mb] = (f32x4){0.f, 0.f, 0.f, 0.f};
        float lsum = 0.f;
        bf16x8 vr[4], kf[2][2];
#define ATT_LOAD(st, VR, KF) do { const int dsh_ = (st) < 12 ? 0 : ((st) < 18 ? 2 : 4), k0_ = -64 + 32 * ((st) < 12 ? (st) : ((st) < 18 ? (st) - 12 : (st) - 18)); \
            _Pragma("unroll") for (int c4 = 0; c4 < 4; ++c4) { const int id = lane + 64 * c4, row = id >> 3, ch = id & 7; int pos = base + ((k0_ + row) << dsh_); pos = pos < 0 ? 0 : (pos > SEQ - 1 ? SEQ - 1 : pos); \
                VR[c4] = ldg8(vbase + (size_t)pos * 3072 + 8 * ch); } \
            _Pragma("unroll") for (int x = 0; x < 2; ++x) { int pos = base + ((k0_ + 8 * (fr >> 2) + 4 * x + (fr & 3)) << dsh_); pos = pos < 0 ? 0 : (pos > SEQ - 1 ? SEQ - 1 : pos); \
                KF[x][0] = ldg8(kbase + (size_t)pos * 3072); KF[x][1] = ldg8(kbase + (size_t)pos * 3072 + 32); } } while (0)
        ATT_LOAD(0, vr, kf);
#pragma unroll 1
        for (int st = 0; st < 23; ++st) {
            bf16x8 vrn[4], kfn[2][2];
            const int stn = st + 1 < 23 ? st + 1 : st;
            ATT_LOAD(stn, vrn, kfn);
            const int dsh = st < 12 ? 0 : (st < 18 ? 2 : 4), k0 = -64 + 32 * (st < 12 ? st : (st < 18 ? st - 12 : st - 18));
            const int kq = fr << (4 - dsh);
            f32x4 s0 = mfma16(kf[0][0], qf0, (f32x4){0.f, 0.f, 0.f, 0.f}); s0 = mfma16(kf[0][1], qf1, s0);
            f32x4 s1 = mfma16(kf[1][0], qf0, (f32x4){0.f, 0.f, 0.f, 0.f}); s1 = mfma16(kf[1][1], qf1, s1);
            float pv[8];
#pragma unroll
            for (int j = 0; j < 8; ++j) { const int kap = k0 + 8 * fq + j, pos = base + (kap << dsh), dk = kap - kq;
                const bool valid = dk <= 64 && dk >= -64 && pos >= 0 && pos < SEQ; const float sv = j < 4 ? s0[j & 3] : s1[j & 3];
                pv[j] = valid ? __builtin_amdgcn_exp2f(sv * c1 - c2) : 0.f; lsum += pv[j]; }
            const bf16x8 pf = pack8(pv);
            asm volatile("" ::: "memory");
#pragma unroll
            for (int c4 = 0; c4 < 4; ++c4) { const int id = lane + 64 * c4, row = id >> 3, ch = id & 7; *(LAS bf16x8*)(vt + row * VLD + ch * 16) = vr[c4]; }
            asm volatile("s_waitcnt lgkmcnt(0)" ::: "memory");
#pragma unroll
            for (int mb = 0; mb < 4; ++mb) {
                const s16x4 t0 = __builtin_amdgcn_ds_read_tr16_b64_v4i16((LAS s16x4*)(vt + (8 * fq + trq) * VLD + (16 * mb + 4 * trp) * 2));
                const s16x4 t1 = __builtin_amdgcn_ds_read_tr16_b64_v4i16((LAS s16x4*)(vt + (8 * fq + 4 + trq) * VLD + (16 * mb + 4 * trp) * 2));
                const bf16x8 vf = __builtin_shufflevector(t0, t1, 0, 1, 2, 3, 4, 5, 6, 7);
                o[mb] = mfma16(vf, pf, o[mb]);
            }
            asm volatile("" ::: "memory");
#pragma unroll
            for (int c4 = 0; c4 < 4; ++c4) vr[c4] = vrn[c4];
            kf[0][0] = kfn[0][0]; kf[0][1] = kfn[0][1]; kf[1][0] = kfn[1][0]; kf[1][1] = kfn[1][1];
        }
#undef ATT_LOAD
        lsum += __shfl_xor(lsum, 16); lsum += __shfl_xor(lsum, 32);
        const float inv = 1.0f / lsum;
#pragma unroll
        for (int mb = 0; mb < 4; ++mb) *(u32x2*)(p.mix + (rowb + base + 16 * fr) * 2048 + h * 64 + 16 * mb + 4 * fq) = pk4(o[mb] * inv);
    }
}

constexpr int OLD = 68;
constexpr int ATT_VT = 32 * VLD;
constexpr int ATT_OPART = 8 * 2 * ATT_VT, ATT_LPART = ATT_OPART + 256 * OLD * 4;
static_assert(ATT_LPART + 1024 <= 147440, "attention LDS");
template <int MODE, bool EDGE>
DEV void attn_stream(LAS unsigned char* lds, const bf16_t* qb, const bf16_t* kb, const bf16_t* vb, bf16_t* outb, const int base0, const float c1, const float c2, const float* qgain, const float* rope) {
    const int wid = __builtin_amdgcn_readfirstlane(threadIdx.x >> 6), lane = threadIdx.x & 63, fr = lane & 15, fq = lane >> 4, trq = fr >> 2, trp = fr & 3;
    LAS unsigned char* vt = lds + wid * (2 * ATT_VT); LAS float* Opart = (LAS float*)(lds + ATT_OPART); LAS float* lpart = (LAS float*)(lds + ATT_LPART);
    constexpr int NSI = MODE == 0 ? 11 : 5, NST = 2 * NSI;
#define ATT_GEOM(st, BASE, DSH, K0) do { const int it_ = (st) >= NSI ? 1 : 0, s_ = (st) - it_ * NSI; BASE = MODE == 0 ? base0 + 2 * wid + it_ : base0 + 32 * wid + 16 * it_; \
        if (MODE == 0) { if (s_ < 6) { DSH = 2; K0 = -64 + 32 * s_; } else { DSH = 4; K0 = -64 + 32 * (s_ - 6); } } else { DSH = 0; K0 = -64 + 32 * s_; } } while (0)
#define ATT_CLAMP(pos) (EDGE ? ((pos) < 0 ? 0 : ((pos) > SEQ - 1 ? SEQ - 1 : (pos))) : (pos))
    unsigned klc[2][2], vlc[2][4];
#pragma unroll
    for (int sl = 0; sl < 2; ++sl) { const int d7 = (MODE == 0 ? (sl == 0 ? 2 : 4) : 0) + 7;
#pragma unroll
        for (int x = 0; x < 2; ++x) klc[sl][x] = (unsigned)((8 * (fr >> 2) + 4 * x + (fr & 3)) << d7) + 16u * fq;
#pragma unroll
        for (int c4 = 0; c4 < 4; ++c4) { const int id = lane + 64 * c4; vlc[sl][c4] = (unsigned)((id >> 3) << d7) + 16u * (id & 7); } }
#define ATT_LOAD(st, KF, VR) do { const int stc_ = (st) < NST ? (st) : NST - 1; int b_, d_, k_; ATT_GEOM(stc_, b_, d_, k_); \
        if (EDGE) { \
            _Pragma("unroll") for (int x = 0; x < 2; ++x) { int pos = b_ + ((k_ + 8 * (fr >> 2) + 4 * x + (fr & 3)) << d_); pos = ATT_CLAMP(pos); \
                KF[x][0] = ldg8(kb + (size_t)pos * 64 + 8 * fq); KF[x][1] = ldg8(kb + (size_t)pos * 64 + 8 * fq + 32); } \
            _Pragma("unroll") for (int c4 = 0; c4 < 4; ++c4) { const int id = lane + 64 * c4, row = id >> 3, ch = id & 7; int pos = b_ + ((k_ + row) << d_); pos = ATT_CLAMP(pos); \
                VR[c4] = ldg8(vb + (size_t)pos * 64 + 8 * ch); } \
        } else { const unsigned ub_ = (unsigned)(b_ + k_ * (1 << d_)) * 128u; const int sl_ = (MODE == 0 && d_ == 4) ? 1 : 0; \
            _Pragma("unroll") for (int x = 0; x < 2; ++x) { const unsigned off = (sl_ ? klc[1][x] : klc[0][x]) + ub_; \
                KF[x][0] = *(const bf16x8*)((const char*)kb + off); KF[x][1] = *(const bf16x8*)((const char*)kb + off + 64); } \
            _Pragma("unroll") for (int c4 = 0; c4 < 4; ++c4) { const unsigned off = (sl_ ? vlc[1][c4] : vlc[0][c4]) + ub_; VR[c4] = *(const bf16x8*)((const char*)vb + off); } } } while (0)
#define ATT_QPOS(it) ((MODE == 0 ? base0 + 2 * wid + (it) + 16 * fr : base0 + 32 * wid + 16 * (it) + fr))
    bf16x8 qf0, qf1, qn0, qn1;
#define ATT_QLOAD(it, Q0, Q1) do { const int qp_ = ATT_QPOS(it); float a_[8], b_[8]; unpack8(ldg8(qb + (size_t)qp_ * 64 + 8 * fq), a_); unpack8(ldg8(qb + (size_t)qp_ * 64 + 8 * fq + 32), b_); \
        float ss_ = 0.f; _Pragma("unroll") for (int j = 0; j < 8; ++j) ss_ += a_[j] * a_[j] + b_[j] * b_[j]; \
        ss_ += __shfl_xor(ss_, 16); ss_ += __shfl_xor(ss_, 32); const float r_ = 1.0f / sqrtf(ss_ * (1.0f / 64.0f) + 1e-6f); \
        _Pragma("unroll") for (int j = 0; j < 8; ++j) { a_[j] *= r_ * qgain[8 * fq + j]; b_[j] *= r_ * qgain[32 + 8 * fq + j]; } \
        _Pragma("unroll") for (int j = 0; j < 8; ++j) { const float oth_ = __shfl_xor(a_[j], 16); const float cs_ = rope[(size_t)qp_ * 16 + j], sn_ = rope[(size_t)qp_ * 16 + 8 + j]; \
            a_[j] = fq == 0 ? a_[j] * cs_ - oth_ * sn_ : (fq == 1 ? a_[j] * cs_ + oth_ * sn_ : a_[j]); } \
        Q0 = pack8(a_); Q1 = pack8(b_); } while (0)
    ATT_QLOAD(0, qf0, qf1); ATT_QLOAD(1, qn0, qn1);
#undef ATT_QLOAD
    bf16x8 kA[2][2], vA[4], kB[2][2], vB[4], kC[2][2], vC[4];
    ATT_LOAD(0, kA, vA); ATT_LOAD(1, kB, vB);
    f32x4 o[4];
#pragma unroll
    for (int mb = 0; mb < 4; ++mb) o[mb] = (f32x4){0.f, 0.f, 0.f, 0.f};
    float lsum = 0.f;
#define ATT_STEP(st, KC, VC_, KN, VN) do { \
        if (PROF_X != 7) ATT_LOAD((st) + 2, KN, VN); \
        LAS unsigned char* vcur = vt + ((st) & 1) * ATT_VT; \
        if (PROF_X != 6) { _Pragma("unroll") for (int c4 = 0; c4 < 4; ++c4) { const int id = lane + 64 * c4, row = id >> 3, ch = id & 7; *(LAS bf16x8*)(vcur + row * VLD + ch * 16) = VC_[c4]; } } \
        int base, dsh, k0; ATT_GEOM(st, base, dsh, k0); \
        f32x4 s0 = mfma16(KC[0][0], qf0, (f32x4){0.f, 0.f, 0.f, 0.f}); s0 = mfma16(KC[0][1], qf1, s0); \
        f32x4 s1 = mfma16(KC[1][0], qf0, (f32x4){0.f, 0.f, 0.f, 0.f}); s1 = mfma16(KC[1][1], qf1, s1); \
        asm volatile("" ::: "memory"); \
        bf16x8 vf[4]; \
        if (PROF_X == 6) { _Pragma("unroll") for (int mb = 0; mb < 4; ++mb) vf[mb] = VC_[mb]; } else \
        _Pragma("unroll") for (int mb = 0; mb < 4; ++mb) { \
            const s16x4 t0v = __builtin_amdgcn_ds_read_tr16_b64_v4i16((LAS s16x4*)(vcur + (8 * fq + trq) * VLD + (16 * mb + 4 * trp) * 2)); \
            const s16x4 t1v = __builtin_amdgcn_ds_read_tr16_b64_v4i16((LAS s16x4*)(vcur + (8 * fq + 4 + trq) * VLD + (16 * mb + 4 * trp) * 2)); \
            vf[mb] = __builtin_shufflevector(t0v, t1v, 0, 1, 2, 3, 4, 5, 6, 7); } \
        const int kq = MODE == 0 ? (fr << (4 - dsh)) : fr; \
        float pv[8]; const int t0 = k0 + 8 * fq - kq + 64; \
        const bool full_ = !EDGE && (dsh == 2 ? (k0 == 0 || k0 == 32) : (k0 >= -32 && k0 <= 32));        \
        if (PROF_X == 5) { _Pragma("unroll") for (int j = 0; j < 8; ++j) { pv[j] = j < 4 ? s0[j & 3] : s1[j & 3]; } lsum += pv[0]; } else \
        if (full_) { _Pragma("unroll") for (int j = 0; j < 8; ++j) { const float sv = j < 4 ? s0[j & 3] : s1[j & 3]; pv[j] = __builtin_amdgcn_exp2f(sv * c1 - c2); lsum += pv[j]; } } \
        else { _Pragma("unroll") for (int j = 0; j < 8; ++j) { bool valid = (unsigned)(t0 + j) <= 128u; \
            if (EDGE) { const int pos = base + ((k0 + 8 * fq + j) << dsh); valid = valid && pos >= 0 && pos < SEQ; } \
            const float sv = j < 4 ? s0[j & 3] : s1[j & 3]; pv[j] = valid ? __builtin_amdgcn_exp2f(sv * c1 - c2) : 0.f; lsum += pv[j]; } } \
        const bf16x8 pf = pack8(pv); \
        if (PROF_X == 8) { _Pragma("unroll") for (int mb = 0; mb < 4; ++mb) o[mb] = o[mb] + __builtin_bit_cast(f32x4, vf[mb]) * __builtin_bit_cast(f32x4, pf)[0]; } else \
        _Pragma("unroll") for (int mb = 0; mb < 4; ++mb) o[mb] = mfma16(vf[mb], pf, o[mb]); \
        asm volatile("" ::: "memory"); \
        if ((st) == NSI - 1 || (st) == NST - 1) { \
            const int it = (st) == NSI - 1 ? 0 : 1; \
            lsum += __shfl_xor(lsum, 16); lsum += __shfl_xor(lsum, 32); \
            if (MODE == 0) { const int ql = 2 * wid + it + 16 * fr; \
                _Pragma("unroll") for (int mb = 0; mb < 4; ++mb) *(LAS f32x4*)(Opart + ql * OLD + 16 * mb + 4 * fq) = o[mb]; \
                if (fq == 0) lpart[ql] = lsum; \
            } else { const int ql = 32 * wid + 16 * it + fr; const float inv = 1.0f / (lsum + lpart[ql]); \
                _Pragma("unroll") for (int mb = 0; mb < 4; ++mb) { const f32x4 tot = (o[mb] + *(const LAS f32x4*)(Opart + ql * OLD + 16 * mb + 4 * fq)) * inv; \
                    *(u32x2*)(outb + (size_t)(base0 + ql) * 2048 + 16 * mb + 4 * fq) = pk4(tot); } } \
            _Pragma("unroll") for (int mb = 0; mb < 4; ++mb) o[mb] = (f32x4){0.f, 0.f, 0.f, 0.f}; \
            lsum = 0.f; qf0 = qn0; qf1 = qn1; } } while (0)
#pragma unroll 1
    for (int st = 0; st < (PROF_X == 1 ? 0 : NST); st += 3) {
        ATT_STEP(st, kA, vA, kC, vC);
        if (st + 1 < NST) ATT_STEP(st + 1, kB, vB, kA, vA);
        if (st + 2 < NST) ATT_STEP(st + 2, kC, vC, kB, vB);
    }
#undef ATT_STEP
#undef ATT_GEOM
#undef ATT_CLAMP
#undef ATT_LOAD
#undef ATT_QPOS
}
template <int MODE, bool EDGE>
DEV void attn_stream3(LAS unsigned char* lds, const bf16_t* qb, const bf16_t* kb, const bf16_t* vb, bf16_t* outb, const int base0, const float c1, const float c2, const float* qgain, const float* rope) {
    const int wid = __builtin_amdgcn_readfirstlane(threadIdx.x >> 6), lane = threadIdx.x & 63, fr = lane & 15, fq = lane >> 4, trq = fr >> 2, trp = fr & 3;
    LAS unsigned char* vt = lds + wid * (2 * ATT_VT); LAS float* Opart = (LAS float*)(lds + ATT_OPART); LAS float* lpart = (LAS float*)(lds + ATT_LPART);
    constexpr int NST = MODE == 0 ? 16 : 5;
    const int rA = MODE == 0 ? (wid & 3) + 8 * (wid >> 2) : 32 * wid, rB = MODE == 0 ? rA + 4 : rA + 16;
#define A3_GEOM(st, BASE, DSH, K0) do { if (MODE == 0) { if ((st) < 6) { BASE = base0 + rA; DSH = 2; K0 = -64 + 32 * (st); } else if ((st) < 11) { BASE = base0 + rA; DSH = 4; K0 = -64 + 32 * ((st) - 6); } \
            else { BASE = base0 + rB; DSH = 4; K0 = -64 + 32 * ((st) - 11); } } else { BASE = base0 + rA; DSH = 0; K0 = -64 + 32 * (st); } } while (0)
#define A3_CLAMP(pos) (EDGE ? ((pos) < 0 ? 0 : ((pos) > SEQ - 1 ? SEQ - 1 : (pos))) : (pos))
    unsigned klc[2][2], vlc[2][4];
#pragma unroll
    for (int sl = 0; sl < 2; ++sl) { const int d7 = (MODE == 0 ? (sl == 0 ? 2 : 4) : 0) + 7;
#pragma unroll
        for (int x = 0; x < 2; ++x) klc[sl][x] = (unsigned)((8 * (fr >> 2) + 4 * x + (fr & 3)) << d7) + 16u * fq;
#pragma unroll
        for (int c4 = 0; c4 < 4; ++c4) { const int id = lane + 64 * c4; vlc[sl][c4] = (unsigned)((id >> 3) << d7) + 16u * (id & 7); } }
#define A3_LOAD(st, KF, VR) do { const int stc_ = (st) < NST ? (st) : NST - 1; int b_, d_, k_; A3_GEOM(stc_, b_, d_, k_); \
        if (EDGE) { \
            _Pragma("unroll") for (int x = 0; x < 2; ++x) { int pos = b_ + ((k_ + 8 * (fr >> 2) + 4 * x + (fr & 3)) << d_); pos = A3_CLAMP(pos); \
                const unsigned off = (unsigned)pos * 128u + 16u * fq; KF[x][0] = *(const bf16x8*)((const char*)kb + off); KF[x][1] = *(const bf16x8*)((const char*)kb + off + 64); } \
            _Pragma("unroll") for (int c4 = 0; c4 < 4; ++c4) { const int id = lane + 64 * c4, row = id >> 3, ch = id & 7; int pos = b_ + ((k_ + row) << d_); pos = A3_CLAMP(pos); \
                VR[c4] = *(const bf16x8*)((const char*)vb + ((unsigned)pos * 128u + 16u * ch)); } \
        } else { const unsigned ub_ = (unsigned)(b_ + k_ * (1 << d_)) * 128u; const int sl_ = (MODE == 0 && d_ == 4) ? 1 : 0; \
            _Pragma("unroll") for (int x = 0; x < 2; ++x) { const unsigned off = (sl_ ? klc[1][x] : klc[0][x]) + ub_; \
                KF[x][0] = *(const bf16x8*)((const char*)kb + off); KF[x][1] = *(const bf16x8*)((const char*)kb + off + 64); } \
            _Pragma("unroll") for (int c4 = 0; c4 < 4; ++c4) { const unsigned off = (sl_ ? vlc[1][c4] : vlc[0][c4]) + ub_; VR[c4] = *(const bf16x8*)((const char*)vb + off); } } } while (0)
    bf16x8 qf[2][2];
#define A3_QLOAD(QPOS, Q0, Q1) do { const int qp_ = (QPOS); float a_[8], b_[8]; unpack8(ldg8(qb + (size_t)qp_ * 64 + 8 * fq), a_); unpack8(ldg8(qb + (size_t)qp_ * 64 + 8 * fq + 32), b_); \
        float ss_ = 0.f; _Pragma("unroll") for (int j = 0; j < 8; ++j) ss_ += a_[j] * a_[j] + b_[j] * b_[j]; \
        ss_ += __shfl_xor(ss_, 16); ss_ += __shfl_xor(ss_, 32); const float r_ = 1.0f / sqrtf(ss_ * (1.0f / 64.0f) + 1e-6f); \
        _Pragma("unroll") for (int j = 0; j < 8; ++j) { a_[j] *= r_ * qgain[8 * fq + j]; b_[j] *= r_ * qgain[32 + 8 * fq + j]; } \
        _Pragma("unroll") for (int j = 0; j < 8; ++j) { const float oth_ = __shfl_xor(a_[j], 16); const float cs_ = rope[(size_t)qp_ * 16 + j], sn_ = rope[(size_t)qp_ * 16 + 8 + j]; \
            a_[j] = fq == 0 ? a_[j] * cs_ - oth_ * sn_ : (fq == 1 ? a_[j] * cs_ + oth_ * sn_ : a_[j]); } \
        Q0 = pack8(a_); Q1 = pack8(b_); } while (0)
    bf16x8 kA[2][2], vA[4], kB[2][2], vB[4];
    A3_LOAD(0, kA, vA);
    A3_QLOAD(MODE == 0 ? base0 + rA + 16 * fr : base0 + rA + fr, qf[0][0], qf[0][1]);
    A3_QLOAD(MODE == 0 ? base0 + rB + 16 * fr : base0 + rB + fr, qf[1][0], qf[1][1]);
    f32x4 o[2][4]; float lsum[2] = {0.f, 0.f};
#pragma unroll
    for (int qi = 0; qi < 2; ++qi)
#pragma unroll
        for (int mb = 0; mb < 4; ++mb) o[qi][mb] = (f32x4){0.f, 0.f, 0.f, 0.f};
#define A3_PROB(S0, S1, KQ, PF, LS) do { float pv[8]; const int t0 = k0 + 8 * fq - (KQ) + 64; \
        if (full_) { _Pragma("unroll") for (int j = 0; j < 8; ++j) { const float sv = j < 4 ? S0[j & 3] : S1[j & 3]; pv[j] = __builtin_amdgcn_exp2f(sv * c1 - c2); LS += pv[j]; } } \
        else { _Pragma("unroll") for (int j = 0; j < 8; ++j) { bool valid = (unsigned)(t0 + j) <= 128u; \
            if (EDGE) { const int pos = base + ((k0 + 8 * fq + j) << dsh); valid = valid && pos >= 0 && pos < SEQ; } \
            const float sv = j < 4 ? S0[j & 3] : S1[j & 3]; pv[j] = valid ? __builtin_amdgcn_exp2f(sv * c1 - c2) : 0.f; LS += pv[j]; } } \
        PF = pack8(pv); } while (0)
#define A3_STEP(st, KC, VC_, KN, VN) do { \
        A3_LOAD((st) + 1, KN, VN); \
        LAS unsigned char* vcur = vt + ((st) & 1) * ATT_VT; \
        _Pragma("unroll") for (int c4 = 0; c4 < 4; ++c4) { const int id = lane + 64 * c4, row = id >> 3, ch = id & 7; *(LAS bf16x8*)(vcur + row * VLD + ch * 16) = VC_[c4]; } \
        int base, dsh, k0; A3_GEOM(st, base, dsh, k0); \
        const bool dual_ = MODE == 1 || (st) < 6; \
        const bool full_ = !EDGE && (dsh == 2 ? (k0 == 0 || k0 == 32) : (k0 >= -32 && k0 <= 32)); \
        f32x4 s0 = mfma16(KC[0][0], qf[0][0], (f32x4){0.f, 0.f, 0.f, 0.f}); s0 = mfma16(KC[0][1], qf[0][1], s0); \
        f32x4 s1 = mfma16(KC[1][0], qf[0][0], (f32x4){0.f, 0.f, 0.f, 0.f}); s1 = mfma16(KC[1][1], qf[0][1], s1); \
        f32x4 u0 = (f32x4){0.f, 0.f, 0.f, 0.f}, u1 = (f32x4){0.f, 0.f, 0.f, 0.f}; \
        if (dual_) { u0 = mfma16(KC[0][0], qf[1][0], u0); u0 = mfma16(KC[0][1], qf[1][1], u0); u1 = mfma16(KC[1][0], qf[1][0], u1); u1 = mfma16(KC[1][1], qf[1][1], u1); } \
        asm volatile("" ::: "memory"); \
        bf16x8 vf[4]; \
        _Pragma("unroll") for (int mb = 0; mb < 4; ++mb) { \
            const s16x4 t0v = __builtin_amdgcn_ds_read_tr16_b64_v4i16((LAS s16x4*)(vcur + (8 * fq + trq) * VLD + (16 * mb + 4 * trp) * 2)); \
            const s16x4 t1v = __builtin_amdgcn_ds_read_tr16_b64_v4i16((LAS s16x4*)(vcur + (8 * fq + 4 + trq) * VLD + (16 * mb + 4 * trp) * 2)); \
            vf[mb] = __builtin_shufflevector(t0v, t1v, 0, 1, 2, 3, 4, 5, 6, 7); } \
        const int kqa = MODE == 0 ? (fr << (4 - dsh)) : fr, kqb = MODE == 0 ? 4 * fr + 1 : 16 + fr; \
        bf16x8 pfa; A3_PROB(s0, s1, kqa, pfa, lsum[0]); \
        _Pragma("unroll") for (int mb = 0; mb < 4; ++mb) o[0][mb] = mfma16(vf[mb], pfa, o[0][mb]); \
        if (dual_) { bf16x8 pfb; A3_PROB(u0, u1, kqb, pfb, lsum[1]); \
            _Pragma("unroll") for (int mb = 0; mb < 4; ++mb) o[1][mb] = mfma16(vf[mb], pfb, o[1][mb]); } \
        asm volatile("" ::: "memory"); \
        if (MODE == 0 && ((st) == 10 || (st) == 15)) {                         \
            const int ql = ((st) == 10 ? rA : rB) + 16 * fr; float ls = lsum[0]; ls += __shfl_xor(ls, 16); ls += __shfl_xor(ls, 32); \
            _Pragma("unroll") for (int mb = 0; mb < 4; ++mb) *(LAS f32x4*)(Opart + ql * 64 + 4 * ((4 * mb + fq) ^ (ql & 15) ^ (ql >> 4))) = o[0][mb]; \
            if (fq == 0) lpart[ql] = ls; \
            _Pragma("unroll") for (int mb = 0; mb < 4; ++mb) o[0][mb] = o[1][mb]; \
            lsum[0] = lsum[1]; qf[0][0] = qf[1][0]; qf[0][1] = qf[1][1]; } \
        if (MODE == 1 && (st) == NST - 1) { \
            _Pragma("unroll") for (int qi = 0; qi < 2; ++qi) { const int ql = (qi ? rB : rA) + fr; float ls = lsum[qi]; ls += __shfl_xor(ls, 16); ls += __shfl_xor(ls, 32); const float inv = 1.0f / (ls + lpart[ql]); \
                _Pragma("unroll") for (int mb = 0; mb < 4; ++mb) { const f32x4 tot = (o[qi][mb] + *(const LAS f32x4*)(Opart + ql * 64 + 4 * ((4 * mb + fq) ^ (ql & 15) ^ (ql >> 4)))) * inv; \
                    *(u32x2*)(outb + (size_t)(base0 + ql) * 2048 + 16 * mb + 4 * fq) = pk4(tot); } } } } while (0)
#pragma unroll 1
    for (int st = 0; st < NST; st += 2) {
        A3_STEP(st, kA, vA, kB, vB);
        if (st + 1 < NST) A3_STEP(st + 1, kB, vB, kA, vA);
    }
#undef A3_STEP
#undef A3_PROB
#undef A3_QLOAD
#undef A3_LOAD
#undef A3_CLAMP
#undef A3_GEOM
}
DEV void ph_attn2(const P& p, LAS unsigned char* lds) {
    float gq = fabsf(p.q_norm[threadIdx.x & 63]), gk = fabsf(p.k_norm[threadIdx.x & 63]);
#pragma unroll
    for (int o = 32; o >= 1; o >>= 1) { gq = fmaxf(gq, __shfl_xor(gq, o)); gk = fmaxf(gk, __shfl_xor(gk, o)); }
    const float c1 = 0.125f * 1.44269504089f, c2 = 8.0f * gq * gk * 1.44269504089f;
    constexpr int NJB = SEQ / 256;
    const bool xmap = gridDim.x == 256 && NJB % 32 == 0;
    for (int u0 = blockIdx.x; u0 < BATCH * 16 * NJB; u0 += gridDim.x) {
        int u = u0;
        if (xmap) { const int k = u0 >> 8, xcd = blockIdx.x & 7, slot = blockIdx.x >> 3; constexpr int RPP = NJB / 32; const int pair = xcd * (BATCH * 16 / 8) + k / RPP; u = pair * NJB + (k % RPP) * 32 + ((slot + 8 * (k / RPP)) & 31); }
        const int jb = u % NJB, h = (u / NJB) & 15, b = (u / NJB) >> 4, base0 = 256 * jb;
        const size_t hm = (size_t)T * 1024; const bf16_t* qb = p.qkv + ((size_t)b * 16 + h) * SEQ * 64; const bf16_t* kb = qb + hm; const bf16_t* vb = kb + hm; bf16_t* outb = p.mix + (size_t)b * SEQ * 2048 + h * 64;
        const bool edge = base0 < 1024 || base0 + 255 + 1520 >= SEQ;
        if (edge) attn_stream3<0, true>(lds, qb, kb, vb, outb, base0, c1, c2, p.q_norm, p.rope); else attn_stream3<0, false>(lds, qb, kb, vb, outb, base0, c1, c2, p.q_norm, p.rope);
        __syncthreads();
        const bool edge2 = base0 < 64 || base0 + 352 > SEQ;
        if (edge2) attn_stream3<1, true>(lds, qb, kb, vb, outb, base0, c1, c2, p.q_norm, p.rope); else attn_stream3<1, false>(lds, qb, kb, vb, outb, base0, c1, c2, p.q_norm, p.rope);
        __syncthreads();
    }
}

static_assert(SEQ % 512 == 0, "top-k: SEQ / 512 values per thread");
DEV void ph_topk(const P& p, LAS unsigned char* lds, const int bid, const int nb) {
    constexpr int NV_T = SEQ / 512;
    LAS unsigned* hist = (LAS unsigned*)lds; LAS unsigned* wtot = hist + 256; LAS unsigned* bcw = hist + 272;
    const int tid = threadIdx.x, lane = tid & 63, wid = tid >> 6;
    for (int be = bid; be < BATCH * NE; be += nb) {
        const float* a = p.aff + (size_t)be * SEQ + (size_t)tid * NV_T;
        unsigned v[NV_T];
#pragma unroll
        for (int q = 0; q < NV_T / 4; ++q) { const uint4 u = *(const uint4*)(a + 4 * q); v[4 * q] = u.x; v[4 * q + 1] = u.y; v[4 * q + 2] = u.z; v[4 * q + 3] = u.w; }
        unsigned prefix = 0u;
#pragma unroll 1
        for (int bit = 30; bit >= 0; --bit) {
            const unsigned cand = prefix | (1u << bit); unsigned cnt = 0u;
#pragma unroll
            for (int j = 0; j < NV_T; ++j) cnt += v[j] >= cand ? 1u : 0u;
#pragma unroll
            for (int o = 32; o >= 1; o >>= 1) cnt += __shfl_xor(cnt, o);
            LAS unsigned* slot = wtot + 16 * (bit & 1);
            if (lane == 0) slot[wid] = cnt;
            __syncthreads();
            unsigned tot = 0u;
#pragma unroll
            for (int w = 0; w < 8; ++w) tot += slot[w];
            if (tot >= (unsigned)CAP) prefix = cand;
        }
        unsigned cgtl = 0u;
#pragma unroll
        for (int j = 0; j < NV_T; ++j) cgtl += v[j] > prefix ? 1u : 0u;
#pragma unroll
        for (int o = 32; o >= 1; o >>= 1) cgtl += __shfl_xor(cgtl, o);
        __syncthreads();
        if (lane == 0) hist[wid] = cgtl;
        __syncthreads();
        unsigned cgt_tot = 0u;
#pragma unroll
        for (int w = 0; w < 8; ++w) cgt_tot += hist[w];
        const unsigned kk = CAP - cgt_tot;
        __syncthreads();
        const unsigned Tb = prefix, need = kk, cgt = CAP - need;
        unsigned ngt = 0u, neq = 0u;
#pragma unroll
        for (int j = 0; j < NV_T; ++j) { ngt += v[j] > Tb ? 1u : 0u; neq += v[j] == Tb ? 1u : 0u; }
        const unsigned packed = ngt | (neq << 16); unsigned inc = packed;
#pragma unroll
        for (int o = 1; o < 64; o <<= 1) { const unsigned t = __shfl_up(inc, o); if (lane >= o) inc += t; }
        if (lane == 63) wtot[wid] = inc;
        __syncthreads();
        unsigned wbase = 0u;
        for (int w = 0; w < wid; ++w) wbase += wtot[w];
        const unsigned exc = wbase + inc - packed; unsigned gbase = exc & 0xffffu, ebase = exc >> 16;
        int* smp = p.slotmap + (size_t)be * SEQ + (size_t)tid * NV_T;
#pragma unroll
        for (int q = 0; q < NV_T / 4; ++q) { int sl[4];
#pragma unroll
            for (int i = 0; i < 4; ++i) { const int j = 4 * q + i; int slot = -1;
                if (v[j] > Tb) { slot = (int)gbase; ++gbase; } else if (v[j] == Tb) { if (ebase < need) slot = (int)(cgt + ebase); ++ebase; }
                if (slot >= 0) { p.idx[(size_t)be * CAP + slot] = tid * NV_T + j; p.gate[(size_t)be * CAP + slot] = __uint_as_float(v[j]); p.rinvs[(size_t)be * CAP + slot] = p.rinv[(size_t)(be / NE) * SEQ + tid * NV_T + j]; }
                sl[i] = slot; }
            *(int4*)(smp + 4 * q) = int4{sl[0], sl[1], sl[2], sl[3]}; }
        __syncthreads();
    }
}

#define XB_TMO      128
#define XB_XCNT(j)  (256  + 64 * (j))
#define XB_XSUB(j)  (1280 + 64 * (j))
#define XB_XGEN(j)  (2304 + 64 * (j))
#define XB_TOP      3328
#define XB_TOPGEN   3392
#define XCD_BAR_WORDS 3456
#define XB_SPIN_CAP (1u << 18)

__device__ __forceinline__ unsigned xb_ld(unsigned* p)              { return __hip_atomic_load(p, __ATOMIC_RELAXED, __HIP_MEMORY_SCOPE_AGENT); }
__device__ __forceinline__ unsigned xb_add(unsigned* p, unsigned v) { return __hip_atomic_fetch_add(p, v, __ATOMIC_RELAXED, __HIP_MEMORY_SCOPE_AGENT); }
__device__ __forceinline__ unsigned xb_xcc_id() { return (unsigned)__builtin_amdgcn_s_getreg((3 << 11) | 20) & 0xFu; }
#define XB_SPIN(cond, bar) do { unsigned _sp = 0; while (cond) { __builtin_amdgcn_s_sleep(1); \
    if ((++_sp & 255u) == 0u) { if (xb_ld(&(bar)[XB_TMO])) break; if (_sp > XB_SPIN_CAP) { atomicAdd(&(bar)[XB_TMO], 1u); break; } } } } while (0)

struct XcdBarrier {
    unsigned* bar; unsigned x;
    volatile LAS unsigned* st;
};

__device__ __forceinline__ XcdBarrier xcd_barrier_post(unsigned* bar, volatile LAS unsigned* st) {
    XcdBarrier b; b.bar = bar; b.x = xb_xcc_id(); b.st = st;
    if (threadIdx.x == 0) (void)xb_add(&bar[XB_XCNT(b.x)], 1u);
    return b;
}
__device__ __forceinline__ void xcd_barrier_complete(unsigned* bar, unsigned x, unsigned& nloc, unsigned& nx) {
    const unsigned G = gridDim.x * gridDim.y * gridDim.z;
    unsigned sum, cnt, mine, sp = 0u;
    for (;;) {
        sum = 0u; cnt = 0u; mine = 0u;
#pragma unroll
        for (unsigned j = 0; j < 16; ++j) { const unsigned c = xb_ld(&bar[XB_XCNT(j)]); sum += c; cnt += (c > 0u) ? 1u : 0u; mine = (j == x) ? c : mine; }
        if (sum == G) break;
        __builtin_amdgcn_s_sleep(1);
        if ((++sp & 255u) == 0u) { if (xb_ld(&bar[XB_TMO])) break; if (sp > XB_SPIN_CAP) { atomicAdd(&bar[XB_TMO], 1u); break; } }
    }
    nloc = mine > 0u ? mine : 1u; nx = cnt > 0u ? cnt : 1u;
}

__device__ __forceinline__ void xcd_barrier(const XcdBarrier& b) {
    asm volatile("s_waitcnt vmcnt(0)" ::: "memory");
    __syncthreads();
    if (threadIdx.x == 0) {
        unsigned* bar = b.bar;
        __builtin_amdgcn_s_waitcnt(0);
        unsigned nloc = b.st[0], nx = b.st[1];
        if (nloc == 0u) { xcd_barrier_complete(bar, b.x, nloc, nx); b.st[0] = nloc; b.st[1] = nx; }
        const unsigned old = xb_add(&bar[XB_XSUB(b.x)], 1u);
        const unsigned gen = old / nloc;
        if (old + 1u == (gen + 1u) * nloc) {
            __builtin_amdgcn_fence(__ATOMIC_RELEASE, "agent");
            asm volatile("s_waitcnt vmcnt(0)" ::: "memory");
            const unsigned og = xb_add(&bar[XB_TOP], 1u);
            const unsigned tg = og / nx;
            if (og + 1u == (tg + 1u) * nx) xb_add(&bar[XB_TOPGEN], 1u);
            else XB_SPIN(xb_ld(&bar[XB_TOPGEN]) == tg, bar);
            __builtin_amdgcn_fence(__ATOMIC_ACQUIRE, "agent");
            xb_add(&bar[XB_XGEN(b.x)], 1u);
            asm volatile("s_waitcnt vmcnt(0)" ::: "memory");
        } else {
            XB_SPIN(xb_ld(&bar[XB_XGEN(b.x)]) == gen, bar);
            __builtin_amdgcn_fence(__ATOMIC_ACQUIRE, "agent");
            asm volatile("s_waitcnt vmcnt(0)" ::: "memory");
        }
    }
    __syncthreads();
}


enum { PH_FIRST = 0, PH_G1, PH_PREP, PH_ATTN, PH_SSDB, PH_SSDC, PH_G2, PH_ROUTE0, PH_TOPK0, PH_UP0, PH_DOWN0, PH_COMB0, PH_G3, PH_CONV3, PH_G4, PH_ROUTE1, PH_TOPK1, PH_UP1, PH_DOWN1, PH_COMB1, NPH };

constexpr int LDS_BYTES = 147456;
constexpr int LDS_XB = LDS_BYTES - 16;
__global__ void __launch_bounds__(512, 2) fwd(P p, int lo, int hi) {
    extern __shared__ __attribute__((aligned(16))) unsigned char shm[];
    LAS unsigned char* lds = (LAS unsigned char*)shm;
    XcdBarrier bar; bar.bar = p.bar; bar.x = 0; bar.st = (volatile LAS unsigned*)(lds + LDS_XB);
    if (hi - lo > 1) {
        if (threadIdx.x == 0) { ((LAS unsigned*)(lds + LDS_XB))[0] = 0u; ((LAS unsigned*)(lds + LDS_XB))[1] = 0u; }
        __syncthreads();
        bar = xcd_barrier_post(p.bar, (volatile LAS unsigned*)(lds + LDS_XB));
    }
#if NAIVE_GEMM
#define GEMM_SEL(a, b) a
#else
#define GEMM_SEL(a, b) b
#endif
#if NAIVE_SSD
#define SSD_SEL(a, b) a
#else
#define SSD_SEL(a, b) b
#endif
#if NAIVE_ATTN
#define ATTN_SEL(a, b) a
#else
#define ATTN_SEL(a, b) b
#endif
#if NAIVE_TOPK
#define TOPK_SEL(a, b) a
#else
#define TOPK_SEL(a, b) b
#endif
#define ROPE_IN_G1 ((int)gridDim.x == 256 && !NAIVE_GEMM)
#define TOPK_CVX(layer) { const int ntk = (int)gridDim.x > 64 ? BATCH * NE : 0; \
        if (ntk == 0) { ph_topk(p, lds, (int)blockIdx.x, (int)gridDim.x); __syncthreads(); ph_convert_experts_f8(p, layer, lds, (int)blockIdx.x, (int)gridDim.x); if ((layer) == 0 && !ROPE_IN_G1) ph_convert_small_late(p, GTID, GSTRIDE); } \
        else if ((int)blockIdx.x < ntk) { ph_topk(p, lds, (int)blockIdx.x, ntk); } \
        else { ph_convert_experts_f8(p, layer, lds, (int)blockIdx.x - ntk, (int)gridDim.x - ntk); if ((layer) == 0 && !ROPE_IN_G1) ph_convert_small_late(p, (size_t)((int)blockIdx.x - ntk) * 512 + threadIdx.x, (size_t)((int)gridDim.x - ntk) * 512); } }
#if FP8_MOE
#define CVX_SEL(layer) ph_convert_experts_f8(p, layer, lds, (int)blockIdx.x, (int)gridDim.x)
#else
#define CVX_SEL(layer) ph_convert_experts_dev(p, layer, lds)
#endif
#ifndef PROBE_DUP
#define PROBE_DUP -1
#endif
#if PROF_A >= 0
#define PROF_STAMP(i) if (blockIdx.x == 0 && threadIdx.x == 0) p.bar[8192 + 2 * (i)] = (unsigned)__builtin_amdgcn_s_memrealtime();
#else
#define PROF_STAMP(i)
#endif
#define PHASE(i, body) if (lo <= (i) && (i) < hi) { PROF_STAMP(i) body; if ((i) == PROBE_DUP) { xcd_barrier(bar); body; } if ((i) + 1 < hi) xcd_barrier(bar); }
    PHASE(PH_FIRST, { ph_convert_small_tiles(p, lds); if (!ROPE_IN_G1) ph_rope_table(p); ph_rmsnorm_dev(p.x, p.attn_norm, p.hn); })
    PHASE(PH_G1, { GEMM_SEL(nv_g1(p), ph_g1(p, lds)); if (ROPE_IN_G1 && blockIdx.x >= 128) { ph_rope_table(p, (size_t)((int)blockIdx.x - 128) * 512 + threadIdx.x, (size_t)128 * 512); ph_convert_late_tiles(p, lds, (int)blockIdx.x - 128, 128); } })
    PHASE(PH_PREP, ph_prep_dev(p, lds))
    PHASE(PH_ATTN, { if (PROF_X != 4) { ATTN_SEL(nv_attn(p), ph_attn2(p, lds)); } if (PROF_X != 3) { SSD_SEL(nv_ssd(p), ph_ssd_states(p, lds)); } })
    PHASE(PH_SSDB, SSD_SEL((void)0, ph_ssd_scan(p)))
    PHASE(PH_SSDC, SSD_SEL(ph_gated_norm_dev(p), ph_ssd_out(p, lds)))
    PHASE(PH_G2, ph_g2(p, lds))
    PHASE(PH_ROUTE0, ph_norm_router_mfma<true>(p, 0, lds, p.x, nullptr))
    PHASE(PH_TOPK0, TOPK_CVX(0))
    PHASE(PH_UP0, GEMM_SEL(nv_up(p), ph_up(p, lds)))
    PHASE(PH_DOWN0, GEMM_SEL(nv_down(p), ph_down(p, lds)))
    PHASE(PH_COMB0, { ph_combine_dev4<true>(p, p.conv_norm, p.x, nullptr, p.xb2); })
    PHASE(PH_G3, GEMM_SEL(nv_g3(p), ph_g3(p, lds)))
    PHASE(PH_CONV3, ph_conv3_dev(p))
    PHASE(PH_G4, ph_g4(p, lds))
    PHASE(PH_ROUTE1, ph_norm_router_mfma<false>(p, 1, lds, nullptr, p.xb2))
    PHASE(PH_TOPK1, TOPK_CVX(1))
    PHASE(PH_UP1, GEMM_SEL(nv_up(p), ph_up(p, lds)))
    PHASE(PH_DOWN1, GEMM_SEL(nv_down(p), ph_down(p, lds)))
    PHASE(PH_COMB1, ph_combine_dev4<false>(p, nullptr, nullptr, p.xb2, nullptr))
#if PROF_A >= 0
    xcd_barrier(bar); PROF_STAMP(NPH) xcd_barrier(bar);
    { const float ca = (float)(p.bar[8192 + 2 * (PROF_A + 1)] - p.bar[8192 + 2 * PROF_A]) * 0.01f, cb = 0.f;
      (void)cb; const float mark = ca > (float)PROF_B ? 0.f : 100.f; for (size_t i = GTID; i < (size_t)T * 1024; i += GSTRIDE) p.out[i] = mark; }
#endif
}

extern "C" void kernel_launch(void* const* d_in, const int* in_sizes, int n_in, void* d_out, int out_size, void* d_ws, size_t ws_size, hipStream_t stream) {
    (void)in_sizes; (void)n_in; (void)out_size; (void)ws_size;
    P p{};
    make_params(p, d_in, d_out, d_ws);
    static int grid = 0;
    if (grid == 0) {
        int dev = 0, cus = 0;
        if (hipGetDevice(&dev) != hipSuccess || hipDeviceGetAttribute(&cus, hipDeviceAttributeMultiprocessorCount, dev) != hipSuccess) cus = 256;
        (void)hipFuncSetAttribute((const void*)fwd, hipFuncAttributeMaxDynamicSharedMemorySize, LDS_BYTES);
        (void)hipGetLastError();
        grid = cus > 0 ? cus : 256;
    }
#if ONE_LAUNCH
    (void)hipMemsetAsync(p.bar, 0, XCD_BAR_WORDS * sizeof(unsigned), stream);
    hipLaunchKernelGGL(fwd, dim3(grid), dim3(512), LDS_BYTES, stream, p, 0, (int)NPH);
#else
    for (int ph = 0; ph < NPH; ++ph) hipLaunchKernelGGL(fwd, dim3(grid), dim3(512), LDS_BYTES, stream, p, ph, ph + 1);
#endif
}
#endif
```

```cpp
#ifndef HOST_EMU
#include <hip/hip_runtime.h>
#define HD __host__ __device__ __forceinline__
#define DEV __device__ __forceinline__
#else
#include <cmath>
#include <cstdio>
#include <cstdlib>
#include <cstring>
#include <cstddef>
#define HD inline
#define DEV inline
struct float4 { float x, y, z, w; };
struct uint4 { unsigned x, y, z, w; };
struct uint2 { unsigned x, y; };
static thread_local size_t emu_tid = 0; static size_t emu_nthreads = 1;
#endif

#ifndef BATCH
#define BATCH 2
#endif
#ifndef SEQ
#define SEQ 16384
#endif
#define XST_OFF(b, ch, pos) ((((size_t)(b) * NCHUNK + ((pos) >> 7)) * 1024 + (ch)) * 128 + ((pos) & 127))
#define BMT_OFF(b, n, pos) ((((size_t)(b) * NCHUNK + ((pos) >> 7)) * 256 + (n)) * 128 + ((pos) & 127))
#ifndef NAIVE_GEMM
#define NAIVE_GEMM 0
#endif
#ifndef NAIVE_ATTN
#define NAIVE_ATTN 0
#endif
#ifndef NAIVE_SSD
#define NAIVE_SSD 0
#endif
#ifndef NAIVE_TOPK
#define NAIVE_TOPK 0
#endif
#ifndef FP8_MOE
#define FP8_MOE 1
#endif
#ifndef PROF_A
#define PROF_A -1
#endif
#ifndef PROF_X
#define PROF_X 0
#endif
#ifndef PROF_B
#define PROF_B -1
#endif
#ifndef ONE_LAUNCH
#define ONE_LAUNCH 1
#endif

typedef unsigned short bf16_t;
constexpr int T = BATCH * SEQ;
constexpr int DM = 1024;
constexpr int NIN = 5664, NIN_PAD = 5888;
constexpr int NE = 16;
constexpr int CAP = 2 * SEQ / NE;
constexpr int NSLOT = BATCH * NE * CAP;
constexpr int DFF = 2048;
constexpr int NCHUNK = SEQ / 128;

HD float bf2f(bf16_t v) { union { unsigned u; float f; } x; x.u = ((unsigned)v) << 16; return x.f; }
HD bf16_t f2bf(float f) { union { unsigned u; float f; } x; x.f = f; unsigned u = x.u; u += 0x7fffu + ((u >> 16) & 1u); return (bf16_t)(u >> 16); }
HD unsigned pack2(float lo, float hi) { return (unsigned)f2bf(lo) | ((unsigned)f2bf(hi) << 16); }
HD float silu_f(float v) { return v / (1.0f + expf(-v)); }
HD float softplus_f(float v) { return v > 20.f ? v : log1pf(expf(v)); }

#ifndef HOST_EMU
#define LANES 64
#define GTID ((size_t)blockIdx.x * blockDim.x + threadIdx.x)
#define GSTRIDE ((size_t)gridDim.x * blockDim.x)
#define LANE ((int)(threadIdx.x & 63))
DEV float wave_sum(float v) {
#pragma unroll
    for (int o = 32; o >= 1; o >>= 1) v += __shfl_xor(v, o);
    return v;
}
#else
#define LANES 1
#define GTID (emu_tid)
#define GSTRIDE (emu_nthreads)
#define LANE 0
DEV float wave_sum(float v) { return v; }
#endif
#define GWAVE (GTID / LANES)
#define NWAVES_G (GSTRIDE / LANES)

struct P {
    const float *x, *attn_norm, *w_in, *q_norm, *k_norm, *conv_w, *conv_b, *a_log_f, *a_log_b, *dtb_f, *dtb_b, *ssd_d, *out_norm, *w_out,
        *conv_norm, *cw_in, *cw, *cw_out, *ffn_norm, *router_w, *wg, *wu, *wd;
    float* out;
    bf16_t *WinT, *WoutT, *WciT, *WcoT, *WguT, *WdT, *hn, *qkv, *z, *xbcraw, *bc, *xsT, *bmT, *states, *mix, *yssd, *xe, *hid, *ye, *pbuf, *gb, *abuf, *dlt, *xb2;
    float *dtraw, *step, *stT, *csT, *wdT, *cdec, *aff, *gate, *rope, *ytmp, *rinv, *rinvs; unsigned char* rtab;
    int *idx, *slotmap;
    unsigned* bar;
};

constexpr size_t MiB = 1024 * 1024;
constexpr size_t al(size_t v) { return (v + 4095) & ~(size_t)4095; }
constexpr size_t WS_BAR = 0;
constexpr size_t WS_WIN = 65536;
constexpr size_t WS_WOUT = WS_WIN + al((size_t)NIN_PAD * 1024 * 2);
constexpr size_t WS_WCI = WS_WOUT + al((size_t)1024 * 2048 * 2);
constexpr size_t WS_WCO = WS_WCI + al((size_t)3072 * 1024 * 2);
constexpr size_t WS_WGU = WS_WCO + al((size_t)1024 * 1024 * 2);
constexpr size_t WS_WD = WS_WGU + al((size_t)NE * 4096 * 1024 * 2);
constexpr size_t WS_ROPE = WS_WD + al((size_t)NE * 1024 * 2048 * 2);
constexpr size_t WS_AFF = WS_ROPE + al((size_t)SEQ * 16 * 4);
constexpr size_t WS_GATE = WS_AFF + al((size_t)BATCH * NE * SEQ * 4);
constexpr size_t WS_IDX = WS_GATE + al((size_t)NSLOT * 4);
constexpr size_t WS_SMAP = WS_IDX + al((size_t)NSLOT * 4);
constexpr size_t WS_RINV = WS_SMAP + al((size_t)BATCH * NE * SEQ * 4);
constexpr size_t WS_RINVS = WS_RINV + al((size_t)T * 4);
constexpr size_t WS_HN = WS_RINVS + al((size_t)NSLOT * 4);
constexpr size_t WS_E = WS_HN + al((size_t)T * 1024 * 2);
constexpr size_t WS_XBCRAW = WS_E;
constexpr size_t WS_QKV = WS_XBCRAW + al((size_t)T * 1536 * 2);
constexpr size_t WS_Z = WS_QKV + al((size_t)T * 3072 * 2);
constexpr size_t WS_BC = WS_Z + al((size_t)T * 1024 * 2);
constexpr size_t WS_XST = WS_BC + al((size_t)T * 512 * 2);
constexpr size_t WS_BMT = WS_XST + al((size_t)T * 1024 * 2);
constexpr size_t WS_DTRAW = WS_BMT + al((size_t)T * 256 * 2);
constexpr size_t WS_STEP = WS_DTRAW + al((size_t)T * 32 * 4);
constexpr size_t WS_STT = WS_STEP + al((size_t)T * 32 * 4);
constexpr size_t WS_CST = WS_STT + al((size_t)T * 32 * 4);
constexpr size_t WS_WDT = WS_CST + al((size_t)T * 32 * 4);
constexpr size_t WS_CDEC = WS_WDT + al((size_t)T * 32 * 4);
constexpr size_t WS_MIX = WS_CDEC + al((size_t)BATCH * 32 * NCHUNK * 4);
constexpr size_t WS_YSSD = WS_MIX + al((size_t)T * 2048 * 2);
constexpr size_t WS_E_END = WS_YSSD + al((size_t)T * 1024 * 2);
constexpr size_t WS_STATES = WS_HN;
constexpr size_t WS_XE = WS_E;
constexpr size_t WS_HID = WS_XE + al((size_t)NSLOT * 1024 * 2);
constexpr size_t WS_YE = WS_HID + al((size_t)NSLOT * 2048 * 2);
constexpr size_t WS_F_END = WS_YE + al((size_t)NSLOT * 1024 * 2);
constexpr size_t WS_PBUF = WS_E;
constexpr size_t WS_GB = WS_PBUF + al((size_t)T * 1024 * 2);
constexpr size_t WS_ABUF = WS_GB + al((size_t)T * 1024 * 2);
constexpr size_t WS_END = WS_E_END > WS_F_END ? WS_E_END : WS_F_END;
static_assert((size_t)T * 1024 * 2 + (size_t)T * 1536 * 2 >= (size_t)T * 1024 * 4, "ytmp overlay");
static_assert((size_t)T * 1024 * 2 + (size_t)T * 1536 * 2 >= (size_t)BATCH * 2 * NCHUNK * 16 * 64 * 128 * 2, "states overlay");
constexpr size_t WS_RTAB = WS_END;
static_assert(BATCH != 2 || SEQ != 16384 || WS_RTAB + 2 * 65536 <= 1024 * MiB, "workspace");

struct CmIdent { int nvalid; HD int operator()(int n) const { return n < nvalid ? n : -1; } };
struct CmGateUp { HD int operator()(int n) const { return n; } };
struct CmOddIn { HD int operator()(int n) const {
        if (n >= 2048) return n - 2048; const int pn = n >> 8, j = n & 255; return j < 128 ? 1024 + pn * 128 + j : 2048 + pn * 128 + (j - 128); } };

template <class CM> DEV void convT(const float* src, int ldsrc, int K, bf16_t* dst, int Ndst, CM cm, size_t gtid = GTID, size_t gstride = GSTRIDE) {
#ifndef HOST_EMU
    const size_t nitems = (size_t)Ndst * (K / 32);
    for (size_t i = gtid; i < nitems; i += gstride) {
        const int n = (int)(i % Ndst), k32 = (int)(i / Ndst); const int c = cm(n);
        float v[32];
#pragma unroll
        for (int j = 0; j < 32; ++j) v[j] = c >= 0 ? src[(size_t)(k32 * 32 + j) * ldsrc + c] : 0.f;
#pragma unroll
        for (int q = 0; q < 4; ++q) *(uint4*)(dst + (size_t)n * K + k32 * 32 + q * 8) = uint4{pack2(v[8 * q], v[8 * q + 1]), pack2(v[8 * q + 2], v[8 * q + 3]), pack2(v[8 * q + 4], v[8 * q + 5]), pack2(v[8 * q + 6], v[8 * q + 7])};
    }
#else
    for (size_t i = gtid; i < (size_t)Ndst * K; i += gstride) { const int n = (int)(i / K), k = (int)(i % K); const int c = cm(n); dst[i] = c >= 0 ? f2bf(src[(size_t)k * ldsrc + c]) : (bf16_t)0; }
#endif
}
struct CmGU { const float* dummy; HD int operator()(int n) const { return n; } };
template <int WHICH> struct CmHalf { HD int operator()(int n) const { const int j = n & 255; const bool isup = j >= 128; if ((int)isup != WHICH) return -2; return (n >> 8) * 128 + (j & 127); } };
DEV void conv_gateup(const float* sg, const float* su, bf16_t* dst) {
#ifndef HOST_EMU
    const size_t nitems = (size_t)4096 * 32;
    for (size_t i = GTID; i < nitems; i += GSTRIDE) {
        const int n = (int)(i % 4096), k32 = (int)(i / 4096); const int j0 = n & 255; const float* src = (j0 >= 128 ? su : sg) + (n >> 8) * 128 + (j0 & 127);
        float v[32];
#pragma unroll
        for (int j = 0; j < 32; ++j) v[j] = src[(size_t)(k32 * 32 + j) * 2048];
#pragma unroll
        for (int q = 0; q < 4; ++q) *(uint4*)(dst + (size_t)n * 1024 + k32 * 32 + q * 8) = uint4{pack2(v[8 * q], v[8 * q + 1]), pack2(v[8 * q + 2], v[8 * q + 3]), pack2(v[8 * q + 4], v[8 * q + 5]), pack2(v[8 * q + 6], v[8 * q + 7])};
    }
#else
    for (size_t i = GTID; i < (size_t)4096 * 1024; i += GSTRIDE) { const int n = (int)(i / 1024), k = (int)(i % 1024); const int j = n & 255; const float* src = j >= 128 ? su : sg; dst[i] = f2bf(src[(size_t)k * 2048 + (n >> 8) * 128 + (j & 127)]); }
#endif
}
DEV void ph_convert_small_late(const P& p, size_t gtid, size_t gstride) {
    convT(p.cw_in, 3072, 1024, p.WciT, 3072, CmOddIn{}, gtid, gstride);
    convT(p.cw_out, 1024, 1024, p.WcoT, 1024, CmIdent{1024}, gtid, gstride);
}
DEV void ph_rope_table(const P& p, size_t gtid = GTID, size_t gstride = GSTRIDE) {
    for (size_t i = gtid; i < (size_t)SEQ * 8; i += gstride) {
        const int pos = (int)(i >> 3), j = (int)(i & 7);
        const float inv = powf(500000.0f, -((float)j * 2.0f / 16.0f)); const float ang = (float)pos * inv;
        p.rope[(size_t)pos * 16 + j] = cosf(ang); p.rope[(size_t)pos * 16 + 8 + j] = sinf(ang);
    }
}
DEV void ph_convert_small(const P& p) {
    convT(p.w_in, NIN, 1024, p.WinT, NIN_PAD, CmIdent{NIN});
    convT(p.w_out, 1024, 2048, p.WoutT, 1024, CmIdent{1024});
#ifdef HOST_EMU
    ph_convert_small_late(p, GTID, GSTRIDE);
#endif
    ph_rope_table(p);
}
DEV void ph_convert_experts(const P& p, int layer) {
    for (int e = 0; e < NE; ++e) {
        const size_t off = ((size_t)layer * NE + e) * 1024 * 2048;
        conv_gateup(p.wg + off, p.wu + off, p.WguT + (size_t)e * 4096 * 1024);
        convT(p.wd + off, 1024, 2048, p.WdT + (size_t)e * 1024 * 2048, 1024, CmIdent{1024});
    }
}

constexpr int NV = 256 / LANES;
DEV void ph_rmsnorm(const float* src, const float* g, bf16_t* dst) {
    for (size_t row = GWAVE; row < (size_t)T; row += NWAVES_G) {
        const float4* s4 = (const float4*)(src + row * 1024); float4 v[NV]; float ss = 0.f;
#pragma unroll
        for (int j = 0; j < NV; ++j) { v[j] = s4[j * LANES + LANE]; ss += v[j].x * v[j].x + v[j].y * v[j].y + v[j].z * v[j].z + v[j].w * v[j].w; }
        ss = wave_sum(ss); const float r = 1.0f / sqrtf(ss * (1.0f / 1024.0f) + 1e-6f);
#pragma unroll
        for (int j = 0; j < NV; ++j) { const int c4 = j * LANES + LANE; const float4 gg = ((const float4*)g)[c4];
            *(uint2*)(dst + row * 1024 + c4 * 4) = uint2{pack2(v[j].x * r * gg.x, v[j].y * r * gg.y), pack2(v[j].z * r * gg.z, v[j].w * r * gg.w)}; }
    }
}
DEV void ph_norm_router(const P& p, int layer) {
    const float* g = p.ffn_norm + (size_t)layer * 1024; const float* rw = p.router_w + (size_t)layer * 1024 * 16;
    for (size_t row = GWAVE; row < (size_t)T; row += NWAVES_G) {
        const float4* s4 = (const float4*)(p.out + row * 1024); float4 v[NV]; float ss = 0.f;
#pragma unroll
        for (int j = 0; j < NV; ++j) { v[j] = s4[j * LANES + LANE]; ss += v[j].x * v[j].x + v[j].y * v[j].y + v[j].z * v[j].z + v[j].w * v[j].w; }
        ss = wave_sum(ss); const float r = 1.0f / sqrtf(ss * (1.0f / 1024.0f) + 1e-6f);
        float lg[16];
#pragma unroll
        for (int e = 0; e < 16; ++e) lg[e] = 0.f;
#pragma unroll
        for (int j = 0; j < NV; ++j) { const int c4 = j * LANES + LANE; const float4 gg = ((const float4*)g)[c4];
            const float h0 = v[j].x * r * gg.x, h1 = v[j].y * r * gg.y, h2 = v[j].z * r * gg.z, h3 = v[j].w * r * gg.w;
            *(uint2*)(p.hn + row * 1024 + c4 * 4) = uint2{pack2(h0, h1), pack2(h2, h3)};
            const float4* w4 = (const float4*)(rw + (size_t)c4 * 4 * 16);
#pragma unroll
            for (int q = 0; q < 4; ++q) { const float4 a = w4[q], b = w4[4 + q], c = w4[8 + q], d = w4[12 + q];
                lg[4 * q + 0] += h0 * a.x + h1 * b.x + h2 * c.x + h3 * d.x; lg[4 * q + 1] += h0 * a.y + h1 * b.y + h2 * c.y + h3 * d.y;
                lg[4 * q + 2] += h0 * a.z + h1 * b.z + h2 * c.z + h3 * d.z; lg[4 * q + 3] += h0 * a.w + h1 * b.w + h2 * c.w + h3 * d.w; } }
        float mx = -1e30f;
#pragma unroll
        for (int e = 0; e < 16; ++e) { lg[e] = wave_sum(lg[e]); mx = fmaxf(mx, lg[e]); }
        float den = 0.f;
#pragma unroll
        for (int e = 0; e < 16; ++e) { lg[e] = expf(lg[e] - mx); den += lg[e]; }
        const float inv = 1.0f / den; const int b = (int)(row / SEQ), s = (int)(row % SEQ);
#pragma unroll
        for (int e = 0; e < 16; ++e) if (LANE == (e & (LANES - 1))) p.aff[((size_t)b * NE + e) * SEQ + s] = lg[e] * inv;
    }
}
DEV void ph_gated_norm(const P& p) {
    for (size_t row = GWAVE; row < (size_t)T; row += NWAVES_G) {
        float4 v[NV]; float ss = 0.f;
#pragma unroll
        for (int j = 0; j < NV; ++j) { const int c4 = j * LANES + LANE; const uint2 y = *(const uint2*)(p.yssd + row * 1024 + c4 * 4), zz = *(const uint2*)(p.z + row * 1024 + c4 * 4);
            v[j].x = bf2f((bf16_t)(y.x & 0xffff)) * silu_f(bf2f((bf16_t)(zz.x & 0xffff))); v[j].y = bf2f((bf16_t)(y.x >> 16)) * silu_f(bf2f((bf16_t)(zz.x >> 16)));
            v[j].z = bf2f((bf16_t)(y.y & 0xffff)) * silu_f(bf2f((bf16_t)(zz.y & 0xffff))); v[j].w = bf2f((bf16_t)(y.y >> 16)) * silu_f(bf2f((bf16_t)(zz.y >> 16)));
            ss += v[j].x * v[j].x + v[j].y * v[j].y + v[j].z * v[j].z + v[j].w * v[j].w; }
        ss = wave_sum(ss); const float r = 1.0f / sqrtf(ss * (1.0f / 1024.0f) + 1e-6f);
#pragma unroll
        for (int j = 0; j < NV; ++j) { const int c4 = j * LANES + LANE; const float4 gg = ((const float4*)p.out_norm)[c4];
            *(uint2*)(p.mix + row * 2048 + 1024 + c4 * 4) = uint2{pack2(v[j].x * r * gg.x, v[j].y * r * gg.y), pack2(v[j].z * r * gg.z, v[j].w * r * gg.w)}; }
    }
}
DEV void ph_combine(const P& p, const float* g) {
    for (size_t row = GWAVE; row < (size_t)T; row += NWAVES_G) {
        const int b = (int)(row / SEQ), s = (int)(row % SEQ);
        float4* o4 = (float4*)(p.out + row * 1024); float4 v[NV];
#pragma unroll
        for (int j = 0; j < NV; ++j) v[j] = o4[j * LANES + LANE];
        for (int e = 0; e < NE; ++e) {
            const int sl = p.slotmap[((size_t)b * NE + e) * SEQ + s];
            if (sl >= 0) { const size_t r = ((size_t)b * NE + e) * CAP + sl; const float gt = p.gate[r];
#pragma unroll
                for (int j = 0; j < NV; ++j) { const int c4 = j * LANES + LANE; const uint2 y = *(const uint2*)(p.ye + r * 1024 + c4 * 4);
                    v[j].x += gt * bf2f((bf16_t)(y.x & 0xffff)); v[j].y += gt * bf2f((bf16_t)(y.x >> 16)); v[j].z += gt * bf2f((bf16_t)(y.y & 0xffff)); v[j].w += gt * bf2f((bf16_t)(y.y >> 16)); } }
        }
        float ss = 0.f;
#pragma unroll
        for (int j = 0; j < NV; ++j) { o4[j * LANES + LANE] = v[j]; ss += v[j].x * v[j].x + v[j].y * v[j].y + v[j].z * v[j].z + v[j].w * v[j].w; }
        if (g) { ss = wave_sum(ss); const float r = 1.0f / sqrtf(ss * (1.0f / 1024.0f) + 1e-6f);
#pragma unroll
            for (int j = 0; j < NV; ++j) { const int c4 = j * LANES + LANE; const float4 gg = ((const float4*)g)[c4];
                *(uint2*)(p.hn + row * 1024 + c4 * 4) = uint2{pack2(v[j].x * r * gg.x, v[j].y * r * gg.y), pack2(v[j].z * r * gg.z, v[j].w * r * gg.w)}; } }
    }
}

DEV void ld8(const bf16_t* p, float (&f)[8]) { const uint4 u = *(const uint4*)p; const unsigned w[4] = {u.x, u.y, u.z, u.w};
#pragma unroll
    for (int j = 0; j < 4; ++j) { f[2 * j] = bf2f((bf16_t)(w[j] & 0xffff)); f[2 * j + 1] = bf2f((bf16_t)(w[j] >> 16)); } }
DEV void st8(bf16_t* p, const float (&f)[8]) { *(uint4*)p = uint4{pack2(f[0], f[1]), pack2(f[2], f[3]), pack2(f[4], f[5]), pack2(f[6], f[7])}; }

DEV void ph_prep(const P& p, bool doqk = true) {
    for (size_t i = GTID; doqk && i < (size_t)T * 32; i += GSTRIDE) {
        const size_t t = i >> 5; const int hh = (int)(i & 31); const int isk = hh >> 4, h = hh & 15; const int pos = (int)(t % SEQ);
        bf16_t* ptr = p.qkv + t * 3072 + isk * 1024 + h * 64; const float* gn = isk ? p.k_norm : p.q_norm;
        float v[64]; float ss = 0.f;
#pragma unroll
        for (int c = 0; c < 8; ++c) { float f[8]; ld8(ptr + c * 8, f);
#pragma unroll
            for (int j = 0; j < 8; ++j) { v[c * 8 + j] = f[j]; ss += f[j] * f[j]; } }
        const float r = 1.0f / sqrtf(ss * (1.0f / 64.0f) + 1e-6f);
#pragma unroll
        for (int c = 0; c < 64; ++c) v[c] = v[c] * r * gn[c];
#pragma unroll
        for (int j = 0; j < 8; ++j) { const float cs = p.rope[(size_t)pos * 16 + j], sn = p.rope[(size_t)pos * 16 + 8 + j]; const float x1 = v[j], x2 = v[8 + j]; v[j] = x1 * cs - x2 * sn; v[8 + j] = x2 * cs + x1 * sn; }
#pragma unroll
        for (int c = 0; c < 8; ++c) { float f[8];
#pragma unroll
            for (int j = 0; j < 8; ++j) f[j] = v[c * 8 + j];
            st8(ptr + c * 8, f); }
    }
    for (size_t i = GTID; i < (size_t)T * 192; i += GSTRIDE) {
        const size_t t = i % T; const int c8 = (int)(i / T) * 8; const int pos = (int)(t % SEQ); const int b = (int)(t / SEQ);
        float acc[8];
#pragma unroll
        for (int j = 0; j < 8; ++j) acc[j] = p.conv_b[c8 + j];
#pragma unroll
        for (int k = 0; k < 5; ++k) { const int pp = pos + k - 2; if (pp < 0 || pp >= SEQ) continue; float f[8]; ld8(p.xbcraw + (t + k - 2) * 1536 + c8, f);
#pragma unroll
            for (int j = 0; j < 8; ++j) acc[j] += f[j] * p.conv_w[k * 1536 + c8 + j]; }
#pragma unroll
        for (int j = 0; j < 8; ++j) acc[j] = silu_f(acc[j]);
        if (c8 < 1024) {
#pragma unroll
            for (int j = 0; j < 8; ++j) p.xsT[XST_OFF(b, c8 + j, pos)] = f2bf(acc[j]);
        } else {
            st8(p.bc + t * 512 + (c8 - 1024), acc);
            if (c8 < 1280) {
#pragma unroll
                for (int j = 0; j < 8; ++j) p.bmT[BMT_OFF(b, (c8 - 1024) + j, pos)] = f2bf(acc[j]); }
        }
    }
    for (size_t i = GTID; i < (size_t)BATCH * NCHUNK * 32; i += GSTRIDE) {
        const int j = (int)(i & 31); const int c = (int)((i >> 5) % NCHUNK), b = (int)((i >> 5) / NCHUNK); const int dir = j >> 4, h = j & 15;
        const float A = -expf(dir ? p.a_log_b[h] : p.a_log_f[h]), bias = dir ? p.dtb_b[h] : p.dtb_f[h];
        const size_t row0 = (size_t)b * SEQ + (size_t)c * 128; float* stT = p.stT + ((size_t)b * 32 + j) * SEQ + c * 128; float* csT = p.csT + ((size_t)b * 32 + j) * SEQ + c * 128; float* wdT = p.wdT + ((size_t)b * 32 + j) * SEQ + c * 128;
        float run = 0.f;
        for (int ll = 0; ll < 128; ++ll) { const int l = dir ? 127 - ll : ll; const float dt = softplus_f(p.dtraw[(row0 + l) * 32 + j] + bias); p.step[(row0 + l) * 32 + j] = dt; stT[l] = dt; run += dt * A; csT[l] = run; }
        for (int l = 0; l < 128; ++l) wdT[l] = stT[l] * expf(run - csT[l]);
        p.cdec[((size_t)b * 32 + j) * NCHUNK + c] = expf(run);
    }
}
DEV void ph_gather(const P& p) {
    for (size_t i = GTID; i < (size_t)NSLOT * 128; i += GSTRIDE) { const size_t r = i >> 7; const int j = (int)(i & 127); const int b = (int)(r / ((size_t)NE * CAP));
        *(uint4*)(p.xe + r * 1024 + j * 8) = *(const uint4*)(p.hn + ((size_t)b * SEQ + p.idx[r]) * 1024 + j * 8); }
}
DEV void ph_conv3(const P& p) {
    for (size_t i = GTID; i < (size_t)T * 128; i += GSTRIDE) {
        const size_t t = i >> 7; const int c8 = (int)(i & 127) * 8; const int pos = (int)(t % SEQ);
        float acc[8], f[8];
#pragma unroll
        for (int j = 0; j < 8; ++j) acc[j] = 0.f;
#pragma unroll
        for (int k = 0; k < 3; ++k) { const int pp = pos + k - 1; if (pp < 0 || pp >= SEQ) continue; ld8(p.pbuf + (t + k - 1) * 1024 + c8, f);
#pragma unroll
            for (int j = 0; j < 8; ++j) acc[j] += f[j] * p.cw[k * 1024 + c8 + j]; }
        ld8(p.gb + t * 1024 + c8, f);
#pragma unroll
        for (int j = 0; j < 8; ++j) acc[j] *= f[j];
        st8(p.abuf + t * 1024 + c8, acc);
    }
}

DEV float dot_bf(const bf16_t* a, const bf16_t* b, int K) { float acc = 0.f; for (int k = 0; k < K; k += 8) { float fa[8], fb[8]; ld8(a + k, fa); ld8(b + k, fb);
#pragma unroll
        for (int j = 0; j < 8; ++j) acc += fa[j] * fb[j]; } return acc; }
DEV void nv_g1(const P& p) {
    for (size_t i = GTID; i < (size_t)T * NIN; i += GSTRIDE) { const size_t m = i / NIN; const int n = (int)(i % NIN); const float acc = dot_bf(p.hn + m * 1024, p.WinT + (size_t)n * 1024, 1024);
        if (n < 3072) p.qkv[m * 3072 + n] = f2bf(acc); else if (n < 4096) p.z[m * 1024 + n - 3072] = f2bf(acc); else if (n < 5632) p.xbcraw[m * 1536 + n - 4096] = f2bf(acc); else p.dtraw[m * 32 + n - 5632] = acc; }
}
DEV void nv_g2(const P& p) {
    for (size_t i = GTID; i < (size_t)T * 1024; i += GSTRIDE) { const size_t m = i >> 10; const int n = (int)(i & 1023); p.out[i] = p.x[i] + dot_bf(p.mix + m * 2048, p.WoutT + (size_t)n * 2048, 2048); }
}
DEV void nv_up(const P& p) {
    for (size_t i = GTID; i < (size_t)NSLOT * 2048; i += GSTRIDE) { const size_t r = i >> 11; const int n = (int)(i & 2047); const int e = (int)((r / CAP) % NE);
        const bf16_t* w = p.WguT + (size_t)e * 4096 * 1024 + (size_t)((n >> 7) * 256 + (n & 127)) * 1024;
        const float g = dot_bf(p.xe + r * 1024, w, 1024), u = dot_bf(p.xe + r * 1024, w + (size_t)128 * 1024, 1024); p.hid[i] = f2bf(silu_f(g) * u); }
}
DEV void nv_down(const P& p) {
    for (size_t i = GTID; i < (size_t)NSLOT * 1024; i += GSTRIDE) { const size_t r = i >> 10; const int n = (int)(i & 1023); const int e = (int)((r / CAP) % NE);
        p.ye[i] = f2bf(dot_bf(p.hid + r * 2048, p.WdT + (size_t)e * 1024 * 2048 + (size_t)n * 2048, 2048)); }
}
DEV void nv_g3(const P& p) {
    for (size_t i = GTID; i < (size_t)T * 2048; i += GSTRIDE) { const size_t m = i >> 11; const int n = (int)(i & 2047);
        if (n < 1024) { const bf16_t* w = p.WciT + (size_t)((n >> 7) * 256 + (n & 127)) * 1024; p.pbuf[m * 1024 + n] = f2bf(dot_bf(p.hn + m * 1024, w, 1024) * dot_bf(p.hn + m * 1024, w + (size_t)128 * 1024, 1024)); }
        else p.gb[m * 1024 + n - 1024] = f2bf(dot_bf(p.hn + m * 1024, p.WciT + (size_t)(2048 + n - 1024) * 1024, 1024)); }
}
DEV void nv_g4(const P& p) {
    for (size_t i = GTID; i < (size_t)T * 1024; i += GSTRIDE) { const size_t m = i >> 10; const int n = (int)(i & 1023); p.out[i] += dot_bf(p.abuf + m * 1024, p.WcoT + (size_t)n * 1024, 1024); }
}
DEV void nv_attn(const P& p) {
    for (size_t i = GTID; i < (size_t)T * 16; i += GSTRIDE) {
        const size_t t = i >> 4; const int h = (int)(i & 15); const int pos = (int)(t % SEQ); const size_t t0 = t - pos;
        const bf16_t* qp = p.qkv + t * 3072 + h * 64;
        float o[64]; float m = -1e30f, l = 0.f;
#pragma unroll
        for (int c = 0; c < 64; ++c) o[c] = 0.f;
        for (int pat = 0; pat < 3; ++pat) { const int d = pat == 0 ? 1 : (pat == 1 ? 4 : 16);
            for (int j = -64; j <= 64; ++j) { const int kp = pos + d * j; if (kp < 0 || kp >= SEQ) continue;
                const bf16_t* kr = p.qkv + (t0 + kp) * 3072 + 1024 + h * 64; const bf16_t* vr = kr + 1024;
                const float s = dot_bf(qp, kr, 64) * 0.125f;
                const float mn = fmaxf(m, s), sc = expf(m - mn), pe = expf(s - mn); l = l * sc + pe; m = mn;
#pragma unroll
                for (int c = 0; c < 8; ++c) { float f[8]; ld8(vr + c * 8, f);
#pragma unroll
                    for (int q = 0; q < 8; ++q) o[c * 8 + q] = o[c * 8 + q] * sc + pe * f[q]; } } }
        const float inv = 1.0f / l;
#pragma unroll
        for (int c = 0; c < 8; ++c) { float f[8];
#pragma unroll
            for (int q = 0; q < 8; ++q) f[q] = o[c * 8 + q] * inv;
            st8(p.mix + t * 2048 + h * 64 + c * 8, f); }
    }
}
DEV void nv_ssd(const P& p) {
    const size_t nitem = (size_t)BATCH * 16 * 64;
#ifndef HOST_EMU
    if (LANE != 0) return;
#endif
    for (size_t it = GWAVE; it < nitem; it += NWAVES_G) {
        const int b = (int)(it / 1024), h = (int)((it >> 6) & 15), pc = (int)(it & 63), g = h >> 3;
        const float af = -expf(p.a_log_f[h]), ab = -expf(p.a_log_b[h]), dsk = p.ssd_d[h];
        float st[128];
        for (int dir = 0; dir < 2; ++dir) {
#pragma unroll
            for (int n = 0; n < 128; ++n) st[n] = 0.f;
            for (int tt = 0; tt < SEQ; ++tt) { const int s = dir ? SEQ - 1 - tt : tt; const size_t row = (size_t)b * SEQ + s;
                const float dt = p.step[row * 32 + dir * 16 + h]; const float dec = expf(dt * (dir ? ab : af)); const float xv = bf2f(p.xsT[XST_OFF(b, h * 64 + pc, s)]); const float xdt = xv * dt;
                const bf16_t* bm = p.bc + row * 512 + g * 128; const bf16_t* cm = bm + 256; float y = 0.f;
#pragma unroll
                for (int n8 = 0; n8 < 16; ++n8) { float fb[8], fc[8]; ld8(bm + n8 * 8, fb); ld8(cm + n8 * 8, fc);
#pragma unroll
                    for (int j = 0; j < 8; ++j) { st[n8 * 8 + j] = st[n8 * 8 + j] * dec + xdt * fb[j]; y += fc[j] * st[n8 * 8 + j]; } }
                if (dir == 0) p.ytmp[row * 1024 + h * 64 + pc] = y; else p.yssd[row * 1024 + h * 64 + pc] = f2bf(p.ytmp[row * 1024 + h * 64 + pc] + y + xv * dsk); }
        }
    }
}
DEV void nv_topk(const P& p) {
    for (size_t i = GTID; i < (size_t)BATCH * NE * SEQ; i += GSTRIDE) { const size_t be = i / SEQ; const int s = (int)(i % SEQ); const float* a = p.aff + be * SEQ; const float v = a[s]; int rank = 0;
        for (int j = 0; j < SEQ; ++j) { const float w = a[j]; rank += (w > v || (w == v && j < s)) ? 1 : 0; }
        if (rank < CAP) { p.idx[be * CAP + rank] = s; p.gate[be * CAP + rank] = v; p.slotmap[i] = rank; } else p.slotmap[i] = -1; }
}

static void make_params(P& p, void* const* d_in, void* d_out, void* d_ws) {
    const float** ins = (const float**)&p.x;
    for (int i = 0; i < 23; ++i) ins[i] = (const float*)d_in[i];
    p.out = (float*)d_out;
    unsigned char* ws = (unsigned char*)d_ws;
    p.WinT = (bf16_t*)(ws + WS_WIN); p.WoutT = (bf16_t*)(ws + WS_WOUT); p.WciT = (bf16_t*)(ws + WS_WCI); p.WcoT = (bf16_t*)(ws + WS_WCO); p.WguT = (bf16_t*)(ws + WS_WGU); p.WdT = (bf16_t*)(ws + WS_WD);
    p.hn = (bf16_t*)(ws + WS_HN); p.qkv = (bf16_t*)(ws + WS_QKV); p.z = (bf16_t*)(ws + WS_Z); p.xbcraw = (bf16_t*)(ws + WS_XBCRAW); p.bc = (bf16_t*)(ws + WS_BC); p.xsT = (bf16_t*)(ws + WS_XST); p.bmT = (bf16_t*)(ws + WS_BMT); p.states = (bf16_t*)(ws + WS_STATES); p.mix = (bf16_t*)(ws + WS_MIX); p.yssd = (bf16_t*)(ws + WS_YSSD);
    p.xe = (bf16_t*)(ws + WS_XE); p.hid = (bf16_t*)(ws + WS_HID); p.ye = (bf16_t*)(ws + WS_YE); p.pbuf = (bf16_t*)(ws + WS_PBUF); p.gb = (bf16_t*)(ws + WS_GB); p.abuf = (bf16_t*)(ws + WS_ABUF); p.dlt = (bf16_t*)(ws + WS_Z); p.xb2 = (bf16_t*)(ws + WS_MIX);
    p.rtab = (unsigned char*)ws + WS_RTAB; p.dtraw = (float*)(ws + WS_DTRAW); p.step = (float*)(ws + WS_STEP); p.aff = (float*)(ws + WS_AFF); p.gate = (float*)(ws + WS_GATE); p.rope = (float*)(ws + WS_ROPE); p.ytmp = (float*)(ws + WS_STATES); p.stT = (float*)(ws + WS_STT); p.csT = (float*)(ws + WS_CST); p.wdT = (float*)(ws + WS_WDT); p.cdec = (float*)(ws + WS_CDEC); p.rinv = (float*)(ws + WS_RINV); p.rinvs = (float*)(ws + WS_RINVS);
    p.idx = (int*)(ws + WS_IDX); p.slotmap = (int*)(ws + WS_SMAP); p.bar = (unsigned*)(ws + WS_BAR);
}
#ifndef HOST_EMU
#define LAS __attribute__((address_space(3)))
typedef short bf16x8 __attribute__((ext_vector_type(8)));
typedef float f32x4 __attribute__((ext_vector_type(4)));
typedef unsigned u32x4 __attribute__((ext_vector_type(4)));
typedef unsigned u32x2 __attribute__((ext_vector_type(2)));
DEV void ph_norm_router_dev(const P& p, int layer) {
    const float4* g4 = (const float4*)(p.ffn_norm + (size_t)layer * 1024); const float4* rw4 = (const float4*)(p.router_w + (size_t)layer * 1024 * 16);
    const int lane = LANE;
    for (size_t row0 = GWAVE * 4; row0 < (size_t)T; row0 += NWAVES_G * 4) {
        float rinv[4];
        { float ss[4] = {0.f, 0.f, 0.f, 0.f};
#pragma unroll
          for (int j = 0; j < 4; ++j)
#pragma unroll
            for (int r = 0; r < 4; ++r) { const float4 t = ((const float4*)(p.out + (row0 + r) * 1024))[j * 64 + lane]; ss[r] += t.x * t.x + t.y * t.y + t.z * t.z + t.w * t.w; }
#pragma unroll
          for (int r = 0; r < 4; ++r) { const float q = wave_sum(ss[r]); rinv[r] = 1.0f / sqrtf(q * (1.0f / 1024.0f) + 1e-6f); } }
        float lg[4][16];
#pragma unroll
        for (int r = 0; r < 4; ++r)
#pragma unroll
            for (int e = 0; e < 16; ++e) lg[r][e] = 0.f;
#pragma unroll 1
        for (int j = 0; j < 4; ++j) { const int c4 = j * 64 + lane; const float4 gg = g4[c4]; float h[4][4];
#pragma unroll
            for (int r = 0; r < 4; ++r) { const float4 t = ((const float4*)(p.out + (row0 + r) * 1024))[c4];
                h[r][0] = t.x * rinv[r] * gg.x; h[r][1] = t.y * rinv[r] * gg.y; h[r][2] = t.z * rinv[r] * gg.z; h[r][3] = t.w * rinv[r] * gg.w;
                *(uint2*)(p.hn + (row0 + r) * 1024 + c4 * 4) = uint2{pack2(h[r][0], h[r][1]), pack2(h[r][2], h[r][3])}; }
#pragma unroll
            for (int cc = 0; cc < 4; ++cc) {
#pragma unroll
                for (int q = 0; q < 4; ++q) { const float4 w = rw4[(size_t)(c4 * 4 + cc) * 4 + q];
#pragma unroll
                    for (int r = 0; r < 4; ++r) { lg[r][4 * q] += h[r][cc] * w.x; lg[r][4 * q + 1] += h[r][cc] * w.y; lg[r][4 * q + 2] += h[r][cc] * w.z; lg[r][4 * q + 3] += h[r][cc] * w.w; } }
                asm volatile("" ::: "memory"); } }
#pragma unroll
        for (int r = 0; r < 4; ++r) { float mx = -1e30f;
#pragma unroll
            for (int e = 0; e < 16; ++e) { lg[r][e] = wave_sum(lg[r][e]); mx = fmaxf(mx, lg[r][e]); }
            float den = 0.f;
#pragma unroll
            for (int e = 0; e < 16; ++e) { lg[r][e] = expf(lg[r][e] - mx); den += lg[r][e]; }
            const float inv = 1.0f / den; const size_t row = row0 + r; const int b = (int)(row / SEQ), s = (int)(row % SEQ);
#pragma unroll
            for (int e = 0; e < 16; ++e) if (lane == e) p.aff[((size_t)b * NE + e) * SEQ + s] = lg[r][e] * inv; }
    }
}
#define GN_LOAD(Y, Z, R0) do { _Pragma("unroll") for (int r = 0; r < 4; ++r) { _Pragma("unroll") for (int j = 0; j < 4; ++j) { const int c4 = j * 64 + lane; \
        Y[r][j] = *(const uint2*)(p.yssd + ((R0) + r) * 1024 + c4 * 4); Z[r][j] = *(const uint2*)(p.z + ((R0) + r) * 1024 + c4 * 4); } } } while (0)
#define GN_DO(Y, Z, R0) do { _Pragma("unroll") for (int r = 0; r < 4; ++r) { float4 v[4]; float ss = 0.f; \
        _Pragma("unroll") for (int j = 0; j < 4; ++j) { const uint2 y = Y[r][j], zz = Z[r][j]; \
            const float z0 = __uint_as_float(zz.x << 16), z1 = __uint_as_float(zz.x & 0xffff0000u), z2 = __uint_as_float(zz.y << 16), z3 = __uint_as_float(zz.y & 0xffff0000u); \
            v[j].x = __uint_as_float(y.x << 16) * z0 * __builtin_amdgcn_rcpf(1.0f + __expf(-z0)); v[j].y = __uint_as_float(y.x & 0xffff0000u) * z1 * __builtin_amdgcn_rcpf(1.0f + __expf(-z1)); \
            v[j].z = __uint_as_float(y.y << 16) * z2 * __builtin_amdgcn_rcpf(1.0f + __expf(-z2)); v[j].w = __uint_as_float(y.y & 0xffff0000u) * z3 * __builtin_amdgcn_rcpf(1.0f + __expf(-z3)); \
            ss += v[j].x * v[j].x + v[j].y * v[j].y + v[j].z * v[j].z + v[j].w * v[j].w; } \
        ss = wave_sum(ss); const float rr = 1.0f / sqrtf(ss * (1.0f / 1024.0f) + 1e-6f); \
        _Pragma("unroll") for (int j = 0; j < 4; ++j) { const int c4 = j * 64 + lane; const float4 gg = gv[j]; \
            *(uint2*)(p.mix + ((R0) + r) * 2048 + 1024 + c4 * 4) = uint2{pack2(v[j].x * rr * gg.x, v[j].y * rr * gg.y), pack2(v[j].z * rr * gg.z, v[j].w * rr * gg.w)}; } } } while (0)
DEV void ph_gated_norm_dev(const P& p) {
    const int lane = LANE; const size_t ST = (size_t)NWAVES_G * 4;
    float4 gv[4];
#pragma unroll
    for (int j = 0; j < 4; ++j) gv[j] = ((const float4*)p.out_norm)[j * 64 + lane];
    uint2 ya[4][4], za[4][4], yb[4][4], zb[4][4];
    size_t row0 = (size_t)GWAVE * 4;
    if (row0 < (size_t)T) GN_LOAD(ya, za, row0);
    for (; row0 < (size_t)T; row0 += 2 * ST) {
        const bool hb = row0 + ST < (size_t)T;
        if (hb) GN_LOAD(yb, zb, row0 + ST);
        GN_DO(ya, za, row0);
        if (row0 + 2 * ST < (size_t)T) GN_LOAD(ya, za, row0 + 2 * ST);
        if (hb) GN_DO(yb, zb, row0 + ST);
    }
}
DEV void ph_combine_dev(const P& p, const float* g) {
    const int lane = LANE;
    for (size_t row = GWAVE; row < (size_t)T; row += NWAVES_G) {
        const int b = (int)(row / SEQ), s = (int)(row % SEQ);
        int mysl = -1; float mygt = 0.f;
        if (lane < 16) { mysl = p.slotmap[((size_t)b * NE + lane) * SEQ + s]; if (mysl >= 0) mygt = p.gate[((size_t)b * NE + lane) * CAP + mysl]; }
        float4* o4 = (float4*)(p.out + row * 1024); float4 v[4];
#pragma unroll
        for (int j = 0; j < 4; ++j) v[j] = o4[j * 64 + lane];
        unsigned long long mask = __ballot(mysl >= 0);
        while (mask) {
            const int e = __builtin_ctzll(mask); mask &= mask - 1;
            const int sl = __shfl(mysl, e); const float gt = __shfl(mygt, e); const size_t r = ((size_t)b * NE + e) * CAP + sl;
            uint2 y[4];
#pragma unroll
            for (int j = 0; j < 4; ++j) y[j] = *(const uint2*)(p.ye + r * 1024 + (j * 64 + lane) * 4);
#pragma unroll
            for (int j = 0; j < 4; ++j) { v[j].x += gt * __uint_as_float(y[j].x << 16); v[j].y += gt * __uint_as_float(y[j].x & 0xffff0000u); v[j].z += gt * __uint_as_float(y[j].y << 16); v[j].w += gt * __uint_as_float(y[j].y & 0xffff0000u); }
        }
        float ss = 0.f;
#pragma unroll
        for (int j = 0; j < 4; ++j) { o4[j * 64 + lane] = v[j]; ss += v[j].x * v[j].x + v[j].y * v[j].y + v[j].z * v[j].z + v[j].w * v[j].w; }
        if (g) { ss = wave_sum(ss); const float rr = 1.0f / sqrtf(ss * (1.0f / 1024.0f) + 1e-6f);
#pragma unroll
            for (int j = 0; j < 4; ++j) { const int c4 = j * 64 + lane; const float4 gg = ((const float4*)g)[c4];
                *(uint2*)(p.hn + row * 1024 + c4 * 4) = uint2{pack2(v[j].x * rr * gg.x, v[j].y * rr * gg.y), pack2(v[j].z * rr * gg.z, v[j].w * rr * gg.w)}; } }
    }
}

#define RMS_LOAD(V, R0) do { _Pragma("unroll") for (int r = 0; r < 4; ++r) { _Pragma("unroll") for (int j = 0; j < 4; ++j) V[r][j] = ((const float4*)(src + ((R0) + r) * 1024))[j * 64 + lane]; } } while (0)
#define RMS_DO(V, R0) do { _Pragma("unroll") for (int r = 0; r < 4; ++r) { float ss = 0.f; \
        _Pragma("unroll") for (int j = 0; j < 4; ++j) ss += V[r][j].x * V[r][j].x + V[r][j].y * V[r][j].y + V[r][j].z * V[r][j].z + V[r][j].w * V[r][j].w; \
        ss = wave_sum(ss); const float rr = 1.0f / sqrtf(ss * (1.0f / 1024.0f) + 1e-6f); \
        _Pragma("unroll") for (int j = 0; j < 4; ++j) { const int c4 = j * 64 + lane; const float4 gg = gv[j]; \
            *(uint2*)(dst + ((R0) + r) * 1024 + c4 * 4) = uint2{pack2(V[r][j].x * rr * gg.x, V[r][j].y * rr * gg.y), pack2(V[r][j].z * rr * gg.z, V[r][j].w * rr * gg.w)}; } } } while (0)
DEV void ph_rmsnorm_dev(const float* src, const float* g, bf16_t* dst) {
    const int lane = LANE; const size_t ST = (size_t)NWAVES_G * 4;
    float4 gv[4];
#pragma unroll
    for (int j = 0; j < 4; ++j) gv[j] = ((const float4*)g)[j * 64 + lane];
    float4 va[4][4], vb[4][4];
    size_t row0 = (size_t)GWAVE * 4;
    if (row0 < (size_t)T) RMS_LOAD(va, row0);
    for (; row0 < (size_t)T; row0 += 2 * ST) {
        const bool hb = row0 + ST < (size_t)T;
        if (hb) RMS_LOAD(vb, row0 + ST);
        RMS_DO(va, row0);
        if (row0 + 2 * ST < (size_t)T) RMS_LOAD(va, row0 + 2 * ST);
        if (hb) RMS_DO(vb, row0 + ST);
    }
}
DEV void ph_gather_dev(const P& p) {
    for (size_t i0 = GTID; i0 + 3 * GSTRIDE < (size_t)NSLOT * 128; i0 += GSTRIDE * 4) {
        const size_t i1 = i0 + GSTRIDE, i2 = i1 + GSTRIDE, i3 = i2 + GSTRIDE;
        const int t0 = p.idx[i0 >> 7], t1 = p.idx[i1 >> 7], t2 = p.idx[i2 >> 7], t3 = p.idx[i3 >> 7];
        const u32x4 v0 = *(const u32x4*)(p.hn + ((size_t)((i0 >> 7) / ((size_t)NE * CAP)) * SEQ + t0) * 1024 + (i0 & 127) * 8);
        const u32x4 v1 = *(const u32x4*)(p.hn + ((size_t)((i1 >> 7) / ((size_t)NE * CAP)) * SEQ + t1) * 1024 + (i1 & 127) * 8);
        const u32x4 v2 = *(const u32x4*)(p.hn + ((size_t)((i2 >> 7) / ((size_t)NE * CAP)) * SEQ + t2) * 1024 + (i2 & 127) * 8);
        const u32x4 v3 = *(const u32x4*)(p.hn + ((size_t)((i3 >> 7) / ((size_t)NE * CAP)) * SEQ + t3) * 1024 + (i3 & 127) * 8);
        *(u32x4*)(p.xe + (i0 >> 7) * 1024 + (i0 & 127) * 8) = v0; *(u32x4*)(p.xe + (i1 >> 7) * 1024 + (i1 & 127) * 8) = v1;
        *(u32x4*)(p.xe + (i2 >> 7) * 1024 + (i2 & 127) * 8) = v2; *(u32x4*)(p.xe + (i3 >> 7) * 1024 + (i3 & 127) * 8) = v3;
    }
}
#define C3_LOAD(A, G, I0) do { _Pragma("unroll") for (int q = 0; q < 4; ++q) { const size_t t = ((I0) + q * GSTRIDE) >> 7; const int pos = (int)(t % SEQ); \
        _Pragma("unroll") for (int k = 0; k < 3; ++k) { const int pp = pos + k - 1; A[q][k] = (pp < 0 || pp >= SEQ) ? uint4{0u, 0u, 0u, 0u} : *(const uint4*)(p.pbuf + (t + k - 1) * 1024 + c8); } \
        G[q] = *(const uint4*)(p.gb + t * 1024 + c8); } } while (0)
#define C3_DO(A, G, I0) do { _Pragma("unroll") for (int q = 0; q < 4; ++q) { const size_t t = ((I0) + q * GSTRIDE) >> 7; float acc[8], f[8]; \
        _Pragma("unroll") for (int j = 0; j < 8; ++j) acc[j] = 0.f; \
        _Pragma("unroll") for (int k = 0; k < 3; ++k) { const unsigned w[4] = {A[q][k].x, A[q][k].y, A[q][k].z, A[q][k].w}; \
            _Pragma("unroll") for (int j = 0; j < 4; ++j) { acc[2 * j] += __uint_as_float(w[j] << 16) * cw[k][2 * j]; acc[2 * j + 1] += __uint_as_float(w[j] & 0xffff0000u) * cw[k][2 * j + 1]; } } \
        { const unsigned w[4] = {G[q].x, G[q].y, G[q].z, G[q].w}; \
          _Pragma("unroll") for (int j = 0; j < 4; ++j) { f[2 * j] = acc[2 * j] * __uint_as_float(w[j] << 16); f[2 * j + 1] = acc[2 * j + 1] * __uint_as_float(w[j] & 0xffff0000u); } } \
        st8(p.abuf + t * 1024 + c8, f); } } while (0)
DEV void ph_conv3_dev(const P& p) {
    const size_t NI = (size_t)T * 128, ST = (size_t)GSTRIDE * 4;
    size_t i0 = GTID; const int c8 = (int)(i0 & 127) * 8;
    float cw[3][8];
#pragma unroll
    for (int k = 0; k < 3; ++k)
#pragma unroll
        for (int j = 0; j < 8; ++j) cw[k][j] = p.cw[k * 1024 + c8 + j];
    uint4 aa[4][3], ga[4], ab[4][3], gb_[4];
    if (i0 < NI) C3_LOAD(aa, ga, i0);
    for (; i0 < NI; i0 += 2 * ST) {
        const bool hb = i0 + ST < NI;
        if (hb) C3_LOAD(ab, gb_, i0 + ST);
        C3_DO(aa, ga, i0);
        if (i0 + 2 * ST < NI) C3_LOAD(aa, ga, i0 + 2 * ST);
        if (hb) C3_DO(ab, gb_, i0 + ST);
    }
}
#define CB_RAW(X, R0) do { _Pragma("unroll") for (int r = 0; r < 4; ++r) { _Pragma("unroll") for (int j = 0; j < 4; ++j) { \
        if constexpr (XF32) X[r][j] = ((const f32x4*)(xin + ((R0) + r) * 1024))[j * 64 + lane]; \
        else { const u32x2 t_ = *(const u32x2*)(xinb + ((R0) + r) * 1024 + (j * 64 + lane) * 4); X[r][j] = (f32x4){__uint_as_float(t_.x), __uint_as_float(t_.y), 0.f, 0.f}; } } } } while (0)
#define CB_ISSUE(Y, SRC) do { _Pragma("unroll") for (int r = 0; r < 4; ++r) { SRC[r] = -1; \
        if (m[r]) { const int e = __builtin_ctz(m[r]); m[r] &= m[r] - 1; const int sl = __shfl(mysl, 16 * r + e); SRC[r] = 16 * r + e; const size_t rr = ((size_t)b * NE + e) * CAP + sl; \
            _Pragma("unroll") for (int j = 0; j < 4; ++j) Y[r][j] = *(const unsigned*)((const unsigned char*)p.ye + rr * 1024 + (j * 64 + lane) * 4); } \
        else { _Pragma("unroll") for (int j = 0; j < 4; ++j) Y[r][j] = 0u; } } } while (0)
#define CB_ACC(Y, SRC) do { _Pragma("unroll") for (int r = 0; r < 4; ++r) { const float gt = SRC[r] >= 0 ? __shfl(mygt, SRC[r] & 63) * (1.0f / 16.0f) : 0.f; \
        _Pragma("unroll") for (int j = 0; j < 4; ++j) { const auto lo = __builtin_amdgcn_cvt_pk_f32_fp8((int)Y[r][j], false), hi = __builtin_amdgcn_cvt_pk_f32_fp8((int)Y[r][j], true); \
            v[r][j].x += gt * lo[0]; v[r][j].y += gt * lo[1]; v[r][j].z += gt * hi[0]; v[r][j].w += gt * hi[1]; } } } while (0)
template <bool XF32>
DEV void ph_combine_dev4(const P& p, const float* g, const float* xin, const bf16_t* xinb, bf16_t* xoutb) {
    static_assert(FP8_MOE, "expert outputs are e4m3 x 16");
    const int lane = LANE, rsub = lane >> 4, e16 = lane & 15; const size_t ST = (size_t)NWAVES_G * 4;
    size_t row0 = (size_t)GWAVE * 4;
    f32x4 xa[4][4]; int sl_n = -1;
    float4 gv[4];
#pragma unroll
    for (int j = 0; j < 4; ++j) gv[j] = g ? ((const float4*)g)[j * 64 + lane] : float4{0.f, 0.f, 0.f, 0.f};
    if (row0 < (size_t)T) { sl_n = p.slotmap[((size_t)(row0 / SEQ) * NE + e16) * SEQ + (row0 % SEQ) + rsub]; CB_RAW(xa, row0); }
    for (; row0 < (size_t)T; row0 += ST) {
        const int b = (int)(row0 / SEQ);
        const int mysl = sl_n;
        const float mygt = mysl >= 0 ? p.gate[((size_t)b * NE + e16) * CAP + mysl] : 0.f;
        const unsigned long long mall = __ballot(mysl >= 0);
        unsigned m[4];
#pragma unroll
        for (int r = 0; r < 4; ++r) m[r] = (unsigned)((mall >> (16 * r)) & 0xffffull);
        u32x2 da[4][4];
#pragma unroll
        for (int r = 0; r < 4; ++r)
#pragma unroll
            for (int j = 0; j < 4; ++j) da[r][j] = *(const u32x2*)(p.dlt + (row0 + r) * 1024 + (j * 64 + lane) * 4);
        if (row0 + ST < (size_t)T) { const size_t rn = row0 + ST; sl_n = p.slotmap[((size_t)(rn / SEQ) * NE + e16) * SEQ + (rn % SEQ) + rsub]; }
        unsigned y0[4][4], y1[4][4]; int s0_[4], s1_[4];
        CB_ISSUE(y0, s0_); if constexpr (!XF32) CB_ISSUE(y1, s1_);
        float4 v[4][4];
#pragma unroll
        for (int r = 0; r < 4; ++r)
#pragma unroll
            for (int j = 0; j < 4; ++j) { const u32x2 dd = da[r][j];
                if constexpr (XF32) v[r][j] = float4{xa[r][j][0], xa[r][j][1], xa[r][j][2], xa[r][j][3]};
                else { const unsigned x0 = __float_as_uint(xa[r][j][0]), x1 = __float_as_uint(xa[r][j][1]); v[r][j] = float4{__uint_as_float(x0 << 16), __uint_as_float(x0 & 0xffff0000u), __uint_as_float(x1 << 16), __uint_as_float(x1 & 0xffff0000u)}; }
                v[r][j].x += __uint_as_float(dd.x << 16); v[r][j].y += __uint_as_float(dd.x & 0xffff0000u); v[r][j].z += __uint_as_float(dd.y << 16); v[r][j].w += __uint_as_float(dd.y & 0xffff0000u); }
        CB_ACC(y0, s0_); if constexpr (!XF32) CB_ACC(y1, s1_);
        if constexpr (!XF32) { if (row0 + ST < (size_t)T) CB_RAW(xa, row0 + ST); }
        while (m[0] | m[1] | m[2] | m[3]) { CB_ISSUE(y0, s0_); CB_ACC(y0, s0_); }
        if constexpr (XF32) { if (row0 + ST < (size_t)T) CB_RAW(xa, row0 + ST); }
#pragma unroll
        for (int r = 0; r < 4; ++r) { float ss = 0.f;
#pragma unroll
            for (int j = 0; j < 4; ++j) { if (xoutb) *(uint2*)(xoutb + (row0 + r) * 1024 + (j * 64 + lane) * 4) = uint2{pack2(v[r][j].x, v[r][j].y), pack2(v[r][j].z, v[r][j].w)}; else __builtin_nontemporal_store((f32x4){v[r][j].x, v[r][j].y, v[r][j].z, v[r][j].w}, (f32x4*)(p.out + (row0 + r) * 1024) + j * 64 + lane); ss += v[r][j].x * v[r][j].x + v[r][j].y * v[r][j].y + v[r][j].z * v[r][j].z + v[r][j].w * v[r][j].w; }
            if (g) { ss = wave_sum(ss); const float rr = 1.0f / sqrtf(ss * (1.0f / 1024.0f) + 1e-6f);
#pragma unroll
                for (int j = 0; j < 4; ++j) { const int c4 = j * 64 + lane; const float4 gg = gv[j];
                    *(uint2*)(p.hn + (row0 + r) * 1024 + c4 * 4) = uint2{pack2(v[r][j].x * rr * gg.x, v[r][j].y * rr * gg.y), pack2(v[r][j].z * rr * gg.z, v[r][j].w * rr * gg.w)}; } } }
    }
}

namespace pg8 {
constexpr int BM = 256, BK = 64, HALF = 128, HTB = HALF * BK * 2  , STAGE_BYTES = 8 * HTB, NXCD = 8, WGM = 8;
DEV int lds_byte(int r, int c) { const int st = (r >> 4) * 2 + (c >> 5), rr = r & 15, cc = c & 31, ob = rr * 64 + cc * 2; return st * 1024 + (ob ^ (((ob >> 9) & 1) << 5)); }
DEV void stage_rc(int b, int& R, int& C) { const int st = b / 1024, sb = b % 1024, swz = sb ^ (((sb >> 9) & 1) << 5); R = (st >> 1) * 16 + swz / 64; C = (st & 1) * 32 + (swz % 64) / 2; }
DEV int perm32(int rho) { const int n = rho >> 4, i = rho & 15; return 8 * (i >> 2) + 4 * n + (i & 3); }
struct Unit { int row0, col0, brow0; };
struct StaticOrder {
    int nM, nN, nwg, G, c, brows, tpg, rev;
    DEV void init(int M, int N, int G_, int c_, int brows_, int tpg_, int rev_ = 0) { nM = M / BM; nN = N / BM; nwg = nM * nN; G = G_; c = c_; brows = brows_; tpg = tpg_; rev = rev_; }
    DEV bool next(int i, Unit& u) const {
        const int nr = (nwg + G - 1) / G; if (i >= nr) return false;
        const long L = (long)(rev ? nr - 1 - i : i) * G + c; if (L >= nwg) return false;
        int wgid = (int)L; { const int q = nwg / NXCD, r = nwg % NXCD, xcd = wgid % NXCD, off = wgid / NXCD; wgid = (xcd < r ? xcd * (q + 1) : r * (q + 1) + (xcd - r) * q) + off; }
        const int nig = WGM * nN, gid = wgid / nig, fm = gid * WGM, gsz = (nM - fm) < WGM ? (nM - fm) : WGM;
        const int pm = fm + ((wgid % nig) % gsz), pn = (wgid % nig) / gsz;
        u.row0 = pm * BM; u.col0 = pn * BM; u.brow0 = pn * BM + (brows ? ((pm / tpg) % NE) * brows : 0); return true;
    }
};
DEV unsigned cvt_pk_bf16(float lo, float hi) { unsigned r; asm volatile("v_cvt_pk_bf16_f32 %0, %1, %2" : "=v"(r) : "v"(lo), "v"(hi)); return r; }
typedef float f32x2_t __attribute__((ext_vector_type(2)));
typedef __bf16 bf16x2_t __attribute__((ext_vector_type(2)));
DEV unsigned cvt_pk_safe(float lo, float hi) { const f32x2_t v = {lo, hi}; return __builtin_bit_cast(unsigned, __builtin_convertvector(v, bf16x2_t)); }

typedef int i32x8 __attribute__((ext_vector_type(8)));
typedef int i32x4 __attribute__((ext_vector_type(4)));
template <bool F8> DEV void pg8_mma(f32x4 (&acc)[4][2], const i32x8 (&At)[4], const i32x8 (&Bq)[2]) {
    __builtin_amdgcn_s_setprio(1);
    if constexpr (F8) {
        const int one = 127;
#pragma unroll
        for (int m = 0; m < 4; ++m)
#pragma unroll
            for (int n = 0; n < 2; ++n) asm volatile("v_mfma_scale_f32_16x16x128_f8f6f4 %0, %1, %2, %0, %3, %3 op_sel_hi:[0,0,0]" : "+v"(acc[m][n]) : "v"(Bq[n]), "v"(At[m]), "v"(one));
    } else {
#pragma unroll
        for (int m = 0; m < 4; ++m)
#pragma unroll
            for (int n = 0; n < 2; ++n)
                acc[m][n] = __builtin_amdgcn_mfma_f32_16x16x32_bf16(__builtin_bit_cast(bf16x8, __builtin_shufflevector(Bq[n], Bq[n], 0, 1, 2, 3)), __builtin_bit_cast(bf16x8, __builtin_shufflevector(At[m], At[m], 0, 1, 2, 3)), acc[m][n], 0, 0, 0);
#pragma unroll
        for (int m = 0; m < 4; ++m)
#pragma unroll
            for (int n = 0; n < 2; ++n)
                acc[m][n] = __builtin_amdgcn_mfma_f32_16x16x32_bf16(__builtin_bit_cast(bf16x8, __builtin_shufflevector(Bq[n], Bq[n], 4, 5, 6, 7)), __builtin_bit_cast(bf16x8, __builtin_shufflevector(At[m], At[m], 4, 5, 6, 7)), acc[m][n], 0, 0, 0);
    }
    __builtin_amdgcn_s_setprio(0);
}
template <class Epi, class Sched, bool F8 = false>
DEV void gemm_phase(LAS unsigned char* lds, const bf16_t* A, const bf16_t* Bt, const int K, const Sched& S, const Epi& E) {
    const int tid = threadIdx.x, wid = __builtin_amdgcn_readfirstlane(tid >> 6), lane = tid & 63, wr = wid >> 2, wc = wid & 3, fr = lane & 15, fq = lane >> 4;
    const int nt = K / BK;
    unsigned voffA[2], voffB[2];
#pragma unroll
    for (int i = 0; i < 2; ++i) { int R, C; stage_rc(tid * 16 + i * 8192, R, C); const int Rb = Epi::PERM ? ((R & ~31) + perm32(R & 31)) : R;
        voffA[i] = (unsigned)(R * K + C) * 2u; voffB[i] = (unsigned)(Rb * K + C) * 2u; }
    const size_t kstep = (size_t)(BK * 2);
    const size_t hstep = (size_t)HALF * K * 2;
    const size_t rstep = (size_t)K * 2;
    const unsigned ldsw = (unsigned)wid * 1024u;
    const int aoff = lds_byte(wr * 64 + fr, fq * 8), boff = lds_byte(wc * 32 + fr, fq * 8);
#define PG8_SA(b, h) (((b) * 2 + (h)) * HTB)
#define PG8_SB(b, h) ((4 + (b) * 2 + (h)) * HTB)
#define PG8_STAGE(bufoff, gbase, voff) do { _Pragma("unroll") for (int _i = 0; _i < 2; ++_i) \
        __builtin_amdgcn_global_load_lds((const unsigned*)((const char*)(gbase) + (voff)[_i]), (LAS unsigned*)(lds + (bufoff) + ldsw + _i * 8192), 16, 0, 0); } while (0)
#define PG8_LDA(dst, b, h) do { _Pragma("unroll") for (int m = 0; m < 4; ++m) dst[m] = __builtin_shufflevector(*(const LAS i32x4*)(lds + PG8_SA(b, h) + aoff + m * 2048), *(const LAS i32x4*)(lds + PG8_SA(b, h) + aoff + m * 2048 + 1024), 0, 1, 2, 3, 4, 5, 6, 7); } while (0)
#define PG8_LDB(dst, b, h) do { _Pragma("unroll") for (int n = 0; n < 2; ++n) dst[n] = __builtin_shufflevector(*(const LAS i32x4*)(lds + PG8_SB(b, h) + boff + n * 2048), *(const LAS i32x4*)(lds + PG8_SB(b, h) + boff + n * 2048 + 1024), 0, 1, 2, 3, 4, 5, 6, 7); } while (0)
#define PG8_MMA(ai, bj, At, Bt_) pg8_mma<F8>(acc[ai][bj], At, Bt_)
#define PG8_WAIT_V(n) asm volatile("s_waitcnt vmcnt(" #n ")" ::: "memory")
#define PG8_WAIT_L(n) asm volatile("s_waitcnt lgkmcnt(" #n ")" ::: "memory")
#define PG8_BAR __builtin_amdgcn_s_barrier()
#define PG8_SCHED __builtin_amdgcn_sched_barrier(0)
    Unit cur, nxt; int ui = 0;
    if (!S.next(0, cur)) return;
    f32x4 acc[2][2][4][2];
#pragma unroll
    for (int a = 0; a < 2; ++a)
#pragma unroll
        for (int b = 0; b < 2; ++b)
#pragma unroll
            for (int m = 0; m < 4; ++m)
#pragma unroll
                for (int n = 0; n < 2; ++n) acc[a][b][m][n] = (f32x4){0.f, 0.f, 0.f, 0.f};
    i32x8 At[4], B0[2], B1[2];
    const char* cA = (const char*)A + (size_t)cur.row0 * rstep; const char* cB = (const char*)Bt + (size_t)cur.brow0 * rstep;
    PG8_STAGE(PG8_SB(0, 0), cB, voffB); PG8_STAGE(PG8_SA(0, 0), cA, voffA); PG8_STAGE(PG8_SB(0, 1), cB + hstep, voffB); PG8_STAGE(PG8_SA(0, 1), cA + hstep, voffA);
    if (wr == 1) PG8_BAR;
    PG8_WAIT_V(4); PG8_BAR;
    PG8_STAGE(PG8_SB(1, 0), cB + kstep, voffB); PG8_STAGE(PG8_SA(1, 0), cA + kstep, voffA); PG8_STAGE(PG8_SB(1, 1), cB + hstep + kstep, voffB);
    PG8_WAIT_V(6); PG8_BAR;
    for (;;) {
        const bool has_next = S.next(ui + 1, nxt);
        const char* nA = has_next ? (const char*)A + (size_t)nxt.row0 * rstep : cA; const char* nB = has_next ? (const char*)Bt + (size_t)nxt.brow0 * rstep : cB;
        for (int t = 0; t < nt; t += 2) {
            const bool last = (t == nt - 2);
            const char* a1 = cA + (size_t)(t + 1) * kstep;
            const char* a2 = last ? nA : cA + (size_t)(t + 2) * kstep; const char* b2 = last ? nB : cB + (size_t)(t + 2) * kstep;
            const char* a3 = a2 + kstep; const char* b3 = b2 + kstep;
            PG8_LDB(B0, 0, 0); PG8_SCHED; PG8_LDA(At, 0, 0); PG8_STAGE(PG8_SA(1, 1), a1 + hstep, voffA);
            PG8_WAIT_L(8); PG8_BAR; PG8_WAIT_L(0); PG8_MMA(0, 0, At, B0); PG8_BAR; PG8_SCHED;
            PG8_LDB(B1, 0, 1); PG8_STAGE(PG8_SB(0, 0), b2, voffB);
            PG8_BAR; PG8_WAIT_L(0); PG8_MMA(0, 1, At, B1); PG8_BAR;
            PG8_LDA(At, 0, 1); PG8_STAGE(PG8_SA(0, 0), a2, voffA);
            PG8_BAR; PG8_WAIT_L(0); PG8_MMA(1, 0, At, B0); PG8_BAR; PG8_SCHED;
            PG8_STAGE(PG8_SB(0, 1), b2 + hstep, voffB);
            PG8_WAIT_V(6); PG8_BAR; PG8_MMA(1, 1, At, B1); PG8_BAR;
            PG8_LDB(B0, 1, 0); PG8_SCHED; PG8_LDA(At, 1, 0); PG8_STAGE(PG8_SA(0, 1), a2 + hstep, voffA);
            PG8_WAIT_L(8); PG8_BAR; PG8_WAIT_L(0); PG8_MMA(0, 0, At, B0); PG8_BAR; PG8_SCHED;
            PG8_LDB(B1, 1, 1); PG8_STAGE(PG8_SB(1, 0), b3, voffB);
            PG8_BAR; PG8_WAIT_L(0); PG8_MMA(0, 1, At, B1); PG8_BAR;
            PG8_LDA(At, 1, 1); PG8_STAGE(PG8_SA(1, 0), a3, voffA);
            PG8_BAR; PG8_WAIT_L(0); PG8_MMA(1, 0, At, B0); PG8_BAR; PG8_SCHED;
            PG8_STAGE(PG8_SB(1, 1), b3 + hstep, voffB);
            PG8_WAIT_V(6); PG8_BAR; PG8_MMA(1, 1, At, B1); PG8_BAR;
        }
        if constexpr (F8) asm volatile("s_nop 15\n\ts_nop 15" ::: "memory");
        E(acc, cur, wr, wc, fr, fq);
        if (!has_next) break;
#pragma unroll
        for (int a = 0; a < 2; ++a)
#pragma unroll
            for (int b = 0; b < 2; ++b)
#pragma unroll
                for (int m = 0; m < 4; ++m)
#pragma unroll
                    for (int n = 0; n < 2; ++n) acc[a][b][m][n] = (f32x4){0.f, 0.f, 0.f, 0.f};
        cur = nxt; cA = nA; cB = nB; ++ui;
    }
    PG8_WAIT_V(0);
    if (wr == 0) PG8_BAR;
    PG8_BAR;
#undef PG8_SA
#undef PG8_SB
#undef PG8_STAGE
#undef PG8_LDA
#undef PG8_LDB
#undef PG8_MMA
#undef PG8_WAIT_V
#undef PG8_WAIT_L
#undef PG8_BAR
#undef PG8_SCHED
}
template <class Epi, class Sched, bool F8 = false>
DEV void gemm_phase_gather(LAS unsigned char* lds, const bf16_t* A, const bf16_t* Bt, const int K, const Sched& S, const Epi& E, const int* idx, const int grp_rows, const int seq, const float* rowf) {
    const int tid = threadIdx.x, wid = __builtin_amdgcn_readfirstlane(tid >> 6), lane = tid & 63, wr = wid >> 2, wc = wid & 3, fr = lane & 15, fq = lane >> 4;
    const int nt = K / BK;
    unsigned voffB[2]; int Ra[2]; unsigned Ca2[2];
#pragma unroll
    for (int i = 0; i < 2; ++i) { int R, C; stage_rc(tid * 16 + i * 8192, R, C); const int Rb = Epi::PERM ? ((R & ~31) + perm32(R & 31)) : R;
        Ra[i] = R; Ca2[i] = (unsigned)C * 2u; voffB[i] = (unsigned)(Rb * K + C) * 2u; }
    unsigned vAc[2][2], vAn[2][2];
#define PG8_IDXT(u) (STAGE_BYTES + 1024 * ((u) & 1))
#define PG8_RFT(u) (STAGE_BYTES + 2048 + 1024 * ((u) % 3))
#define PG8_SETVA(V, U, ui_) do { const LAS int* tab_ = (const LAS int*)(lds + PG8_IDXT(ui_)); const unsigned bo_ = (unsigned)((U).row0 / grp_rows) * (unsigned)seq; \
        _Pragma("unroll") for (int h_ = 0; h_ < 2; ++h_) _Pragma("unroll") for (int i_ = 0; i_ < 2; ++i_) V[h_][i_] = (bo_ + (unsigned)tab_[Ra[i_] + 128 * h_]) * (unsigned)(K * 2) + Ca2[i_]; } while (0)
    const size_t kstep = (size_t)(BK * 2);
    const size_t hstep = (size_t)HALF * K * 2;
    const size_t rstep = (size_t)K * 2;
    const unsigned ldsw = (unsigned)wid * 1024u;
    const int aoff = lds_byte(wr * 64 + fr, fq * 8), boff = lds_byte(wc * 32 + fr, fq * 8);
#define PG8_SA(b, h) (((b) * 2 + (h)) * HTB)
#define PG8_SB(b, h) ((4 + (b) * 2 + (h)) * HTB)
#define PG8_STAGE(bufoff, gbase, voff) do { _Pragma("unroll") for (int _i = 0; _i < 2; ++_i) \
        __builtin_amdgcn_global_load_lds((const unsigned*)((const char*)(gbase) + (voff)[_i]), (LAS unsigned*)(lds + (bufoff) + ldsw + _i * 8192), 16, 0, 0); } while (0)
#define PG8_LDA(dst, b, h) do { _Pragma("unroll") for (int m = 0; m < 4; ++m) dst[m] = __builtin_shufflevector(*(const LAS i32x4*)(lds + PG8_SA(b, h) + aoff + m * 2048), *(const LAS i32x4*)(lds + PG8_SA(b, h) + aoff + m * 2048 + 1024), 0, 1, 2, 3, 4, 5, 6, 7); } while (0)
#define PG8_LDB(dst, b, h) do { _Pragma("unroll") for (int n = 0; n < 2; ++n) dst[n] = __builtin_shufflevector(*(const LAS i32x4*)(lds + PG8_SB(b, h) + boff + n * 2048), *(const LAS i32x4*)(lds + PG8_SB(b, h) + boff + n * 2048 + 1024), 0, 1, 2, 3, 4, 5, 6, 7); } while (0)
#define PG8_MMA(ai, bj, At, Bt_) pg8_mma<F8>(acc[ai][bj], At, Bt_)
#define PG8_WAIT_V(n) asm volatile("s_waitcnt vmcnt(" #n ")" ::: "memory")
#define PG8_WAIT_L(n) asm volatile("s_waitcnt lgkmcnt(" #n ")" ::: "memory")
#define PG8_BAR __builtin_amdgcn_s_barrier()
#define PG8_SCHED __builtin_amdgcn_sched_barrier(0)
    Unit cur, nxt; int ui = 0;
    if (!S.next(0, cur)) return;
    f32x4 acc[2][2][4][2];
#pragma unroll
    for (int a = 0; a < 2; ++a)
#pragma unroll
        for (int b = 0; b < 2; ++b)
#pragma unroll
            for (int m = 0; m < 4; ++m)
#pragma unroll
                for (int n = 0; n < 2; ++n) acc[a][b][m][n] = (f32x4){0.f, 0.f, 0.f, 0.f};
    i32x8 At[4], B0[2], B1[2];
    const char* cA = (const char*)A; const char* cB = (const char*)Bt + (size_t)cur.brow0 * rstep;
    if (wid == 0) { __builtin_amdgcn_global_load_lds((const unsigned*)(idx + cur.row0 + lane * 4), (LAS unsigned*)(lds + PG8_IDXT(0)), 16, 0, 0);
        __builtin_amdgcn_global_load_lds((const unsigned*)(rowf + cur.row0 + lane * 4), (LAS unsigned*)(lds + PG8_RFT(0)), 16, 0, 0); }
    asm volatile("s_waitcnt vmcnt(0)" ::: "memory"); __syncthreads();
    PG8_SETVA(vAc, cur, 0);
    PG8_STAGE(PG8_SB(0, 0), cB, voffB); PG8_STAGE(PG8_SA(0, 0), cA, vAc[0]); PG8_STAGE(PG8_SB(0, 1), cB + hstep, voffB); PG8_STAGE(PG8_SA(0, 1), cA, vAc[1]);
    if (wr == 1) PG8_BAR;
    PG8_WAIT_V(4); PG8_BAR;
    PG8_STAGE(PG8_SB(1, 0), cB + kstep, voffB); PG8_STAGE(PG8_SA(1, 0), cA + kstep, vAc[0]); PG8_STAGE(PG8_SB(1, 1), cB + hstep + kstep, voffB);
    PG8_WAIT_V(6); PG8_BAR;
    for (;;) {
        const bool has_next = S.next(ui + 1, nxt);
        const char* nB = has_next ? (const char*)Bt + (size_t)nxt.brow0 * rstep : cB;
        if (has_next && wid == 0) { __builtin_amdgcn_global_load_lds((const unsigned*)(idx + nxt.row0 + lane * 4), (LAS unsigned*)(lds + PG8_IDXT(ui + 1)), 16, 0, 0);
            __builtin_amdgcn_global_load_lds((const unsigned*)(rowf + nxt.row0 + lane * 4), (LAS unsigned*)(lds + PG8_RFT(ui + 1)), 16, 0, 0); }
        for (int t = 0; t < nt; t += 2) {
            const bool last = (t == nt - 2);
            const char* a1 = cA + (size_t)(t + 1) * kstep;
            const char* a2 = last ? cA : cA + (size_t)(t + 2) * kstep; const char* b2 = last ? nB : cB + (size_t)(t + 2) * kstep;
            if (last) { if (has_next) PG8_SETVA(vAn, nxt, ui + 1); else { vAn[0][0] = vAc[0][0]; vAn[0][1] = vAc[0][1]; vAn[1][0] = vAc[1][0]; vAn[1][1] = vAc[1][1]; } }
            unsigned v2[2][2];
#pragma unroll
            for (int h_ = 0; h_ < 2; ++h_)
#pragma unroll
                for (int i_ = 0; i_ < 2; ++i_) v2[h_][i_] = last ? vAn[h_][i_] : vAc[h_][i_];
            const char* a3 = a2 + kstep; const char* b3 = b2 + kstep;
            PG8_LDB(B0, 0, 0); PG8_SCHED; PG8_LDA(At, 0, 0); PG8_STAGE(PG8_SA(1, 1), a1, vAc[1]);
            PG8_WAIT_L(8); PG8_BAR; PG8_WAIT_L(0); PG8_MMA(0, 0, At, B0); PG8_BAR; PG8_SCHED;
            PG8_LDB(B1, 0, 1); PG8_STAGE(PG8_SB(0, 0), b2, voffB);
            PG8_BAR; PG8_WAIT_L(0); PG8_MMA(0, 1, At, B1); PG8_BAR;
            PG8_LDA(At, 0, 1); PG8_STAGE(PG8_SA(0, 0), a2, v2[0]);
            PG8_BAR; PG8_WAIT_L(0); PG8_MMA(1, 0, At, B0); PG8_BAR; PG8_SCHED;
            PG8_STAGE(PG8_SB(0, 1), b2 + hstep, voffB);
            PG8_WAIT_V(6); PG8_BAR; PG8_MMA(1, 1, At, B1); PG8_BAR;
            PG8_LDB(B0, 1, 0); PG8_SCHED; PG8_LDA(At, 1, 0); PG8_STAGE(PG8_SA(0, 1), a2, v2[1]);
            PG8_WAIT_L(8); PG8_BAR; PG8_WAIT_L(0); PG8_MMA(0, 0, At, B0); PG8_BAR; PG8_SCHED;
            PG8_LDB(B1, 1, 1); PG8_STAGE(PG8_SB(1, 0), b3, voffB);
            PG8_BAR; PG8_WAIT_L(0); PG8_MMA(0, 1, At, B1); PG8_BAR;
            PG8_LDA(At, 1, 1); PG8_STAGE(PG8_SA(1, 0), a3, v2[0]);
            PG8_BAR; PG8_WAIT_L(0); PG8_MMA(1, 0, At, B0); PG8_BAR; PG8_SCHED;
            PG8_STAGE(PG8_SB(1, 1), b3 + hstep, voffB);
            PG8_WAIT_V(6); PG8_BAR; PG8_MMA(1, 1, At, B1); PG8_BAR;
        }
        if constexpr (F8) asm volatile("s_nop 15\n\ts_nop 15" ::: "memory");
        E(acc, cur, wr, wc, fr, fq, (const LAS float*)(lds + PG8_RFT(ui)));
        if (!has_next) break;
#pragma unroll
        for (int a = 0; a < 2; ++a)
#pragma unroll
            for (int b = 0; b < 2; ++b)
#pragma unroll
                for (int m = 0; m < 4; ++m)
#pragma unroll
                    for (int n = 0; n < 2; ++n) acc[a][b][m][n] = (f32x4){0.f, 0.f, 0.f, 0.f};
        cur = nxt; cB = nB; ++ui; vAc[0][0] = vAn[0][0]; vAc[0][1] = vAn[0][1]; vAc[1][0] = vAn[1][0]; vAc[1][1] = vAn[1][1];
    }
    PG8_WAIT_V(0);
    if (wr == 0) PG8_BAR;
    PG8_BAR;
#undef PG8_IDXT
#undef PG8_RFT
#undef PG8_SETVA
#undef PG8_SA
#undef PG8_SB
#undef PG8_STAGE
#undef PG8_LDA
#undef PG8_LDB
#undef PG8_MMA
#undef PG8_WAIT_V
#undef PG8_WAIT_L
#undef PG8_BAR
#undef PG8_SCHED
}
typedef const f32x4 (&AccRef)[2][2][4][2];
DEV u32x4 pk8(const f32x4 a, const f32x4 b) { u32x4 w; w.x = cvt_pk_bf16(a[0], a[1]); w.y = cvt_pk_bf16(a[2], a[3]); w.z = cvt_pk_bf16(b[0], b[1]); w.w = cvt_pk_bf16(b[2], b[3]); return w; }
DEV f32x4 silu4(const f32x4 v) { f32x4 r;
#pragma unroll
    for (int i = 0; i < 4; ++i) r[i] = v[i] * __builtin_amdgcn_rcpf(1.0f + __expf(-v[i]));
    return r; }
struct EpiG1 { static constexpr bool PERM = true; bf16_t *qkv, *z, *xbcraw; float* dtraw;
    DEV void operator()(AccRef acc, const Unit& u, int wr, int wc, int fr, int fq) const {
        const int ct = u.col0, rbase = u.row0 + wr * 64 + fr;
        if (ct < 5632) {
            bf16_t* base; int ld, cc;
            if (ct < 3072) {
                const int which = ct >> 10, b = u.row0 / SEQ, s0 = u.row0 - b * SEQ + wr * 64 + fr;
#pragma unroll
                for (int bj = 0; bj < 2; ++bj) { const int cw = (ct & 1023) + bj * HALF + wc * 32 + 8 * fq, hd = cw >> 6, dd = cw & 63;
                    bf16_t* hb = qkv + ((size_t)which * BATCH * 16 + (size_t)b * 16 + hd) * SEQ * 64 + dd;
#pragma unroll
                    for (int ai = 0; ai < 2; ++ai)
#pragma unroll
                        for (int m = 0; m < 4; ++m) *(u32x4*)(hb + (size_t)(s0 + ai * HALF + m * 16) * 64) = pk8(acc[ai][bj][m][0], acc[ai][bj][m][1]); }
                return; }
            if (ct < 4096) { base = z; ld = 1024; cc = ct - 3072; } else { base = xbcraw; ld = 1536; cc = ct - 4096; }
            const int col = cc + wc * 32 + 8 * fq;
#pragma unroll
            for (int ai = 0; ai < 2; ++ai)
#pragma unroll
                for (int m = 0; m < 4; ++m) { bf16_t* rowp = base + (size_t)(rbase + ai * HALF + m * 16) * ld + col;
#pragma unroll
                    for (int bj = 0; bj < 2; ++bj) *(u32x4*)(rowp + bj * HALF) = pk8(acc[ai][bj][m][0], acc[ai][bj][m][1]); }
        } else if (wc == 0) {
#pragma unroll
            for (int ai = 0; ai < 2; ++ai)
#pragma unroll
                for (int m = 0; m < 4; ++m) { float* rowp = dtraw + (size_t)(rbase + ai * HALF + m * 16) * 32 + 8 * fq; *(f32x4*)rowp = acc[ai][0][m][0]; *(f32x4*)(rowp + 4) = acc[ai][0][m][1]; }
        }
    } };
struct EpiResF32 { static constexpr bool PERM = false; float* out; const float* resid;
    DEV void operator()(AccRef acc, const Unit& u, int wr, int wc, int fr, int fq) const {
        const int rbase = u.row0 + wr * 64 + fr, col = u.col0 + wc * 32 + 4 * fq;
#pragma unroll
        for (int ai = 0; ai < 2; ++ai)
#pragma unroll
            for (int m = 0; m < 4; ++m) { const size_t ro = (size_t)(rbase + ai * HALF + m * 16) * 1024 + col;
#pragma unroll
                for (int bj = 0; bj < 2; ++bj)
#pragma unroll
                    for (int n = 0; n < 2; ++n) *(f32x4*)(out + ro + bj * HALF + n * 16) = *(const f32x4*)(resid + ro + bj * HALF + n * 16) + acc[ai][bj][m][n]; }
    } };
struct EpiSwiglu { static constexpr bool PERM = true; bf16_t* hid;
    DEV void operator()(AccRef acc, const Unit& u, int wr, int wc, int fr, int fq) const {
        const int rbase = u.row0 + wr * 64 + fr, col = (u.col0 >> 1) + wc * 32 + 8 * fq;
#pragma unroll
        for (int ai = 0; ai < 2; ++ai)
#pragma unroll
            for (int m = 0; m < 4; ++m) *(u32x4*)(hid + (size_t)(rbase + ai * HALF + m * 16) * 2048 + col) = pk8(silu4(acc[ai][0][m][0]) * acc[ai][1][m][0], silu4(acc[ai][0][m][1]) * acc[ai][1][m][1]);
    } };
struct EpiBf16Plain { static constexpr bool PERM = true; bf16_t* O; int ld;
    DEV void operator()(AccRef acc, const Unit& u, int wr, int wc, int fr, int fq) const {
        const int rbase = u.row0 + wr * 64 + fr, col = u.col0 + wc * 32 + 8 * fq;
#pragma unroll
        for (int ai = 0; ai < 2; ++ai)
#pragma unroll
            for (int m = 0; m < 4; ++m) { bf16_t* rowp = O + (size_t)(rbase + ai * HALF + m * 16) * ld + col;
#pragma unroll
                for (int bj = 0; bj < 2; ++bj) *(u32x4*)(rowp + bj * HALF) = pk8(acc[ai][bj][m][0], acc[ai][bj][m][1]); }
    } };
struct EpiG3 { static constexpr bool PERM = true; bf16_t *pbuf, *gb;
    DEV void operator()(AccRef acc, const Unit& u, int wr, int wc, int fr, int fq) const {
        const int rbase = u.row0 + wr * 64 + fr;
        if (u.col0 < 2048) { const int col = (u.col0 >> 1) + wc * 32 + 8 * fq;
#pragma unroll
            for (int ai = 0; ai < 2; ++ai)
#pragma unroll
                for (int m = 0; m < 4; ++m) *(u32x4*)(pbuf + (size_t)(rbase + ai * HALF + m * 16) * 1024 + col) = pk8(acc[ai][0][m][0] * acc[ai][1][m][0], acc[ai][0][m][1] * acc[ai][1][m][1]);
        } else { const int col = u.col0 - 2048 + wc * 32 + 8 * fq;
#pragma unroll
            for (int ai = 0; ai < 2; ++ai)
#pragma unroll
                for (int m = 0; m < 4; ++m) { bf16_t* rowp = gb + (size_t)(rbase + ai * HALF + m * 16) * 1024 + col;
#pragma unroll
                    for (int bj = 0; bj < 2; ++bj) *(u32x4*)(rowp + bj * HALF) = pk8(acc[ai][bj][m][0], acc[ai][bj][m][1]); }
        }
    } };
typedef unsigned u32x2 __attribute__((ext_vector_type(2)));
DEV unsigned pk4_fp8(float a, float b, float c, float d) { int w = 0; w = __builtin_amdgcn_cvt_pk_fp8_f32(a, b, w, false); w = __builtin_amdgcn_cvt_pk_fp8_f32(c, d, w, true); return (unsigned)w; }
constexpr float F8_SA = 8.0f, F8_SW = 256.0f, F8_INV = 1.0f / (F8_SA * F8_SW);
DEV float f8clamp(float v) { return __builtin_amdgcn_fmed3f(v, -448.0f, 448.0f); }
DEV f32x4 swiglu8(const f32x4 a0, const f32x4 a1, const float rs) {
    const f32x4 t = a0 * (rs * (-F8_INV * 1.44269504089f)); f32x4 e;
#pragma unroll
    for (int i = 0; i < 4; ++i) e[i] = __builtin_amdgcn_exp2f(t[i]);
    const f32x4 d = e + 1.0f; f32x4 r;
#pragma unroll
    for (int i = 0; i < 4; ++i) r[i] = __builtin_amdgcn_rcpf(d[i]);
    return (a0 * (rs * rs * (F8_INV * F8_INV * F8_SA))) * a1 * r;
}
struct EpiSwiglu8 { static constexpr bool PERM = true; unsigned char* hid8;
    DEV void operator()(AccRef acc, const Unit& u, int wr, int wc, int fr, int fq, const LAS float* rtab) const {
        const int rbase = u.row0 + wr * 64 + fr, col = (u.col0 >> 1) + wc * 32 + 8 * fq;
#pragma unroll
        for (int ai = 0; ai < 2; ++ai)
#pragma unroll
            for (int m = 0; m < 4; ++m) { const float rs = rtab[wr * 64 + fr + ai * HALF + m * 16];
                const f32x4 h0 = swiglu8(acc[ai][0][m][0], acc[ai][1][m][0], rs), h1 = swiglu8(acc[ai][0][m][1], acc[ai][1][m][1], rs);
                u32x2 w; w.x = pk4_fp8(f8clamp(h0[0]), f8clamp(h0[1]), f8clamp(h0[2]), f8clamp(h0[3])); w.y = pk4_fp8(f8clamp(h1[0]), f8clamp(h1[1]), f8clamp(h1[2]), f8clamp(h1[3]));
                *(u32x2*)(hid8 + (size_t)(rbase + ai * HALF + m * 16) * 2048 + col) = w; }
    } };
struct EpiFp8Scaled { static constexpr bool PERM = true; unsigned char* O; int ld; float sc;
    DEV void operator()(AccRef acc, const Unit& u, int wr, int wc, int fr, int fq) const {
        const int rbase = u.row0 + wr * 64 + fr, col = u.col0 + wc * 32 + 8 * fq;
#pragma unroll
        for (int ai = 0; ai < 2; ++ai)
#pragma unroll
            for (int m = 0; m < 4; ++m) { unsigned char* rowp = O + (size_t)(rbase + ai * HALF + m * 16) * ld + col;
#pragma unroll
                for (int bj = 0; bj < 2; ++bj) { const f32x4 a = acc[ai][bj][m][0] * sc, b = acc[ai][bj][m][1] * sc; u32x2 w;
                    w.x = pk4_fp8(f8clamp(a[0]), f8clamp(a[1]), f8clamp(a[2]), f8clamp(a[3])); w.y = pk4_fp8(f8clamp(b[0]), f8clamp(b[1]), f8clamp(b[2]), f8clamp(b[3]));
                    *(u32x2*)(rowp + bj * HALF) = w; } }
    } };
constexpr float F8_SY = 16.0f;
struct EpiBf16Scaled { static constexpr bool PERM = true; bf16_t* O; int ld; float sc;
    DEV void operator()(AccRef acc, const Unit& u, int wr, int wc, int fr, int fq) const {
        const int rbase = u.row0 + wr * 64 + fr, col = u.col0 + wc * 32 + 8 * fq;
#pragma unroll
        for (int ai = 0; ai < 2; ++ai)
#pragma unroll
            for (int m = 0; m < 4; ++m) { bf16_t* rowp = O + (size_t)(rbase + ai * HALF + m * 16) * ld + col;
#pragma unroll
                for (int bj = 0; bj < 2; ++bj) *(u32x4*)(rowp + bj * HALF) = pk8(acc[ai][bj][m][0] * sc, acc[ai][bj][m][1] * sc); }
    } };
}
DEV void ph_g1(const P& p, LAS unsigned char* lds) { pg8::StaticOrder S; S.init(T, NIN_PAD, (int)gridDim.x, (int)blockIdx.x, 0, 1); pg8::EpiG1 E{p.qkv, p.z, p.xbcraw, p.dtraw}; pg8::gemm_phase(lds, p.hn, p.WinT, 1024, S, E); }
DEV void ph_g2(const P& p, LAS unsigned char* lds) { pg8::StaticOrder S; S.init(T, 1024, (int)gridDim.x, (int)blockIdx.x, 0, 1); pg8::EpiBf16Plain E{p.dlt, 1024}; pg8::gemm_phase(lds, p.mix, p.WoutT, 2048, S, E); }
DEV void ph_up(const P& p, LAS unsigned char* lds) { pg8::StaticOrder S; S.init(NSLOT, 4096, (int)gridDim.x, (int)blockIdx.x, 4096, CAP / 256);
#if FP8_MOE
    pg8::EpiSwiglu8 E{(unsigned char*)p.hid}; pg8::gemm_phase_gather<pg8::EpiSwiglu8, pg8::StaticOrder, true>(lds, p.hn, p.WguT, 512, S, E, p.idx, NE * CAP, SEQ, p.rinvs); }
#else
    pg8::EpiSwiglu E{p.hid}; pg8::gemm_phase_gather(lds, p.hn, p.WguT, 1024, S, E, p.idx, NE * CAP, SEQ); }
#endif

DEV void ph_down(const P& p, LAS unsigned char* lds) { pg8::StaticOrder S; S.init(NSLOT, 1024, (int)gridDim.x, (int)blockIdx.x, 1024, CAP / 256, (NSLOT / 256 * 4) % (int)gridDim.x == 0);
#if FP8_MOE
    pg8::EpiFp8Scaled E{(unsigned char*)p.ye, 1024, pg8::F8_INV * pg8::F8_SY}; pg8::gemm_phase<pg8::EpiFp8Scaled, pg8::StaticOrder, true>(lds, p.hid, p.WdT, 1024, S, E); }
#else
    pg8::EpiBf16Plain E{p.ye, 1024}; pg8::gemm_phase(lds, p.hid, p.WdT, 2048, S, E); }
#endif
DEV void ph_g3(const P& p, LAS unsigned char* lds) { pg8::StaticOrder S; S.init(T, 3072, (int)gridDim.x, (int)blockIdx.x, 0, 1); pg8::EpiG3 E{p.pbuf, p.gb}; pg8::gemm_phase(lds, p.hn, p.WciT, 1024, S, E); }
DEV void ph_g4(const P& p, LAS unsigned char* lds) { pg8::StaticOrder S; S.init(T, 1024, (int)gridDim.x, (int)blockIdx.x, 0, 1); pg8::EpiBf16Plain E{p.dlt, 1024}; pg8::gemm_phase(lds, p.abuf, p.WcoT, 1024, S, E); }

DEV bf16x8 ldg8(const bf16_t* p) { return *(const bf16x8*)p; }
DEV f32x4 mfma16(bf16x8 a, bf16x8 b, f32x4 c) { return __builtin_amdgcn_mfma_f32_16x16x32_bf16(a, b, c, 0, 0, 0); }
DEV bf16x8 pack8(const float (&m)[8]) { u32x4 r; r.x = pg8::cvt_pk_safe(m[0], m[1]); r.y = pg8::cvt_pk_safe(m[2], m[3]); r.z = pg8::cvt_pk_safe(m[4], m[5]); r.w = pg8::cvt_pk_safe(m[6], m[7]); return __builtin_bit_cast(bf16x8, r); }
DEV void unpack8(bf16x8 v, float (&f)[8]) { const u32x4 u = __builtin_bit_cast(u32x4, v);
#pragma unroll
    for (int q = 0; q < 4; ++q) { f[2 * q] = __uint_as_float(u[q] << 16); f[2 * q + 1] = __uint_as_float(u[q] & 0xffff0000u); } }
typedef unsigned u32x2 __attribute__((ext_vector_type(2)));
DEV u32x2 pk4(const f32x4 a) { u32x2 r; r.x = pg8::cvt_pk_safe(a[0], a[1]); r.y = pg8::cvt_pk_safe(a[2], a[3]); return r; }
DEV void ph_ssd_states(const P& p, LAS unsigned char* lds) {
    const int tid = threadIdx.x, wid = __builtin_amdgcn_readfirstlane(tid >> 6), lane = tid & 63, fr = lane & 15, fq = lane >> 4;
    const int hh = wid >> 2, dir = (wid >> 1) & 1, nh = wid & 1;
    constexpr int NSTEP = BATCH * NCHUNK * 8; const int G = (int)gridDim.x;
#define SAL_DMA(STP, BUF) do { const int hp_ = (STP) & 7, c_ = ((STP) >> 3) % NCHUNK, b_ = ((STP) >> 3) / NCHUNK; \
        const bf16_t* bsrc_ = p.bmT + BMT_OFF(b_, (hp_ >> 2) * 128, c_ * 128); const bf16_t* xsrc_ = p.xsT + XST_OFF(b_, hp_ * 128, c_ * 128); \
        _Pragma("unroll") for (int n_ = 0; n_ < 8; ++n_) { const int r_ = (tid >> 4) + 32 * n_, sl_ = tid & 15; \
            const bf16_t* src_ = (n_ < 4 ? bsrc_ + r_ * 128 : xsrc_ + (r_ - 128) * 128) + ((sl_ ^ (r_ & 15)) * 8); \
            __builtin_amdgcn_global_load_lds((const unsigned*)src_, (LAS unsigned*)(lds + (BUF) * 65536 + n_ * 8192 + wid * 1024), 16, 0, 0); } } while (0)
    int stp = blockIdx.x, k = 0;
    __syncthreads();
    if (stp < NSTEP) SAL_DMA(stp, 0);
    for (; stp < NSTEP; stp += G, k ^= 1) {
        const int hp = stp & 7, c = (stp >> 3) % NCHUNK, b = (stp >> 3) / NCHUNK, h = 2 * hp + hh, j = dir * 16 + h;
        const float* w = p.wdT + ((size_t)b * 32 + j) * SEQ + c * 128 + 8 * fq;
        f32x4 wv[4][2];
#pragma unroll
        for (int ks = 0; ks < 4; ++ks) { wv[ks][0] = *(const f32x4*)(w + 32 * ks); wv[ks][1] = *(const f32x4*)(w + 32 * ks + 4); }
        __syncthreads();
        const bool more = stp + G < NSTEP;
        if (more) { SAL_DMA(stp + G, k ^ 1); asm volatile("s_waitcnt vmcnt(8)" ::: "memory"); }
        else asm volatile("s_waitcnt vmcnt(0)" ::: "memory");
        __syncthreads();
        f32x4 acc[4][4];
#pragma unroll
        for (int nb = 0; nb < 4; ++nb)
#pragma unroll
            for (int pb = 0; pb < 4; ++pb) acc[nb][pb] = (f32x4){0.f, 0.f, 0.f, 0.f};
        const LAS unsigned char* xrow = lds + k * 65536 + (128 + hh * 64 + fr) * 256; const LAS unsigned char* brow = lds + k * 65536 + (nh * 64 + fr) * 256;
#pragma unroll
        for (int ks = 0; ks < 4; ++ks) {
            const int po = ((4 * ks + fq) ^ fr) * 16;
            bf16x8 xf[4];
#pragma unroll
            for (int pb = 0; pb < 4; ++pb) { float f[8]; unpack8(*(const LAS bf16x8*)(xrow + pb * 4096 + po), f);
#pragma unroll
                for (int q = 0; q < 4; ++q) { f[q] *= wv[ks][0][q]; f[4 + q] *= wv[ks][1][q]; }
                xf[pb] = pack8(f); }
#pragma unroll
            for (int nb = 0; nb < 4; ++nb) { const bf16x8 bfv = *(const LAS bf16x8*)(brow + nb * 4096 + po);
#pragma unroll
                for (int pb = 0; pb < 4; ++pb) acc[nb][pb] = mfma16(bfv, xf[pb], acc[nb][pb]); }
        }
        bf16_t* st = p.states + ((((size_t)b * 2 + dir) * NCHUNK + c) * 16 + h) * 8192 + 64 * nh;
#pragma unroll
        for (int nb = 0; nb < 4; ++nb)
#pragma unroll
            for (int pb = 0; pb < 4; ++pb) *(u32x2*)(st + (16 * pb + fr) * 128 + 16 * nb + 4 * fq) = pk4(acc[nb][pb]);
    }
    asm volatile("s_waitcnt vmcnt(0)" ::: "memory"); __syncthreads();
#undef SAL_DMA
}
#define SCAN_LOAD(V, D, CC0) do { _Pragma("unroll") for (int u_ = 0; u_ < 16; ++u_) { const int c = c0 + cstep * ((CC0) + u_); V[u_] = *(const u32x2*)(base + (long)c * (16 * 8192)); D[u_] = dec[c]; } } while (0)
#define SCAN_DO(V, D, CC0) do { _Pragma("unroll") for (int u_ = 0; u_ < 16; ++u_) { const int c = c0 + cstep * ((CC0) + u_); const float d = D[u_]; \
        *(u32x2*)(base + (long)c * (16 * 8192)) = (u32x2){pg8::cvt_pk_safe(r0, r1), pg8::cvt_pk_safe(r2, r3)}; \
        r0 = r0 * d + __uint_as_float(V[u_].x << 16); r1 = r1 * d + __uint_as_float(V[u_].x & 0xffff0000u); r2 = r2 * d + __uint_as_float(V[u_].y << 16); r3 = r3 * d + __uint_as_float(V[u_].y & 0xffff0000u); } } while (0)
DEV void ph_ssd_scan(const P& p) {
    static_assert(NCHUNK % 32 == 0, "chunk groups of 16 come in pairs");
    for (size_t i = GTID; i < (size_t)BATCH * 2 * 16 * 64 * 32; i += GSTRIDE) {
        const int n4 = (int)(i & 31), pp = (int)((i >> 5) & 63), hsel = __builtin_amdgcn_readfirstlane((int)(i >> 11)), h = hsel & 15, dir = (hsel >> 4) & 1, b = hsel >> 5;
        bf16_t* base = p.states + (((size_t)b * 2 + dir) * NCHUNK * 16 + h) * 8192 + pp * 128 + n4 * 4;
        const float* dec = p.cdec + ((size_t)b * 32 + dir * 16 + h) * NCHUNK;
        const int c0 = dir ? NCHUNK - 1 : 0, cstep = dir ? -1 : 1;
        float r0 = 0.f, r1 = 0.f, r2 = 0.f, r3 = 0.f;
        u32x2 va[16], vb[16]; float da[16], db[16];
        SCAN_LOAD(va, da, 0);
#pragma unroll 1
        for (int cc = 0; cc < NCHUNK; cc += 32) {
            SCAN_LOAD(vb, db, cc + 16);
            SCAN_DO(va, da, cc);
            if (cc + 32 < NCHUNK) SCAN_LOAD(va, da, cc + 32);
            SCAN_DO(vb, db, cc + 16);
        }
    }
}
constexpr int GLD = 136;
#define SC_XLOAD(XF, KS) do { _Pragma("unroll") for (int pb = 0; pb < 4; ++pb) XF[pb] = ldg8(xT + pb * 16 * 128 + 32 * (KS)); } while (0)
#define SC_DIAG(XF, KS) do { const int s0 = 32 * (KS) + 8 * fq; float cs_s[8], cb_s[8], df[8], db[8]; \
        _Pragma("unroll") for (int j = 0; j < 8; ++j) { cs_s[j] = vec[s0 + j]; cb_s[j] = vec[128 + s0 + j]; df[j] = vec[256 + s0 + j]; db[j] = vec[384 + s0 + j]; } \
        _Pragma("unroll") for (int lb = 0; lb < 4; ++lb) { const int l = l0 + 16 * lb + fr; \
            float gf[8], m[8]; unpack8(*(const LAS bf16x8*)(Gl + (16 * lb + fr) * GLD + s0), gf); \
            _Pragma("unroll") for (int j = 0; j < 8; ++j) { const int s = s0 + j; \
                const float wf = s <= l ? df[j] * __expf(fminf(csfl[lb] - cs_s[j], 0.f)) : 0.f, wb = s >= l ? db[j] * __expf(fminf(cbl[lb] - cb_s[j], 0.f)) : 0.f; \
                m[j] = gf[j] * (wf + wb) + (s == l ? Dh : 0.f); } \
            const bf16x8 mf = pack8(m); \
            _Pragma("unroll") for (int pb = 0; pb < 4; ++pb) acc[pb][lb] = mfma16(XF[pb], mf, acc[pb][lb]); __builtin_amdgcn_sched_barrier(0); } } while (0)
#define SC_CFRAG(LB, KS) (*(const LAS bf16x8*)(Cl + (16 * (LB) + fr) * 256 + (((4 * (KS) + fq) ^ fr) * 16)))
#define SC_PLOAD(PF, T_) do { const bf16_t* pv_ = ((T_) >> 2) ? pv1 : pv0; _Pragma("unroll") for (int pb = 0; pb < 4; ++pb) PF[pb] = ldg8(pv_ + pb * 2048 + 32 * ((T_) & 3)); } while (0)
#define SC_YOFF(PF, T_) do { _Pragma("unroll") for (int lb = 0; lb < 4; ++lb) { float f[8]; unpack8(SC_CFRAG(lb, (T_) & 3), f); const float sc_ = ((T_) >> 2) ? scb[lb] : scf[lb]; \
            _Pragma("unroll") for (int j = 0; j < 8; ++j) f[j] *= sc_; \
            const bf16x8 cf = pack8(f); \
            _Pragma("unroll") for (int pb = 0; pb < 4; ++pb) acc[pb][lb] = mfma16(PF[pb], cf, acc[pb][lb]); } } while (0)
DEV void ph_ssd_out(const P& p, LAS unsigned char* lds) {
    const int wid = threadIdx.x >> 6, lane = threadIdx.x & 63, fr = lane & 15, fq = lane >> 4;
    LAS bf16_t* Gl = (LAS bf16_t*)lds;
    LAS float* vec = (LAS float*)(lds + 64 * GLD * 2) + wid * 512;
    int ub = 0;
    for (int up = blockIdx.x; up < BATCH * NCHUNK * 2; up += gridDim.x) {
      const int lh = up & 1, c = (up >> 1) % NCHUNK, b = (up >> 1) / NCHUNK, l0 = 64 * lh; const size_t row0 = (size_t)b * SEQ + (size_t)c * 128;
#pragma unroll 1
      for (int g = 0; g < 2; ++g) {
        const int h = 8 * g + wid;
        const bf16_t* bmrow = p.bc + (row0 + 16 * wid + fr) * 512 + g * 128 + 8 * fq;
        const LAS unsigned char* Cl = lds + 34816 + ub * 16384; ub ^= 1;
#pragma unroll
        for (int n_ = 0; n_ < 2; ++n_) { const int r_ = ((int)threadIdx.x >> 4) + 32 * n_, sl_ = (int)threadIdx.x & 15;
            __builtin_amdgcn_global_load_lds((const unsigned*)(p.bc + (row0 + l0 + r_) * 512 + 256 + g * 128 + ((sl_ ^ (r_ & 15)) * 8)), (LAS unsigned*)(lds + 34816 + (ub ^ 1) * 16384 + n_ * 8192 + wid * 1024), 16, 0, 0); }
        float vr[8];
        f32x4 ag[4];
        { bf16x8 bm[4];
#pragma unroll
        for (int ks = 0; ks < 4; ++ks) bm[ks] = ldg8(bmrow + 32 * ks);
#pragma unroll
        for (int q = 0; q < 2; ++q) { const size_t o = ((size_t)b * 32 + h) * SEQ + c * 128 + lane + 64 * q;
            vr[4 * q] = p.csT[o]; vr[4 * q + 1] = p.csT[o + (size_t)16 * SEQ]; vr[4 * q + 2] = p.stT[o]; vr[4 * q + 3] = p.stT[o + (size_t)16 * SEQ]; }
#pragma unroll
        for (int lb = 0; lb < 4; ++lb) ag[lb] = (f32x4){0.f, 0.f, 0.f, 0.f};
        asm volatile("s_waitcnt vmcnt(0)" ::: "memory"); __syncthreads();
#pragma unroll
        for (int ks = 0; ks < 4; ++ks)
#pragma unroll
            for (int lb = 0; lb < 4; ++lb) ag[lb] = mfma16(bm[ks], SC_CFRAG(lb, ks), ag[lb]); }
        const float Dh = p.ssd_d[h];
#pragma unroll
        for (int lb = 0; lb < 4; ++lb) *(LAS u32x2*)(Gl + (16 * lb + fr) * GLD + 16 * wid + 4 * fq) = pk4(ag[lb]);
#pragma unroll
        for (int q = 0; q < 2; ++q) { const int s = lane + 64 * q; vec[s] = vr[4 * q]; vec[128 + s] = vr[4 * q + 1]; vec[256 + s] = vr[4 * q + 2]; vec[384 + s] = vr[4 * q + 3]; }
        const bf16_t* xT = p.xsT + XST_OFF(b, h * 64 + fr, c * 128) + 8 * fq;
        const bf16_t* pv0 = p.states + ((((size_t)b * 2 + 0) * NCHUNK + c) * 16 + h) * 8192 + fr * 128 + 8 * fq;
        const bf16_t* pv1 = p.states + ((((size_t)b * 2 + 1) * NCHUNK + c) * 16 + h) * 8192 + fr * 128 + 8 * fq;
        bf16x8 xfa[4], xfb[4], pfa[4], pfb[4];
        SC_XLOAD(xfa, 0);
        __syncthreads();
        f32x4 acc[4][4];
#pragma unroll
        for (int pb = 0; pb < 4; ++pb)
#pragma unroll
            for (int lb = 0; lb < 4; ++lb) acc[pb][lb] = (f32x4){0.f, 0.f, 0.f, 0.f};
        float csfl[4], cbl[4], scf[4], scb[4];
#pragma unroll
        for (int lb = 0; lb < 4; ++lb) { csfl[lb] = vec[l0 + 16 * lb + fr]; cbl[lb] = vec[128 + l0 + 16 * lb + fr]; scf[lb] = __expf(csfl[lb]); scb[lb] = __expf(cbl[lb]); }
#pragma unroll 1
        for (int ks = 0; ks < 4; ks += 2) {
            SC_XLOAD(xfb, ks + 1); SC_DIAG(xfa, ks);
            if (ks + 2 < 4) SC_XLOAD(xfa, ks + 2);
            SC_DIAG(xfb, ks + 1);
        }
        SC_PLOAD(pfa, 0);
#pragma unroll 1
        for (int t = 0; t < 8; t += 2) {
            SC_PLOAD(pfb, t + 1); SC_YOFF(pfa, t);
            if (t + 2 < 8) SC_PLOAD(pfa, t + 2);
            SC_YOFF(pfb, t + 1);
        }
#pragma unroll
        for (int pb = 0; pb < 4; ++pb)
#pragma unroll
            for (int lb = 0; lb < 4; ++lb) *(u32x2*)(p.yssd + (row0 + l0 + 16 * lb + fr) * 1024 + h * 64 + 16 * pb + 4 * fq) = pk4(acc[pb][lb]);
      }
      asm volatile("s_waitcnt vmcnt(0)" ::: "memory"); __syncthreads();
      { const size_t rb = row0 + l0 + 8 * wid; float4 gv[4]; uint2 ya[4][4], za[4][4], yb[4][4], zb[4][4];
#pragma unroll
        for (int j = 0; j < 4; ++j) gv[j] = ((const float4*)p.out_norm)[j * 64 + lane];
        GN_LOAD(ya, za, rb); GN_LOAD(yb, zb, rb + 4); GN_DO(ya, za, rb); GN_DO(yb, zb, rb + 4); }
    }
}

#define RT_LOAD(X, D, KS0) do { _Pragma("unroll") for (int u_ = 0; u_ < 4; ++u_) { D[u_] = ldg8(dr + 32 * ((KS0) + u_)); \
        if constexpr (XF32) { X[2 * u_] = *(const f32x4*)(xr + 32 * ((KS0) + u_)); X[2 * u_ + 1] = *(const f32x4*)(xr + 32 * ((KS0) + u_) + 4); } \
        else X[u_] = __builtin_bit_cast(f32x4, ldg8(xbr + 32 * ((KS0) + u_))); } } while (0)
#define RT_DO(X, D, KS0) do { _Pragma("unroll") for (int u_ = 0; u_ < 4; ++u_) { const int ks = (KS0) + u_; \
        float dv[8]; unpack8(D[u_], dv); float x[8]; \
        if constexpr (XF32) { _Pragma("unroll") for (int j = 0; j < 4; ++j) { x[j] = X[2 * u_][j]; x[4 + j] = X[2 * u_ + 1][j]; } } \
        else unpack8(__builtin_bit_cast(bf16x8, X[u_]), x); \
        const f32x4 ga = *(const LAS f32x4*)(lds + 65536 + (32 * ks + 8 * fq) * 4), gb = *(const LAS f32x4*)(lds + 65536 + (32 * ks + 8 * fq) * 4 + 16); \
        _Pragma("unroll") for (int j = 0; j < 8; ++j) { x[j] += dv[j]; ss += x[j] * x[j]; } \
        { u32x2 w8; const float sa = pg8::F8_SA; \
          w8.x = pg8::pk4_fp8(pg8::f8clamp(x[0] * ga.x * sa), pg8::f8clamp(x[1] * ga.y * sa), pg8::f8clamp(x[2] * ga.z * sa), pg8::f8clamp(x[3] * ga.w * sa)); \
          w8.y = pg8::pk4_fp8(pg8::f8clamp(x[4] * gb.x * sa), pg8::f8clamp(x[5] * gb.y * sa), pg8::f8clamp(x[6] * gb.z * sa), pg8::f8clamp(x[7] * gb.w * sa)); \
          *(u32x2*)(h8 + 32 * ks) = w8; } \
        const bf16x8 xh = pack8(x); float xhf[8], lo[8]; unpack8(xh, xhf); \
        _Pragma("unroll") for (int j = 0; j < 8; ++j) lo[j] = x[j] - xhf[j]; \
        const bf16x8 xl = pack8(lo); \
        const bf16x8 wh = *(const LAS bf16x8*)(lds + (size_t)(ks * 64 + lane) * 16), wl = *(const LAS bf16x8*)(lds + 32768 + (size_t)(ks * 64 + lane) * 16); \
        acc = mfma16(xh, wh, acc); acc = mfma16(xl, wh, acc); acc = mfma16(xh, wl, acc); } } while (0)
DEV void ph_router_tables(const P& p) {
    for (size_t f0 = GTID; f0 < 4096; f0 += GSTRIDE) { const int layer = (int)(f0 >> 11), f = (int)(f0 & 2047), ks = f >> 6, ln = f & 63, e = ln & 15, kb = 32 * ks + 8 * (ln >> 4);
        const float* g = p.ffn_norm + (size_t)layer * 1024; const float* rw = p.router_w + (size_t)layer * 1024 * 16;
        float hi[8], lo[8];
#pragma unroll
        for (int j = 0; j < 8; ++j) { const float w = g[kb + j] * rw[(size_t)(kb + j) * 16 + e]; const float h = bf2f(f2bf(w)); hi[j] = h; lo[j] = w - h; }
        *(bf16x8*)(p.rtab + (size_t)layer * 65536 + (size_t)f * 16) = pack8(hi); *(bf16x8*)(p.rtab + (size_t)layer * 65536 + 32768 + (size_t)f * 16) = pack8(lo); }
}
template <bool XF32>
DEV void ph_norm_router_mfma(const P& p, int layer, LAS unsigned char* lds, const float* xin, const bf16_t* xinb) {
    const float* g = p.ffn_norm + (size_t)layer * 1024; const float* rw = p.router_w + (size_t)layer * 1024 * 16;
    const int tid = threadIdx.x, wid = tid >> 6, lane = tid & 63, fr = lane & 15, fq = lane >> 4;
    __syncthreads();
    { const unsigned char* tab = p.rtab + (size_t)layer * 65536; const int wu = __builtin_amdgcn_readfirstlane(wid);
#pragma unroll
      for (int n = 0; n < 8; ++n) __builtin_amdgcn_global_load_lds((const unsigned*)(tab + (size_t)(n * 512 + tid) * 16), (LAS unsigned*)(lds + n * 8192 + wu * 1024), 16, 0, 0);
      asm volatile("s_waitcnt vmcnt(0)" ::: "memory"); }
    (void)rw;
    if (tid < 256) *(LAS f32x4*)(lds + 65536 + tid * 16) = ((const f32x4*)g)[tid];
    __syncthreads();
    for (size_t row0 = ((size_t)blockIdx.x * 8 + wid) * 16; row0 < (size_t)T; row0 += (size_t)gridDim.x * 128) {
        const float* xr = xin + (row0 + fr) * 1024 + 8 * fq; const bf16_t* xbr = xinb + (row0 + fr) * 1024 + 8 * fq; const bf16_t* dr = p.dlt + (row0 + fr) * 1024 + 8 * fq;
        unsigned char* h8 = (unsigned char*)p.hn + (row0 + fr) * 1024 + 8 * fq;
        f32x4 acc = (f32x4){0.f, 0.f, 0.f, 0.f}; float ss = 0.f;
        f32x4 xa[8], xb[8]; bf16x8 da[4], db[4];
        RT_LOAD(xa, da, 0);
#pragma unroll 1
        for (int kg = 0; kg < 8; kg += 2) {
            RT_LOAD(xb, db, 4 * kg + 4);
            RT_DO(xa, da, 4 * kg);
            if (kg + 2 < 8) RT_LOAD(xa, da, 4 * kg + 8);
            RT_DO(xb, db, 4 * kg + 4);
        }
        ss += __shfl_xor(ss, 16); ss += __shfl_xor(ss, 32);
        const float rinv = 1.0f / sqrtf(ss * (1.0f / 1024.0f) + 1e-6f);
        if (fq == 0) p.rinv[row0 + fr] = rinv;
        float lg[4];
#pragma unroll
        for (int i = 0; i < 4; ++i) { lg[i] = acc[i] * __shfl(rinv, 4 * fq + i);
            float mx = lg[i]; mx = fmaxf(mx, __shfl_xor(mx, 1)); mx = fmaxf(mx, __shfl_xor(mx, 2)); mx = fmaxf(mx, __shfl_xor(mx, 4)); mx = fmaxf(mx, __shfl_xor(mx, 8));
            const float ex = expf(lg[i] - mx); float den = ex; den += __shfl_xor(den, 1); den += __shfl_xor(den, 2); den += __shfl_xor(den, 4); den += __shfl_xor(den, 8);
            lg[i] = ex / den; }
        { const size_t r4 = row0 + 4 * fq; const int b = (int)(r4 / SEQ), s = (int)(r4 % SEQ); *(float4*)(p.aff + ((size_t)b * NE + fr) * SEQ + s) = float4{lg[0], lg[1], lg[2], lg[3]}; }
    }
    __syncthreads();
}

DEV void ph_convert_small_tiles(const P& p, LAS unsigned char* lds) {
    LAS unsigned* tl = (LAS unsigned*)lds;
    const int tid = threadIdx.x, n4 = tid & 31, seg = (tid >> 5) & 1, kp = tid >> 6;
    const int rrow = tid >> 1, rhalf = tid & 1, rseg = rrow >> 7, rq = (rrow >> 5) & 3, rn4 = rrow & 31;
    constexpr int NT_IN = (NIN_PAD / 256) * 16, NTILE = NT_IN + 4 * 32;
#define CS_SRC(ID, S_, LD_, NV_, N0_, K0_, D_, KK_) const float* S_; int LD_, NV_, N0_, K0_, KK_; bf16_t* D_; \
        if ((ID) < NT_IN) { S_ = p.w_in; LD_ = NIN; NV_ = NIN; N0_ = 256 * ((ID) >> 4); K0_ = 64 * ((ID) & 15); D_ = p.WinT; KK_ = 1024; } \
        else { const int r_ = (ID) - NT_IN; S_ = p.w_out; LD_ = 1024; NV_ = 1024; N0_ = 256 * (r_ >> 5); K0_ = 64 * (r_ & 31); D_ = p.WoutT; KK_ = 2048; }
#define CS_LOAD(ID, DST) do { CS_SRC(ID, s_, ld_, nv_, n0_, k0_, d_, kk_) (void)d_; (void)kk_; const int c_ = n0_ + 128 * seg + 4 * n4; \
        _Pragma("unroll") for (int i = 0; i < 4; ++i) { const size_t ro = (size_t)(k0_ + 2 * (kp + 8 * i)) * ld_ + c_; \
            if (c_ < nv_) { DST[2 * i] = *(const float4*)(s_ + ro); DST[2 * i + 1] = *(const float4*)(s_ + ro + ld_); } else { DST[2 * i] = float4{0.f, 0.f, 0.f, 0.f}; DST[2 * i + 1] = float4{0.f, 0.f, 0.f, 0.f}; } } } while (0)
#define CS_TILE(ID, SRC) do { __syncthreads(); \
        _Pragma("unroll") for (int i = 0; i < 4; ++i) { const float4 a = SRC[2 * i], b = SRC[2 * i + 1]; const int kd = kp + 8 * i; const int rb = seg * 128 + n4; \
            tl[(rb) * 33 + kd] = pack2(a.x, b.x); tl[(rb + 32) * 33 + kd] = pack2(a.y, b.y); tl[(rb + 64) * 33 + kd] = pack2(a.z, b.z); tl[(rb + 96) * 33 + kd] = pack2(a.w, b.w); } \
        __syncthreads(); \
        { CS_SRC(ID, s_, ld_, nv_, n0_, k0_, d_, kk_) (void)s_; (void)ld_; (void)nv_; unsigned w[16]; \
          _Pragma("unroll") for (int i = 0; i < 16; ++i) w[i] = tl[rrow * 33 + 16 * rhalf + i]; \
          bf16_t* dp = d_ + (size_t)(n0_ + rseg * 128 + 4 * rn4 + rq) * kk_ + k0_ + 32 * rhalf; \
          _Pragma("unroll") for (int q = 0; q < 4; ++q) *(uint4*)(dp + 8 * q) = uint4{w[4 * q], w[4 * q + 1], w[4 * q + 2], w[4 * q + 3]}; } } while (0)
    float4 ca[8], cb[8];
    int id = blockIdx.x; const int G = (int)gridDim.x;
    if (id < NTILE) CS_LOAD(id, ca);
    for (; id < NTILE; id += 2 * G) {
        const bool hb = id + G < NTILE;
        if (hb) CS_LOAD(id + G, cb);
        CS_TILE(id, ca);
        if (id + 2 * G < NTILE) CS_LOAD(id + 2 * G, ca);
        if (hb) CS_TILE(id + G, cb);
    }
    __syncthreads();
#undef CS_SRC
#undef CS_LOAD
#undef CS_TILE
}

DEV void ph_convert_late_tiles(const P& p, LAS unsigned char* lds, const int bid, const int nb) {
    LAS unsigned* tl = (LAS unsigned*)lds;
    const int tid = threadIdx.x, n4 = tid & 31, seg = (tid >> 5) & 1, kp = tid >> 6;
    const int rrow = tid >> 1, rhalf = tid & 1, rseg = rrow >> 7, rq = (rrow >> 5) & 3, rn4 = rrow & 31;
    constexpr int NT_IN = 12 * 16, NTILE = NT_IN + 4 * 16;
#define CL_SRC(ID, S_, LD_, CB_, N0_, K0_, D_) const float* S_; int LD_, CB_, N0_, K0_; bf16_t* D_; \
        if ((ID) < NT_IN) { const int nt_ = (ID) >> 4; S_ = p.cw_in; LD_ = 3072; N0_ = 256 * nt_; K0_ = 64 * ((ID) & 15); D_ = p.WciT; CB_ = nt_ < 8 ? (seg ? 2048 + 128 * nt_ : 1024 + 128 * nt_) : (256 * nt_ - 2048 + 128 * seg); } \
        else { const int r_ = (ID) - NT_IN; S_ = p.cw_out; LD_ = 1024; N0_ = 256 * (r_ >> 4); K0_ = 64 * (r_ & 15); D_ = p.WcoT; CB_ = N0_ + 128 * seg; }
#define CL_LOAD(ID, DST) do { CL_SRC(ID, s_, ld_, cb_, n0_, k0_, d_) (void)d_; (void)n0_; \
        _Pragma("unroll") for (int i = 0; i < 4; ++i) { const size_t ro = (size_t)(k0_ + 2 * (kp + 8 * i)) * ld_ + cb_ + 4 * n4; DST[2 * i] = *(const float4*)(s_ + ro); DST[2 * i + 1] = *(const float4*)(s_ + ro + ld_); } } while (0)
#define CL_TILE(ID, SRC) do { __syncthreads(); \
        _Pragma("unroll") for (int i = 0; i < 4; ++i) { const float4 a = SRC[2 * i], b = SRC[2 * i + 1]; const int kd = kp + 8 * i; const int rb = seg * 128 + n4; \
            tl[(rb) * 33 + kd] = pack2(a.x, b.x); tl[(rb + 32) * 33 + kd] = pack2(a.y, b.y); tl[(rb + 64) * 33 + kd] = pack2(a.z, b.z); tl[(rb + 96) * 33 + kd] = pack2(a.w, b.w); } \
        __syncthreads(); \
        { const int sv_ = seg; (void)sv_; CL_SRC(ID, s_, ld_, cb_, n0_, k0_, d_) (void)s_; (void)ld_; (void)cb_; unsigned w[16]; \
          _Pragma("unroll") for (int i = 0; i < 16; ++i) w[i] = tl[rrow * 33 + 16 * rhalf + i]; \
          bf16_t* dp = d_ + (size_t)(n0_ + rseg * 128 + 4 * rn4 + rq) * 1024 + k0_ + 32 * rhalf; \
          _Pragma("unroll") for (int q = 0; q < 4; ++q) *(uint4*)(dp + 8 * q) = uint4{w[4 * q], w[4 * q + 1], w[4 * q + 2], w[4 * q + 3]}; } } while (0)
    float4 ca[8], cb[8];
    int id = bid;
    if (id < NTILE) CL_LOAD(id, ca);
    for (; id < NTILE; id += 2 * nb) {
        const bool hb = id + nb < NTILE;
        if (hb) CL_LOAD(id + nb, cb);
        CL_TILE(id, ca);
        if (id + 2 * nb < NTILE) CL_LOAD(id + 2 * nb, ca);
        if (hb) CL_TILE(id + nb, cb);
    }
    __syncthreads();
#undef CL_SRC
#undef CL_LOAD
#undef CL_TILE
}

DEV void cvx_src(const P& p, int layer, int id, int seg, const float*& src, int& ld, int& k0) {
    const int e = id / 384, r = id % 384; const size_t off = ((size_t)layer * NE + e) * 1024 * 2048;
    if (r < 256) { const int pn = r >> 4, kt = r & 15; src = (seg ? p.wu : p.wg) + off + 128 * pn; ld = 2048; k0 = 64 * kt; }
    else { const int r2 = r - 256, nt = r2 >> 5, kt = r2 & 31; src = p.wd + off + 256 * nt + 128 * seg; ld = 1024; k0 = 64 * kt; }
}
DEV void ph_convert_experts_dev(const P& p, int layer, LAS unsigned char* lds) {
    LAS unsigned* tl = (LAS unsigned*)lds;
    const int tid = threadIdx.x, n4 = tid & 31, seg = (tid >> 5) & 1, kp = tid >> 6;
    const int rrow = tid >> 1, rhalf = tid & 1, rseg = rrow >> 7, rq = (rrow >> 5) & 3, rn4 = rrow & 31;
    constexpr int NTILE = NE * 384;
    float4 cur[8], nxt[8];
#define CVX_LOAD(ID, DST) do { const float* s_; int ld_, k0_; cvx_src(p, layer, (ID), seg, s_, ld_, k0_); \
        _Pragma("unroll") for (int i = 0; i < 4; ++i) { const size_t ro = (size_t)(k0_ + 2 * (kp + 8 * i)) * ld_ + 4 * n4; DST[2 * i] = *(const float4*)(s_ + ro); DST[2 * i + 1] = *(const float4*)(s_ + ro + ld_); } } while (0)
    int id = blockIdx.x;
    if (id < NTILE) CVX_LOAD(id, cur);
    for (; id < NTILE; id += gridDim.x) {
        const int nid = id + gridDim.x;
        if (nid < NTILE) CVX_LOAD(nid, nxt);
        __syncthreads();
#pragma unroll
        for (int i = 0; i < 4; ++i) { const float4 a = cur[2 * i], b = cur[2 * i + 1]; const int kd = kp + 8 * i; const int rb = seg * 128 + n4;
            tl[(rb) * 33 + kd] = pack2(a.x, b.x); tl[(rb + 32) * 33 + kd] = pack2(a.y, b.y); tl[(rb + 64) * 33 + kd] = pack2(a.z, b.z); tl[(rb + 96) * 33 + kd] = pack2(a.w, b.w); }
        __syncthreads();
        { const int e = id / 384, r = id % 384; bf16_t* d; int K, n0, k0;
          if (r < 256) { d = p.WguT + (size_t)e * 4096 * 1024; K = 1024; n0 = 256 * (r >> 4); k0 = 64 * (r & 15); } else { const int r2 = r - 256; d = p.WdT + (size_t)e * 1024 * 2048; K = 2048; n0 = 256 * (r2 >> 5); k0 = 64 * (r2 & 31); }
          unsigned w[16];
#pragma unroll
          for (int i = 0; i < 16; ++i) w[i] = tl[rrow * 33 + 16 * rhalf + i];
          bf16_t* dp = d + (size_t)(n0 + rseg * 128 + 4 * rn4 + rq) * K + k0 + 32 * rhalf;
#pragma unroll
          for (int q = 0; q < 4; ++q) *(uint4*)(dp + 8 * q) = uint4{w[4 * q], w[4 * q + 1], w[4 * q + 2], w[4 * q + 3]}; }
#pragma unroll
        for (int i = 0; i < 8; ++i) cur[i] = nxt[i];
    }
#undef CVX_LOAD
    __syncthreads();
}

DEV void ph_convert_experts_f8(const P& p, int layer, LAS unsigned char* lds, const int bid, const int nb) {
    LAS unsigned* tl = (LAS unsigned*)lds;
    const int tid = threadIdx.x, n4 = tid & 31, seg = (tid >> 5) & 1, kp = tid >> 6;
    const int rrow = tid >> 1, rhalf = tid & 1, rseg = rrow >> 7, rq = (rrow >> 5) & 3, rn4 = rrow & 31;
    constexpr int NTILE = NE * 384;
    float4 cur[8], nxt[8];
#define CVX8_LOAD(ID, DST) do { const float* s_; int ld_, k0_; cvx_src(p, layer, (ID), seg, s_, ld_, k0_); \
        _Pragma("unroll") for (int i = 0; i < 2; ++i) _Pragma("unroll") for (int r = 0; r < 4; ++r) { const f32x4 t_ = __builtin_nontemporal_load((const f32x4*)(s_ + (size_t)(k0_ + 4 * (kp + 8 * i) + r) * ld_ + 4 * n4)); DST[4 * i + r] = float4{t_[0], t_[1], t_[2], t_[3]}; } } while (0)
    int id = bid; const int G2 = 2 * nb;
    if (id < NTILE) CVX8_LOAD(id, cur);
    for (; id < NTILE; id += G2) {
        const int id1 = id + nb, id2 = id + G2;
        if (id1 < NTILE) CVX8_LOAD(id1, nxt);
        {
        __syncthreads();
#pragma unroll
        for (int i = 0; i < 2; ++i) { const float4 a = cur[4 * i], b = cur[4 * i + 1], c = cur[4 * i + 2], d = cur[4 * i + 3]; const int kd = kp + 8 * i, rb = seg * 128 + n4; const float sw = pg8::F8_SW;
#define F8W(v) pg8::f8clamp((v) * sw)
            tl[(rb) * 17 + kd] = pg8::pk4_fp8(F8W(a.x), F8W(b.x), F8W(c.x), F8W(d.x)); tl[(rb + 32) * 17 + kd] = pg8::pk4_fp8(F8W(a.y), F8W(b.y), F8W(c.y), F8W(d.y));
            tl[(rb + 64) * 17 + kd] = pg8::pk4_fp8(F8W(a.z), F8W(b.z), F8W(c.z), F8W(d.z)); tl[(rb + 96) * 17 + kd] = pg8::pk4_fp8(F8W(a.w), F8W(b.w), F8W(c.w), F8W(d.w)); }
#undef F8W
        __syncthreads();
        { const int e = id / 384, r = id % 384; unsigned char* d; int K, n0, k0;
          if (r < 256) { d = (unsigned char*)p.WguT + (size_t)e * 4096 * 1024; K = 1024; n0 = 256 * (r >> 4); k0 = 64 * (r & 15); } else { const int r2 = r - 256; d = (unsigned char*)p.WdT + (size_t)e * 1024 * 2048; K = 2048; n0 = 256 * (r2 >> 5); k0 = 64 * (r2 & 31); }
          unsigned w[8];
#pragma unroll
          for (int i = 0; i < 8; ++i) w[i] = tl[rrow * 17 + 8 * rhalf + i];
          unsigned char* dp = d + (size_t)(n0 + rseg * 128 + 4 * rn4 + rq) * K + k0 + 32 * rhalf;
          *(uint4*)dp = uint4{w[0], w[1], w[2], w[3]}; *(uint4*)(dp + 16) = uint4{w[4], w[5], w[6], w[7]}; }
        }
        if (id1 < NTILE) {
            if (id2 < NTILE) CVX8_LOAD(id2, cur);
        __syncthreads();
#pragma unroll
        for (int i = 0; i < 2; ++i) { const float4 a = nxt[4 * i], b = nxt[4 * i + 1], c = nxt[4 * i + 2], d = nxt[4 * i + 3]; const int kd = kp + 8 * i, rb = seg * 128 + n4; const float sw = pg8::F8_SW;
#define F8W(v) pg8::f8clamp((v) * sw)
            tl[(rb) * 17 + kd] = pg8::pk4_fp8(F8W(a.x), F8W(b.x), F8W(c.x), F8W(d.x)); tl[(rb + 32) * 17 + kd] = pg8::pk4_fp8(F8W(a.y), F8W(b.y), F8W(c.y), F8W(d.y));
            tl[(rb + 64) * 17 + kd] = pg8::pk4_fp8(F8W(a.z), F8W(b.z), F8W(c.z), F8W(d.z)); tl[(rb + 96) * 17 + kd] = pg8::pk4_fp8(F8W(a.w), F8W(b.w), F8W(c.w), F8W(d.w)); }
#undef F8W
        __syncthreads();
        { const int e = id1 / 384, r = id1 % 384; unsigned char* d; int K, n0, k0;
          if (r < 256) { d = (unsigned char*)p.WguT + (size_t)e * 4096 * 1024; K = 1024; n0 = 256 * (r >> 4); k0 = 64 * (r & 15); } else { const int r2 = r - 256; d = (unsigned char*)p.WdT + (size_t)e * 1024 * 2048; K = 2048; n0 = 256 * (r2 >> 5); k0 = 64 * (r2 & 31); }
          unsigned w[8];
#pragma unroll
          for (int i = 0; i < 8; ++i) w[i] = tl[rrow * 17 + 8 * rhalf + i];
          unsigned char* dp = d + (size_t)(n0 + rseg * 128 + 4 * rn4 + rq) * K + k0 + 32 * rhalf;
          *(uint4*)dp = uint4{w[0], w[1], w[2], w[3]}; *(uint4*)(dp + 16) = uint4{w[4], w[5], w[6], w[7]}; }
        }
    }
#undef CVX8_LOAD
    __syncthreads();
}
constexpr int CTLD = 136;
DEV void ph_prep_dev(const P& p, LAS unsigned char* lds) {
    {
        const int sub = (int)(GTID & 7);
        float gnq[8], gnk[8];
#pragma unroll
        for (int j = 0; j < 8; ++j) { gnq[j] = p.q_norm[sub * 8 + j]; gnk[j] = p.k_norm[sub * 8 + j]; }
        constexpr size_t NPIECE = (size_t)T * 128; const size_t BSTEP = GSTRIDE * 4;
        u32x4 rawA[4], rawB[4]; bf16_t* kreg = p.qkv + (size_t)T * 1024;
        float cs[8], sn[8];
        { const int pos = (int)((GTID >> 3) % SEQ); const float4 c0 = *(const float4*)(p.rope + (size_t)pos * 16), c1 = *(const float4*)(p.rope + (size_t)pos * 16 + 4), s0 = *(const float4*)(p.rope + (size_t)pos * 16 + 8), s1 = *(const float4*)(p.rope + (size_t)pos * 16 + 12);
          cs[0] = c0.x; cs[1] = c0.y; cs[2] = c0.z; cs[3] = c0.w; cs[4] = c1.x; cs[5] = c1.y; cs[6] = c1.z; cs[7] = c1.w; sn[0] = s0.x; sn[1] = s0.y; sn[2] = s0.z; sn[3] = s0.w; sn[4] = s1.x; sn[5] = s1.y; sn[6] = s1.z; sn[7] = s1.w; }
#define QK_LOAD(I0, DST) do { _Pragma("unroll") for (int q = 0; q < 4; ++q) DST[q] = *(const u32x4*)(kreg + ((I0) + q * GSTRIDE) * 8); } while (0)
        size_t i0 = GTID;
        if (i0 + 3 * GSTRIDE < NPIECE) QK_LOAD(i0, rawA);
        for (; PROF_X != 11 && i0 + 3 * GSTRIDE < NPIECE; i0 += 2 * BSTEP) {
            const size_t i1 = i0 + BSTEP, i2 = i0 + 2 * BSTEP;
            if (i1 + 3 * GSTRIDE < NPIECE) QK_LOAD(i1, rawB);
            {
#pragma unroll
            for (int q = 0; q < 4; ++q) { const size_t i = i0 + q * GSTRIDE;
                const bool isk = true;
                float f[8]; float ss = 0.f;
#pragma unroll
                for (int j = 0; j < 4; ++j) { f[2 * j] = __uint_as_float(rawA[q][j] << 16); f[2 * j + 1] = __uint_as_float(rawA[q][j] & 0xffff0000u); }
#pragma unroll
                for (int j = 0; j < 8; ++j) ss += f[j] * f[j];
                ss += __shfl_xor(ss, 1); ss += __shfl_xor(ss, 2); ss += __shfl_xor(ss, 4);
                const float r = 1.0f / sqrtf(ss * (1.0f / 64.0f) + 1e-6f);
#pragma unroll
                for (int j = 0; j < 8; ++j) f[j] = f[j] * r * (isk ? gnk[j] : gnq[j]);
                float oth[8];
#pragma unroll
                for (int j = 0; j < 8; ++j) oth[j] = __shfl_xor(f[j], 1);
                if (sub < 2) {
#pragma unroll
                    for (int j = 0; j < 8; ++j) f[j] = sub == 0 ? f[j] * cs[j] - oth[j] * sn[j] : f[j] * cs[j] + oth[j] * sn[j];
                }
                st8(kreg + i * 8, f); }
            }
            if (i1 + 3 * GSTRIDE < NPIECE) {
                if (i2 + 3 * GSTRIDE < NPIECE) QK_LOAD(i2, rawA);
#pragma unroll
            for (int q = 0; q < 4; ++q) { const size_t i = i1 + q * GSTRIDE;
                const bool isk = true;
                float f[8]; float ss = 0.f;
#pragma unroll
                for (int j = 0; j < 4; ++j) { f[2 * j] = __uint_as_float(rawB[q][j] << 16); f[2 * j + 1] = __uint_as_float(rawB[q][j] & 0xffff0000u); }
#pragma unroll
                for (int j = 0; j < 8; ++j) ss += f[j] * f[j];
                ss += __shfl_xor(ss, 1); ss += __shfl_xor(ss, 2); ss += __shfl_xor(ss, 4);
                const float r = 1.0f / sqrtf(ss * (1.0f / 64.0f) + 1e-6f);
#pragma unroll
                for (int j = 0; j < 8; ++j) f[j] = f[j] * r * (isk ? gnk[j] : gnq[j]);
                float oth[8];
#pragma unroll
                for (int j = 0; j < 8; ++j) oth[j] = __shfl_xor(f[j], 1);
                if (sub < 2) {
#pragma unroll
                    for (int j = 0; j < 8; ++j) f[j] = sub == 0 ? f[j] * cs[j] - oth[j] * sn[j] : f[j] * cs[j] + oth[j] * sn[j];
                }
                st8(kreg + i * 8, f); }
            }
        }
#undef QK_LOAD
    }
    {
        constexpr int CT2 = 264;
        LAS bf16_t* tl = (LAS bf16_t*)lds;
        const int tid = threadIdx.x, c8 = tid & 7, tq = tid >> 3;
        LAS float* wl = (LAS float*)(lds + 34816);
        __syncthreads();
        for (int f = tid; f < 6 * 1536 / 4; f += 512) *(LAS f32x4*)(wl + 4 * f) = f < 5 * 384 ? ((const f32x4*)p.conv_w)[f] : ((const f32x4*)p.conv_b)[f - 5 * 384];
        __syncthreads();
        constexpr int NTILE = (T / 256) * 24;
        u32x4 ra[8], rb[8];
#define PREP_LOAD(TILE, DST) do { const int ct_ = (TILE) % 24, tt_ = (TILE) / 24, c0_ = ct_ * 64; const size_t t0_ = (size_t)tt_ * 256; const int pos0_ = (int)(t0_ % SEQ) + 4 * tq; \
            _Pragma("unroll") for (int r = 0; r < 8; ++r) { const int pp = pos0_ + r - 2; DST[r] = (pp < 0 || pp >= SEQ) ? (u32x4){0u, 0u, 0u, 0u} : *(const u32x4*)(p.xbcraw + (t0_ + 4 * tq + r - 2) * 1536 + c0_ + c8 * 8); } } while (0)
#define PREP_TILE(TILE, BUF) do { const int ct = (TILE) % 24, tt = (TILE) / 24, c0 = ct * 64; const size_t t0 = (size_t)tt * 256; const int b = (int)(t0 / SEQ), pos0 = (int)(t0 % SEQ); \
            float wgt[5][8], bias[8]; \
            _Pragma("unroll") for (int j = 0; j < 8; ++j) { bias[j] = wl[5 * 1536 + c0 + c8 * 8 + j]; _Pragma("unroll") for (int k = 0; k < 5; ++k) wgt[k][j] = wl[k * 1536 + c0 + c8 * 8 + j]; } \
            float rowf[8][8]; \
            _Pragma("unroll") for (int r = 0; r < 8; ++r) _Pragma("unroll") for (int j = 0; j < 4; ++j) { rowf[r][2 * j] = __uint_as_float(BUF[r][j] << 16); rowf[r][2 * j + 1] = __uint_as_float(BUF[r][j] & 0xffff0000u); } \
            unsigned pk[8][2]; \
            _Pragma("unroll") for (int o = 0; o < 4; ++o) { float acc[8]; \
                _Pragma("unroll") for (int j = 0; j < 8; ++j) { acc[j] = bias[j]; _Pragma("unroll") for (int k = 0; k < 5; ++k) acc[j] += rowf[o + k][j] * wgt[k][j]; acc[j] = acc[j] * __builtin_amdgcn_rcpf(1.0f + __expf(-acc[j])); } \
                if (c0 >= 1024) st8(p.bc + (t0 + 4 * tq + o) * 512 + (c0 - 1024) + c8 * 8, acc); \
                _Pragma("unroll") for (int j = 0; j < 8; ++j) { const unsigned hv = (unsigned)f2bf(acc[j]); if (o & 1) pk[j][o >> 1] |= hv << 16; else pk[j][o >> 1] = hv; } } \
            __syncthreads(); \
            if (c0 < 1280) { _Pragma("unroll") for (int j = 0; j < 8; ++j) { u32x2 w; w.x = pk[j][0]; w.y = pk[j][1]; *(LAS u32x2*)(tl + (c8 * 8 + j) * CT2 + ((4 * tq) ^ (c8 << 3))) = w; } } \
            __syncthreads(); \
            if (c0 < 1280) { _Pragma("unroll") for (int q = 0; q < 4; ++q) { const int pq = pos0 + 8 * (c8 + 8 * q); bf16_t* dst = c0 < 1024 ? p.xsT + XST_OFF(b, c0 + tq, pq) : p.bmT + BMT_OFF(b, (c0 - 1024) + tq, pq); \
                *(u32x4*)dst = *(const LAS u32x4*)(tl + tq * CT2 + ((8 * (c8 + 8 * q)) ^ ((tq >> 3) << 3))); } } } while (0)
        int tile = blockIdx.x; const int G2 = 2 * (int)gridDim.x;
        if (tile < NTILE) PREP_LOAD(tile, ra);
        for (; PROF_X != 12 && tile < NTILE; tile += G2) {
            const int tile1 = tile + (int)gridDim.x, tile2 = tile + G2;
            if (tile1 < NTILE) PREP_LOAD(tile1, rb);
            PREP_TILE(tile, ra);
            if (tile1 < NTILE) { if (tile2 < NTILE) PREP_LOAD(tile2, ra); PREP_TILE(tile1, rb); }
        }
#undef PREP_LOAD
#undef PREP_TILE
    }
    {
        const int tid = threadIdx.x, lane = tid & 63, wid = tid >> 6;
        LAS float* dl = (LAS float*)(lds + 73728);
        float Aj[4], bj[4];
#pragma unroll
        for (int i = 0; i < 4; ++i) { const int j = wid * 4 + i, dir = j >> 4, h = j & 15; Aj[i] = -expf(dir ? p.a_log_b[h] : p.a_log_f[h]); bj[i] = dir ? p.dtb_b[h] : p.dtb_f[h]; }
        for (int blk = blockIdx.x; PROF_X != 13 && blk < BATCH * NCHUNK; blk += gridDim.x) {
            const int c = blk % NCHUNK, b = blk / NCHUNK; const size_t row0 = (size_t)b * SEQ + (size_t)c * 128;
            __syncthreads();
#pragma unroll
            for (int q = 0; q < 2; ++q) { const int f = tid + 512 * q, tok = f >> 3, j4 = f & 7; const float4 v = ((const float4*)(p.dtraw + (row0 + tok) * 32))[j4];
                dl[tok * 33 + 4 * j4] = v.x; dl[tok * 33 + 4 * j4 + 1] = v.y; dl[tok * 33 + 4 * j4 + 2] = v.z; dl[tok * 33 + 4 * j4 + 3] = v.w; }
            __syncthreads();
#pragma unroll
            for (int i = 0; i < 4; ++i) { const int j = wid * 4 + i, dir = j >> 4; const float A = Aj[i], bias = bj[i];
                const int l0 = dir ? 127 - 2 * lane : 2 * lane, l1 = dir ? 126 - 2 * lane : 2 * lane + 1;
                const size_t ob = ((size_t)b * 32 + j) * SEQ + c * 128;
                const float dt0 = softplus_f(dl[l0 * 33 + j] + bias), dt1 = softplus_f(dl[l1 * 33 + j] + bias);
                const float a0 = dt0 * A, a1 = dt1 * A, pr = a0 + a1; float inc = pr;
#pragma unroll
                for (int o = 1; o < 64; o <<= 1) { const float tq = __shfl_up(inc, o); if (lane >= o) inc += tq; }
                const float cs0 = inc - pr + a0, cs1 = inc, total = __shfl(inc, 63);
                if (NAIVE_SSD) { p.step[(row0 + l0) * 32 + j] = dt0; p.step[(row0 + l1) * 32 + j] = dt1; }
                p.stT[ob + l0] = dt0; p.stT[ob + l1] = dt1; p.csT[ob + l0] = cs0; p.csT[ob + l1] = cs1;
                p.wdT[ob + l0] = dt0 * expf(total - cs0); p.wdT[ob + l1] = dt1 * expf(total - cs1);
                if (lane == 0) p.cdec[((size_t)b * 32 + j) * NCHUNK + c] = expf(total); }
        }
        __syncthreads();
    }
}

typedef short s16x4 __attribute__((ext_vector_type(4)));
constexpr int VLD = 144;
DEV void ph_attn(const P& p, LAS unsigned char* lds) {
    const int wid = threadIdx.x >> 6, lane = threadIdx.x & 63, fr = lane & 15, fq = lane >> 4;
    LAS unsigned char* vt = lds + wid * (32 * VLD);
    float gq = 0.f, gk = 0.f;
    for (int c = 0; c < 64; ++c) { gq = fmaxf(gq, fabsf(p.q_norm[c])); gk = fmaxf(gk, fabsf(p.k_norm[c])); }
    const float c1 = 0.125f * 1.44269504089f, c2 = 8.0f * gq * gk * 1.44269504089f;
    const int trq = fr >> 2, trp = fr & 3;
    constexpr int NJB = SEQ / 256;
    for (int it = blockIdx.x * 8 + wid; it < BATCH * 16 * NJB * 16; it += gridDim.x * 8) {
        const int r = it & 15, jb = (it >> 4) % NJB, h = ((it >> 4) / NJB) & 15, b = ((it >> 4) / NJB) >> 4;
        const size_t rowb = (size_t)b * SEQ; const int base = r + 256 * jb;
        const bf16_t* qp = p.qkv + (rowb + base + 16 * fr) * 3072 + h * 64 + 8 * fq;
        const bf16x8 qf0 = ldg8(qp), qf1 = ldg8(qp + 32);
        const bf16_t* kbase = p.qkv + rowb * 3072 + 1024 + h * 64 + 8 * fq;
        const bf16_t* vbase = p.qkv + rowb * 3072 + 2048 + h * 64;
        f32x4 o[4];
#pragma unroll
        for (int mb = 0; mb < 4; ++mb) o[mb] = (f32x4){0.f, 0.f, 0.f, 0.f};
        float lsum = 0.f;
        bf16x8 vr[4], kf[2][2];
#define ATT_LOAD(st, VR, KF) do { const int dsh_ = (st) < 12 ? 0 : ((st) < 18 ? 2 : 4), k0_ = -64 + 32 * ((st) < 12 ? (st) : ((st) < 18 ? (st) - 12 : (st) - 18)); \
            _Pragma("unroll") for (int c4 = 0; c4 < 4; ++c4) { const int id = lane + 64 * c4, row = id >> 3, ch = id & 7; int pos = base + ((k0_ + row) << dsh_); pos = pos < 0 ? 0 : (pos > SEQ - 1 ? SEQ - 1 : pos); \
                VR[c4] = ldg8(vbase + (size_t)pos * 3072 + 8 * ch); } \
            _Pragma("unroll") for (int x = 0; x < 2; ++x) { int pos = base + ((k0_ + 8 * (fr >> 2) + 4 * x + (fr & 3)) << dsh_); pos = pos < 0 ? 0 : (pos > SEQ - 1 ? SEQ - 1 : pos); \
                KF[x][0] = ldg8(kbase + (size_t)pos * 3072); KF[x][1] = ldg8(kbase + (size_t)pos * 3072 + 32); } } while (0)
        ATT_LOAD(0, vr, kf);
#pragma unroll 1
        for (int st = 0; st < 23; ++st) {
            bf16x8 vrn[4], kfn[2][2];
            const int stn = st + 1 < 23 ? st + 1 : st;
            ATT_LOAD(stn, vrn, kfn);
            const int dsh = st < 12 ? 0 : (st < 18 ? 2 : 4), k0 = -64 + 32 * (st < 12 ? st : (st < 18 ? st - 12 : st - 18));
            const int kq = fr << (4 - dsh);
            f32x4 s0 = mfma16(kf[0][0], qf0, (f32x4){0.f, 0.f, 0.f, 0.f}); s0 = mfma16(kf[0][1], qf1, s0);
            f32x4 s1 = mfma16(kf[1][0], qf0, (f32x4){0.f, 0.f, 0.f, 0.f}); s1 = mfma16(kf[1][1], qf1, s1);
            float pv[8];
#pragma unroll
            for (int j = 0; j < 8; ++j) { const int kap = k0 + 8 * fq + j, pos = base + (kap << dsh), dk = kap - kq;
                const bool valid = dk <= 64 && dk >= -64 && pos >= 0 && pos < SEQ; const float sv = j < 4 ? s0[j & 3] : s1[j & 3];
                pv[j] = valid ? __builtin_amdgcn_exp2f(sv * c1 - c2) : 0.f; lsum += pv[j]; }
            const bf16x8 pf = pack8(pv);
            asm volatile("" ::: "memory");
#pragma unroll
            for (int c4 = 0; c4 < 4; ++c4) { const int id = lane + 64 * c4, row = id >> 3, ch = id & 7; *(LAS bf16x8*)(vt + row * VLD + ch * 16) = vr[c4]; }
            asm volatile("s_waitcnt lgkmcnt(0)" ::: "memory");
#pragma unroll
            for (int mb = 0; mb < 4; ++mb) {
                const s16x4 t0 = __builtin_amdgcn_ds_read_tr16_b64_v4i16((LAS s16x4*)(vt + (8 * fq + trq) * VLD + (16 * mb + 4 * trp) * 2));
                const s16x4 t1 = __builtin_amdgcn_ds_read_tr16_b64_v4i16((LAS s16x4*)(vt + (8 * fq + 4 + trq) * VLD + (16 * mb + 4 * trp) * 2));
                const bf16x8 vf = __builtin_shufflevector(t0, t1, 0, 1, 2, 3, 4, 5, 6, 7);
                o[mb] = mfma16(vf, pf, o[mb]);
            }
            asm volatile("" ::: "memory");
#pragma unroll
            for (int c4 = 0; c4 < 4; ++c4) vr[c4] = vrn[c4];
            kf[0][0] = kfn[0][0]; kf[0][1] = kfn[0][1]; kf[1][0] = kfn[1][0]; kf[1][1] = kfn[1][1];
        }
#undef ATT_LOAD
        lsum += __shfl_xor(lsum, 16); lsum += __shfl_xor(lsum, 32);
        const float inv = 1.0f / lsum;
#pragma unroll
        for (int mb = 0; mb < 4; ++mb) *(u32x2*)(p.mix + (rowb + base + 16 * fr) * 2048 + h * 64 + 16 * mb + 4 * fq) = pk4(o[mb] * inv);
    }
}

constexpr int OLD = 68;
constexpr int ATT_VT = 32 * VLD;
constexpr int ATT_OPART = 8 * 2 * ATT_VT, ATT_LPART = ATT_OPART + 256 * OLD * 4;
static_assert(ATT_LPART + 1024 <= 147440, "attention LDS");
template <int MODE, bool EDGE>
DEV void attn_stream(LAS unsigned char* lds, const bf16_t* qb, const bf16_t* kb, const bf16_t* vb, bf16_t* outb, const int base0, const float c1, const float c2, const float* qgain, const float* rope) {
    const int wid = __builtin_amdgcn_readfirstlane(threadIdx.x >> 6), lane = threadIdx.x & 63, fr = lane & 15, fq = lane >> 4, trq = fr >> 2, trp = fr & 3;
    LAS unsigned char* vt = lds + wid * (2 * ATT_VT); LAS float* Opart = (LAS float*)(lds + ATT_OPART); LAS float* lpart = (LAS float*)(lds + ATT_LPART);
    constexpr int NSI = MODE == 0 ? 11 : 5, NST = 2 * NSI;
#define ATT_GEOM(st, BASE, DSH, K0) do { const int it_ = (st) >= NSI ? 1 : 0, s_ = (st) - it_ * NSI; BASE = MODE == 0 ? base0 + 2 * wid + it_ : base0 + 32 * wid + 16 * it_; \
        if (MODE == 0) { if (s_ < 6) { DSH = 2; K0 = -64 + 32 * s_; } else { DSH = 4; K0 = -64 + 32 * (s_ - 6); } } else { DSH = 0; K0 = -64 + 32 * s_; } } while (0)
#define ATT_CLAMP(pos) (EDGE ? ((pos) < 0 ? 0 : ((pos) > SEQ - 1 ? SEQ - 1 : (pos))) : (pos))
    unsigned klc[2][2], vlc[2][4];
#pragma unroll
    for (int sl = 0; sl < 2; ++sl) { const int d7 = (MODE == 0 ? (sl == 0 ? 2 : 4) : 0) + 7;
#pragma unroll
        for (int x = 0; x < 2; ++x) klc[sl][x] = (unsigned)((8 * (fr >> 2) + 4 * x + (fr & 3)) << d7) + 16u * fq;
#pragma unroll
        for (int c4 = 0; c4 < 4; ++c4) { const int id = lane + 64 * c4; vlc[sl][c4] = (unsigned)((id >> 3) << d7) + 16u * (id & 7); } }
#define ATT_LOAD(st, KF, VR) do { const int stc_ = (st) < NST ? (st) : NST - 1; int b_, d_, k_; ATT_GEOM(stc_, b_, d_, k_); \
        if (EDGE) { \
            _Pragma("unroll") for (int x = 0; x < 2; ++x) { int pos = b_ + ((k_ + 8 * (fr >> 2) + 4 * x + (fr & 3)) << d_); pos = ATT_CLAMP(pos); \
                KF[x][0] = ldg8(kb + (size_t)pos * 64 + 8 * fq); KF[x][1] = ldg8(kb + (size_t)pos * 64 + 8 * fq + 32); } \
            _Pragma("unroll") for (int c4 = 0; c4 < 4; ++c4) { const int id = lane + 64 * c4, row = id >> 3, ch = id & 7; int pos = b_ + ((k_ + row) << d_); pos = ATT_CLAMP(pos); \
                VR[c4] = ldg8(vb + (size_t)pos * 64 + 8 * ch); } \
        } else { const unsigned ub_ = (unsigned)(b_ + k_ * (1 << d_)) * 128u; const int sl_ = (MODE == 0 && d_ == 4) ? 1 : 0; \
            _Pragma("unroll") for (int x = 0; x < 2; ++x) { const unsigned off = (sl_ ? klc[1][x] : klc[0][x]) + ub_; \
                KF[x][0] = *(const bf16x8*)((const char*)kb + off); KF[x][1] = *(const bf16x8*)((const char*)kb + off + 64); } \
            _Pragma("unroll") for (int c4 = 0; c4 < 4; ++c4) { const unsigned off = (sl_ ? vlc[1][c4] : vlc[0][c4]) + ub_; VR[c4] = *(const bf16x8*)((const char*)vb + off); } } } while (0)
#define ATT_QPOS(it) ((MODE == 0 ? base0 + 2 * wid + (it) + 16 * fr : base0 + 32 * wid + 16 * (it) + fr))
    bf16x8 qf0, qf1, qn0, qn1;
#define ATT_QLOAD(it, Q0, Q1) do { const int qp_ = ATT_QPOS(it); float a_[8], b_[8]; unpack8(ldg8(qb + (size_t)qp_ * 64 + 8 * fq), a_); unpack8(ldg8(qb + (size_t)qp_ * 64 + 8 * fq + 32), b_); \
        float ss_ = 0.f; _Pragma("unroll") for (int j = 0; j < 8; ++j) ss_ += a_[j] * a_[j] + b_[j] * b_[j]; \
        ss_ += __shfl_xor(ss_, 16); ss_ += __shfl_xor(ss_, 32); const float r_ = 1.0f / sqrtf(ss_ * (1.0f / 64.0f) + 1e-6f); \
        _Pragma("unroll") for (int j = 0; j < 8; ++j) { a_[j] *= r_ * qgain[8 * fq + j]; b_[j] *= r_ * qgain[32 + 8 * fq + j]; } \
        _Pragma("unroll") for (int j = 0; j < 8; ++j) { const float oth_ = __shfl_xor(a_[j], 16); const float cs_ = rope[(size_t)qp_ * 16 + j], sn_ = rope[(size_t)qp_ * 16 + 8 + j]; \
            a_[j] = fq == 0 ? a_[j] * cs_ - oth_ * sn_ : (fq == 1 ? a_[j] * cs_ + oth_ * sn_ : a_[j]); } \
        Q0 = pack8(a_); Q1 = pack8(b_); } while (0)
    ATT_QLOAD(0, qf0, qf1); ATT_QLOAD(1, qn0, qn1);
#undef ATT_QLOAD
    bf16x8 kA[2][2], vA[4], kB[2][2], vB[4], kC[2][2], vC[4];
    ATT_LOAD(0, kA, vA); ATT_LOAD(1, kB, vB);
    f32x4 o[4];
#pragma unroll
    for (int mb = 0; mb < 4; ++mb) o[mb] = (f32x4){0.f, 0.f, 0.f, 0.f};
    float lsum = 0.f;
#define ATT_STEP(st, KC, VC_, KN, VN) do { \
        if (PROF_X != 7) ATT_LOAD((st) + 2, KN, VN); \
        LAS unsigned char* vcur = vt + ((st) & 1) * ATT_VT; \
        if (PROF_X != 6) { _Pragma("unroll") for (int c4 = 0; c4 < 4; ++c4) { const int id = lane + 64 * c4, row = id >> 3, ch = id & 7; *(LAS bf16x8*)(vcur + row * VLD + ch * 16) = VC_[c4]; } } \
        int base, dsh, k0; ATT_GEOM(st, base, dsh, k0); \
        f32x4 s0 = mfma16(KC[0][0], qf0, (f32x4){0.f, 0.f, 0.f, 0.f}); s0 = mfma16(KC[0][1], qf1, s0); \
        f32x4 s1 = mfma16(KC[1][0], qf0, (f32x4){0.f, 0.f, 0.f, 0.f}); s1 = mfma16(KC[1][1], qf1, s1); \
        asm volatile("" ::: "memory"); \
        bf16x8 vf[4]; \
        if (PROF_X == 6) { _Pragma("unroll") for (int mb = 0; mb < 4; ++mb) vf[mb] = VC_[mb]; } else \
        _Pragma("unroll") for (int mb = 0; mb < 4; ++mb) { \
            const s16x4 t0v = __builtin_amdgcn_ds_read_tr16_b64_v4i16((LAS s16x4*)(vcur + (8 * fq + trq) * VLD + (16 * mb + 4 * trp) * 2)); \
            const s16x4 t1v = __builtin_amdgcn_ds_read_tr16_b64_v4i16((LAS s16x4*)(vcur + (8 * fq + 4 + trq) * VLD + (16 * mb + 4 * trp) * 2)); \
            vf[mb] = __builtin_shufflevector(t0v, t1v, 0, 1, 2, 3, 4, 5, 6, 7); } \
        const int kq = MODE == 0 ? (fr << (4 - dsh)) : fr; \
        float pv[8]; const int t0 = k0 + 8 * fq - kq + 64; \
        const bool full_ = !EDGE && (dsh == 2 ? (k0 == 0 || k0 == 32) : (k0 >= -32 && k0 <= 32));        \
        if (PROF_X == 5) { _Pragma("unroll") for (int j = 0; j < 8; ++j) { pv[j] = j < 4 ? s0[j & 3] : s1[j & 3]; } lsum += pv[0]; } else \
        if (full_) { _Pragma("unroll") for (int j = 0; j < 8; ++j) { const float sv = j < 4 ? s0[j & 3] : s1[j & 3]; pv[j] = __builtin_amdgcn_exp2f(sv * c1 - c2); lsum += pv[j]; } } \
        else { _Pragma("unroll") for (int j = 0; j < 8; ++j) { bool valid = (unsigned)(t0 + j) <= 128u; \
            if (EDGE) { const int pos = base + ((k0 + 8 * fq + j) << dsh); valid = valid && pos >= 0 && pos < SEQ; } \
            const float sv = j < 4 ? s0[j & 3] : s1[j & 3]; pv[j] = valid ? __builtin_amdgcn_exp2f(sv * c1 - c2) : 0.f; lsum += pv[j]; } } \
        const bf16x8 pf = pack8(pv); \
        if (PROF_X == 8) { _Pragma("unroll") for (int mb = 0; mb < 4; ++mb) o[mb] = o[mb] + __builtin_bit_cast(f32x4, vf[mb]) * __builtin_bit_cast(f32x4, pf)[0]; } else \
        _Pragma("unroll") for (int mb = 0; mb < 4; ++mb) o[mb] = mfma16(vf[mb], pf, o[mb]); \
        asm volatile("" ::: "memory"); \
        if ((st) == NSI - 1 || (st) == NST - 1) { \
            const int it = (st) == NSI - 1 ? 0 : 1; \
            lsum += __shfl_xor(lsum, 16); lsum += __shfl_xor(lsum, 32); \
            if (MODE == 0) { const int ql = 2 * wid + it + 16 * fr; \
                _Pragma("unroll") for (int mb = 0; mb < 4; ++mb) *(LAS f32x4*)(Opart + ql * OLD + 16 * mb + 4 * fq) = o[mb]; \
                if (fq == 0) lpart[ql] = lsum; \
            } else { const int ql = 32 * wid + 16 * it + fr; const float inv = 1.0f / (lsum + lpart[ql]); \
                _Pragma("unroll") for (int mb = 0; mb < 4; ++mb) { const f32x4 tot = (o[mb] + *(const LAS f32x4*)(Opart + ql * OLD + 16 * mb + 4 * fq)) * inv; \
                    *(u32x2*)(outb + (size_t)(base0 + ql) * 2048 + 16 * mb + 4 * fq) = pk4(tot); } } \
            _Pragma("unroll") for (int mb = 0; mb < 4; ++mb) o[mb] = (f32x4){0.f, 0.f, 0.f, 0.f}; \
            lsum = 0.f; qf0 = qn0; qf1 = qn1; } } while (0)
#pragma unroll 1
    for (int st = 0; st < (PROF_X == 1 ? 0 : NST); st += 3) {
        ATT_STEP(st, kA, vA, kC, vC);
        if (st + 1 < NST) ATT_STEP(st + 1, kB, vB, kA, vA);
        if (st + 2 < NST) ATT_STEP(st + 2, kC, vC, kB, vB);
    }
#undef ATT_STEP
#undef ATT_GEOM
#undef ATT_CLAMP
#undef ATT_LOAD
#undef ATT_QPOS
}
template <int MODE, bool EDGE>
DEV void attn_stream3(LAS unsigned char* lds, const bf16_t* qb, const bf16_t* kb, const bf16_t* vb, bf16_t* outb, const int base0, const float c1, const float c2, const float* qgain, const float* rope) {
    const int wid = __builtin_amdgcn_readfirstlane(threadIdx.x >> 6), lane = threadIdx.x & 63, fr = lane & 15, fq = lane >> 4, trq = fr >> 2, trp = fr & 3;
    LAS unsigned char* vt = lds + wid * (2 * ATT_VT); LAS float* Opart = (LAS float*)(lds + ATT_OPART); LAS float* lpart = (LAS float*)(lds + ATT_LPART);
    constexpr int NST = MODE == 0 ? 16 : 5;
    const int rA = MODE == 0 ? (wid & 3) + 8 * (wid >> 2) : 32 * wid, rB = MODE == 0 ? rA + 4 : rA + 16;
#define A3_GEOM(st, BASE, DSH, K0) do { if (MODE == 0) { if ((st) < 6) { BASE = base0 + rA; DSH = 2; K0 = -64 + 32 * (st); } else if ((st) < 11) { BASE = base0 + rA; DSH = 4; K0 = -64 + 32 * ((st) - 6); } \
            else { BASE = base0 + rB; DSH = 4; K0 = -64 + 32 * ((st) - 11); } } else { BASE = base0 + rA; DSH = 0; K0 = -64 + 32 * (st); } } while (0)
#define A3_CLAMP(pos) (EDGE ? ((pos) < 0 ? 0 : ((pos) > SEQ - 1 ? SEQ - 1 : (pos))) : (pos))
    unsigned klc[2][2], vlc[2][4];
#pragma unroll
    for (int sl = 0; sl < 2; ++sl) { const int d7 = (MODE == 0 ? (sl == 0 ? 2 : 4) : 0) + 7;
#pragma unroll
        for (int x = 0; x < 2; ++x) klc[sl][x] = (unsigned)((8 * (fr >> 2) + 4 * x + (fr & 3)) << d7) + 16u * fq;
#pragma unroll
        for (int c4 = 0; c4 < 4; ++c4) { const int id = lane + 64 * c4; vlc[sl][c4] = (unsigned)((id >> 3) << d7) + 16u * (id & 7); } }
#define A3_LOAD(st, KF, VR) do { const int stc_ = (st) < NST ? (st) : NST - 1; int b_, d_, k_; A3_GEOM(stc_, b_, d_, k_); \
        if (EDGE) { \
            _Pragma("unroll") for (int x = 0; x < 2; ++x) { int pos = b_ + ((k_ + 8 * (fr >> 2) + 4 * x + (fr & 3)) << d_); pos = A3_CLAMP(pos); \
                const unsigned off = (unsigned)pos * 128u + 16u * fq; KF[x][0] = *(const bf16x8*)((const char*)kb + off); KF[x][1] = *(const bf16x8*)((const char*)kb + off + 64); } \
            _Pragma("unroll") for (int c4 = 0; c4 < 4; ++c4) { const int id = lane + 64 * c4, row = id >> 3, ch = id & 7; int pos = b_ + ((k_ + row) << d_); pos = A3_CLAMP(pos); \
                VR[c4] = *(const bf16x8*)((const char*)vb + ((unsigned)pos * 128u + 16u * ch)); } \
        } else { const unsigned ub_ = (unsigned)(b_ + k_ * (1 << d_)) * 128u; const int sl_ = (MODE == 0 && d_ == 4) ? 1 : 0; \
            _Pragma("unroll") for (int x = 0; x < 2; ++x) { const unsigned off = (sl_ ? klc[1][x] : klc[0][x]) + ub_; \
                KF[x][0] = *(const bf16x8*)((const char*)kb + off); KF[x][1] = *(const bf16x8*)((const char*)kb + off + 64); } \
            _Pragma("unroll") for (int c4 = 0; c4 < 4; ++c4) { const unsigned off = (sl_ ? vlc[1][c4] : vlc[0][c4]) + ub_; VR[c4] = *(const bf16x8*)((const char*)vb + off); } } } while (0)
    bf16x8 qf[2][2];
#define A3_QLOAD(QPOS, Q0, Q1) do { const int qp_ = (QPOS); float a_[8], b_[8]; unpack8(ldg8(qb + (size_t)qp_ * 64 + 8 * fq), a_); unpack8(ldg8(qb + (size_t)qp_ * 64 + 8 * fq + 32), b_); \
        float ss_ = 0.f; _Pragma("unroll") for (int j = 0; j < 8; ++j) ss_ += a_[j] * a_[j] + b_[j] * b_[j]; \
        ss_ += __shfl_xor(ss_, 16); ss_ += __shfl_xor(ss_, 32); const float r_ = 1.0f / sqrtf(ss_ * (1.0f / 64.0f) + 1e-6f); \
        _Pragma("unroll") for (int j = 0; j < 8; ++j) { a_[j] *= r_ * qgain[8 * fq + j]; b_[j] *= r_ * qgain[32 + 8 * fq + j]; } \
        _Pragma("unroll") for (int j = 0; j < 8; ++j) { const float oth_ = __shfl_xor(a_[j], 16); const float cs_ = rope[(size_t)qp_ * 16 + j], sn_ = rope[(size_t)qp_ * 16 + 8 + j]; \
            a_[j] = fq == 0 ? a_[j] * cs_ - oth_ * sn_ : (fq == 1 ? a_[j] * cs_ + oth_ * sn_ : a_[j]); } \
        Q0 = pack8(a_); Q1 = pack8(b_); } while (0)
    bf16x8 kA[2][2], vA[4], kB[2][2], vB[4];
    A3_LOAD(0, kA, vA);
    A3_QLOAD(MODE == 0 ? base0 + rA + 16 * fr : base0 + rA + fr, qf[0][0], qf[0][1]);
    A3_QLOAD(MODE == 0 ? base0 + rB + 16 * fr : base0 + rB + fr, qf[1][0], qf[1][1]);
    f32x4 o[2][4]; float lsum[2] = {0.f, 0.f};
#pragma unroll
    for (int qi = 0; qi < 2; ++qi)
#pragma unroll
        for (int mb = 0; mb < 4; ++mb) o[qi][mb] = (f32x4){0.f, 0.f, 0.f, 0.f};
#define A3_PROB(S0, S1, KQ, PF, LS) do { float pv[8]; const int t0 = k0 + 8 * fq - (KQ) + 64; \
        if (full_) { _Pragma("unroll") for (int j = 0; j < 8; ++j) { const float sv = j < 4 ? S0[j & 3] : S1[j & 3]; pv[j] = __builtin_amdgcn_exp2f(sv * c1 - c2); LS += pv[j]; } } \
        else { _Pragma("unroll") for (int j = 0; j < 8; ++j) { bool valid = (unsigned)(t0 + j) <= 128u; \
            if (EDGE) { const int pos = base + ((k0 + 8 * fq + j) << dsh); valid = valid && pos >= 0 && pos < SEQ; } \
            const float sv = j < 4 ? S0[j & 3] : S1[j & 3]; pv[j] = valid ? __builtin_amdgcn_exp2f(sv * c1 - c2) : 0.f; LS += pv[j]; } } \
        PF = pack8(pv); } while (0)
#define A3_STEP(st, KC, VC_, KN, VN) do { \
        A3_LOAD((st) + 1, KN, VN); \
        LAS unsigned char* vcur = vt + ((st) & 1) * ATT_VT; \
        _Pragma("unroll") for (int c4 = 0; c4 < 4; ++c4) { const int id = lane + 64 * c4, row = id >> 3, ch = id & 7; *(LAS bf16x8*)(vcur + row * VLD + ch * 16) = VC_[c4]; } \
        int base, dsh, k0; A3_GEOM(st, base, dsh, k0); \
        const bool dual_ = MODE == 1 || (st) < 6; \
        const bool full_ = !EDGE && (dsh == 2 ? (k0 == 0 || k0 == 32) : (k0 >= -32 && k0 <= 32)); \
        f32x4 s0 = mfma16(KC[0][0], qf[0][0], (f32x4){0.f, 0.f, 0.f, 0.f}); s0 = mfma16(KC[0][1], qf[0][1], s0); \
        f32x4 s1 = mfma16(KC[1][0], qf[0][0], (f32x4){0.f, 0.f, 0.f, 0.f}); s1 = mfma16(KC[1][1], qf[0][1], s1); \
        f32x4 u0 = (f32x4){0.f, 0.f, 0.f, 0.f}, u1 = (f32x4){0.f, 0.f, 0.f, 0.f}; \
        if (dual_) { u0 = mfma16(KC[0][0], qf[1][0], u0); u0 = mfma16(KC[0][1], qf[1][1], u0); u1 = mfma16(KC[1][0], qf[1][0], u1); u1 = mfma16(KC[1][1], qf[1][1], u1); } \
        asm volatile("" ::: "memory"); \
        bf16x8 vf[4]; \
        _Pragma("unroll") for (int mb = 0; mb < 4; ++mb) { \
            const s16x4 t0v = __builtin_amdgcn_ds_read_tr16_b64_v4i16((LAS s16x4*)(vcur + (8 * fq + trq) * VLD + (16 * mb + 4 * trp) * 2)); \
            const s16x4 t1v = __builtin_amdgcn_ds_read_tr16_b64_v4i16((LAS s16x4*)(vcur + (8 * fq + 4 + trq) * VLD + (16 * mb + 4 * trp) * 2)); \
            vf[mb] = __builtin_shufflevector(t0v, t1v, 0, 1, 2, 3, 4, 5, 6, 7); } \
        const int kqa = MODE == 0 ? (fr << (4 - dsh)) : fr, kqb = MODE == 0 ? 4 * fr + 1 : 16 + fr; \
        bf16x8 pfa; A3_PROB(s0, s1, kqa, pfa, lsum[0]); \
        _Pragma("unroll") for (int mb = 0; mb < 4; ++mb) o[0][mb] = mfma16(vf[mb], pfa, o[0][mb]); \
        if (dual_) { bf16x8 pfb; A3_PROB(u0, u1, kqb, pfb, lsum[1]); \
            _Pragma("unroll") for (int mb = 0; mb < 4; ++mb) o[1][mb] = mfma16(vf[mb], pfb, o[1][mb]); } \
        asm volatile("" ::: "memory"); \
        if (MODE == 0 && ((st) == 10 || (st) == 15)) {                         \
            const int ql = ((st) == 10 ? rA : rB) + 16 * fr; float ls = lsum[0]; ls += __shfl_xor(ls, 16); ls += __shfl_xor(ls, 32); \
            _Pragma("unroll") for (int mb = 0; mb < 4; ++mb) *(LAS f32x4*)(Opart + ql * 64 + 4 * ((4 * mb + fq) ^ (ql & 15) ^ (ql >> 4))) = o[0][mb]; \
            if (fq == 0) lpart[ql] = ls; \
            _Pragma("unroll") for (int mb = 0; mb < 4; ++mb) o[0][mb] = o[1][mb]; \
            lsum[0] = lsum[1]; qf[0][0] = qf[1][0]; qf[0][1] = qf[1][1]; } \
        if (MODE == 1 && (st) == NST - 1) { \
            _Pragma("unroll") for (int qi = 0; qi < 2; ++qi) { const int ql = (qi ? rB : rA) + fr; float ls = lsum[qi]; ls += __shfl_xor(ls, 16); ls += __shfl_xor(ls, 32); const float inv = 1.0f / (ls + lpart[ql]); \
                _Pragma("unroll") for (int mb = 0; mb < 4; ++mb) { const f32x4 tot = (o[qi][mb] + *(const LAS f32x4*)(Opart + ql * 64 + 4 * ((4 * mb + fq) ^ (ql & 15) ^ (ql >> 4)))) * inv; \
                    *(u32x2*)(outb + (size_t)(base0 + ql) * 2048 + 16 * mb + 4 * fq) = pk4(tot); } } } } while (0)
#pragma unroll 1
    for (int st = 0; st < NST; st += 2) {
        A3_STEP(st, kA, vA, kB, vB);
        if (st + 1 < NST) A3_STEP(st + 1, kB, vB, kA, vA);
    }
#undef A3_STEP
#undef A3_PROB
#undef A3_QLOAD
#undef A3_LOAD
#undef A3_CLAMP
#undef A3_GEOM
}
DEV void ph_attn2(const P& p, LAS unsigned char* lds) {
    float gq = fabsf(p.q_norm[threadIdx.x & 63]), gk = fabsf(p.k_norm[threadIdx.x & 63]);
#pragma unroll
    for (int o = 32; o >= 1; o >>= 1) { gq = fmaxf(gq, __shfl_xor(gq, o)); gk = fmaxf(gk, __shfl_xor(gk, o)); }
    const float c1 = 0.125f * 1.44269504089f, c2 = 8.0f * gq * gk * 1.44269504089f;
    constexpr int NJB = SEQ / 256;
    const bool xmap = gridDim.x == 256 && NJB % 32 == 0;
    for (int u0 = blockIdx.x; u0 < BATCH * 16 * NJB; u0 += gridDim.x) {
        int u = u0;
        if (xmap) { const int k = u0 >> 8, xcd = blockIdx.x & 7, slot = blockIdx.x >> 3; constexpr int RPP = NJB / 32; const int pair = xcd * (BATCH * 16 / 8) + k / RPP; u = pair * NJB + (k % RPP) * 32 + ((slot + 8 * (k / RPP)) & 31); }
        const int jb = u % NJB, h = (u / NJB) & 15, b = (u / NJB) >> 4, base0 = 256 * jb;
        const size_t hm = (size_t)T * 1024; const bf16_t* qb = p.qkv + ((size_t)b * 16 + h) * SEQ * 64; const bf16_t* kb = qb + hm; const bf16_t* vb = kb + hm; bf16_t* outb = p.mix + (size_t)b * SEQ * 2048 + h * 64;
        const bool edge = base0 < 1024 || base0 + 255 + 1520 >= SEQ;
        if (edge) attn_stream3<0, true>(lds, qb, kb, vb, outb, base0, c1, c2, p.q_norm, p.rope); else attn_stream3<0, false>(lds, qb, kb, vb, outb, base0, c1, c2, p.q_norm, p.rope);
        __syncthreads();
        const bool edge2 = base0 < 64 || base0 + 352 > SEQ;
        if (edge2) attn_stream3<1, true>(lds, qb, kb, vb, outb, base0, c1, c2, p.q_norm, p.rope); else attn_stream3<1, false>(lds, qb, kb, vb, outb, base0, c1, c2, p.q_norm, p.rope);
        __syncthreads();
    }
}

static_assert(SEQ % 512 == 0, "top-k: SEQ / 512 values per thread");
DEV void ph_topk(const P& p, LAS unsigned char* lds, const int bid, const int nb) {
    constexpr int NV_T = SEQ / 512;
    LAS unsigned* hist = (LAS unsigned*)lds; LAS unsigned* wtot = hist + 256; LAS unsigned* bcw = hist + 272;
    const int tid = threadIdx.x, lane = tid & 63, wid = tid >> 6;
    for (int be = bid; be < BATCH * NE; be += nb) {
        const float* a = p.aff + (size_t)be * SEQ + (size_t)tid * NV_T;
        unsigned v[NV_T];
#pragma unroll
        for (int q = 0; q < NV_T / 4; ++q) { const uint4 u = *(const uint4*)(a + 4 * q); v[4 * q] = u.x; v[4 * q + 1] = u.y; v[4 * q + 2] = u.z; v[4 * q + 3] = u.w; }
        unsigned prefix = 0u;
#pragma unroll 1
        for (int bit = 30; bit >= 0; --bit) {
            const unsigned cand = prefix | (1u << bit); unsigned cnt = 0u;
#pragma unroll
            for (int j = 0; j < NV_T; ++j) cnt += v[j] >= cand ? 1u : 0u;
#pragma unroll
            for (int o = 32; o >= 1; o >>= 1) cnt += __shfl_xor(cnt, o);
            LAS unsigned* slot = wtot + 16 * (bit & 1);
            if (lane == 0) slot[wid] = cnt;
            __syncthreads();
            unsigned tot = 0u;
#pragma unroll
            for (int w = 0; w < 8; ++w) tot += slot[w];
            if (tot >= (unsigned)CAP) prefix = cand;
        }
        unsigned cgtl = 0u;
#pragma unroll
        for (int j = 0; j < NV_T; ++j) cgtl += v[j] > prefix ? 1u : 0u;
#pragma unroll
        for (int o = 32; o >= 1; o >>= 1) cgtl += __shfl_xor(cgtl, o);
        __syncthreads();
        if (lane == 0) hist[wid] = cgtl;
        __syncthreads();
        unsigned cgt_tot = 0u;
#pragma unroll
        for (int w = 0; w < 8; ++w) cgt_tot += hist[w];
        const unsigned kk = CAP - cgt_tot;
        __syncthreads();
        const unsigned Tb = prefix, need = kk, cgt = CAP - need;
        unsigned ngt = 0u, neq = 0u;
#pragma unroll
        for (int j = 0; j < NV_T; ++j) { ngt += v[j] > Tb ? 1u : 0u; neq += v[j] == Tb ? 1u : 0u; }
        const unsigned packed = ngt | (neq << 16); unsigned inc = packed;
#pragma unroll
        for (int o = 1; o < 64; o <<= 1) { const unsigned t = __shfl_up(inc, o); if (lane >= o) inc += t; }
        if (lane == 63) wtot[wid] = inc;
        __syncthreads();
        unsigned wbase = 0u;
        for (int w = 0; w < wid; ++w) wbase += wtot[w];
        const unsigned exc = wbase + inc - packed; unsigned gbase = exc & 0xffffu, ebase = exc >> 16;
        int* smp = p.slotmap + (size_t)be * SEQ + (size_t)tid * NV_T;
#pragma unroll
        for (int q = 0; q < NV_T / 4; ++q) { int sl[4];
#pragma unroll
            for (int i = 0; i < 4; ++i) { const int j = 4 * q + i; int slot = -1;
                if (v[j] > Tb) { slot = (int)gbase; ++gbase; } else if (v[j] == Tb) { if (ebase < need) slot = (int)(cgt + ebase); ++ebase; }
                if (slot >= 0) { p.idx[(size_t)be * CAP + slot] = tid * NV_T + j; p.gate[(size_t)be * CAP + slot] = __uint_as_float(v[j]); p.rinvs[(size_t)be * CAP + slot] = p.rinv[(size_t)(be / NE) * SEQ + tid * NV_T + j]; }
                sl[i] = slot; }
            *(int4*)(smp + 4 * q) = int4{sl[0], sl[1], sl[2], sl[3]}; }
        __syncthreads();
    }
}

#define XB_TMO      128
#define XB_XCNT(j)  (256  + 64 * (j))
#define XB_XSUB(j)  (1280 + 64 * (j))
#define XB_XGEN(j)  (2304 + 64 * (j))
#define XB_TOP      3328
#define XB_TOPGEN   3392
#define XCD_BAR_WORDS 3456
#define XB_SPIN_CAP (1u << 18)

__device__ __forceinline__ unsigned xb_ld(unsigned* p)              { return __hip_atomic_load(p, __ATOMIC_RELAXED, __HIP_MEMORY_SCOPE_AGENT); }
__device__ __forceinline__ unsigned xb_add(unsigned* p, unsigned v) { return __hip_atomic_fetch_add(p, v, __ATOMIC_RELAXED, __HIP_MEMORY_SCOPE_AGENT); }
__device__ __forceinline__ unsigned xb_xcc_id() { return (unsigned)__builtin_amdgcn_s_getreg((3 << 11) | 20) & 0xFu; }
#define XB_SPIN(cond, bar) do { unsigned _sp = 0; while (cond) { __builtin_amdgcn_s_sleep(1); \
    if ((++_sp & 255u) == 0u) { if (xb_ld(&(bar)[XB_TMO])) break; if (_sp > XB_SPIN_CAP) { atomicAdd(&(bar)[XB_TMO], 1u); break; } } } } while (0)

struct XcdBarrier {
    unsigned* bar; unsigned x;
    volatile LAS unsigned* st;
};

__device__ __forceinline__ XcdBarrier xcd_barrier_post(unsigned* bar, volatile LAS unsigned* st) {
    XcdBarrier b; b.bar = bar; b.x = xb_xcc_id(); b.st = st;
    if (threadIdx.x == 0) (void)xb_add(&bar[XB_XCNT(b.x)], 1u);
    return b;
}
__device__ __forceinline__ void xcd_barrier_complete(unsigned* bar, unsigned x, unsigned& nloc, unsigned& nx) {
    const unsigned G = gridDim.x * gridDim.y * gridDim.z;
    unsigned sum, cnt, mine, sp = 0u;
    for (;;) {
        sum = 0u; cnt = 0u; mine = 0u;
#pragma unroll
        for (unsigned j = 0; j < 16; ++j) { const unsigned c = xb_ld(&bar[XB_XCNT(j)]); sum += c; cnt += (c > 0u) ? 1u : 0u; mine = (j == x) ? c : mine; }
        if (sum == G) break;
        __builtin_amdgcn_s_sleep(1);
        if ((++sp & 255u) == 0u) { if (xb_ld(&bar[XB_TMO])) break; if (sp > XB_SPIN_CAP) { atomicAdd(&bar[XB_TMO], 1u); break; } }
    }
    nloc = mine > 0u ? mine : 1u; nx = cnt > 0u ? cnt : 1u;
}

__device__ __forceinline__ void xcd_barrier(const XcdBarrier& b) {
    asm volatile("s_waitcnt vmcnt(0)" ::: "memory");
    __syncthreads();
    if (threadIdx.x == 0) {
        unsigned* bar = b.bar;
        __builtin_amdgcn_s_waitcnt(0);
        unsigned nloc = b.st[0], nx = b.st[1];
        if (nloc == 0u) { xcd_barrier_complete(bar, b.x, nloc, nx); b.st[0] = nloc; b.st[1] = nx; }
        const unsigned old = xb_add(&bar[XB_XSUB(b.x)], 1u);
        const unsigned gen = old / nloc;
        if (old + 1u == (gen + 1u) * nloc) {
            __builtin_amdgcn_fence(__ATOMIC_RELEASE, "agent");
            asm volatile("s_waitcnt vmcnt(0)" ::: "memory");
            const unsigned og = xb_add(&bar[XB_TOP], 1u);
            const unsigned tg = og / nx;
            if (og + 1u == (tg + 1u) * nx) xb_add(&bar[XB_TOPGEN], 1u);
            else XB_SPIN(xb_ld(&bar[XB_TOPGEN]) == tg, bar);
            __builtin_amdgcn_fence(__ATOMIC_ACQUIRE, "agent");
            xb_add(&bar[XB_XGEN(b.x)], 1u);
            asm volatile("s_waitcnt vmcnt(0)" ::: "memory");
        } else {
            XB_SPIN(xb_ld(&bar[XB_XGEN(b.x)]) == gen, bar);
            __builtin_amdgcn_fence(__ATOMIC_ACQUIRE, "agent");
            asm volatile("s_waitcnt vmcnt(0)" ::: "memory");
        }
    }
    __syncthreads();
}


enum { PH_FIRST = 0, PH_G1, PH_PREP, PH_ATTN, PH_SSDB, PH_SSDC, PH_G2, PH_ROUTE0, PH_TOPK0, PH_UP0, PH_DOWN0, PH_COMB0, PH_G3, PH_CONV3, PH_G4, PH_ROUTE1, PH_TOPK1, PH_UP1, PH_DOWN1, PH_COMB1, NPH };

constexpr int LDS_BYTES = 147456;
constexpr int LDS_XB = LDS_BYTES - 16;
__global__ void __launch_bounds__(512, 2) fwd(P p, int lo, int hi) {
    extern __shared__ __attribute__((aligned(16))) unsigned char shm[];
    LAS unsigned char* lds = (LAS unsigned char*)shm;
    XcdBarrier bar; bar.bar = p.bar; bar.x = 0; bar.st = (volatile LAS unsigned*)(lds + LDS_XB);
    if (hi - lo > 1) {
        if (threadIdx.x == 0) { ((LAS unsigned*)(lds + LDS_XB))[0] = 0u; ((LAS unsigned*)(lds + LDS_XB))[1] = 0u; }
        __syncthreads();
        bar = xcd_barrier_post(p.bar, (volatile LAS unsigned*)(lds + LDS_XB));
    }
#if NAIVE_GEMM
#define GEMM_SEL(a, b) a
#else
#define GEMM_SEL(a, b) b
#endif
#if NAIVE_SSD
#define SSD_SEL(a, b) a
#else
#define SSD_SEL(a, b) b
#endif
#if NAIVE_ATTN
#define ATTN_SEL(a, b) a
#else
#define ATTN_SEL(a, b) b
#endif
#if NAIVE_TOPK
#define TOPK_SEL(a, b) a
#else
#define TOPK_SEL(a, b) b
#endif
#define ROPE_IN_G1 ((int)gridDim.x == 256 && !NAIVE_GEMM)
#define TOPK_CVX(layer) { const int ntk = (int)gridDim.x > 64 ? BATCH * NE : 0; \
        if (ntk == 0) { ph_topk(p, lds, (int)blockIdx.x, (int)gridDim.x); __syncthreads(); ph_convert_experts_f8(p, layer, lds, (int)blockIdx.x, (int)gridDim.x); if ((layer) == 0 && !ROPE_IN_G1) ph_convert_small_late(p, GTID, GSTRIDE); } \
        else if ((int)blockIdx.x < ntk) { ph_topk(p, lds, (int)blockIdx.x, ntk); } \
        else { ph_convert_experts_f8(p, layer, lds, (int)blockIdx.x - ntk, (int)gridDim.x - ntk); if ((layer) == 0 && !ROPE_IN_G1) ph_convert_small_late(p, (size_t)((int)blockIdx.x - ntk) * 512 + threadIdx.x, (size_t)((int)gridDim.x - ntk) * 512); } }
#if FP8_MOE
#define CVX_SEL(layer) ph_convert_experts_f8(p, layer, lds, (int)blockIdx.x, (int)gridDim.x)
#else
#define CVX_SEL(layer) ph_convert_experts_dev(p, layer, lds)
#endif
#ifndef PROBE_DUP
#define PROBE_DUP -1
#endif
#if PROF_A >= 0
#define PROF_STAMP(i) if (blockIdx.x == 0 && threadIdx.x == 0) p.bar[8192 + 2 * (i)] = (unsigned)__builtin_amdgcn_s_memrealtime();
#else
#define PROF_STAMP(i)
#endif
#define PHASE(i, body) if (lo <= (i) && (i) < hi) { PROF_STAMP(i) body; if ((i) == PROBE_DUP) { xcd_barrier(bar); body; } if ((i) + 1 < hi) xcd_barrier(bar); }
    PHASE(PH_FIRST, { ph_router_tables(p); ph_convert_small_tiles(p, lds); if (!ROPE_IN_G1) ph_rope_table(p); ph_rmsnorm_dev(p.x, p.attn_norm, p.hn); })
    PHASE(PH_G1, { GEMM_SEL(nv_g1(p), ph_g1(p, lds)); if (ROPE_IN_G1 && blockIdx.x >= 128) { ph_rope_table(p, (size_t)((int)blockIdx.x - 128) * 512 + threadIdx.x, (size_t)128 * 512); ph_convert_late_tiles(p, lds, (int)blockIdx.x - 128, 128); } })
    PHASE(PH_PREP, ph_prep_dev(p, lds))
    PHASE(PH_ATTN, { if (PROF_X != 4) { ATTN_SEL(nv_attn(p), ph_attn2(p, lds)); } if (PROF_X != 3) { SSD_SEL(nv_ssd(p), ph_ssd_states(p, lds)); } })
    PHASE(PH_SSDB, SSD_SEL((void)0, ph_ssd_scan(p)))
    PHASE(PH_SSDC, SSD_SEL(ph_gated_norm_dev(p), ph_ssd_out(p, lds)))
    PHASE(PH_G2, ph_g2(p, lds))
    PHASE(PH_ROUTE0, ph_norm_router_mfma<true>(p, 0, lds, p.x, nullptr))
    PHASE(PH_TOPK0, TOPK_CVX(0))
    PHASE(PH_UP0, GEMM_SEL(nv_up(p), ph_up(p, lds)))
    PHASE(PH_DOWN0, GEMM_SEL(nv_down(p), ph_down(p, lds)))
    PHASE(PH_COMB0, { ph_combine_dev4<true>(p, p.conv_norm, p.x, nullptr, p.xb2); })
    PHASE(PH_G3, GEMM_SEL(nv_g3(p), ph_g3(p, lds)))
    PHASE(PH_CONV3, ph_conv3_dev(p))
    PHASE(PH_G4, ph_g4(p, lds))
    PHASE(PH_ROUTE1, ph_norm_router_mfma<false>(p, 1, lds, nullptr, p.xb2))
    PHASE(PH_TOPK1, TOPK_CVX(1))
    PHASE(PH_UP1, GEMM_SEL(nv_up(p), ph_up(p, lds)))
    PHASE(PH_DOWN1, GEMM_SEL(nv_down(p), ph_down(p, lds)))
    PHASE(PH_COMB1, ph_combine_dev4<false>(p, nullptr, nullptr, p.xb2, nullptr))
#if PROF_A >= 0
    xcd_barrier(bar); PROF_STAMP(NPH) xcd_barrier(bar);
    { const float ca = (float)(p.bar[8192 + 2 * (PROF_A + 1)] - p.bar[8192 + 2 * PROF_A]) * 0.01f, cb = 0.f;
      (void)cb; const float mark = ca > (float)PROF_B ? 0.f : 100.f; for (size_t i = GTID; i < (size_t)T * 1024; i += GSTRIDE) p.out[i] = mark; }
#endif
}

extern "C" void kernel_launch(void* const* d_in, const int* in_sizes, int n_in, void* d_out, int out_size, void* d_ws, size_t ws_size, hipStream_t stream) {
    (void)in_sizes; (void)n_in; (void)out_size; (void)ws_size;
    P p{};
    make_params(p, d_in, d_out, d_ws);
    static int grid = 0;
    if (grid == 0) {
        int dev = 0, cus = 0;
        if (hipGetDevice(&dev) != hipSuccess || hipDeviceGetAttribute(&cus, hipDeviceAttributeMultiprocessorCount, dev) != hipSuccess) cus = 256;
        (void)hipFuncSetAttribute((const void*)fwd, hipFuncAttributeMaxDynamicSharedMemorySize, LDS_BYTES);
        (void)hipGetLastError();
        grid = cus > 0 ? cus : 256;
    }
#if ONE_LAUNCH
    (void)hipMemsetAsync(p.bar, 0, XCD_BAR_WORDS * sizeof(unsigned), stream);
    hipLaunchKernelGGL(fwd, dim3(grid), dim3(512), LDS_BYTES, stream, p, 0, (int)NPH);
#else
    for (int ph = 0; ph < NPH; ++ph) hipLaunchKernelGGL(fwd, dim3(grid), dim3(512), LDS_BYTES, stream, p, ph, ph + 1);
#endif
}
#endif
```
